# Optimizing an MI355X kernel written in HIP

```python
import jax, jax.numpy as jnp
from jax import lax
import numpy as np

D_MODEL = 1024
BATCH = 8
SEQ = 4096
DEPTH = 4

N_MIXERS = 2
N_POOL_LAYERS = (DEPTH + N_MIXERS - 1) // N_MIXERS
N_LRU_LAYERS = DEPTH // N_MIXERS
N_META = 16
POOL_WINDOWS = (2, 4, 8, 16)
N_POOL_GROUPS = len(POOL_WINDOWS)
POOL_GROUP = D_MODEL // N_POOL_GROUPS
LRU_WIDTH = D_MODEL
LRU_HEADS = 4
LRU_HEAD_DIM = LRU_WIDTH // LRU_HEADS
LRU_C = 8.0
CONV_WIDTH = 4
CONV_LEFT = 1
N_DIRS = 2
N_EXPERTS = 16
CAPACITY_FACTOR = 2
D_EXPERT = 2048
RMS_EPS = 1e-6

kernel_name = "hybrid_pool_rglru_ec_moe_encoder"


def _rmsnorm(x, g):
    xf = x.astype(jnp.float32)
    y = xf * lax.rsqrt(jnp.mean(xf * xf, axis=-1, keepdims=True) + RMS_EPS)
    return (y * g.astype(jnp.float32)).astype(x.dtype)


def _pool_mixer(u, w, scale):
    B, T, _ = u.shape
    uf = u.astype(jnp.float32)
    cs = jnp.pad(jnp.cumsum(uf, axis=1), ((0, 0), (1, 0), (0, 0)))
    t = jnp.arange(T)
    outs = []
    for g, win in enumerate(POOL_WINDOWS):
        sl = slice(g * POOL_GROUP, (g + 1) * POOL_GROUP)
        lo = jnp.clip(t - win // 2, 0, T)
        hi = jnp.clip(t + win - win // 2, 0, T)
        cnt = (hi - lo).astype(jnp.float32)[:, None]
        csg = cs[..., sl]
        mean = (jnp.take(csg, hi, axis=1) - jnp.take(csg, lo, axis=1)) / cnt
        outs.append(mean - uf[..., sl])
    p = jnp.stack(outs, axis=2).astype(u.dtype)
    y = jnp.einsum('btgc,gcd->btgd', p, w).reshape(B, T, D_MODEL)
    return y * scale


def _lru_combine(left, right):
    a1, b1 = left
    a2, b2 = right
    return a1 * a2, a2 * b1 + b2


def _rglru_mixer(u, w_in, conv_w, conv_b, w_gates, b_gates, lam, w_out):
    B, T, _ = u.shape
    xy = jnp.einsum('btd,de->bte', u, w_in)
    xb, yb = jnp.split(xy, 2, axis=-1)
    xp = jnp.pad(xb, ((0, 0), (CONV_LEFT, CONV_WIDTH - 1 - CONV_LEFT), (0, 0)))
    xc = conv_b + sum(xp[:, k:k + T] * conv_w[k] for k in range(CONV_WIDTH))
    xh = xc.reshape(B, T, LRU_HEADS, LRU_HEAD_DIM)
    xf = xc.astype(jnp.float32)
    hs = []
    for d in range(N_DIRS):
        gl = jnp.einsum('bthi,ghij->gbthj', xh, w_gates[d]) + b_gates[d][:, None, None]
        gates = jax.nn.sigmoid(gl.astype(jnp.float32)).reshape(2, B, T, LRU_WIDTH)
        r, i = gates[0], gates[1]
        log_a = -LRU_C * r * jax.nn.softplus(-lam[d].astype(jnp.float32))
        a = jnp.exp(log_a)
        b = jnp.sqrt(-jnp.expm1(2.0 * log_a)) * (i * xf)
        _, h = lax.associative_scan(_lru_combine, (a, b), axis=1, reverse=(d == 1))
        hs.append(h)
    hsum = (hs[0] + hs[1]).astype(u.dtype)
    return jnp.einsum('bte,ed->btd', hsum * jax.nn.gelu(yb), w_out)


def _expert_choice_ffn(u, router_w, w_gate, w_up, w_down):
    B, T, D = u.shape
    cap = CAPACITY_FACTOR * T // N_EXPERTS
    logits = jnp.einsum('btd,de->bte', u, router_w).astype(jnp.float32)
    aff = jax.nn.softmax(logits, axis=-1)
    g, idx = lax.top_k(jnp.swapaxes(aff, 1, 2), cap)
    flat_idx = idx.reshape(B, N_EXPERTS * cap)
    xs = jax.vmap(lambda ub, ib: ub[ib])(u, flat_idx).reshape(B, N_EXPERTS, cap, D)
    hid = jax.nn.silu(jnp.einsum('becd,edf->becf', xs, w_gate)) * \
        jnp.einsum('becd,edf->becf', xs, w_up)
    ys = jnp.einsum('becf,efd->becd', hid, w_down) * g[..., None].astype(u.dtype)
    out = jax.vmap(lambda yb, ib: jnp.zeros((T, D), u.dtype).at[ib].add(yb))(
        ys.reshape(B, N_EXPERTS * cap, D), flat_idx)
    return out


def setup_inputs(seed: int = 0) -> dict:
    key = jax.random.key(seed)
    ks = jax.random.split(key, 20)
    f32 = jnp.float32
    nrm = lambda k, s: jax.random.normal(k, s, f32)
    R, H, hd = LRU_WIDTH, LRU_HEADS, LRU_HEAD_DIM
    a8 = jax.random.uniform(ks[12], (N_LRU_LAYERS, N_DIRS, R), f32, 0.9, 0.999)
    s = a8 ** (1.0 / LRU_C)
    lam = jnp.log(s) - jnp.log1p(-s)
    return {
        "x": nrm(ks[0], (BATCH, SEQ, D_MODEL)),
        "meta_tokens": nrm(ks[1], (N_META, D_MODEL)),
        "norm_mix": 1.0 + 0.02 * nrm(ks[2], (DEPTH, D_MODEL)),
        "norm_ffn": 1.0 + 0.02 * nrm(ks[3], (DEPTH, D_MODEL)),
        "norm_final": 1.0 + 0.02 * nrm(ks[4], (D_MODEL,)),
        "pool_w": nrm(ks[5], (N_POOL_LAYERS, N_POOL_GROUPS, POOL_GROUP, POOL_GROUP)) * POOL_GROUP ** -0.5,
        "pool_scale": 1.0 + 0.02 * nrm(ks[6], (N_POOL_LAYERS, D_MODEL)),
        "lru_w_in": nrm(ks[7], (N_LRU_LAYERS, D_MODEL, 2 * R)) * D_MODEL ** -0.5,
        "lru_conv_w": nrm(ks[8], (N_LRU_LAYERS, CONV_WIDTH, R)) * CONV_WIDTH ** -0.5,
        "lru_conv_b": 0.01 * nrm(ks[9], (N_LRU_LAYERS, R)),
        "lru_w_gates": nrm(ks[10], (N_LRU_LAYERS, N_DIRS, 2, H, hd, hd)) * hd ** -0.5,
        "lru_b_gates": 0.01 * nrm(ks[11], (N_LRU_LAYERS, N_DIRS, 2, H, hd)),
        "lru_lambda": lam,
        "lru_w_out": nrm(ks[13], (N_LRU_LAYERS, R, D_MODEL)) * R ** -0.5,
        "router_w": nrm(ks[14], (DEPTH, D_MODEL, N_EXPERTS)) * D_MODEL ** -0.5,
        "moe_w_gate": nrm(ks[15], (DEPTH, N_EXPERTS, D_MODEL, D_EXPERT)) * D_MODEL ** -0.5,
        "moe_w_up": nrm(ks[16], (DEPTH, N_EXPERTS, D_MODEL, D_EXPERT)) * D_MODEL ** -0.5,
        "moe_w_down": nrm(ks[17], (DEPTH, N_EXPERTS, D_EXPERT, D_MODEL)) * D_EXPERT ** -0.5,
    }


def reference(x, meta_tokens, norm_mix, norm_ffn, norm_final, pool_w, pool_scale,
              lru_w_in, lru_conv_w, lru_conv_b, lru_w_gates, lru_b_gates, lru_lambda,
              lru_w_out, router_w, moe_w_gate, moe_w_up, moe_w_down):
    B = x.shape[0]
    meta = jnp.broadcast_to(meta_tokens.astype(x.dtype)[None], (B, N_META, D_MODEL))
    h = jnp.concatenate([meta, x], axis=1)
    for i in range(DEPTH):
        u = _rmsnorm(h, norm_mix[i])
        j = i // N_MIXERS
        if i % N_MIXERS == 0:
            h = h + _pool_mixer(u, pool_w[j], pool_scale[j])
        else:
            h = h + _rglru_mixer(u, lru_w_in[j], lru_conv_w[j], lru_conv_b[j],
                                 lru_w_gates[j], lru_b_gates[j], lru_lambda[j], lru_w_out[j])
        h = h + _expert_choice_ffn(_rmsnorm(h, norm_ffn[i]), router_w[i],
                                   moe_w_gate[i], moe_w_up[i], moe_w_down[i])
    h = _rmsnorm(h, norm_final)
    return h[:, N_META:]
```

```cpp
#include <hip/hip_runtime.h>
#include <cstdio>
#include <cstdint>

#ifndef SINGLE_LAUNCH
#define SINGLE_LAUNCH 1
#endif

constexpr int NB = 8, SEQ = 4096, NMETA = 16, T = SEQ + NMETA, D = 1024, NE = 16, CAP = 2 * T / NE, DF = 2048, DEPTH = 4;
constexpr int MMAIN = NB * SEQ;
constexpr int MROWS = NB * T;
constexpr int MPAD = 33024;
constexpr int EROWS = NB * CAP;
constexpr int EPAD = 4352;
constexpr int HIDP8 = 2112, WDP8 = 2112;
constexpr float WSCALE = 32.0f, WINV = 1.0f / 32.0f;
constexpr int NCHUNK = 17;
static_assert(CAP == 514 && T == 4112 && EROWS == 4112, "shapes");
constexpr float RMS_EPS = 1e-6f;

constexpr size_t MiB = 1u << 20;
constexpr size_t WS_CTL = 0, CTL_ZERO_BYTES = 1 * MiB;
constexpr size_t WS_WG1 = 1 * MiB;
constexpr size_t WS_WD = WS_WG1 + 512 * MiB;
constexpr size_t WS_WIN = WS_WD + 264 * MiB;
constexpr size_t WS_WGT = WS_WIN + 8 * MiB;
constexpr size_t WS_WOUT = WS_WGT + 4 * MiB;
constexpr size_t WS_WPOOL = WS_WOUT + 4 * MiB;
constexpr size_t WS_H = WS_WPOOL + 1 * MiB;
constexpr size_t WS_U = WS_H + 129 * MiB;
constexpr size_t WS_P = WS_U + 65 * MiB;
constexpr size_t WS_XB = WS_P + 65 * MiB;
constexpr size_t WS_GY = WS_XB + 65 * MiB;
constexpr size_t WS_HG = WS_GY + 65 * MiB;
constexpr size_t WS_BIG = WS_HG + 65 * MiB;
constexpr size_t WS_Y = WS_BIG + 282 * MiB;
constexpr size_t WS_AFF = WS_Y + 136 * MiB;
constexpr size_t WS_SLOT = WS_AFF + 3 * MiB;
constexpr size_t WS_GMAP = WS_SLOT + 3 * MiB;
constexpr size_t WS_ROWL = WS_GMAP + 3 * MiB;
constexpr size_t WS_AGG = WS_ROWL + 1 * MiB;
constexpr size_t WS_SPT = WS_AGG + 5 * MiB / 2;
constexpr size_t WS_END = WS_AGG + 3 * MiB;
constexpr size_t LA_BYTES = (size_t)MPAD * 1024 * 2;

constexpr int CW_BAR = 4096;

constexpr int RING_BYTES = 131072;
constexpr int MISC_OFF = RING_BYTES + 320;
constexpr int LDS_BYTES = 147456;

#define LAS __attribute__((address_space(3)))
typedef unsigned short bf16;
typedef short bf16x8 __attribute__((ext_vector_type(8)));
typedef float f32x4 __attribute__((ext_vector_type(4)));
typedef float f32x2 __attribute__((ext_vector_type(2)));
typedef unsigned u32x4 __attribute__((ext_vector_type(4)));
typedef unsigned u32x2 __attribute__((ext_vector_type(2)));

__device__ __forceinline__ unsigned cvt_pk_bf16(float lo, float hi) { unsigned r; asm volatile("v_cvt_pk_bf16_f32 %0, %1, %2" : "=v"(r) : "v"(lo), "v"(hi)); return r; }
__device__ __forceinline__ float bflo(unsigned w) { return __uint_as_float(w << 16); }
__device__ __forceinline__ float bfhi(unsigned w) { return __uint_as_float(w & 0xffff0000u); }
__device__ __forceinline__ float fast_exp(float x) { return __builtin_amdgcn_exp2f(x * 1.44269504089f); }
__device__ __forceinline__ float fast_rcp(float x) { return __builtin_amdgcn_rcpf(x); }
__device__ __forceinline__ float sigmoidf_(float x) { return fast_rcp(1.0f + fast_exp(-x)); }
__device__ __forceinline__ float siluf_(float x) { return x * sigmoidf_(x); }
typedef int v4i __attribute__((ext_vector_type(4)));
typedef int v8i __attribute__((ext_vector_type(8)));
__device__ __forceinline__ unsigned pk4_fp8(float a, float b, float c, float d) {
    a = __builtin_amdgcn_fmed3f(a, -448.f, 448.f); b = __builtin_amdgcn_fmed3f(b, -448.f, 448.f); c = __builtin_amdgcn_fmed3f(c, -448.f, 448.f); d = __builtin_amdgcn_fmed3f(d, -448.f, 448.f);
    unsigned r = 0; r = (unsigned)__builtin_amdgcn_cvt_pk_fp8_f32(a, b, (int)r, false); r = (unsigned)__builtin_amdgcn_cvt_pk_fp8_f32(c, d, (int)r, true); return r; }
__device__ __forceinline__ f32x4 fp8x4_to_f32(unsigned w) { const f32x2 lo = __builtin_amdgcn_cvt_pk_f32_fp8((int)w, false), hi = __builtin_amdgcn_cvt_pk_f32_fp8((int)w, true); return (f32x4){lo.x, lo.y, hi.x, hi.y}; }
__device__ __forceinline__ float silu_mul_s(float G, float U) { const float e = __builtin_amdgcn_exp2f(G * (-1.44269504089f * WINV)); return (G * U) * fast_rcp(__builtin_fmaf(e, 1024.0f, 1024.0f)); }
__device__ __forceinline__ float gelu_tanh(float x) { const float z = 0.7978845608f * (x + 0.044715f * x * x * x); return x * sigmoidf_(2.0f * z); }
__device__ __forceinline__ float wave_sum(float v) {
#pragma unroll
    for (int o = 1; o < 64; o <<= 1) v += __shfl_xor(v, o);
    return v;
}
__device__ __forceinline__ int opaque(int v) { asm volatile("" : "+v"(v)); return v; }
__device__ __forceinline__ int row_of(int b, int t) { return t >= NMETA ? b * SEQ + (t - NMETA) : MMAIN + b * NMETA + t; }

#define XB_TMO      128
#define XB_XCNT(j)  (256  + 64 * (j))
#define XB_XSUB(j)  (1280 + 64 * (j))
#define XB_XGEN(j)  (2304 + 64 * (j))
#define XB_TOP      3328
#define XB_TOPGEN   3392
#define XCD_BAR_WORDS 3456
#define XB_SPIN_CAP (1u << 18)
__device__ __forceinline__ unsigned xb_ld(unsigned* p)              { return __hip_atomic_load(p, __ATOMIC_RELAXED, __HIP_MEMORY_SCOPE_AGENT); }
__device__ __forceinline__ unsigned xb_add(unsigned* p, unsigned v) { return __hip_atomic_fetch_add(p, v, __ATOMIC_RELAXED, __HIP_MEMORY_SCOPE_AGENT); }
__device__ __forceinline__ unsigned xb_xcc_id() { return (unsigned)__builtin_amdgcn_s_getreg((3 << 11) | 20) & 0xFu; }
#define XB_SPIN(cond, bar) do { unsigned _sp = 0; while (cond) { __builtin_amdgcn_s_sleep(1); \
    if ((++_sp & 255u) == 0u) { if (xb_ld(&(bar)[XB_TMO])) break; if (_sp > XB_SPIN_CAP) { atomicAdd(&(bar)[XB_TMO], 1u); break; } } } } while (0)
struct XcdBarrier { unsigned* bar; unsigned x; volatile LAS unsigned* st; };
__device__ __forceinline__ XcdBarrier xcd_barrier_post(unsigned* bar, volatile LAS unsigned* st) {
    XcdBarrier b; b.bar = bar; b.x = xb_xcc_id(); b.st = st;
    if (threadIdx.x == 0) (void)xb_add(&bar[XB_XCNT(b.x)], 1u);
    return b;
}
__device__ __forceinline__ void xcd_barrier_complete(unsigned* bar, unsigned x, unsigned& nloc, unsigned& nx) {
    const unsigned G = gridDim.x * gridDim.y * gridDim.z;
    unsigned sum, cnt, mine, sp = 0u;
    for (;;) {
        sum = 0u; cnt = 0u; mine = 0u;
#pragma unroll
        for (unsigned j = 0; j < 16; ++j) { const unsigned c = xb_ld(&bar[XB_XCNT(j)]); sum += c; cnt += (c > 0u) ? 1u : 0u; mine = (j == x) ? c : mine; }
        if (sum == G) break;
        __builtin_amdgcn_s_sleep(1);
        if ((++sp & 255u) == 0u) { if (xb_ld(&bar[XB_TMO])) break; if (sp > XB_SPIN_CAP) { atomicAdd(&bar[XB_TMO], 1u); break; } }
    }
    nloc = mine > 0u ? mine : 1u; nx = cnt > 0u ? cnt : 1u;
}
__device__ __forceinline__ void xcd_barrier(const XcdBarrier& b) {
    asm volatile("s_waitcnt vmcnt(0)" ::: "memory");
    __syncthreads();
    if (threadIdx.x == 0) {
        unsigned* bar = b.bar;
        __builtin_amdgcn_s_waitcnt(0);
        unsigned nloc = b.st[0], nx = b.st[1];
        if (nloc == 0u) { xcd_barrier_complete(bar, b.x, nloc, nx); b.st[0] = nloc; b.st[1] = nx; }
        const unsigned old = xb_add(&bar[XB_XSUB(b.x)], 1u);
        const unsigned gen = old / nloc;
        if (old + 1u == (gen + 1u) * nloc) {
            __builtin_amdgcn_fence(__ATOMIC_RELEASE, "agent");
            asm volatile("s_waitcnt vmcnt(0)" ::: "memory");
            const unsigned og = xb_add(&bar[XB_TOP], 1u);
            const unsigned tg = og / nx;
            if (og + 1u == (tg + 1u) * nx) xb_add(&bar[XB_TOPGEN], 1u);
            else XB_SPIN(xb_ld(&bar[XB_TOPGEN]) == tg, bar);
            __builtin_amdgcn_fence(__ATOMIC_ACQUIRE, "agent");
            xb_add(&bar[XB_XGEN(b.x)], 1u);
            asm volatile("s_waitcnt vmcnt(0)" ::: "memory");
        } else {
            XB_SPIN(xb_ld(&bar[XB_XGEN(b.x)]) == gen, bar);
            __builtin_amdgcn_fence(__ATOMIC_ACQUIRE, "agent");
            asm volatile("s_waitcnt vmcnt(0)" ::: "memory");
        }
    }
    __syncthreads();
}

struct Args { const float* in[18]; float* out; unsigned char* ws; int lo, hi; };
struct Frame {
    LAS unsigned char* lds;
    int tid, lane, wave, vcu, G;
    const float *x, *meta, *norm_mix, *norm_ffn, *norm_final, *pool_w, *pool_scale, *w_in, *conv_w, *conv_b, *w_gates, *b_gates, *lam, *w_out, *router_w, *moe_g, *moe_u, *moe_d;
    float* out; unsigned char* ws;
    bf16 *WG1, *WD, *WIN, *WGT, *WOUT, *WPOOL;
    bf16* H; float* HF; bf16 *U, *P, *XB, *GY, *HG, *LA, *BV, *HID, *Y;
    float* AFF; int* SLOT; float* GMAP; int* ROWL; float* AGG; float* SPT;
};

struct ProItem { const float* src; unsigned char* dst; int ldw, ldt, f8; };
__device__ __forceinline__ ProItem pro_decode(const Frame& F, int it) {
    constexpr int I_MOE = 64 * 512, I_IN = 2 * 512, I_OUT = 2 * 256, I_GT = 32 * 16;
    ProItem p; int r = it;
    if (r < 2 * I_MOE) {
        const int up = r >= I_MOE; if (up) r -= I_MOE;
        const int le = r >> 9, q = r & 511, k0 = (q >> 6) * 128, n0 = (q & 63) * 32;
        p.src = (up ? F.moe_u : F.moe_g) + (size_t)le * 1024 * 2048 + (size_t)k0 * 2048 + n0; p.ldw = 2048;
        p.dst = (unsigned char*)F.WG1 + ((size_t)le * 4096 + (n0 >> 7) * 256 + up * 128 + (n0 & 127)) * 1024 + k0; p.ldt = 1024; p.f8 = 1; return p; }
    r -= 2 * I_MOE;
    if (r < I_MOE) {
        const int le = r >> 9, q = r & 511, k0 = (q >> 5) * 128, n0 = (q & 31) * 32;
        p.src = F.moe_d + (size_t)le * 2048 * 1024 + (size_t)k0 * 1024 + n0; p.ldw = 1024;
        p.dst = (unsigned char*)F.WD + ((size_t)le * 1024 + n0) * WDP8 + k0; p.ldt = WDP8; p.f8 = 1; return p; }
    r -= I_MOE; p.f8 = 0;
    if (r < I_IN) {
        const int j = r >> 9, q = r & 511, k0 = (q >> 6) * 128, n0 = (q & 63) * 32;
        p.src = F.w_in + (size_t)j * 1024 * 2048 + (size_t)k0 * 2048 + n0; p.ldw = 2048; p.dst = (unsigned char*)(F.WIN + ((size_t)j * 2048 + n0) * 1024 + k0); p.ldt = 2048; return p; }
    r -= I_IN;
    if (r < I_OUT) {
        const int j = r >> 8, q = r & 255, k0 = (q >> 5) * 128, n0 = (q & 31) * 32;
        p.src = F.w_out + (size_t)j * 1024 * 1024 + (size_t)k0 * 1024 + n0; p.ldw = 1024; p.dst = (unsigned char*)(F.WOUT + ((size_t)j * 1024 + n0) * 1024 + k0); p.ldt = 2048; return p; }
    r -= I_OUT;
    if (r < I_GT) {
        const int mat = r >> 4, q = r & 15, k0 = (q >> 3) * 128, n0 = (q & 7) * 32;
        const int j = mat >> 4, d = (mat >> 3) & 1, g = (mat >> 2) & 1, h = mat & 3, nt = d * 8 + h * 2 + (n0 >> 7);
        p.src = F.w_gates + (size_t)mat * 65536 + (size_t)k0 * 256 + n0; p.ldw = 256; p.dst = (unsigned char*)(F.WGT + (((size_t)j * 16 + nt) * 256 + g * 128 + (n0 & 127)) * 256 + k0); p.ldt = 512; return p; }
    r -= I_GT;
    {
        const int mat = r >> 4, q = r & 15, k0 = (q >> 3) * 128, n0 = (q & 7) * 32;
        p.src = F.pool_w + (size_t)mat * 65536 + (size_t)k0 * 256 + n0; p.ldw = 256; p.dst = (unsigned char*)(F.WPOOL + ((size_t)mat * 256 + n0) * 256 + k0); p.ldt = 512; return p; }
}
__device__ __forceinline__ void pro_load(const ProItem& p, f32x4 (&v)[16], int lane) {
    const int rr = lane >> 3, sg = lane & 7;
#pragma unroll
    for (int i = 0; i < 16; ++i) v[i] = __builtin_nontemporal_load((const f32x4*)(p.src + (size_t)(8 * i + rr) * p.ldw + 4 * sg));
}
__device__ __forceinline__ void pro_finish(const ProItem& p, const f32x4 (&v)[16], LAS float* scr, int lane) {
    { const int rr = lane >> 3, sg = lane & 7;
#pragma unroll
        for (int i = 0; i < 16; ++i) *(LAS f32x4*)(scr + (8 * i + rr) * 32 + ((4 * sg) ^ (((i >> 1) & 3) << 3))) = v[i]; }
    asm volatile("s_waitcnt lgkmcnt(0)" ::: "memory");
    const int c = lane & 7;
#pragma unroll
    for (int j = 0; j < 4; ++j) { const int n = (lane >> 3) + 8 * j; const LAS float* s = scr + (16 * c) * 32 + (n ^ ((c & 3) << 3));
        float t[16];
#pragma unroll
        for (int q = 0; q < 16; ++q) t[q] = s[q * 32];
        if (p.f8) { u32x4 o; o.x = pk4_fp8(t[0] * WSCALE, t[1] * WSCALE, t[2] * WSCALE, t[3] * WSCALE); o.y = pk4_fp8(t[4] * WSCALE, t[5] * WSCALE, t[6] * WSCALE, t[7] * WSCALE);
            o.z = pk4_fp8(t[8] * WSCALE, t[9] * WSCALE, t[10] * WSCALE, t[11] * WSCALE); o.w = pk4_fp8(t[12] * WSCALE, t[13] * WSCALE, t[14] * WSCALE, t[15] * WSCALE);
            __builtin_nontemporal_store(o, (u32x4*)(p.dst + (size_t)n * p.ldt + 16 * c)); }
        else { u32x4 o0, o1; o0.x = cvt_pk_bf16(t[0], t[1]); o0.y = cvt_pk_bf16(t[2], t[3]); o0.z = cvt_pk_bf16(t[4], t[5]); o0.w = cvt_pk_bf16(t[6], t[7]);
            o1.x = cvt_pk_bf16(t[8], t[9]); o1.y = cvt_pk_bf16(t[10], t[11]); o1.z = cvt_pk_bf16(t[12], t[13]); o1.w = cvt_pk_bf16(t[14], t[15]);
            unsigned char* d = p.dst + (size_t)n * p.ldt + 32 * c; __builtin_nontemporal_store(o0, (u32x4*)d); __builtin_nontemporal_store(o1, (u32x4*)(d + 16)); } }
    asm volatile("s_waitcnt lgkmcnt(0)" ::: "memory");
}
__device__ __forceinline__ void phase_prologue(const Frame& F) {
    LAS float* scr = (LAS float*)(F.lds + F.wave * 16384);
    const int gw = F.vcu * 8 + F.wave, NGW = F.G * 8, lane = F.lane;
    for (int i = gw * 64 + lane; i < 4 * D; i += NGW * 64) F.SPT[i] = -8.0f * log1pf(expf(-F.lam[i]));
    constexpr int NITEMS = 3 * 64 * 512 + 2 * 512 + 2 * 256 + 32 * 16 + 8 * 16;
    int it = gw; if (it >= NITEMS) return;
    ProItem cur = pro_decode(F, it); f32x4 v[16], w[16]; pro_load(cur, v, lane);
    for (;;) {
        const int nit = it + NGW; const bool more = nit < NITEMS; ProItem nxt = cur;
        if (more) nxt = pro_decode(F, nit);
        pro_load(nxt, w, lane);
        pro_finish(cur, v, scr, lane);
        if (!more) break;
        cur = nxt; it = nit;
#pragma unroll
        for (int i = 0; i < 16; ++i) v[i] = w[i];
    }
}

template <bool FINAL, bool FIRST, bool DRY = false>
__device__ __forceinline__ void phase_rowA(const Frame& F, int layer) {
    const int gw = F.vcu * 8 + F.wave, NGW = F.G * 8, lane = F.lane;
    const float* gain = FINAL ? F.norm_final : F.norm_mix + layer * D;
    f32x4 gn[4];
#pragma unroll
    for (int j = 0; j < 4; ++j) gn[j] = *(const f32x4*)(gain + 4 * lane + 256 * j);
    const int rend = FINAL ? MMAIN : MROWS;
    int sl_n = -1; float gg_n = 0.f;
    if (!FIRST) { if (lane < 16 && gw < rend) { sl_n = F.SLOT[(size_t)gw * 16 + lane]; gg_n = F.GMAP[(size_t)gw * 16 + lane]; } }
    for (int r = gw; r < rend; r += NGW) {
        f32x4 v[4];
        if (FIRST) {
            const float* src = r < MMAIN ? F.x + (size_t)r * D : F.meta + (size_t)((r - MMAIN) & 15) * D;
#pragma unroll
            for (int j = 0; j < 4; ++j) v[j] = *(const f32x4*)(src + 4 * lane + 256 * j);
        } else {
            const int sl = sl_n; const float gg = gg_n;
            const bf16* src = F.H + (size_t)r * D;
#pragma unroll
            for (int j = 0; j < 4; ++j) { const u32x2 w = *(const u32x2*)(src + 4 * lane + 256 * j); v[j] = (f32x4){bflo(w.x), bfhi(w.x), bflo(w.y), bfhi(w.y)}; }
            { const int rn = r + NGW; sl_n = -1; if (lane < 16 && rn < rend) { sl_n = F.SLOT[(size_t)rn * 16 + lane]; gg_n = F.GMAP[(size_t)rn * 16 + lane]; } }
            unsigned mask = (unsigned)__ballot(sl >= 0) & 0xffffu;
            while (mask) {
                int ee[4]; float gq[4]; const unsigned char* yr[4];
#pragma unroll
                for (int q = 0; q < 4; ++q) { const bool on = mask != 0u; const int e = on ? (__builtin_ffs((int)mask) - 1) : 0; mask &= mask - 1u;
                    const int s = __builtin_amdgcn_readlane(sl, e); const float g = __uint_as_float(__builtin_amdgcn_readlane(__float_as_uint(gg), e));
                    ee[q] = e; gq[q] = on ? g : 0.f; yr[q] = (const unsigned char*)F.Y + ((size_t)e * EPAD + (on ? s : 0)) * D; }
                unsigned w[4][4];
#pragma unroll
                for (int q = 0; q < 4; ++q)
#pragma unroll
                    for (int j = 0; j < 4; ++j) w[q][j] = *(const unsigned*)(yr[q] + 4 * lane + 256 * j);
#pragma unroll
                for (int q = 0; q < 4; ++q)
#pragma unroll
                    for (int j = 0; j < 4; ++j) v[j] += fp8x4_to_f32(w[q][j]) * gq[q];
                (void)ee;
            }
        }
        if (!FINAL && !DRY) {
            bf16* dst = F.H + (size_t)r * D;
#pragma unroll
            for (int j = 0; j < 4; ++j) { u32x2 w; w.x = cvt_pk_bf16(v[j].x, v[j].y); w.y = cvt_pk_bf16(v[j].z, v[j].w); *(u32x2*)(dst + 4 * lane + 256 * j) = w; }
        }
        float ss = 0.f;
#pragma unroll
        for (int j = 0; j < 4; ++j) ss += (v[j].x * v[j].x + v[j].y * v[j].y) + (v[j].z * v[j].z + v[j].w * v[j].w);
        const float rstd = 1.0f / sqrtf(wave_sum(ss) * (1.0f / D) + RMS_EPS);
        if (FINAL) {
            float* dst = F.out + (size_t)r * D;
#pragma unroll
            for (int j = 0; j < 4; ++j) *(f32x4*)(dst + 4 * lane + 256 * j) = v[j] * rstd * gn[j];
        } else {
            bf16* dst = F.U + (size_t)r * D;
#pragma unroll
            for (int j = 0; j < 4; ++j) { const f32x4 o = v[j] * rstd * gn[j]; u32x2 w; w.x = cvt_pk_bf16(o.x, o.y); w.y = cvt_pk_bf16(o.z, o.w); *(u32x2*)(dst + 4 * lane + 256 * j) = w; }
        }
    }
}
__device__ __forceinline__ void phase_rowB(const Frame& F, int layer) {
    const int gw = F.vcu * 8 + F.wave, NGW = F.G * 8, lane = F.lane;
    LAS float* wT = (LAS float*)F.lds;
    const float* rw = F.router_w + (size_t)layer * D * NE;
    const float* gain = F.norm_ffn + layer * D;
    f32x4 gn[4];
#pragma unroll
    for (int j = 0; j < 4; ++j) gn[j] = *(const f32x4*)(gain + 4 * lane + 256 * j);
    f32x4 nx[2][4];
#pragma unroll
    for (int q = 0; q < 2; ++q) { const int r = gw + q * NGW; const bf16* src = F.H + (size_t)(r < MROWS ? r : gw) * D;
#pragma unroll
        for (int j = 0; j < 4; ++j) { const u32x2 w = *(const u32x2*)(src + 4 * lane + 256 * j); nx[q][j] = (f32x4){bflo(w.x), bfhi(w.x), bflo(w.y), bfhi(w.y)}; } }
    {
        f32x4 rv[8];
#pragma unroll
        for (int i = 0; i < 8; ++i) rv[i] = *(const f32x4*)(rw + 4 * (F.tid + 512 * i));
#pragma unroll
        for (int i = 0; i < 8; ++i) { const int i4 = F.tid + 512 * i, c = i4 >> 2, e = (i4 & 3) * 4; wT[e * 1024 + c] = rv[i].x; wT[(e + 1) * 1024 + c] = rv[i].y; wT[(e + 2) * 1024 + c] = rv[i].z; wT[(e + 3) * 1024 + c] = rv[i].w; }
    }
    __syncthreads();
    for (int r0 = gw; r0 < MROWS; r0 += 2 * NGW) {
        f32x4 v[2][4];
#pragma unroll
        for (int q = 0; q < 2; ++q)
#pragma unroll
            for (int j = 0; j < 4; ++j) v[q][j] = nx[q][j];
#pragma unroll
        for (int q = 0; q < 2; ++q) { const int r = r0 + (2 + q) * NGW; const bf16* src = F.H + (size_t)(r < MROWS ? r : gw) * D;
#pragma unroll
            for (int j = 0; j < 4; ++j) { const u32x2 w = *(const u32x2*)(src + 4 * lane + 256 * j); nx[q][j] = (f32x4){bflo(w.x), bfhi(w.x), bflo(w.y), bfhi(w.y)}; } }
        const bool has1 = (r0 + NGW) < MROWS;
#pragma unroll
        for (int q = 0; q < 2; ++q) {
            float ss = 0.f;
#pragma unroll
            for (int j = 0; j < 4; ++j) ss += (v[q][j].x * v[q][j].x + v[q][j].y * v[q][j].y) + (v[q][j].z * v[q][j].z + v[q][j].w * v[q][j].w);
            const float rstd = 1.0f / sqrtf(wave_sum(ss) * (1.0f / D) + RMS_EPS);
            const int r = r0 + q * NGW;
#pragma unroll
            for (int j = 0; j < 4; ++j) v[q][j] = v[q][j] * rstd * gn[j];
            if (q == 0 || has1) { unsigned char* dst = (unsigned char*)F.U + (size_t)r * D;
#pragma unroll
                for (int j = 0; j < 4; ++j) *(unsigned*)(dst + 4 * lane + 256 * j) = pk4_fp8(v[q][j].x, v[q][j].y, v[q][j].z, v[q][j].w); }
        }
        float val[32];
        const int woff = opaque(4 * lane);
#pragma unroll
        for (int e = 0; e < 16; ++e) { f32x2 p0 = (f32x2){0.f, 0.f}, p1 = p0;
#pragma unroll
            for (int j = 0; j < 4; ++j) { const f32x4 w = *(const LAS f32x4*)(wT + e * 1024 + woff + 256 * j); const f32x2 wl = (f32x2){w.x, w.y}, wh = (f32x2){w.z, w.w};
                p0 += (f32x2){v[0][j].x, v[0][j].y} * wl; p0 += (f32x2){v[0][j].z, v[0][j].w} * wh; p1 += (f32x2){v[1][j].x, v[1][j].y} * wl; p1 += (f32x2){v[1][j].z, v[1][j].w} * wh; }
            val[e] = p0.x + p0.y; val[16 + e] = p1.x + p1.y; }
#define BFLY(S, HH) { const bool up = (lane >> (S)) & 1; _Pragma("unroll") for (int i = 0; i < (HH); ++i) { const float keep = up ? val[(HH) + i] : val[i], send = up ? val[i] : val[(HH) + i]; val[i] = keep + __shfl_xor(send, 1 << (S)); } }
        BFLY(0, 16) BFLY(1, 8) BFLY(2, 4) BFLY(3, 2) BFLY(4, 1)
#undef BFLY
        float lg = val[0] + __shfl_xor(val[0], 32);
        const int vi = ((lane & 1) << 4) | ((lane & 2) << 2) | (lane & 4) | ((lane & 8) >> 2) | ((lane & 16) >> 4);
        float mx = lg;
#pragma unroll
        for (int o = 2; o <= 16; o <<= 1) mx = fmaxf(mx, __shfl_xor(mx, o));
        const float p = expf(lg - mx); float sum = p;
#pragma unroll
        for (int o = 2; o <= 16; o <<= 1) sum += __shfl_xor(sum, o);
        const int q = vi >> 4, e = vi & 15, r = r0 + q * NGW;
        if (lane < 32 && (q == 0 || has1)) {
            int b, t; if (r < MMAIN) { b = r >> 12; t = (r & 4095) + NMETA; } else { b = (r - MMAIN) >> 4; t = (r - MMAIN) & 15; }
            F.AFF[((size_t)b * NE + e) * T + t] = p / sum;
        }
    }
    __syncthreads();
}

__device__ __forceinline__ int block_excl_scan(int v, LAS int* wsum, int tid, int lane, int wave, int& total) {
    int s = v;
#pragma unroll
    for (int o = 1; o < 64; o <<= 1) { const int t = __shfl_up(s, o); if (lane >= o) s += t; }
    __syncthreads();
    if (lane == 63) wsum[wave] = s;
    __syncthreads();
    int base = 0, tot = 0;
#pragma unroll
    for (int w = 0; w < 8; ++w) { const int x = wsum[w]; if (w < wave) base += x; tot += x; }
    total = tot;
    return base + s - v;
}
__device__ __forceinline__ void phase_topk(const Frame& F) {
    LAS unsigned* keys = (LAS unsigned*)F.lds;
    LAS int* hist = (LAS int*)(F.lds + 20480);
    LAS int* misc = (LAS int*)(F.lds + 20480 + 1024);
    const int tid = F.tid, lane = F.lane, wave = F.wave;
    for (int task = blockIdx.x; task < NB * NE; task += F.G) {
        const int b = task >> 4, e = task & 15;
        const float* aff = F.AFF + ((size_t)b * NE + e) * T;
        __syncthreads();
        {   unsigned kv[9];
#pragma unroll
            for (int i = 0; i < 9; ++i) { const int t = tid + 512 * i; kv[i] = __float_as_uint(aff[t < T ? t : T - 1]); }
#pragma unroll
            for (int i = 0; i < 9; ++i) { const int t = tid + 512 * i; if (t < T) keys[t] = kv[i]; } }
        unsigned prefix = 0u, pmask = 0u; int need = CAP;
        for (int p = 3; p >= 0; --p) {
            if (tid < 256) hist[tid] = 0;
            __syncthreads();
            for (int t = tid; t < T; t += 512) { const unsigned k = keys[t]; if ((k & pmask) == prefix) __hip_atomic_fetch_add(&hist[(k >> (8 * p)) & 255u], 1, __ATOMIC_RELAXED, __HIP_MEMORY_SCOPE_WORKGROUP); }
            __syncthreads();
            if (wave == 0) {
                int c[4]; int tot = 0;
#pragma unroll
                for (int q = 0; q < 4; ++q) { c[q] = hist[4 * lane + q]; tot += c[q]; }
                int s = tot;
#pragma unroll
                for (int o = 1; o < 64; o <<= 1) { const int x = __shfl_down(s, o); if (lane + o < 64) s += x; }
                int above = s - tot;
                if (above < need && need <= s) {
                    int a = above;
#pragma unroll
                    for (int q = 3; q >= 0; --q) { if (need <= a + c[q] && need > a) { misc[0] = 4 * lane + q; misc[1] = need - a; } a += c[q]; }
                }
            }
            __syncthreads();
            prefix |= (unsigned)misc[0] << (8 * p); pmask |= 0xFFu << (8 * p); need = misc[1];
            __syncthreads();
        }
        const unsigned vstar = prefix;
        const int t0 = tid * 9, t1 = (t0 + 9 < T) ? t0 + 9 : T;
        int neq = 0;
        for (int t = t0; t < t1; ++t) neq += (keys[t] == vstar) ? 1 : 0;
        int toteq; int eqbase = block_excl_scan(neq, misc + 8, tid, lane, wave, toteq);
        int nsel = 0; unsigned selmask = 0u; { int er = eqbase;
            for (int t = t0; t < t1; ++t) { const unsigned k = keys[t]; bool s = k > vstar; if (k == vstar) { s = er < need; ++er; } if (s) { selmask |= 1u << (t - t0); ++nsel; } } }
        int totsel; int sbase = block_excl_scan(nsel, misc + 8, tid, lane, wave, totsel);
        for (int t = t0; t < t1; ++t) {
            const int row = row_of(b, t);
            if ((selmask >> (t - t0)) & 1u) { const int pos = b * CAP + sbase; ++sbase;
                F.ROWL[e * EPAD + pos] = row; F.SLOT[(size_t)row * 16 + e] = pos; F.GMAP[(size_t)row * 16 + e] = __uint_as_float(keys[t]); }
            else F.SLOT[(size_t)row * 16 + e] = -1;
        }
        if (b == 0 && tid < EPAD - EROWS) F.ROWL[e * EPAD + EROWS + tid] = 0;
    }
    __syncthreads();
}

__device__ __forceinline__ void phase_poolwin(const Frame& F) {
    const int gw = F.vcu * 8 + F.wave, NGW = F.G * 8, lane = F.lane;
    constexpr int CHS = 33, NTC = (T + CHS - 1) / CHS;
    for (int it = gw; it < NB * NTC * 2; it += NGW) {
        const int half = it & 1, tc = (it >> 1) % NTC, b = (it >> 1) / NTC;
        const int col = half * 512 + lane * 8, g = col >> 8, hw = 1 << g;
        const int t0 = tc * CHS, t1 = (t0 + CHS < T) ? t0 + CHS : T;
        float sum[8];
#pragma unroll
        for (int q = 0; q < 8; ++q) sum[q] = 0.f;
        const u32x4 zero4 = (u32x4){0u, 0u, 0u, 0u};
        const bf16* ucol = F.U + col;
#define PW_ADD(V_) do { sum[0] += bflo(V_.x); sum[1] += bfhi(V_.x); sum[2] += bflo(V_.y); sum[3] += bfhi(V_.y); sum[4] += bflo(V_.z); sum[5] += bfhi(V_.z); sum[6] += bflo(V_.w); sum[7] += bfhi(V_.w); } while (0)
#define PW_SUB(V_) do { sum[0] -= bflo(V_.x); sum[1] -= bfhi(V_.x); sum[2] -= bflo(V_.y); sum[3] -= bfhi(V_.y); sum[4] -= bflo(V_.z); sum[5] -= bfhi(V_.z); sum[6] -= bflo(V_.w); sum[7] -= bfhi(V_.w); } while (0)
        {
            u32x4 iw[16];
#pragma unroll
            for (int q = 0; q < 16; ++q) { const int dt = q - 8, tt = t0 + dt; const bool v = dt >= -hw && dt < hw && tt >= 0 && tt < T; iw[q] = *(const u32x4*)(ucol + (size_t)row_of(b, v ? tt : t0) * D); }
#pragma unroll
            for (int q = 0; q < 16; ++q) { const int dt = q - 8, tt = t0 + dt; const bool v = dt >= -hw && dt < hw && tt >= 0 && tt < T; const u32x4 w = v ? iw[q] : zero4; PW_ADD(w); }
        }
        for (int tb = t0; tb < t1; tb += 11) {
            u32x4 c[11], wp[11], wm[11];
#pragma unroll
            for (int q = 0; q < 11; ++q) { const int t = (tb + q < t1) ? tb + q : t1 - 1; const bool vp = t + hw < T, vm = t - hw >= 0;
                c[q] = *(const u32x4*)(ucol + (size_t)row_of(b, t) * D); wp[q] = *(const u32x4*)(ucol + (size_t)row_of(b, vp ? t + hw : t) * D); wm[q] = *(const u32x4*)(ucol + (size_t)row_of(b, vm ? t - hw : t) * D); }
#pragma unroll
            for (int q = 0; q < 11; ++q) { const int t = tb + q;
                if (t < t1) {
                    const int lo = (t - hw > 0) ? t - hw : 0, hi = (t + hw < T) ? t + hw : T;
                    const float inv = 1.0f / (float)(hi - lo);
                    u32x4 o;
                    o.x = cvt_pk_bf16(sum[0] * inv - bflo(c[q].x), sum[1] * inv - bfhi(c[q].x)); o.y = cvt_pk_bf16(sum[2] * inv - bflo(c[q].y), sum[3] * inv - bfhi(c[q].y));
                    o.z = cvt_pk_bf16(sum[4] * inv - bflo(c[q].z), sum[5] * inv - bfhi(c[q].z)); o.w = cvt_pk_bf16(sum[6] * inv - bflo(c[q].w), sum[7] * inv - bfhi(c[q].w));
                    *(u32x4*)(F.P + (size_t)row_of(b, t) * D + col) = o;
                    const u32x4 a = (t + hw < T) ? wp[q] : zero4, m = (t - hw >= 0) ? wm[q] : zero4;
                    PW_ADD(a); PW_SUB(m);
                }
            }
        }
#undef PW_ADD
#undef PW_SUB
    }
}
__device__ __forceinline__ void phase_conv(const Frame& F, int j) {
    const int gw = F.vcu * 8 + F.wave, NGW = F.G * 8, lane = F.lane;
    constexpr int CHS = 33, NTC = (T + CHS - 1) / CHS;
    const float* cw = F.conv_w + (size_t)j * 4 * D; const float* cb = F.conv_b + (size_t)j * D;
    for (int it = gw; it < NB * NTC * 2; it += NGW) {
        const int half = it & 1, tc = (it >> 1) % NTC, b = (it >> 1) / NTC;
        const int col = half * 512 + lane * 8;
        const int t0 = tc * CHS, t1 = (t0 + CHS < T) ? t0 + CHS : T;
        float w[4][8], bias[8];
#pragma unroll
        for (int k = 0; k < 4; ++k) { const f32x4 a = *(const f32x4*)(cw + k * D + col), c = *(const f32x4*)(cw + k * D + col + 4);
            w[k][0] = a.x; w[k][1] = a.y; w[k][2] = a.z; w[k][3] = a.w; w[k][4] = c.x; w[k][5] = c.y; w[k][6] = c.z; w[k][7] = c.w; }
        { const f32x4 a = *(const f32x4*)(cb + col), c = *(const f32x4*)(cb + col + 4); bias[0] = a.x; bias[1] = a.y; bias[2] = a.z; bias[3] = a.w; bias[4] = c.x; bias[5] = c.y; bias[6] = c.z; bias[7] = c.w; }
        u32x4 xm1 = (u32x4){0u, 0u, 0u, 0u}, x0 = xm1, xp1 = xm1, xp2 = xm1;
        if (t0 - 1 >= 0) xm1 = *(const u32x4*)(F.XB + (size_t)row_of(b, t0 - 1) * D + col);
        x0 = *(const u32x4*)(F.XB + (size_t)row_of(b, t0) * D + col);
        if (t0 + 1 < T) xp1 = *(const u32x4*)(F.XB + (size_t)row_of(b, t0 + 1) * D + col);
        for (int tb = t0; tb < t1; tb += 11) {
            u32x4 xn[11];
#pragma unroll
            for (int q = 0; q < 11; ++q) { const int tt = tb + q + 2; xn[q] = *(const u32x4*)(F.XB + (size_t)row_of(b, tt < T ? tt : T - 1) * D + col); }
#pragma unroll
            for (int q = 0; q < 11; ++q) { const int t = tb + q;
                if (t < t1) {
                    xp2 = (t + 2 < T) ? xn[q] : (u32x4){0u, 0u, 0u, 0u};
                    float o[8];
#define CONV2(q_, m) o[2 * q_] = bias[2 * q_] + w[0][2 * q_] * bflo(xm1.m) + w[1][2 * q_] * bflo(x0.m) + w[2][2 * q_] * bflo(xp1.m) + w[3][2 * q_] * bflo(xp2.m); \
                     o[2 * q_ + 1] = bias[2 * q_ + 1] + w[0][2 * q_ + 1] * bfhi(xm1.m) + w[1][2 * q_ + 1] * bfhi(x0.m) + w[2][2 * q_ + 1] * bfhi(xp1.m) + w[3][2 * q_ + 1] * bfhi(xp2.m);
                    CONV2(0, x) CONV2(1, y) CONV2(2, z) CONV2(3, w)
#undef CONV2
                    u32x4 ov; ov.x = cvt_pk_bf16(o[0], o[1]); ov.y = cvt_pk_bf16(o[2], o[3]); ov.z = cvt_pk_bf16(o[4], o[5]); ov.w = cvt_pk_bf16(o[6], o[7]);
                    *(u32x4*)(F.P + (size_t)row_of(b, t) * D + col) = ov;
                    xm1 = x0; x0 = xp1; xp1 = xp2;
                }
            }
        }
    }
}
__device__ __forceinline__ void chunk_rows(int b, int k, int& r0, int& n) { if (k == 0) { r0 = MMAIN + b * NMETA; n = NMETA; } else { r0 = b * SEQ + (k - 1) * 256; n = 256; } }
__device__ __forceinline__ void phase_scan1(const Frame& F) {
    const int lane = F.lane;
    for (int it = F.wave * F.G + F.vcu; it < 2 * NB * NCHUNK * 8; it += 8 * F.G) {
        int cq, k, b, d;
        if (it < 2048) { cq = it & 7; k = 1 + ((it >> 3) & 15); b = (it >> 7) & 7; d = it >> 10; } else { const int u = it - 2048; cq = u & 7; k = 0; b = (u >> 3) & 7; d = u >> 6; }
        const int c0 = cq * 128 + lane * 2;
        int r0, n; chunk_rows(b, k, r0, n);
        const bf16* la = F.LA + (size_t)d * MPAD * D + c0; const bf16* bv = F.BV + (size_t)d * MPAD * D + c0;
        float h0 = 0.f, h1 = 0.f, s0 = 0.f, s1 = 0.f;
        for (int s = 0; s < n; s += 32) {
            unsigned lw[32], bw[32];
#pragma unroll
            for (int q = 0; q < 32; ++q) { const int sq = (s + q < n) ? s + q : n - 1; const int r = d ? (r0 + n - 1 - sq) : (r0 + sq); lw[q] = *(const unsigned*)(la + (size_t)r * D); bw[q] = *(const unsigned*)(bv + (size_t)r * D); }
#pragma unroll
            for (int q = 0; q < 32; ++q) { const bool ok = s + q < n; const unsigned lq = ok ? lw[q] : 0u, bq = ok ? bw[q] : 0u;
                const float l0 = bflo(lq), l1 = bfhi(lq); s0 += l0; s1 += l1; h0 = fast_exp(l0) * h0 + bflo(bq); h1 = fast_exp(l1) * h1 + bfhi(bq); }
        }
        float* agg = F.AGG + ((size_t)(d * NB + b) * NCHUNK + k) * D + c0;
        *(f32x2*)agg = (f32x2){s0, s1};
        *(f32x2*)(agg + (size_t)2 * NB * NCHUNK * D) = (f32x2){h0, h1};
    }
}
__device__ __forceinline__ void phase_scan3(const Frame& F) {
    const int lane = F.lane;
    constexpr size_t HOFF = (size_t)2 * NB * NCHUNK * D;
    bf16* HX = (bf16*)F.HF;
    for (int it = F.wave * F.G + F.vcu; it < NB * NCHUNK * 8; it += 8 * F.G) {
        const int cq = it & 7, k = (it >> 3) % NCHUNK, b = (it >> 3) / NCHUNK;
        const int c0 = cq * 128 + lane * 2;
        int r0, n; chunk_rows(b, k, r0, n);
        const int half = n >> 1;
        float hf0 = 0.f, hf1 = 0.f, hb0 = 0.f, hb1 = 0.f;
        for (int jx = 0; jx < k; ++jx) { const float* agg = F.AGG + ((size_t)(0 * NB + b) * NCHUNK + jx) * D + c0; const f32x2 al = *(const f32x2*)agg, he = *(const f32x2*)(agg + HOFF);
            hf0 = fast_exp(al.x) * hf0 + he.x; hf1 = fast_exp(al.y) * hf1 + he.y; }
        for (int jx = NCHUNK - 1; jx > k; --jx) { const float* agg = F.AGG + ((size_t)(1 * NB + b) * NCHUNK + jx) * D + c0; const f32x2 al = *(const f32x2*)agg, he = *(const f32x2*)(agg + HOFF);
            hb0 = fast_exp(al.x) * hb0 + he.x; hb1 = fast_exp(al.y) * hb1 + he.y; }
        const bf16* laf = F.LA + c0; const bf16* bvf = F.BV + c0; const bf16* lab = laf + (size_t)MPAD * D; const bf16* bvb = bvf + (size_t)MPAD * D;
        for (int s = 0; s < half; s += 8) {
            unsigned lf[8], bf_[8], lb[8], bb[8];
#pragma unroll
            for (int q = 0; q < 8; ++q) { const size_t rf = (size_t)(r0 + s + q) * D, rb = (size_t)(r0 + n - 1 - s - q) * D;
                lf[q] = *(const unsigned*)(laf + rf); bf_[q] = *(const unsigned*)(bvf + rf); lb[q] = *(const unsigned*)(lab + rb); bb[q] = *(const unsigned*)(bvb + rb); }
#pragma unroll
            for (int q = 0; q < 8; ++q) { const size_t rf = (size_t)(r0 + s + q) * D, rb = (size_t)(r0 + n - 1 - s - q) * D;
                hf0 = fast_exp(bflo(lf[q])) * hf0 + bflo(bf_[q]); hf1 = fast_exp(bfhi(lf[q])) * hf1 + bfhi(bf_[q]); *(unsigned*)(HX + rf + c0) = cvt_pk_bf16(hf0, hf1);
                hb0 = fast_exp(bflo(lb[q])) * hb0 + bflo(bb[q]); hb1 = fast_exp(bfhi(lb[q])) * hb1 + bfhi(bb[q]); *(unsigned*)(HX + rb + c0) = cvt_pk_bf16(hb0, hb1); }
        }
        asm volatile("s_waitcnt vmcnt(0)" ::: "memory");
        for (int s = half; s < n; s += 8) {
            unsigned lf[8], bf_[8], lb[8], bb[8], xf[8], gf[8], xb[8], gb[8];
#pragma unroll
            for (int q = 0; q < 8; ++q) { const size_t rf = (size_t)(r0 + s + q) * D, rb = (size_t)(r0 + n - 1 - s - q) * D;
                lf[q] = *(const unsigned*)(laf + rf); bf_[q] = *(const unsigned*)(bvf + rf); lb[q] = *(const unsigned*)(lab + rb); bb[q] = *(const unsigned*)(bvb + rb);
                xf[q] = *(const unsigned*)(HX + rf + c0); gf[q] = *(const unsigned*)(F.GY + rf + c0); xb[q] = *(const unsigned*)(HX + rb + c0); gb[q] = *(const unsigned*)(F.GY + rb + c0); }
#pragma unroll
            for (int q = 0; q < 8; ++q) { const size_t rf = (size_t)(r0 + s + q) * D, rb = (size_t)(r0 + n - 1 - s - q) * D;
                hf0 = fast_exp(bflo(lf[q])) * hf0 + bflo(bf_[q]); hf1 = fast_exp(bfhi(lf[q])) * hf1 + bfhi(bf_[q]);
                *(unsigned*)(F.HG + rf + c0) = cvt_pk_bf16((hf0 + bflo(xf[q])) * bflo(gf[q]), (hf1 + bfhi(xf[q])) * bfhi(gf[q]));
                hb0 = fast_exp(bflo(lb[q])) * hb0 + bflo(bb[q]); hb1 = fast_exp(bfhi(lb[q])) * hb1 + bfhi(bb[q]);
                *(unsigned*)(F.HG + rb + c0) = cvt_pk_bf16((bflo(xb[q]) + hb0) * bflo(gb[q]), (bfhi(xb[q]) + hb1) * bfhi(gb[q])); }
        }
    }
}

struct TaskMap { int ntask, ncb, rb0, rbstride; };
template <class Fn>
__device__ __forceinline__ void wave_gemm(const Fn& fn, const TaskMap tm, int gw, int ngw, int lane_) {
    const int lane = opaque(lane_), fr = lane & 15, fq = lane >> 4;
    for (int task = gw; task < tm.ntask; task += ngw) {
        const int cb = task % tm.ncb, rb = tm.rb0 + (task / tm.ncb) * tm.rbstride;
        const bf16* ap[2]; const bf16* bp[4];
#pragma unroll
        for (int mi = 0; mi < 2; ++mi) ap[mi] = fn.arow(rb, cb, mi * 16 + fr) + 8 * fq;
#pragma unroll
        for (int nb = 0; nb < 4; ++nb) bp[nb] = fn.brow(rb, cb, nb * 16 + fr) + 8 * fq;
        f32x4 acc[2][4];
#pragma unroll
        for (int mi = 0; mi < 2; ++mi)
#pragma unroll
            for (int nb = 0; nb < 4; ++nb) acc[mi][nb] = (f32x4){0.f, 0.f, 0.f, 0.f};
#pragma unroll 2
        for (int k0 = 0; k0 < fn.K; k0 += 32) {
            bf16x8 a[2], bb[4];
#pragma unroll
            for (int mi = 0; mi < 2; ++mi) a[mi] = *(const bf16x8*)(ap[mi] + k0);
#pragma unroll
            for (int nb = 0; nb < 4; ++nb) bb[nb] = *(const bf16x8*)(bp[nb] + k0);
#pragma unroll
            for (int mi = 0; mi < 2; ++mi)
#pragma unroll
                for (int nb = 0; nb < 4; ++nb) acc[mi][nb] = __builtin_amdgcn_mfma_f32_16x16x32_bf16(bb[nb], a[mi], acc[mi][nb], 0, 0, 0);
        }
#pragma unroll
        for (int mi = 0; mi < 2; ++mi)
#pragma unroll
            for (int nb = 0; nb < (Fn::PAIRED ? 2 : 4); ++nb) fn.epi_blk(rb, cb, mi, nb, acc[mi][nb], acc[mi][Fn::PAIRED ? nb + 2 : nb], fr, fq);
    }
}
struct FnPool {
    static constexpr int nrb = MROWS / 32, ncb = 16, K = 256; static constexpr bool PAIRED = false;
    const bf16* P; const bf16* W; bf16* H; const float* scale;
    __device__ __forceinline__ const bf16* arow(int rb, int cb, int r) const { return P + (size_t)(rb * 32 + r) * D + (cb >> 2) * 256; }
    __device__ __forceinline__ const bf16* brow(int rb, int cb, int n) const { return W + (size_t)(cb * 64 + n) * 256; }
    __device__ __forceinline__ void epi_blk(int rb, int cb, int mi, int nb, const f32x4& v, const f32x4&, int fr, int fq) const {
        const int c = cb * 64 + nb * 16 + 4 * fq; bf16* p = H + (size_t)(rb * 32 + mi * 16 + fr) * D + c; const u32x2 w = *(const u32x2*)p; const f32x4 o = (f32x4){bflo(w.x), bfhi(w.x), bflo(w.y), bfhi(w.y)} + v * *(const f32x4*)(scale + c);
        u32x2 ow; ow.x = cvt_pk_bf16(o.x, o.y); ow.y = cvt_pk_bf16(o.z, o.w); *(u32x2*)p = ow; }
};
struct FnIn {
    static constexpr int nrb = MROWS / 32, ncb = 32, K = 1024; static constexpr bool PAIRED = false;
    const bf16* U; const bf16* W; bf16* XB; bf16* GY;
    __device__ __forceinline__ const bf16* arow(int rb, int cb, int r) const { return U + (size_t)(rb * 32 + r) * D; }
    __device__ __forceinline__ const bf16* brow(int rb, int cb, int n) const { return W + (size_t)(cb * 64 + n) * 1024; }
    __device__ __forceinline__ void epi_blk(int rb, int cb, int mi, int nb, const f32x4& v, const f32x4&, int fr, int fq) const {
        const int c = cb * 64 + nb * 16 + 4 * fq; const size_t ro = (size_t)(rb * 32 + mi * 16 + fr) * D; u32x2 w;
        if (cb < 16) { w.x = cvt_pk_bf16(v.x, v.y); w.y = cvt_pk_bf16(v.z, v.w); *(u32x2*)(XB + ro + c) = w; }
        else { w.x = cvt_pk_bf16(gelu_tanh(v.x), gelu_tanh(v.y)); w.y = cvt_pk_bf16(gelu_tanh(v.z), gelu_tanh(v.w)); *(u32x2*)(GY + ro + c - 1024) = w; } }
};
__device__ __forceinline__ void lru_gate2(f32x2 zr, f32x2 zi, f32x2 sp, f32x2 x, bool slow, f32x2& la, f32x2& bv) {
    const f32x2 tr = zr * (-1.44269504089f), ti = zi * (-1.44269504089f);
    f32x2 e1, e2; e1.x = __builtin_amdgcn_exp2f(tr.x); e1.y = __builtin_amdgcn_exp2f(tr.y); e2.x = __builtin_amdgcn_exp2f(ti.x); e2.y = __builtin_amdgcn_exp2f(ti.y);
    const f32x2 d1 = e1 + 1.0f, d2 = e2 + 1.0f, dd = d1 * d2;
    f32x2 inv; inv.x = fast_rcp(dd.x); inv.y = fast_rcp(dd.y);
    const f32x2 l = (inv * d2) * sp, x2 = l * 2.0f;
    f32x2 q = x2 * 0.0001984127f + 0.0013888889f; q = q * x2 + 0.0083333333f; q = q * x2 + 0.041666667f; q = q * x2 + 0.16666667f; q = q * x2 + 0.5f; q = q * x2 + 1.0f;
    f32x2 em = -x2 * q;
    if (__builtin_expect(slow, 0)) { asm volatile("" ::: "memory"); em.x = 1.0f - fast_exp(x2.x); em.y = 1.0f - fast_exp(x2.y); }
    f32x2 sq; sq.x = __builtin_amdgcn_sqrtf(em.x); sq.y = __builtin_amdgcn_sqrtf(em.y);
    la = l; bv = sq * (inv * d1) * x;
}
struct FnGates {
    static constexpr int nrb = MROWS / 32, ncb = 64, K = 256; static constexpr bool PAIRED = true;
    const bf16* XC; const bf16* W; bf16* LA; bf16* BV; const float* bg; const float* lam;
    __device__ __forceinline__ const bf16* arow(int rb, int cb, int r) const { return XC + (size_t)(rb * 32 + r) * D + (((cb & 31) * 32) >> 8) * 256; }
    __device__ __forceinline__ const bf16* brow(int rb, int cb, int n) const {
        const int d = cb >> 5, nb = n >> 4, frn = n & 15, ch = (cb & 31) * 32 + (nb & 1) * 16 + frn, g = nb >> 1, h = ch >> 8, jl = ch & 255;
        return W + (((size_t)(d * 8 + h * 2 + (jl >> 7)) * 256) + g * 128 + (jl & 127)) * 256; }
    __device__ __forceinline__ void epi_blk(int rb, int cb, int mi, int nb, const f32x4& vr, const f32x4& vi, int fr, int fq) const {
        const int d = cb >> 5, ch = (cb & 31) * 32 + nb * 16 + 4 * fq;
        const f32x4 br = *(const f32x4*)(bg + (d * 2 + 0) * D + ch), bi = *(const f32x4*)(bg + (d * 2 + 1) * D + ch), lm = *(const f32x4*)(lam + d * D + ch);
        const size_t ro = (size_t)(rb * 32 + mi * 16 + fr) * D + ch;
        const u32x2 xw = *(const u32x2*)(XC + ro); const float xv[4] = {bflo(xw.x), bfhi(xw.x), bflo(xw.y), bfhi(xw.y)};
        float la[4], bvv[4];
        const bool slow = __any((lm.x < -0.25f) | (lm.y < -0.25f) | (lm.z < -0.25f) | (lm.w < -0.25f));
#pragma unroll
        for (int q = 0; q < 4; q += 2) { f32x2 l2, b2; lru_gate2((f32x2){vr[q] + br[q], vr[q + 1] + br[q + 1]}, (f32x2){vi[q] + bi[q], vi[q + 1] + bi[q + 1]}, (f32x2){lm[q], lm[q + 1]}, (f32x2){xv[q], xv[q + 1]}, slow, l2, b2);
            la[q] = l2.x; la[q + 1] = l2.y; bvv[q] = b2.x; bvv[q + 1] = b2.y; }
        u32x2 w; w.x = cvt_pk_bf16(la[0], la[1]); w.y = cvt_pk_bf16(la[2], la[3]); *(u32x2*)(LA + (size_t)d * MPAD * D + ro) = w;
        w.x = cvt_pk_bf16(bvv[0], bvv[1]); w.y = cvt_pk_bf16(bvv[2], bvv[3]); *(u32x2*)(BV + (size_t)d * MPAD * D + ro) = w; }
};
struct FnOut {
    static constexpr int nrb = MROWS / 32, ncb = 16, K = 1024; static constexpr bool PAIRED = false;
    const bf16* A; const bf16* W; bf16* H;
    __device__ __forceinline__ const bf16* arow(int rb, int cb, int r) const { return A + (size_t)(rb * 32 + r) * D; }
    __device__ __forceinline__ const bf16* brow(int rb, int cb, int n) const { return W + (size_t)(cb * 64 + n) * 1024; }
    __device__ __forceinline__ void epi_blk(int rb, int cb, int mi, int nb, const f32x4& v, const f32x4&, int fr, int fq) const {
        bf16* p = H + (size_t)(rb * 32 + mi * 16 + fr) * D + cb * 64 + nb * 16 + 4 * fq; const u32x2 w = *(const u32x2*)p; const f32x4 o = (f32x4){bflo(w.x), bfhi(w.x), bflo(w.y), bfhi(w.y)} + v;
        u32x2 ow; ow.x = cvt_pk_bf16(o.x, o.y); ow.y = cvt_pk_bf16(o.z, o.w); *(u32x2*)p = ow; }
};
constexpr int ERB = (EROWS + 31) / 32;
constexpr int ERB16 = (EROWS + 15) / 16;
struct FnM1f8 {
    static constexpr int KB = 1024; static constexpr bool PAIRED = true;
    const unsigned char* U; const unsigned char* W; const int* ROWL; unsigned char* HID;
    __device__ __forceinline__ const unsigned char* arow(int rb, int cb, int r) const { const int e = rb / ERB16, pos = (rb % ERB16) * 16 + r; return U + (size_t)ROWL[e * EPAD + pos] * 1024; }
    __device__ __forceinline__ const unsigned char* brow(int rb, int cb, int n) const { const int e = rb / ERB16, nb = n >> 4, f = cb * 32 + (nb & 1) * 16 + (n & 15);
        return W + ((size_t)e * 4096 + (f >> 7) * 256 + (nb >> 1) * 128 + (f & 127)) * 1024; }
    __device__ __forceinline__ void epi_blk(int rb, int cb, int nb, const f32x4& gs, const f32x4& us, int fr, int fq) const {
        const int e = rb / ERB16, pos = (rb % ERB16) * 16 + fr, f = cb * 32 + nb * 16 + 4 * fq; const f32x4 g = gs * WINV, u = us * WINV;
        *(unsigned*)(HID + ((size_t)e * EPAD + pos) * HIDP8 + f) = pk4_fp8(siluf_(g.x) * u.x, siluf_(g.y) * u.y, siluf_(g.z) * u.z, siluf_(g.w) * u.w); }
};
struct FnM2f8 {
    static constexpr int KB = 2048; static constexpr bool PAIRED = false;
    const unsigned char* HID; const unsigned char* W; bf16* Y;
    __device__ __forceinline__ const unsigned char* arow(int rb, int cb, int r) const { const int e = rb / ERB16, pos = (rb % ERB16) * 16 + r; return HID + ((size_t)e * EPAD + pos) * HIDP8; }
    __device__ __forceinline__ const unsigned char* brow(int rb, int cb, int n) const { const int e = rb / ERB16; return W + ((size_t)e * 1024 + cb * 64 + n) * WDP8; }
    __device__ __forceinline__ void epi_blk(int rb, int cb, int nb, const f32x4& vs, const f32x4&, int fr, int fq) const {
        const int e = rb / ERB16, pos = (rb % ERB16) * 16 + fr; const f32x4 v = vs * WINV;
        *(unsigned*)((unsigned char*)Y + ((size_t)e * EPAD + pos) * D + cb * 64 + nb * 16 + 4 * fq) = pk4_fp8(v.x, v.y, v.z, v.w); }
};
template <class Fn>
__device__ __forceinline__ void wg_gemm_ksplit8(const Fn& fn, const TaskMap tm, LAS unsigned char* lds, int vcu, int G, int tid_) {
    const int tid = opaque(tid_), lane = tid & 63, wave = __builtin_amdgcn_readfirstlane(tid >> 6), fr = lane & 15, fq = lane >> 4;
    constexpr int KW = Fn::KB / 8, NS = KW / 128;
    LAS f32x4* part = (LAS f32x4*)lds;
    for (int task = vcu; task < tm.ntask; task += G) {
        const int cb = task % tm.ncb, rb = tm.rb0 + (task / tm.ncb) * tm.rbstride;
        const unsigned char* ap = fn.arow(rb, cb, fr) + wave * KW + 32 * fq; const unsigned char* bp[4];
#pragma unroll
        for (int nb = 0; nb < 4; ++nb) bp[nb] = fn.brow(rb, cb, nb * 16 + fr) + wave * KW + 32 * fq;
        v4i a[NS][2], bb[NS][4][2];
#pragma unroll
        for (int s = 0; s < NS; ++s) { a[s][0] = *(const v4i*)(ap + s * 128); a[s][1] = *(const v4i*)(ap + s * 128 + 16);
#pragma unroll
            for (int nb = 0; nb < 4; ++nb) { bb[s][nb][0] = *(const v4i*)(bp[nb] + s * 128); bb[s][nb][1] = *(const v4i*)(bp[nb] + s * 128 + 16); } }
        f32x4 acc[4];
#pragma unroll
        for (int nb = 0; nb < 4; ++nb) acc[nb] = (f32x4){0.f, 0.f, 0.f, 0.f};
#pragma unroll
        for (int s = 0; s < NS; ++s)
#pragma unroll
            for (int nb = 0; nb < 4; ++nb) acc[nb] = __builtin_amdgcn_mfma_scale_f32_16x16x128_f8f6f4(__builtin_shufflevector(bb[s][nb][0], bb[s][nb][1], 0, 1, 2, 3, 4, 5, 6, 7),
                                                                                                     __builtin_shufflevector(a[s][0], a[s][1], 0, 1, 2, 3, 4, 5, 6, 7), acc[nb], 0, 0, 0, 0, 0, 0);
#pragma unroll
        for (int nb = 0; nb < 4; ++nb) part[(wave * 4 + nb) * 64 + lane] = acc[nb];
        __syncthreads();
        if (wave < 4 && (!Fn::PAIRED || wave < 2)) {
            const int nb = wave;
            f32x4 v = (f32x4){0.f, 0.f, 0.f, 0.f}, v2 = v;
#pragma unroll
            for (int w = 0; w < 8; ++w) { v += part[(w * 4 + nb) * 64 + lane]; if (Fn::PAIRED) v2 += part[(w * 4 + nb + 2) * 64 + lane]; }
            fn.epi_blk(rb, cb, nb, v, v2, fr, fq);
        }
        __syncthreads();
    }
}

template <int MI, class Fn>
__device__ __forceinline__ void wg_gemm_ksplit(const Fn& fn, const TaskMap tm, LAS unsigned char* lds, int vcu, int G, int tid_) {
    const int tid = opaque(tid_), lane = tid & 63, wave = __builtin_amdgcn_readfirstlane(tid >> 6), fr = lane & 15, fq = lane >> 4;
    constexpr int KW = Fn::K / 8, NS = KW / 32;
    LAS f32x4* part = (LAS f32x4*)lds;
    for (int task = vcu; task < tm.ntask; task += G) {
        const int cb = task % tm.ncb, rb = tm.rb0 + (task / tm.ncb) * tm.rbstride;
        const bf16* ap[MI]; const bf16* bp[4];
#pragma unroll
        for (int mi = 0; mi < MI; ++mi) ap[mi] = fn.arow(rb, cb, mi * 16 + fr) + wave * KW + 8 * fq;
#pragma unroll
        for (int nb = 0; nb < 4; ++nb) bp[nb] = fn.brow(rb, cb, nb * 16 + fr) + wave * KW + 8 * fq;
        f32x4 acc[MI][4];
#pragma unroll
        for (int mi = 0; mi < MI; ++mi)
#pragma unroll
            for (int nb = 0; nb < 4; ++nb) acc[mi][nb] = (f32x4){0.f, 0.f, 0.f, 0.f};
#pragma unroll
        for (int s0 = 0; s0 < NS; s0 += 4) {
            bf16x8 a[4][MI], bb[4][4];
#pragma unroll
            for (int s = 0; s < 4; ++s) if (s0 + s < NS) {
#pragma unroll
                for (int mi = 0; mi < MI; ++mi) a[s][mi] = *(const bf16x8*)(ap[mi] + (s0 + s) * 32);
#pragma unroll
                for (int nb = 0; nb < 4; ++nb) bb[s][nb] = *(const bf16x8*)(bp[nb] + (s0 + s) * 32); }
#pragma unroll
            for (int s = 0; s < 4; ++s) if (s0 + s < NS) {
#pragma unroll
                for (int mi = 0; mi < MI; ++mi)
#pragma unroll
                    for (int nb = 0; nb < 4; ++nb) acc[mi][nb] = __builtin_amdgcn_mfma_f32_16x16x32_bf16(bb[s][nb], a[s][mi], acc[mi][nb], 0, 0, 0); }
        }
#pragma unroll
        for (int mi = 0; mi < MI; ++mi)
#pragma unroll
            for (int nb = 0; nb < 4; ++nb) part[((wave * MI + mi) * 4 + nb) * 64 + lane] = acc[mi][nb];
        __syncthreads();
        if (wave < MI * 4) {
            const int mi = wave >> 2, nb = wave & 3;
            if (!Fn::PAIRED || nb < 2) {
                f32x4 v = (f32x4){0.f, 0.f, 0.f, 0.f}, v2 = v;
#pragma unroll
                for (int w = 0; w < 8; ++w) { v += part[((w * MI + mi) * 4 + nb) * 64 + lane]; if (Fn::PAIRED) v2 += part[((w * MI + mi) * 4 + nb + 2) * 64 + lane]; }
                fn.epi_blk(rb, cb, mi, nb, v, v2, fr, fq);
            }
        }
        __syncthreads();
    }
}

namespace pg8 {
constexpr int BM = 256, BK = 64, HALF = 128, HTB = HALF * BK * 2, STAGE_BYTES = 8 * HTB;
__device__ __forceinline__ int lds_byte(int r, int c) { const int st = (r >> 4) * 2 + (c >> 5), rr = r & 15, cc = c & 31, ob = rr * 64 + cc * 2; return st * 1024 + (ob ^ (((ob >> 9) & 1) << 5)); }
__device__ __forceinline__ void stage_rc(int b, int& R, int& C) { const int st = b / 1024, sb = b % 1024, swz = sb ^ (((sb >> 9) & 1) << 5); R = (st >> 1) * 16 + swz / 64; C = (st & 1) * 32 + (swz % 64) / 2; }
__device__ __forceinline__ int perm32(int rho) { const int n = rho >> 4, i = rho & 15; return 8 * (i >> 2) + 4 * n + (i & 3); }
struct Unit { int pm, pn, e; };
struct SchedStd {
    int nM, nN, nwg, G, c;
    __device__ __forceinline__ void init(int nM_, int nN_, int G_, int c_) { nM = nM_; nN = nN_; nwg = nM * nN; G = G_; c = c_; }
    __device__ __forceinline__ bool next(int i, Unit& u) const {
        const int L = i * G + c; if (L >= nwg) return false;
        int wgid = L; { const int q = nwg / 8, r = nwg % 8, xcd = wgid % 8, off = wgid / 8; wgid = (xcd < r ? xcd * (q + 1) : r * (q + 1) + (xcd - r) * q) + off; }
        const int nig = 8 * nN, gid = wgid / nig, fm = gid * 8, gsz = (nM - fm) < 8 ? (nM - fm) : 8;
        u.pm = fm + ((wgid % nig) % gsz); u.pn = (wgid % nig) / gsz; u.e = 0; return true;
    }
};
struct SchedMoe {
    int nN, total, G, c, rev, gm;
    __device__ __forceinline__ void init(int nN_, int G_, int c_, int rev_ = 0, int gm_ = 8) { nN = nN_; total = 16 * 16 * nN_; G = G_; c = c_; rev = rev_; gm = gm_; }
    __device__ __forceinline__ bool next(int i, Unit& u) const {
        const int L = i * G + c; if (L >= total) return false;
        const int off = rev ? (total / 8 - 1 - L / 8) : L / 8;
        const int wgid = (L % 8) * (total / 8) + off, per = 16 * nN, w = wgid % per, nig = gm * nN;
        u.e = wgid / per; u.pm = (w / nig) * gm + (w % nig) % gm; u.pn = (w % nig) / gm; return true;
    }
};
template <class Cfg>
__device__ __forceinline__ void gemm_phase(LAS unsigned char* lds, const Cfg& cfg) {
    const int tid = opaque((int)threadIdx.x), wid = __builtin_amdgcn_readfirstlane(tid >> 6), lane = tid & 63, wr = wid >> 2, wc = wid & 3, fr = lane & 15, fq = lane >> 4;
    constexpr bool F8 = Cfg::FP8;
    constexpr int nt = Cfg::KB / 128;
    int Rr[2], Cc[2]; unsigned voffB[2];
#pragma unroll
    for (int i = 0; i < 2; ++i) { stage_rc(tid * 16 + i * 8192, Rr[i], Cc[i]); const int R = Rr[i];
        const int Rb = Cfg::PERMX ? (((R >> 5) & 3) * 64 + 16 * ((R & 15) >> 2) + 4 * ((R >> 4) & 1) + (R & 3)) : (Cfg::PERM ? ((R & ~31) + perm32(R & 31)) : R);
        voffB[i] = (unsigned)Rb * (unsigned)Cfg::ldb + (unsigned)Cc[i] * 2u; }
    const size_t kstep = (size_t)(BK * 2);
    const size_t hstepB = (size_t)(Cfg::PERMX ? 8 : HALF) * Cfg::ldb;
    const unsigned ldsw = (unsigned)wid * 1024u;
    const int aoff = lds_byte(wr * 64 + fr, F8 ? fq * 16 : fq * 8), boff = lds_byte(wc * 32 + fr, F8 ? fq * 16 : fq * 8);

#define PG8_SA(b, h) (((b) * 2 + (h)) * HTB)
#define PG8_SB(b, h) ((4 + (b) * 2 + (h)) * HTB)
#define PG8_STAGE(bufoff, gbase, voff) do { _Pragma("unroll") for (int _i = 0; _i < 2; ++_i) \
        __builtin_amdgcn_global_load_lds((const unsigned*)((const char*)(gbase) + (voff)[_i]), (LAS unsigned*)(lds + (bufoff) + ldsw + _i * 8192), 16, 0, 0); } while (0)
typedef v8i v8i_a16 __attribute__((aligned(16)));
#define PG8_LD32(p) (*(const LAS v8i_a16*)(p))
#define PG8_LDA(dst, b, h) do { if constexpr (F8) { _Pragma("unroll") for (int m = 0; m < 4; ++m) dst##8[m] = PG8_LD32(lds + PG8_SA(b, h) + aoff + m * 2048); } \
        else { _Pragma("unroll") for (int m = 0; m < 4; ++m) _Pragma("unroll") for (int k = 0; k < 2; ++k) dst[m][k] = *(const LAS bf16x8*)(lds + PG8_SA(b, h) + aoff + m * 2048 + k * 1024); } } while (0)
#define PG8_LDB(dst, b, h) do { if constexpr (F8) { _Pragma("unroll") for (int n = 0; n < 2; ++n) dst##8[n] = PG8_LD32(lds + PG8_SB(b, h) + boff + n * 2048); } \
        else { _Pragma("unroll") for (int n = 0; n < 2; ++n) _Pragma("unroll") for (int k = 0; k < 2; ++k) dst[n][k] = *(const LAS bf16x8*)(lds + PG8_SB(b, h) + boff + n * 2048 + k * 1024); } } while (0)
#define PG8_MMA(ai, bj, At, Bt) do { __builtin_amdgcn_s_setprio(1); _Pragma("unroll") for (int m = 0; m < 4; ++m) _Pragma("unroll") for (int n = 0; n < 2; ++n) { \
        if constexpr (F8) asm volatile("v_mfma_f32_16x16x128_f8f6f4 %0, %1, %2, %0" : "+v"(acc[ai][bj][m][n]) : "v"(Bt##8[n]), "v"(At##8[m]));   \
        else { _Pragma("unroll") for (int k = 0; k < 2; ++k) acc[ai][bj][m][n] = __builtin_amdgcn_mfma_f32_16x16x32_bf16(Bt[n][k], At[m][k], acc[ai][bj][m][n], 0, 0, 0); } } __builtin_amdgcn_s_setprio(0); } while (0)
#define PG8_WAIT_V(n) asm volatile("s_waitcnt vmcnt(" #n ")" ::: "memory")
#define PG8_WAIT_L(n) asm volatile("s_waitcnt lgkmcnt(" #n ")" ::: "memory")
#define PG8_BAR __builtin_amdgcn_s_barrier()
#define PG8_SCHED __builtin_amdgcn_sched_barrier(0)
    Unit cur, nxt; int ui = 0;
    if (!cfg.next(0, cur)) return;
    f32x4 acc[2][2][4][2];
#pragma unroll
    for (int a = 0; a < 2; ++a)
#pragma unroll
        for (int b = 0; b < 2; ++b)
#pragma unroll
            for (int m = 0; m < 4; ++m)
#pragma unroll
                for (int n = 0; n < 2; ++n) acc[a][b][m][n] = (f32x4){0.f, 0.f, 0.f, 0.f};
    bf16x8 At[4][2], B0[2][2], B1[2][2]; v8i At8[4], B08[2], B18[2];
    unsigned voffA[2][2], voffAn[2][2];
    cfg.a_offs(cur, 0, Rr, Cc, voffA);
    const char* cA = cfg.a_base(cur); const char* cB = cfg.b_base(cur);
    PG8_STAGE(PG8_SB(0, 0), cB, voffB); PG8_STAGE(PG8_SB(0, 1), cB + hstepB, voffB); PG8_STAGE(PG8_SA(0, 0), cA, voffA[0]); PG8_STAGE(PG8_SA(0, 1), cA, voffA[1]);
    if (wr == 1) PG8_BAR;
    PG8_WAIT_V(2); PG8_BAR;
    PG8_STAGE(PG8_SB(1, 0), cB + kstep, voffB); PG8_STAGE(PG8_SA(1, 0), cA + kstep, voffA[0]); PG8_STAGE(PG8_SB(1, 1), cB + hstepB + kstep, voffB);
    PG8_WAIT_V(6); PG8_BAR;
    for (;;) {
        const bool has_next = cfg.next(ui + 1, nxt);
        const char* nA = has_next ? cfg.a_base(nxt) : cA; const char* nB = has_next ? cfg.b_base(nxt) : cB;
#pragma unroll 1
        for (int t = 0; t < nt; t += 2) {
            const bool last = (t == nt - 2);
            const char* a1 = cA + (size_t)(t + 1) * kstep;
            const char* a2 = last ? nA : cA + (size_t)(t + 2) * kstep; const char* b2 = last ? nB : cB + (size_t)(t + 2) * kstep;
            const char* a3 = a2 + kstep; const char* b3 = b2 + kstep;
            unsigned o2[2][2];
            if constexpr (Cfg::GATHER) {
                if (last) { if (has_next) { int R2[2], C2[2]; stage_rc(tid * 16, R2[0], C2[0]); stage_rc(tid * 16 + 8192, R2[1], C2[1]); cfg.a_offs(nxt, ui + 1, R2, C2, voffAn); } else {
#pragma unroll
                    for (int h = 0; h < 2; ++h) { voffAn[h][0] = voffA[h][0]; voffAn[h][1] = voffA[h][1]; } } }
#pragma unroll
                for (int h = 0; h < 2; ++h) { o2[h][0] = last ? voffAn[h][0] : voffA[h][0]; o2[h][1] = last ? voffAn[h][1] : voffA[h][1]; }
            } else {
#pragma unroll
                for (int h = 0; h < 2; ++h) { o2[h][0] = voffA[h][0]; o2[h][1] = voffA[h][1]; }
            }
            PG8_LDB(B0, 0, 0); PG8_LDB(B1, 0, 1); PG8_SCHED; PG8_LDA(At, 0, 0); PG8_STAGE(PG8_SA(1, 1), a1, voffA[1]);
            PG8_WAIT_V(8); PG8_WAIT_L(0); PG8_BAR; PG8_MMA(0, 0, At, B0); PG8_MMA(0, 1, At, B1); PG8_BAR; PG8_SCHED;
            PG8_LDA(At, 0, 1); PG8_STAGE(PG8_SB(0, 0), b2, voffB); PG8_STAGE(PG8_SB(0, 1), b2 + hstepB, voffB); PG8_STAGE(PG8_SA(0, 0), a2, o2[0]);
            PG8_WAIT_V(8); PG8_WAIT_L(0); PG8_BAR; PG8_MMA(1, 0, At, B0); PG8_MMA(1, 1, At, B1); PG8_BAR; PG8_SCHED;
            PG8_LDB(B0, 1, 0); PG8_LDB(B1, 1, 1); PG8_SCHED; PG8_LDA(At, 1, 0); PG8_STAGE(PG8_SA(0, 1), a2, o2[1]);
            PG8_WAIT_V(8); PG8_WAIT_L(0); PG8_BAR; PG8_MMA(0, 0, At, B0); PG8_MMA(0, 1, At, B1); PG8_BAR; PG8_SCHED;
            PG8_LDA(At, 1, 1); PG8_STAGE(PG8_SB(1, 0), b3, voffB); PG8_STAGE(PG8_SB(1, 1), b3 + hstepB, voffB); PG8_STAGE(PG8_SA(1, 0), a3, o2[0]);
            PG8_WAIT_V(8); PG8_WAIT_L(0); PG8_BAR; PG8_MMA(1, 0, At, B0); PG8_MMA(1, 1, At, B1); PG8_BAR; PG8_SCHED;
        }
        if (wr == 0) PG8_BAR;
        if constexpr (F8) asm volatile("s_nop 15\n\ts_nop 15" ::: "memory");
        cfg.epi(acc, cur, wr, wc, fr, fq);
        if (!has_next) break;
#pragma unroll
        for (int a = 0; a < 2; ++a)
#pragma unroll
            for (int b = 0; b < 2; ++b)
#pragma unroll
                for (int m = 0; m < 4; ++m)
#pragma unroll
                    for (int n = 0; n < 2; ++n) acc[a][b][m][n] = (f32x4){0.f, 0.f, 0.f, 0.f};
        cur = nxt; cA = nA; cB = nB; ++ui;
        if constexpr (Cfg::GATHER) {
#pragma unroll
            for (int h = 0; h < 2; ++h) { voffA[h][0] = voffAn[h][0]; voffA[h][1] = voffAn[h][1]; } }
        if (wr == 1) PG8_BAR;
    }
    PG8_WAIT_V(0);
    PG8_BAR;
#undef PG8_SA
#undef PG8_SB
#undef PG8_STAGE
#undef PG8_LDA
#undef PG8_LDB
#undef PG8_MMA
#undef PG8_LD32
#undef PG8_WAIT_V
#undef PG8_WAIT_L
#undef PG8_BAR
#undef PG8_SCHED
}
template <int LDA> __device__ __forceinline__ void lin_offs(const int (&R)[2], const int (&C)[2], unsigned (&off)[2][2]) {
#pragma unroll
    for (int h = 0; h < 2; ++h)
#pragma unroll
        for (int i = 0; i < 2; ++i) off[h][i] = (unsigned)(h * HALF + R[i]) * (unsigned)LDA + (unsigned)C[i] * 2u;
}
struct CfgPool {
    static constexpr bool PERMX = false; static constexpr bool GATHER = false; static constexpr bool FP8 = false; static constexpr int KB = 256 * 2; static constexpr bool PERM = true; static constexpr int K = 256, ldb = 512;
    SchedStd S; const bf16* P; const bf16* W; bf16* H; const float* scale;
    __device__ __forceinline__ bool next(int i, Unit& u) const { return S.next(i, u); }
    __device__ __forceinline__ const char* a_base(const Unit& u) const { return (const char*)(P + (size_t)u.pm * 256 * D + u.pn * 256); }
    __device__ __forceinline__ void a_offs(const Unit&, int, const int (&R)[2], const int (&C)[2], unsigned (&off)[2][2]) const { lin_offs<2048>(R, C, off); }
    __device__ __forceinline__ const char* b_base(const Unit& u) const { return (const char*)(W + (size_t)u.pn * 65536); }
    __device__ __forceinline__ void epi(const f32x4 (&acc)[2][2][4][2], const Unit& u, int wr, int wc, int fr, int fq) const {
        const int row0 = u.pm * 256 + wr * 64 + fr, col0 = u.pn * 256 + wc * 32 + 8 * fq;
        f32x4 sc[2][2];
#pragma unroll
        for (int bj = 0; bj < 2; ++bj)
#pragma unroll
            for (int n = 0; n < 2; ++n) sc[bj][n] = *(const f32x4*)(scale + col0 + bj * 128 + n * 4);
#pragma unroll
        for (int ai = 0; ai < 2; ++ai) {
            u32x4 hw[4][2];
#pragma unroll
            for (int m = 0; m < 4; ++m)
#pragma unroll
                for (int bj = 0; bj < 2; ++bj) hw[m][bj] = *(const u32x4*)(H + (size_t)(row0 + ai * 128 + m * 16) * D + col0 + bj * 128);
            asm volatile("" ::: "memory");
#pragma unroll
            for (int m = 0; m < 4; ++m) { bf16* rowp = H + (size_t)(row0 + ai * 128 + m * 16) * D + col0;
#pragma unroll
                for (int bj = 0; bj < 2; ++bj) { const u32x4 w = hw[m][bj];
                    const f32x4 o0 = (f32x4){bflo(w.x), bfhi(w.x), bflo(w.y), bfhi(w.y)} + acc[ai][bj][m][0] * sc[bj][0], o1 = (f32x4){bflo(w.z), bfhi(w.z), bflo(w.w), bfhi(w.w)} + acc[ai][bj][m][1] * sc[bj][1];
                    u32x4 ow; ow.x = cvt_pk_bf16(o0.x, o0.y); ow.y = cvt_pk_bf16(o0.z, o0.w); ow.z = cvt_pk_bf16(o1.x, o1.y); ow.w = cvt_pk_bf16(o1.z, o1.w);
                    *(u32x4*)(rowp + bj * 128) = ow; } }
            asm volatile("" ::: "memory");
        }
    }
};
struct CfgOut {
    static constexpr bool PERMX = false; static constexpr bool GATHER = false; static constexpr bool FP8 = false; static constexpr int KB = 1024 * 2; static constexpr bool PERM = true; static constexpr int K = 1024, ldb = 2048;
    SchedStd S; const bf16* A; const bf16* W; bf16* H;
    __device__ __forceinline__ bool next(int i, Unit& u) const { return S.next(i, u); }
    __device__ __forceinline__ const char* a_base(const Unit& u) const { return (const char*)(A + (size_t)u.pm * 256 * D); }
    __device__ __forceinline__ void a_offs(const Unit&, int, const int (&R)[2], const int (&C)[2], unsigned (&off)[2][2]) const { lin_offs<2048>(R, C, off); }
    __device__ __forceinline__ const char* b_base(const Unit& u) const { return (const char*)(W + (size_t)u.pn * 256 * 1024); }
    __device__ __forceinline__ void epi(const f32x4 (&acc)[2][2][4][2], const Unit& u, int wr, int wc, int fr, int fq) const {
        const int row0 = u.pm * 256 + wr * 64 + fr, col0 = u.pn * 256 + wc * 32 + 8 * fq;
#pragma unroll
        for (int ai = 0; ai < 2; ++ai) {
            u32x4 hw[4][2];
#pragma unroll
            for (int m = 0; m < 4; ++m)
#pragma unroll
                for (int bj = 0; bj < 2; ++bj) hw[m][bj] = *(const u32x4*)(H + (size_t)(row0 + ai * 128 + m * 16) * D + col0 + bj * 128);
            asm volatile("" ::: "memory");
#pragma unroll
            for (int m = 0; m < 4; ++m) { bf16* rowp = H + (size_t)(row0 + ai * 128 + m * 16) * D + col0;
#pragma unroll
                for (int bj = 0; bj < 2; ++bj) { const u32x4 w = hw[m][bj];
                    const f32x4 o0 = (f32x4){bflo(w.x), bfhi(w.x), bflo(w.y), bfhi(w.y)} + acc[ai][bj][m][0], o1 = (f32x4){bflo(w.z), bfhi(w.z), bflo(w.w), bfhi(w.w)} + acc[ai][bj][m][1];
                    u32x4 ow; ow.x = cvt_pk_bf16(o0.x, o0.y); ow.y = cvt_pk_bf16(o0.z, o0.w); ow.z = cvt_pk_bf16(o1.x, o1.y); ow.w = cvt_pk_bf16(o1.z, o1.w);
                    *(u32x4*)(rowp + bj * 128) = ow; } }
            asm volatile("" ::: "memory");
        }
    }
};
struct CfgIn {
    static constexpr bool PERMX = false; static constexpr bool GATHER = false; static constexpr bool FP8 = false; static constexpr int KB = 1024 * 2; static constexpr bool PERM = true; static constexpr int K = 1024, ldb = 2048;
    SchedStd S; const bf16* U; const bf16* W; bf16* XB; bf16* GY;
    __device__ __forceinline__ bool next(int i, Unit& u) const { return S.next(i, u); }
    __device__ __forceinline__ const char* a_base(const Unit& u) const { return (const char*)(U + (size_t)u.pm * 256 * D); }
    __device__ __forceinline__ void a_offs(const Unit&, int, const int (&R)[2], const int (&C)[2], unsigned (&off)[2][2]) const { lin_offs<2048>(R, C, off); }
    __device__ __forceinline__ const char* b_base(const Unit& u) const { return (const char*)(W + (size_t)u.pn * 256 * 1024); }
    __device__ __forceinline__ void epi(const f32x4 (&acc)[2][2][4][2], const Unit& u, int wr, int wc, int fr, int fq) const {
        const int row0 = u.pm * 256 + wr * 64 + fr, col0 = (u.pn & 3) * 256 + wc * 32 + 8 * fq; const bool act = u.pn >= 4; bf16* base = act ? GY : XB;
#pragma unroll
        for (int ai = 0; ai < 2; ++ai)
#pragma unroll
            for (int m = 0; m < 4; ++m) { bf16* rowp = base + (size_t)(row0 + ai * 128 + m * 16) * D + col0;
#pragma unroll
                for (int bj = 0; bj < 2; ++bj) { f32x4 v0 = acc[ai][bj][m][0], v1 = acc[ai][bj][m][1];
                    if (act) { v0.x = gelu_tanh(v0.x); v0.y = gelu_tanh(v0.y); v0.z = gelu_tanh(v0.z); v0.w = gelu_tanh(v0.w); v1.x = gelu_tanh(v1.x); v1.y = gelu_tanh(v1.y); v1.z = gelu_tanh(v1.z); v1.w = gelu_tanh(v1.w); }
                    u32x4 w; w.x = cvt_pk_bf16(v0.x, v0.y); w.y = cvt_pk_bf16(v0.z, v0.w); w.z = cvt_pk_bf16(v1.x, v1.y); w.w = cvt_pk_bf16(v1.z, v1.w);
                    *(u32x4*)(rowp + bj * 128) = w; } }
    }
};
struct CfgGates {
    static constexpr bool PERMX = false; static constexpr bool GATHER = false; static constexpr bool FP8 = false; static constexpr int KB = 256 * 2; static constexpr bool PERM = true; static constexpr int K = 256, ldb = 512;
    SchedStd S; const bf16* XC; const bf16* W; bf16* LA; bf16* BV; const float* bg; const float* lam;
    __device__ __forceinline__ bool next(int i, Unit& u) const { return S.next(i, u); }
    __device__ __forceinline__ const char* a_base(const Unit& u) const { return (const char*)(XC + (size_t)u.pm * 256 * D + ((u.pn & 7) >> 1) * 256); }
    __device__ __forceinline__ void a_offs(const Unit&, int, const int (&R)[2], const int (&C)[2], unsigned (&off)[2][2]) const { lin_offs<2048>(R, C, off); }
    __device__ __forceinline__ const char* b_base(const Unit& u) const { return (const char*)(W + (size_t)u.pn * 65536); }
    __device__ __forceinline__ void epi(const f32x4 (&acc)[2][2][4][2], const Unit& u, int wr, int wc, int fr, int fq) const {
        const int d = u.pn >> 3, ch0 = (u.pn & 7) * 128 + wc * 32 + 8 * fq, row0 = u.pm * 256 + wr * 64 + fr;
        float br[8], bi[8], sp[8];
#pragma unroll
        for (int q = 0; q < 2; ++q) { const f32x4 a = *(const f32x4*)(bg + (d * 2 + 0) * D + ch0 + 4 * q), b = *(const f32x4*)(bg + (d * 2 + 1) * D + ch0 + 4 * q), l = *(const f32x4*)(lam + d * D + ch0 + 4 * q);
#pragma unroll
            for (int x = 0; x < 4; ++x) { br[4 * q + x] = a[x]; bi[4 * q + x] = b[x]; sp[4 * q + x] = l[x]; } }
        bool sl = false;
#pragma unroll
        for (int q = 0; q < 8; ++q) sl |= sp[q] < -0.25f;
        const bool slow = __any(sl);
        u32x4 xin[2][4];
#pragma unroll
        for (int ai = 0; ai < 2; ++ai)
#pragma unroll
            for (int m = 0; m < 4; ++m) xin[ai][m] = *(const u32x4*)(XC + (size_t)(row0 + ai * 128 + m * 16) * D + ch0);
        asm volatile("" ::: "memory");
#pragma unroll
        for (int ai = 0; ai < 2; ++ai)
#pragma unroll
            for (int m = 0; m < 4; ++m) { const size_t ro = (size_t)(row0 + ai * 128 + m * 16) * D + ch0;
                const u32x4 xw = xin[ai][m];
                const float xv[8] = {bflo(xw.x), bfhi(xw.x), bflo(xw.y), bfhi(xw.y), bflo(xw.z), bfhi(xw.z), bflo(xw.w), bfhi(xw.w)};
                float la[8], bv[8];
#pragma unroll
                for (int q = 0; q < 8; q += 2) { f32x2 l2, b2;
                    lru_gate2((f32x2){acc[ai][0][m][q >> 2][q & 3] + br[q], acc[ai][0][m][q >> 2][(q & 3) + 1] + br[q + 1]}, (f32x2){acc[ai][1][m][q >> 2][q & 3] + bi[q], acc[ai][1][m][q >> 2][(q & 3) + 1] + bi[q + 1]},
                              (f32x2){sp[q], sp[q + 1]}, (f32x2){xv[q], xv[q + 1]}, slow, l2, b2);
                    la[q] = l2.x; la[q + 1] = l2.y; bv[q] = b2.x; bv[q + 1] = b2.y; }
                u32x4 w; w.x = cvt_pk_bf16(la[0], la[1]); w.y = cvt_pk_bf16(la[2], la[3]); w.z = cvt_pk_bf16(la[4], la[5]); w.w = cvt_pk_bf16(la[6], la[7]);
                *(u32x4*)(LA + (size_t)d * MPAD * D + ro) = w;
                w.x = cvt_pk_bf16(bv[0], bv[1]); w.y = cvt_pk_bf16(bv[2], bv[3]); w.z = cvt_pk_bf16(bv[4], bv[5]); w.w = cvt_pk_bf16(bv[6], bv[7]);
                *(u32x4*)(BV + (size_t)d * MPAD * D + ro) = w; }
    }
};
struct CfgM1 {
    static constexpr bool PERMX = false; static constexpr bool GATHER = true; static constexpr bool FP8 = true; static constexpr int KB = 1024; static constexpr bool PERM = true; static constexpr int K = 1024, ldb = 1024;
    SchedMoe S; const unsigned char* U; const unsigned char* W; unsigned char* HID; const LAS unsigned short* idx;
    __device__ __forceinline__ bool next(int i, Unit& u) const { return S.next(i, u); }
    __device__ __forceinline__ const char* a_base(const Unit&) const { return (const char*)U; }
    __device__ __forceinline__ void a_offs(const Unit&, int ui, const int (&R)[2], const int (&C)[2], unsigned (&off)[2][2]) const {
#pragma unroll
        for (int h = 0; h < 2; ++h)
#pragma unroll
            for (int i = 0; i < 2; ++i) off[h][i] = (unsigned)idx[ui * 256 + h * HALF + R[i]] * 1024u + (unsigned)C[i] * 2u;
    }
    __device__ __forceinline__ const char* b_base(const Unit& u) const { return (const char*)(W + ((size_t)u.e * 4096 + u.pn * 256) * 1024); }
    __device__ __forceinline__ void epi(const f32x4 (&acc)[2][2][4][2], const Unit& u, int wr, int wc, int fr, int fq) const {
        const int row0 = u.e * EPAD + u.pm * 256 + wr * 64 + fr, col0 = u.pn * 128 + wc * 32 + 8 * fq;
#pragma unroll
        for (int ai = 0; ai < 2; ++ai)
#pragma unroll
            for (int m = 0; m < 4; ++m) { const f32x4 g0 = acc[ai][0][m][0], g1 = acc[ai][0][m][1], u0 = acc[ai][1][m][0], u1 = acc[ai][1][m][1];
                u32x2 w; w.x = pk4_fp8(silu_mul_s(g0.x, u0.x), silu_mul_s(g0.y, u0.y), silu_mul_s(g0.z, u0.z), silu_mul_s(g0.w, u0.w));
                w.y = pk4_fp8(silu_mul_s(g1.x, u1.x), silu_mul_s(g1.y, u1.y), silu_mul_s(g1.z, u1.z), silu_mul_s(g1.w, u1.w));
                *(u32x2*)(HID + (size_t)(row0 + ai * 128 + m * 16) * HIDP8 + col0) = w; }
    }
};
struct CfgM2 {
    static constexpr bool PERMX = true; static constexpr bool GATHER = false; static constexpr bool FP8 = true; static constexpr int KB = 2048; static constexpr bool PERM = true; static constexpr int K = 2048, ldb = WDP8;
    SchedMoe S; const unsigned char* HID; const unsigned char* W; bf16* Y;
    __device__ __forceinline__ bool next(int i, Unit& u) const { return S.next(i, u); }
    __device__ __forceinline__ const char* a_base(const Unit& u) const { return (const char*)(HID + ((size_t)u.e * EPAD + u.pm * 256) * HIDP8); }
    __device__ __forceinline__ void a_offs(const Unit&, int, const int (&R)[2], const int (&C)[2], unsigned (&off)[2][2]) const { lin_offs<HIDP8>(R, C, off); }
    __device__ __forceinline__ const char* b_base(const Unit& u) const { return (const char*)(W + ((size_t)u.e * 1024 + u.pn * 256) * WDP8); }
    __device__ __forceinline__ void epi(const f32x4 (&acc)[2][2][4][2], const Unit& u, int wr, int wc, int fr, int fq) const {
        const int row0 = u.e * EPAD + u.pm * 256 + wr * 64 + fr, col0 = u.pn * 256 + wc * 64 + 16 * fq;
#pragma unroll
        for (int ai = 0; ai < 2; ++ai)
#pragma unroll
            for (int m = 0; m < 4; ++m) { const f32x4 v0 = acc[ai][0][m][0] * WINV, v1 = acc[ai][0][m][1] * WINV, v2 = acc[ai][1][m][0] * WINV, v3 = acc[ai][1][m][1] * WINV;
                u32x4 w; w.x = pk4_fp8(v0.x, v0.y, v0.z, v0.w); w.y = pk4_fp8(v1.x, v1.y, v1.z, v1.w); w.z = pk4_fp8(v2.x, v2.y, v2.z, v2.w); w.w = pk4_fp8(v3.x, v3.y, v3.z, v3.w);
                *(u32x4*)((unsigned char*)Y + (size_t)(row0 + ai * 128 + m * 16) * D + col0) = w; }
    }
};
}

#ifndef FAST_PG
#define FAST_PG 1
#endif
#ifndef FAST_LIN
#define FAST_LIN 1
#endif
#ifndef FAST_LGT
#define FAST_LGT 1
#endif
#ifndef FAST_LOUT
#define FAST_LOUT 1
#endif
#ifndef FAST_M1
#define FAST_M1 1
#endif
#ifndef FAST_M2
#define FAST_M2 1
#endif
constexpr int IDX_OFF = RING_BYTES + 1024;

#ifndef REP_PRO
#define REP_PRO 1
#endif
#ifndef REP_PP
#define REP_PP 1
#endif
#ifndef REP_LIN
#define REP_LIN 1
#endif
#ifndef REP_LCV
#define REP_LCV 1
#endif
#ifndef REP_LGT
#define REP_LGT 1
#endif
#ifndef REP_LS1
#define REP_LS1 1
#endif
#ifndef REP_LS3
#define REP_LS3 1
#endif
#ifndef REP_RB
#define REP_RB 1
#endif
#ifndef REP_TK
#define REP_TK 1
#endif
#ifndef REP_M1
#define REP_M1 1
#endif
#ifndef REP_M2
#define REP_M2 1
#endif
#ifndef REP_RA
#define REP_RA 1
#endif
#ifndef REP_LOUT
#define REP_LOUT 1
#endif
#ifndef REP_PG
#define REP_PG 1
#endif
#define REPEAT(n) _Pragma("unroll") for (int rep_ = 0; rep_ < (n); ++rep_)
#define IN(k) (lo <= (k) && (k) < hi)
#define SEAM(k) do { if ((k) + 1 < hi) xcd_barrier(bar); } while (0)
template <int layer>
__device__ __forceinline__ void run_layer(const Frame& F, const int lo, const int hi, const XcdBarrier& bar) {
    const int gw = F.vcu * 8 + F.wave, NGW = F.G * 8;
    const bool fast = (F.G == 256);
    {
        const int pb = layer * 16, j = layer >> 1;
        if (IN(pb + 0)) { if constexpr (layer == 0) REPEAT(REP_PRO) phase_prologue(F); if (REP_RA > 1) phase_rowA<false, layer == 0, true>(F, layer); phase_rowA<false, layer == 0>(F, layer); SEAM(pb + 0); }
        if constexpr ((layer & 1) == 0) {
            if (IN(pb + 1)) { REPEAT(REP_PP) phase_poolwin(F); SEAM(pb + 1); }
            if (IN(pb + 2)) { FnPool fn{F.P, F.WPOOL + (size_t)j * 4 * 65536, F.H, F.pool_scale + (size_t)j * D};
                if (FAST_PG && fast) { pg8::CfgPool cfg; cfg.S.init(128, 4, F.G, (int)blockIdx.x); cfg.P = F.P; cfg.W = fn.W; cfg.scale = fn.scale; if (REP_PG > 1) { cfg.H = (bf16*)F.HF; pg8::gemm_phase(F.lds, cfg); } cfg.H = F.H; pg8::gemm_phase(F.lds, cfg);
                    wg_gemm_ksplit<2>(fn, TaskMap{4 * 16, 16, 1024, 1}, F.lds, F.vcu, F.G, F.tid); }
                else wave_gemm(fn, TaskMap{FnPool::nrb * 16, 16, 0, 1}, gw, NGW, F.lane);
                SEAM(pb + 2); }
        } else {
            if (IN(pb + 3)) { REPEAT(REP_LIN) { FnIn fn{F.U, F.WIN + (size_t)j * 2048 * 1024, F.XB, F.GY};
                if (FAST_LIN && fast) { pg8::CfgIn cfg; cfg.S.init(128, 8, F.G, (int)blockIdx.x); cfg.U = F.U; cfg.W = fn.W; cfg.XB = F.XB; cfg.GY = F.GY; pg8::gemm_phase(F.lds, cfg);
                    wg_gemm_ksplit<2>(fn, TaskMap{4 * 32, 32, 1024, 1}, F.lds, F.vcu, F.G, F.tid); }
                else wave_gemm(fn, TaskMap{FnIn::nrb * 32, 32, 0, 1}, gw, NGW, F.lane);
                } SEAM(pb + 3); }
            if (IN(pb + 4)) { REPEAT(REP_LCV) phase_conv(F, j); SEAM(pb + 4); }
            if (IN(pb + 5)) { REPEAT(REP_LGT) { FnGates fn{F.P, F.WGT + (size_t)j * 16 * 65536, F.LA, F.BV, F.b_gates + (size_t)j * 4 * D, F.SPT + (size_t)j * 2 * D};
                if (FAST_LGT && fast) { pg8::CfgGates cfg; cfg.S.init(128, 16, F.G, (int)blockIdx.x); cfg.XC = F.P; cfg.W = fn.W; cfg.LA = F.LA; cfg.BV = F.BV; cfg.bg = fn.bg; cfg.lam = fn.lam; pg8::gemm_phase(F.lds, cfg);
                    wg_gemm_ksplit<2>(fn, TaskMap{4 * 64, 64, 1024, 1}, F.lds, F.vcu, F.G, F.tid); }
                else wave_gemm(fn, TaskMap{FnGates::nrb * 64, 64, 0, 1}, gw, NGW, F.lane);
                } SEAM(pb + 5); }
            if (IN(pb + 6)) { REPEAT(REP_LS1) phase_scan1(F); SEAM(pb + 6); }
            if (IN(pb + 7)) { REPEAT(REP_LS3) phase_scan3(F); SEAM(pb + 7); }
            if (IN(pb + 8)) { FnOut fn{F.HG, F.WOUT + (size_t)j * 1024 * 1024, F.H};
                if (FAST_LOUT && fast) { pg8::CfgOut cfg; cfg.S.init(128, 4, F.G, (int)blockIdx.x); cfg.A = F.HG; cfg.W = fn.W; if (REP_LOUT > 1) { cfg.H = (bf16*)F.HF; pg8::gemm_phase(F.lds, cfg); } cfg.H = F.H; pg8::gemm_phase(F.lds, cfg);
                    wg_gemm_ksplit<2>(fn, TaskMap{4 * 16, 16, 1024, 1}, F.lds, F.vcu, F.G, F.tid); }
                else wave_gemm(fn, TaskMap{FnOut::nrb * 16, 16, 0, 1}, gw, NGW, F.lane);
                SEAM(pb + 8); }
        }
        if (IN(pb + 9)) { REPEAT(REP_RB) phase_rowB(F, layer); SEAM(pb + 9); }
        if (IN(pb + 10)) { REPEAT(REP_TK) phase_topk(F); SEAM(pb + 10); }
        if (IN(pb + 11)) { REPEAT(REP_M1) { FnM1f8 fn{(const unsigned char*)F.U, (const unsigned char*)F.WG1 + (size_t)layer * NE * 4096 * 1024, F.ROWL, (unsigned char*)F.HID};
            if (FAST_M1 && fast) { pg8::CfgM1 cfg; cfg.S.init(16, F.G, (int)blockIdx.x, 0, 4); cfg.U = fn.U; cfg.W = fn.W; cfg.HID = fn.HID;
                LAS unsigned short* idx = (LAS unsigned short*)(F.lds + IDX_OFF); cfg.idx = idx;
                {
                    int rl[16];
#pragma unroll
                    for (int ui = 0; ui < 16; ++ui) { pg8::Unit u; const bool ok = cfg.S.next(ui, u); rl[ui] = F.ROWL[(ok ? u.e * EPAD + u.pm * 256 : 0) + (F.tid & 255)]; }
#pragma unroll
                    for (int ui = 0; ui < 16; ++ui) if (F.tid < 256) idx[ui * 256 + F.tid] = (unsigned short)rl[ui];
                }
                __syncthreads();
                pg8::gemm_phase(F.lds, cfg);
                wg_gemm_ksplit8(fn, TaskMap{16 * 64, 64, ERB16 - 1, ERB16}, F.lds, F.vcu, F.G, F.tid); }
            else wg_gemm_ksplit8(fn, TaskMap{NE * ERB16 * 64, 64, 0, 1}, F.lds, F.vcu, F.G, F.tid);
            } SEAM(pb + 11); }
        if (IN(pb + 12)) { REPEAT(REP_M2) { FnM2f8 fn{(const unsigned char*)F.HID, (const unsigned char*)F.WD + (size_t)layer * NE * 1024 * WDP8, F.Y};
            if (FAST_M2 && fast) { pg8::CfgM2 cfg; cfg.S.init(4, F.G, (int)blockIdx.x); cfg.HID = fn.HID; cfg.W = fn.W; cfg.Y = F.Y; pg8::gemm_phase(F.lds, cfg);
                wg_gemm_ksplit8(fn, TaskMap{16 * 16, 16, ERB16 - 1, ERB16}, F.lds, F.vcu, F.G, F.tid); }
            else wg_gemm_ksplit8(fn, TaskMap{NE * ERB16 * 16, 16, 0, 1}, F.lds, F.vcu, F.G, F.tid);
            } SEAM(pb + 12); }
    }
}
#undef IN
#undef SEAM

__global__ void __launch_bounds__(512, 2) mega(Args args) {
    extern __shared__ __attribute__((aligned(16))) unsigned char lds_raw[];
    Frame F;
    F.lds = (LAS unsigned char*)lds_raw;
    F.tid = threadIdx.x; F.lane = F.tid & 63; F.wave = __builtin_amdgcn_readfirstlane(F.tid >> 6);
    F.G = gridDim.x; { const int bx = blockIdx.x; F.vcu = (F.G % 8 == 0) ? (bx % 8) * (F.G / 8) + bx / 8 : bx; }
    F.x = args.in[0]; F.meta = args.in[1]; F.norm_mix = args.in[2]; F.norm_ffn = args.in[3]; F.norm_final = args.in[4]; F.pool_w = args.in[5]; F.pool_scale = args.in[6]; F.w_in = args.in[7]; F.conv_w = args.in[8];
    F.conv_b = args.in[9]; F.w_gates = args.in[10]; F.b_gates = args.in[11]; F.lam = args.in[12]; F.w_out = args.in[13]; F.router_w = args.in[14]; F.moe_g = args.in[15]; F.moe_u = args.in[16]; F.moe_d = args.in[17];
    F.out = args.out; F.ws = args.ws;
    unsigned char* ws = args.ws;
    F.WG1 = (bf16*)(ws + WS_WG1); F.WD = (bf16*)(ws + WS_WD); F.WIN = (bf16*)(ws + WS_WIN); F.WGT = (bf16*)(ws + WS_WGT); F.WOUT = (bf16*)(ws + WS_WOUT); F.WPOOL = (bf16*)(ws + WS_WPOOL);
    F.H = (bf16*)(ws + WS_H); F.U = (bf16*)(ws + WS_U); F.P = (bf16*)(ws + WS_P); F.XB = (bf16*)(ws + WS_XB); F.GY = (bf16*)(ws + WS_GY); F.HG = (bf16*)(ws + WS_HG); F.HF = (float*)(ws + WS_Y);
    F.LA = (bf16*)(ws + WS_BIG); F.BV = (bf16*)(ws + WS_BIG + 2 * LA_BYTES); F.HID = (bf16*)(ws + WS_BIG); F.Y = (bf16*)(ws + WS_Y);
    F.AFF = (float*)(ws + WS_AFF); F.SLOT = (int*)(ws + WS_SLOT); F.GMAP = (float*)(ws + WS_GMAP); F.ROWL = (int*)(ws + WS_ROWL); F.AGG = (float*)(ws + WS_AGG); F.SPT = (float*)(ws + WS_SPT);
    volatile LAS unsigned* MISC = (volatile LAS unsigned*)(F.lds + MISC_OFF);
    if (F.tid < 32) MISC[F.tid] = 0u;
    __syncthreads();
    const int lo = args.lo, hi = args.hi;
    const bool multi = (hi - lo) > 1;
    XcdBarrier bar; bar.bar = (unsigned*)(ws + WS_CTL) + CW_BAR; bar.x = 0; bar.st = nullptr;
    if (multi) bar = xcd_barrier_post((unsigned*)(ws + WS_CTL) + CW_BAR, MISC + 8);
#define IN(k) (lo <= (k) && (k) < hi)
#define SEAM(k) do { if ((k) + 1 < hi) xcd_barrier(bar); } while (0)
    run_layer<0>(F, lo, hi, bar); run_layer<1>(F, lo, hi, bar); run_layer<2>(F, lo, hi, bar); run_layer<3>(F, lo, hi, bar);
    if (IN(64)) { if (REP_RA > 1) phase_rowA<true, false>(F, DEPTH); phase_rowA<true, false>(F, DEPTH); }
#undef IN
#undef SEAM
}

extern "C" void kernel_launch(void* const* d_in, const int* in_sizes, int n_in, void* d_out, int out_size, void* d_ws, size_t ws_size, hipStream_t stream) {
    static int grid = 0;
    if (grid == 0) {
        if (n_in != 18 || in_sizes[0] != NB * SEQ * D || out_size != NB * SEQ * D || ws_size < WS_END) {
            fprintf(stderr, "kernel_launch: unexpected shapes (n_in %d, in0 %d, out %d, ws %zu < %zu)\n", n_in, n_in > 0 ? in_sizes[0] : -1, out_size, ws_size, (size_t)WS_END); grid = -1; return; }
        int dev = 0, cus = 0;
        if (hipGetDevice(&dev) != hipSuccess || hipDeviceGetAttribute(&cus, hipDeviceAttributeMultiprocessorCount, dev) != hipSuccess) { grid = -1; return; }
        if (hipFuncSetAttribute((const void*)mega, hipFuncAttributeMaxDynamicSharedMemorySize, LDS_BYTES) != hipSuccess) { fprintf(stderr, "kernel_launch: hipFuncSetAttribute failed\n"); grid = -1; return; }
        int per_cu = 0;
        if (hipOccupancyMaxActiveBlocksPerMultiprocessor(&per_cu, (const void*)mega, 512, LDS_BYTES) != hipSuccess || per_cu < 1) fprintf(stderr, "kernel_launch: occupancy query reports %d\n", per_cu);
        (void)hipGetLastError();
        grid = cus;
    }
    if (grid < 0) return;
    if (hipMemsetAsync((char*)d_ws + WS_CTL, 0, CTL_ZERO_BYTES, stream) != hipSuccess) return;
    Args a{};
    for (int i = 0; i < 18; ++i) a.in[i] = (const float*)d_in[i];
    a.out = (float*)d_out; a.ws = (unsigned char*)d_ws;
#if SINGLE_LAUNCH
    a.lo = 0; a.hi = 65;
    hipLaunchKernelGGL(mega, dim3(grid), dim3(512), LDS_BYTES, stream, a);
#else
    for (int layer = 0; layer < DEPTH; ++layer) {
        static const int pool_ph[] = {0, 1, 2, 9, 10, 11, 12}, lru_ph[] = {0, 3, 4, 5, 6, 7, 8, 9, 10, 11, 12};
        const int* ph = (layer & 1) ? lru_ph : pool_ph; const int n = (layer & 1) ? 11 : 7;
        for (int q = 0; q < n; ++q) { a.lo = layer * 16 + ph[q]; a.hi = a.lo + 1; hipLaunchKernelGGL(mega, dim3(grid), dim3(512), LDS_BYTES, stream, a); }
    }
    a.lo = 64; a.hi = 65; hipLaunchKernelGGL(mega, dim3(grid), dim3(512), LDS_BYTES, stream, a);
#endif
}
```

```cpp
#include <hip/hip_runtime.h>
#include <cstdio>
#include <cstdint>

#ifndef SINGLE_LAUNCH
#define SINGLE_LAUNCH 1
#endif

constexpr int NB = 8, SEQ = 4096, NMETA = 16, T = SEQ + NMETA, D = 1024, NE = 16, CAP = 2 * T / NE, DF = 2048, DEPTH = 4;
constexpr int MMAIN = NB * SEQ;
constexpr int MROWS = NB * T;
constexpr int MPAD = 33024;
constexpr int EROWS = NB * CAP;
constexpr int EPAD = 4352;
constexpr int HIDP8 = 2112, WDP8 = 2112;
constexpr float WSCALE = 32.0f, WINV = 1.0f / 32.0f;
constexpr int NCHUNK = 17;
static_assert(CAP == 514 && T == 4112 && EROWS == 4112, "shapes");
constexpr float RMS_EPS = 1e-6f;

constexpr size_t MiB = 1u << 20;
constexpr size_t WS_CTL = 0, CTL_ZERO_BYTES = 1 * MiB;
constexpr size_t WS_WG1 = 1 * MiB;
constexpr size_t WS_WD = WS_WG1 + 512 * MiB;
constexpr size_t WS_WIN = WS_WD + 264 * MiB;
constexpr size_t WS_WGT = WS_WIN + 8 * MiB;
constexpr size_t WS_WOUT = WS_WGT + 4 * MiB;
constexpr size_t WS_WPOOL = WS_WOUT + 4 * MiB;
constexpr size_t WS_H = WS_WPOOL + 1 * MiB;
constexpr size_t WS_U = WS_H + 129 * MiB;
constexpr size_t WS_P = WS_U + 65 * MiB;
constexpr size_t WS_XB = WS_P + 65 * MiB;
constexpr size_t WS_GY = WS_XB + 65 * MiB;
constexpr size_t WS_HG = WS_GY + 65 * MiB;
constexpr size_t WS_BIG = WS_HG + 65 * MiB;
constexpr size_t WS_Y = WS_BIG + 282 * MiB;
constexpr size_t WS_AFF = WS_Y + 136 * MiB;
constexpr size_t WS_SLOT = WS_AFF + 3 * MiB;
constexpr size_t WS_GMAP = WS_SLOT + 3 * MiB;
constexpr size_t WS_ROWL = WS_GMAP + 3 * MiB;
constexpr size_t WS_AGG = WS_ROWL + 1 * MiB;
constexpr size_t WS_SPT = WS_AGG + 5 * MiB / 2;
constexpr size_t WS_RSTD = WS_SPT + 64 * 1024;
constexpr size_t WS_END = WS_AGG + 3 * MiB;
constexpr size_t LA_BYTES = (size_t)MPAD * 1024 * 2;

constexpr int CW_BAR = 4096;

constexpr int RING_BYTES = 131072;
constexpr int MISC_OFF = RING_BYTES + 320;
constexpr int LDS_BYTES = 147456;

#define LAS __attribute__((address_space(3)))
typedef unsigned short bf16;
typedef short bf16x8 __attribute__((ext_vector_type(8)));
typedef float f32x4 __attribute__((ext_vector_type(4)));
typedef float f32x2 __attribute__((ext_vector_type(2)));
typedef unsigned u32x4 __attribute__((ext_vector_type(4)));
typedef unsigned u32x2 __attribute__((ext_vector_type(2)));

__device__ __forceinline__ unsigned cvt_pk_bf16(float lo, float hi) { unsigned r; asm volatile("v_cvt_pk_bf16_f32 %0, %1, %2" : "=v"(r) : "v"(lo), "v"(hi)); return r; }
__device__ __forceinline__ float bflo(unsigned w) { return __uint_as_float(w << 16); }
__device__ __forceinline__ float bfhi(unsigned w) { return __uint_as_float(w & 0xffff0000u); }
__device__ __forceinline__ float fast_exp(float x) { return __builtin_amdgcn_exp2f(x * 1.44269504089f); }
__device__ __forceinline__ float fast_rcp(float x) { return __builtin_amdgcn_rcpf(x); }
__device__ __forceinline__ float sigmoidf_(float x) { return fast_rcp(1.0f + fast_exp(-x)); }
__device__ __forceinline__ float siluf_(float x) { return x * sigmoidf_(x); }
typedef int v4i __attribute__((ext_vector_type(4)));
typedef int v8i __attribute__((ext_vector_type(8)));
__device__ __forceinline__ unsigned pk4_fp8(float a, float b, float c, float d) {
    a = __builtin_amdgcn_fmed3f(a, -448.f, 448.f); b = __builtin_amdgcn_fmed3f(b, -448.f, 448.f); c = __builtin_amdgcn_fmed3f(c, -448.f, 448.f); d = __builtin_amdgcn_fmed3f(d, -448.f, 448.f);
    unsigned r = 0; r = (unsigned)__builtin_amdgcn_cvt_pk_fp8_f32(a, b, (int)r, false); r = (unsigned)__builtin_amdgcn_cvt_pk_fp8_f32(c, d, (int)r, true); return r; }
__device__ __forceinline__ f32x4 fp8x4_to_f32(unsigned w) { const f32x2 lo = __builtin_amdgcn_cvt_pk_f32_fp8((int)w, false), hi = __builtin_amdgcn_cvt_pk_f32_fp8((int)w, true); return (f32x4){lo.x, lo.y, hi.x, hi.y}; }
__device__ __forceinline__ float silu_mul_s(float G, float U) { const float e = __builtin_amdgcn_exp2f(G * (-1.44269504089f * WINV)); return (G * U) * fast_rcp(__builtin_fmaf(e, 1024.0f, 1024.0f)); }
__device__ __forceinline__ float gelu_tanh(float x) { const float z = 0.7978845608f * (x + 0.044715f * x * x * x); return x * sigmoidf_(2.0f * z); }
__device__ __forceinline__ float wave_sum(float v) {
#pragma unroll
    for (int o = 1; o < 64; o <<= 1) v += __shfl_xor(v, o);
    return v;
}
__device__ __forceinline__ int opaque(int v) { asm volatile("" : "+v"(v)); return v; }
__device__ __forceinline__ int row_of(int b, int t) { return t >= NMETA ? b * SEQ + (t - NMETA) : MMAIN + b * NMETA + t; }

#define XB_TMO      128
#define XB_XCNT(j)  (256  + 64 * (j))
#define XB_XSUB(j)  (1280 + 64 * (j))
#define XB_XGEN(j)  (2304 + 64 * (j))
#define XB_TOP      3328
#define XB_TOPGEN   3392
#define XCD_BAR_WORDS 3456
#define XB_SPIN_CAP (1u << 18)
__device__ __forceinline__ unsigned xb_ld(unsigned* p)              { return __hip_atomic_load(p, __ATOMIC_RELAXED, __HIP_MEMORY_SCOPE_AGENT); }
__device__ __forceinline__ unsigned xb_add(unsigned* p, unsigned v) { return __hip_atomic_fetch_add(p, v, __ATOMIC_RELAXED, __HIP_MEMORY_SCOPE_AGENT); }
__device__ __forceinline__ unsigned xb_xcc_id() { return (unsigned)__builtin_amdgcn_s_getreg((3 << 11) | 20) & 0xFu; }
#define XB_SPIN(cond, bar) do { unsigned _sp = 0; while (cond) { __builtin_amdgcn_s_sleep(1); \
    if ((++_sp & 255u) == 0u) { if (xb_ld(&(bar)[XB_TMO])) break; if (_sp > XB_SPIN_CAP) { atomicAdd(&(bar)[XB_TMO], 1u); break; } } } } while (0)
struct XcdBarrier { unsigned* bar; unsigned x; volatile LAS unsigned* st; };
__device__ __forceinline__ XcdBarrier xcd_barrier_post(unsigned* bar, volatile LAS unsigned* st) {
    XcdBarrier b; b.bar = bar; b.x = xb_xcc_id(); b.st = st;
    if (threadIdx.x == 0) (void)xb_add(&bar[XB_XCNT(b.x)], 1u);
    return b;
}
__device__ __forceinline__ void xcd_barrier_complete(unsigned* bar, unsigned x, unsigned& nloc, unsigned& nx) {
    const unsigned G = gridDim.x * gridDim.y * gridDim.z;
    unsigned sum, cnt, mine, sp = 0u;
    for (;;) {
        sum = 0u; cnt = 0u; mine = 0u;
#pragma unroll
        for (unsigned j = 0; j < 16; ++j) { const unsigned c = xb_ld(&bar[XB_XCNT(j)]); sum += c; cnt += (c > 0u) ? 1u : 0u; mine = (j == x) ? c : mine; }
        if (sum == G) break;
        __builtin_amdgcn_s_sleep(1);
        if ((++sp & 255u) == 0u) { if (xb_ld(&bar[XB_TMO])) break; if (sp > XB_SPIN_CAP) { atomicAdd(&bar[XB_TMO], 1u); break; } }
    }
    nloc = mine > 0u ? mine : 1u; nx = cnt > 0u ? cnt : 1u;
}
__device__ __forceinline__ void xcd_barrier(const XcdBarrier& b) {
    asm volatile("s_waitcnt vmcnt(0)" ::: "memory");
    __syncthreads();
    if (threadIdx.x == 0) {
        unsigned* bar = b.bar;
        __builtin_amdgcn_s_waitcnt(0);
        unsigned nloc = b.st[0], nx = b.st[1];
        if (nloc == 0u) { xcd_barrier_complete(bar, b.x, nloc, nx); b.st[0] = nloc; b.st[1] = nx; }
        const unsigned old = xb_add(&bar[XB_XSUB(b.x)], 1u);
        const unsigned gen = old / nloc;
        if (old + 1u == (gen + 1u) * nloc) {
            __builtin_amdgcn_fence(__ATOMIC_RELEASE, "agent");
            asm volatile("s_waitcnt vmcnt(0)" ::: "memory");
            const unsigned og = xb_add(&bar[XB_TOP], 1u);
            const unsigned tg = og / nx;
            if (og + 1u == (tg + 1u) * nx) xb_add(&bar[XB_TOPGEN], 1u);
            else XB_SPIN(xb_ld(&bar[XB_TOPGEN]) == tg, bar);
            __builtin_amdgcn_fence(__ATOMIC_ACQUIRE, "agent");
            xb_add(&bar[XB_XGEN(b.x)], 1u);
            asm volatile("s_waitcnt vmcnt(0)" ::: "memory");
        } else {
            XB_SPIN(xb_ld(&bar[XB_XGEN(b.x)]) == gen, bar);
            __builtin_amdgcn_fence(__ATOMIC_ACQUIRE, "agent");
            asm volatile("s_waitcnt vmcnt(0)" ::: "memory");
        }
    }
    __syncthreads();
}

struct Args { const float* in[18]; float* out; unsigned char* ws; int lo, hi; };
struct Frame {
    LAS unsigned char* lds;
    int tid, lane, wave, vcu, G;
    const float *x, *meta, *norm_mix, *norm_ffn, *norm_final, *pool_w, *pool_scale, *w_in, *conv_w, *conv_b, *w_gates, *b_gates, *lam, *w_out, *router_w, *moe_g, *moe_u, *moe_d;
    float* out; unsigned char* ws;
    bf16 *WG1, *WD, *WIN, *WGT, *WOUT, *WPOOL;
    bf16* H; float* HF; bf16 *U, *P, *XB, *GY, *HG, *LA, *BV, *HID, *Y;
    float* AFF; int* SLOT; float* GMAP; int* ROWL; float* AGG; float* SPT; float* RSTD;
};

struct ProItem { const float* src; unsigned char* dst; const float* ks; int ldw, ldt, f8; };
__device__ __forceinline__ ProItem pro_decode(const Frame& F, int it) {
    constexpr int I_MOE = 64 * 512, I_IN = 2 * 512, I_OUT = 2 * 256, I_GT = 32 * 16;
    ProItem p; p.ks = nullptr; int r = it;
    if (r < 2 * I_MOE) {
        const int up = r >= I_MOE; if (up) r -= I_MOE;
        const int le = r >> 9, q = r & 511, k0 = (q >> 6) * 128, n0 = (q & 63) * 32;
        p.src = (up ? F.moe_u : F.moe_g) + (size_t)le * 1024 * 2048 + (size_t)k0 * 2048 + n0; p.ldw = 2048;
        p.dst = (unsigned char*)F.WG1 + ((size_t)le * 4096 + (n0 >> 7) * 256 + up * 128 + (n0 & 127)) * 1024 + k0; p.ldt = 1024; p.f8 = 1; return p; }
    r -= 2 * I_MOE;
    if (r < I_MOE) {
        const int le = r >> 9, q = r & 511, k0 = (q >> 5) * 128, n0 = (q & 31) * 32;
        p.src = F.moe_d + (size_t)le * 2048 * 1024 + (size_t)k0 * 1024 + n0; p.ldw = 1024;
        p.dst = (unsigned char*)F.WD + ((size_t)le * 1024 + n0) * WDP8 + k0; p.ldt = WDP8; p.f8 = 1; return p; }
    r -= I_MOE; p.f8 = 0;
    if (r < I_IN) {
        const int j = r >> 9, q = r & 511, k0 = (q >> 6) * 128, n0 = (q & 63) * 32;
        p.src = F.w_in + (size_t)j * 1024 * 2048 + (size_t)k0 * 2048 + n0; p.ldw = 2048; p.dst = (unsigned char*)(F.WIN + ((size_t)j * 2048 + n0) * 1024 + k0); p.ldt = 2048; p.ks = F.norm_mix + (size_t)(2 * j + 1) * D + k0; return p; }
    r -= I_IN;
    if (r < I_OUT) {
        const int j = r >> 8, q = r & 255, k0 = (q >> 5) * 128, n0 = (q & 31) * 32;
        p.src = F.w_out + (size_t)j * 1024 * 1024 + (size_t)k0 * 1024 + n0; p.ldw = 1024; p.dst = (unsigned char*)(F.WOUT + ((size_t)j * 1024 + n0) * 1024 + k0); p.ldt = 2048; return p; }
    r -= I_OUT;
    if (r < I_GT) {
        const int mat = r >> 4, q = r & 15, k0 = (q >> 3) * 128, n0 = (q & 7) * 32;
        const int j = mat >> 4, d = (mat >> 3) & 1, g = (mat >> 2) & 1, h = mat & 3, nt = d * 8 + h * 2 + (n0 >> 7);
        p.src = F.w_gates + (size_t)mat * 65536 + (size_t)k0 * 256 + n0; p.ldw = 256; p.dst = (unsigned char*)(F.WGT + (((size_t)j * 16 + nt) * 256 + g * 128 + (n0 & 127)) * 256 + k0); p.ldt = 512; return p; }
    r -= I_GT;
    {
        const int mat = r >> 4, q = r & 15, k0 = (q >> 3) * 128, n0 = (q & 7) * 32;
        p.src = F.pool_w + (size_t)mat * 65536 + (size_t)k0 * 256 + n0; p.ldw = 256; p.dst = (unsigned char*)(F.WPOOL + ((size_t)mat * 256 + n0) * 256 + k0); p.ldt = 512; return p; }
}
__device__ __forceinline__ void pro_load(const ProItem& p, f32x4 (&v)[16], int lane) {
    const int rr = lane >> 3, sg = lane & 7;
#pragma unroll
    for (int i = 0; i < 16; ++i) v[i] = __builtin_nontemporal_load((const f32x4*)(p.src + (size_t)(8 * i + rr) * p.ldw + 4 * sg));
}
__device__ __forceinline__ void pro_finish(const ProItem& p, const f32x4 (&v)[16], LAS float* scr, int lane) {
    { const int rr = lane >> 3, sg = lane & 7;
#pragma unroll
        for (int i = 0; i < 16; ++i) *(LAS f32x4*)(scr + (8 * i + rr) * 32 + ((4 * sg) ^ (((i >> 1) & 3) << 3))) = v[i]; }
    asm volatile("s_waitcnt lgkmcnt(0)" ::: "memory");
    const int c = lane & 7;
#pragma unroll
    for (int j = 0; j < 4; ++j) { const int n = (lane >> 3) + 8 * j; const LAS float* s = scr + (16 * c) * 32 + (n ^ ((c & 3) << 3));
        float t[16];
#pragma unroll
        for (int q = 0; q < 16; ++q) t[q] = s[q * 32];
        if (p.f8) { u32x4 o; o.x = pk4_fp8(t[0] * WSCALE, t[1] * WSCALE, t[2] * WSCALE, t[3] * WSCALE); o.y = pk4_fp8(t[4] * WSCALE, t[5] * WSCALE, t[6] * WSCALE, t[7] * WSCALE);
            o.z = pk4_fp8(t[8] * WSCALE, t[9] * WSCALE, t[10] * WSCALE, t[11] * WSCALE); o.w = pk4_fp8(t[12] * WSCALE, t[13] * WSCALE, t[14] * WSCALE, t[15] * WSCALE);
            __builtin_nontemporal_store(o, (u32x4*)(p.dst + (size_t)n * p.ldt + 16 * c)); }
        else { if (p.ks) { const float* ks = p.ks + 16 * c;
#pragma unroll
                for (int q4 = 0; q4 < 4; ++q4) { const f32x4 g4 = *(const f32x4*)(ks + 4 * q4); t[4 * q4] *= g4.x; t[4 * q4 + 1] *= g4.y; t[4 * q4 + 2] *= g4.z; t[4 * q4 + 3] *= g4.w; } }
            u32x4 o0, o1; o0.x = cvt_pk_bf16(t[0], t[1]); o0.y = cvt_pk_bf16(t[2], t[3]); o0.z = cvt_pk_bf16(t[4], t[5]); o0.w = cvt_pk_bf16(t[6], t[7]);
            o1.x = cvt_pk_bf16(t[8], t[9]); o1.y = cvt_pk_bf16(t[10], t[11]); o1.z = cvt_pk_bf16(t[12], t[13]); o1.w = cvt_pk_bf16(t[14], t[15]);
            unsigned char* d = p.dst + (size_t)n * p.ldt + 32 * c; __builtin_nontemporal_store(o0, (u32x4*)d); __builtin_nontemporal_store(o1, (u32x4*)(d + 16)); } }
    asm volatile("s_waitcnt lgkmcnt(0)" ::: "memory");
}
__device__ __forceinline__ void phase_prologue(const Frame& F) {
    LAS float* scr = (LAS float*)(F.lds + F.wave * 16384);
    const int gw = F.vcu * 8 + F.wave, NGW = F.G * 8, lane = F.lane;
    for (int i = gw * 64 + lane; i < 4 * D; i += NGW * 64) F.SPT[i] = -8.0f * log1pf(expf(-F.lam[i]));
    constexpr int NITEMS = 3 * 64 * 512 + 2 * 512 + 2 * 256 + 32 * 16 + 8 * 16;
    int it = gw; if (it >= NITEMS) return;
    ProItem cur = pro_decode(F, it); f32x4 v[16], w[16]; pro_load(cur, v, lane);
    for (;;) {
        const int nit = it + NGW; const bool more = nit < NITEMS; ProItem nxt = cur;
        if (more) nxt = pro_decode(F, nit);
        pro_load(nxt, w, lane);
        pro_finish(cur, v, scr, lane);
        if (!more) break;
        cur = nxt; it = nit;
#pragma unroll
        for (int i = 0; i < 16; ++i) v[i] = w[i];
    }
}

template <bool FINAL, bool FIRST, bool DRY = false>
__device__ __forceinline__ void phase_rowA(const Frame& F, int layer) {
    const int gw = F.vcu * 8 + F.wave, NGW = F.G * 8, lane = F.lane;
    const float* gain = FINAL ? F.norm_final : F.norm_mix + layer * D;
    f32x4 gn[4];
#pragma unroll
    for (int j = 0; j < 4; ++j) gn[j] = *(const f32x4*)(gain + 4 * lane + 256 * j);
    const int rend = FINAL ? MMAIN : MROWS;
    int sl_n = -1; float gg_n = 0.f;
    if (!FIRST) { if (lane < 16 && gw < rend) { sl_n = F.SLOT[(size_t)gw * 16 + lane]; gg_n = F.GMAP[(size_t)gw * 16 + lane]; } }
    for (int r = gw; r < rend; r += NGW) {
        f32x4 v[4];
        if (FIRST) {
            const float* src = r < MMAIN ? F.x + (size_t)r * D : F.meta + (size_t)((r - MMAIN) & 15) * D;
#pragma unroll
            for (int j = 0; j < 4; ++j) v[j] = *(const f32x4*)(src + 4 * lane + 256 * j);
        } else {
            const int sl = sl_n; const float gg = gg_n;
            const bf16* src = F.H + (size_t)r * D;
#pragma unroll
            for (int j = 0; j < 4; ++j) { const u32x2 w = *(const u32x2*)(src + 4 * lane + 256 * j); v[j] = (f32x4){bflo(w.x), bfhi(w.x), bflo(w.y), bfhi(w.y)}; }
            { const int rn = r + NGW; sl_n = -1; if (lane < 16 && rn < rend) { sl_n = F.SLOT[(size_t)rn * 16 + lane]; gg_n = F.GMAP[(size_t)rn * 16 + lane]; } }
            unsigned mask = (unsigned)__ballot(sl >= 0) & 0xffffu;
            while (mask) {
                int ee[4]; float gq[4]; const unsigned char* yr[4];
#pragma unroll
                for (int q = 0; q < 4; ++q) { const bool on = mask != 0u; const int e = on ? (__builtin_ffs((int)mask) - 1) : 0; mask &= mask - 1u;
                    const int s = __builtin_amdgcn_readlane(sl, e); const float g = __uint_as_float(__builtin_amdgcn_readlane(__float_as_uint(gg), e));
                    ee[q] = e; gq[q] = on ? g : 0.f; yr[q] = (const unsigned char*)F.Y + ((size_t)e * EPAD + (on ? s : 0)) * D; }
                unsigned w[4][4];
#pragma unroll
                for (int q = 0; q < 4; ++q)
#pragma unroll
                    for (int j = 0; j < 4; ++j) w[q][j] = *(const unsigned*)(yr[q] + 4 * lane + 256 * j);
#pragma unroll
                for (int q = 0; q < 4; ++q)
#pragma unroll
                    for (int j = 0; j < 4; ++j) v[j] += fp8x4_to_f32(w[q][j]) * gq[q];
                (void)ee;
            }
        }
        if (!FINAL && !DRY) {
            bf16* dst = F.H + (size_t)r * D;
#pragma unroll
            for (int j = 0; j < 4; ++j) { u32x2 w; w.x = cvt_pk_bf16(v[j].x, v[j].y); w.y = cvt_pk_bf16(v[j].z, v[j].w); *(u32x2*)(dst + 4 * lane + 256 * j) = w; }
        }
        float ss = 0.f;
#pragma unroll
        for (int j = 0; j < 4; ++j) ss += (v[j].x * v[j].x + v[j].y * v[j].y) + (v[j].z * v[j].z + v[j].w * v[j].w);
        const float rstd = 1.0f / sqrtf(wave_sum(ss) * (1.0f / D) + RMS_EPS);
        if (FINAL) {
            float* dst = F.out + (size_t)r * D;
#pragma unroll
            for (int j = 0; j < 4; ++j) *(f32x4*)(dst + 4 * lane + 256 * j) = v[j] * rstd * gn[j];
        } else {
            if (lane == 0) F.RSTD[r] = rstd;
        }
    }
}
__device__ __forceinline__ void phase_rowB(const Frame& F, int layer) {
    const int gw = F.vcu * 8 + F.wave, NGW = F.G * 8, lane = F.lane;
    LAS float* wT = (LAS float*)F.lds;
    const float* rw = F.router_w + (size_t)layer * D * NE;
    const float* gain = F.norm_ffn + layer * D;
    f32x4 gn[4];
#pragma unroll
    for (int j = 0; j < 4; ++j) gn[j] = *(const f32x4*)(gain + 4 * lane + 256 * j);
    f32x4 nx[2][4];
#pragma unroll
    for (int q = 0; q < 2; ++q) { const int r = gw + q * NGW; const bf16* src = F.H + (size_t)(r < MROWS ? r : gw) * D;
#pragma unroll
        for (int j = 0; j < 4; ++j) { const u32x2 w = *(const u32x2*)(src + 4 * lane + 256 * j); nx[q][j] = (f32x4){bflo(w.x), bfhi(w.x), bflo(w.y), bfhi(w.y)}; } }
    {
        f32x4 rv[8];
#pragma unroll
        for (int i = 0; i < 8; ++i) rv[i] = *(const f32x4*)(rw + 4 * (F.tid + 512 * i));
#pragma unroll
        for (int i = 0; i < 8; ++i) { const int i4 = F.tid + 512 * i, c = i4 >> 2, e = (i4 & 3) * 4; wT[e * 1024 + c] = rv[i].x; wT[(e + 1) * 1024 + c] = rv[i].y; wT[(e + 2) * 1024 + c] = rv[i].z; wT[(e + 3) * 1024 + c] = rv[i].w; }
    }
    __syncthreads();
    for (int r0 = gw; r0 < MROWS; r0 += 2 * NGW) {
        f32x4 v[2][4];
#pragma unroll
        for (int q = 0; q < 2; ++q)
#pragma unroll
            for (int j = 0; j < 4; ++j) v[q][j] = nx[q][j];
#pragma unroll
        for (int q = 0; q < 2; ++q) { const int r = r0 + (2 + q) * NGW; const bf16* src = F.H + (size_t)(r < MROWS ? r : gw) * D;
#pragma unroll
            for (int j = 0; j < 4; ++j) { const u32x2 w = *(const u32x2*)(src + 4 * lane + 256 * j); nx[q][j] = (f32x4){bflo(w.x), bfhi(w.x), bflo(w.y), bfhi(w.y)}; } }
        const bool has1 = (r0 + NGW) < MROWS;
#pragma unroll
        for (int q = 0; q < 2; ++q) {
            float ss = 0.f;
#pragma unroll
            for (int j = 0; j < 4; ++j) ss += (v[q][j].x * v[q][j].x + v[q][j].y * v[q][j].y) + (v[q][j].z * v[q][j].z + v[q][j].w * v[q][j].w);
            const float rstd = 1.0f / sqrtf(wave_sum(ss) * (1.0f / D) + RMS_EPS);
            const int r = r0 + q * NGW;
#pragma unroll
            for (int j = 0; j < 4; ++j) v[q][j] = v[q][j] * rstd * gn[j];
            if (q == 0 || has1) { unsigned char* dst = (unsigned char*)F.U + (size_t)r * D;
#pragma unroll
                for (int j = 0; j < 4; ++j) *(unsigned*)(dst + 4 * lane + 256 * j) = pk4_fp8(v[q][j].x, v[q][j].y, v[q][j].z, v[q][j].w); }
        }
        float val[32];
        const int woff = opaque(4 * lane);
#pragma unroll
        for (int e = 0; e < 16; ++e) { f32x2 p0 = (f32x2){0.f, 0.f}, p1 = p0;
#pragma unroll
            for (int j = 0; j < 4; ++j) { const f32x4 w = *(const LAS f32x4*)(wT + e * 1024 + woff + 256 * j); const f32x2 wl = (f32x2){w.x, w.y}, wh = (f32x2){w.z, w.w};
                p0 += (f32x2){v[0][j].x, v[0][j].y} * wl; p0 += (f32x2){v[0][j].z, v[0][j].w} * wh; p1 += (f32x2){v[1][j].x, v[1][j].y} * wl; p1 += (f32x2){v[1][j].z, v[1][j].w} * wh; }
            val[e] = p0.x + p0.y; val[16 + e] = p1.x + p1.y; }
#define BFLY(S, HH) { const bool up = (lane >> (S)) & 1; _Pragma("unroll") for (int i = 0; i < (HH); ++i) { const float keep = up ? val[(HH) + i] : val[i], send = up ? val[i] : val[(HH) + i]; val[i] = keep + __shfl_xor(send, 1 << (S)); } }
        BFLY(0, 16) BFLY(1, 8) BFLY(2, 4) BFLY(3, 2) BFLY(4, 1)
#undef BFLY
        float lg = val[0] + __shfl_xor(val[0], 32);
        const int vi = ((lane & 1) << 4) | ((lane & 2) << 2) | (lane & 4) | ((lane & 8) >> 2) | ((lane & 16) >> 4);
        float mx = lg;
#pragma unroll
        for (int o = 2; o <= 16; o <<= 1) mx = fmaxf(mx, __shfl_xor(mx, o));
        const float p = expf(lg - mx); float sum = p;
#pragma unroll
        for (int o = 2; o <= 16; o <<= 1) sum += __shfl_xor(sum, o);
        const int q = vi >> 4, e = vi & 15, r = r0 + q * NGW;
        if (lane < 32 && (q == 0 || has1)) {
            int b, t; if (r < MMAIN) { b = r >> 12; t = (r & 4095) + NMETA; } else { b = (r - MMAIN) >> 4; t = (r - MMAIN) & 15; }
            F.AFF[((size_t)b * NE + e) * T + t] = p / sum;
        }
    }
    __syncthreads();
}

__device__ __forceinline__ int block_excl_scan(int v, LAS int* wsum, int tid, int lane, int wave, int& total) {
    int s = v;
#pragma unroll
    for (int o = 1; o < 64; o <<= 1) { const int t = __shfl_up(s, o); if (lane >= o) s += t; }
    __syncthreads();
    if (lane == 63) wsum[wave] = s;
    __syncthreads();
    int base = 0, tot = 0;
#pragma unroll
    for (int w = 0; w < 8; ++w) { const int x = wsum[w]; if (w < wave) base += x; tot += x; }
    total = tot;
    return base + s - v;
}
__device__ __forceinline__ void phase_topk(const Frame& F) {
    LAS unsigned* keys = (LAS unsigned*)F.lds;
    LAS int* hist = (LAS int*)(F.lds + 20480);
    LAS int* misc = (LAS int*)(F.lds + 20480 + 1024);
    const int tid = F.tid, lane = F.lane, wave = F.wave;
    for (int task = blockIdx.x; task < NB * NE; task += F.G) {
        const int b = task >> 4, e = task & 15;
        const float* aff = F.AFF + ((size_t)b * NE + e) * T;
        __syncthreads();
        {   unsigned kv[9];
#pragma unroll
            for (int i = 0; i < 9; ++i) { const int t = tid + 512 * i; kv[i] = __float_as_uint(aff[t < T ? t : T - 1]); }
#pragma unroll
            for (int i = 0; i < 9; ++i) { const int t = tid + 512 * i; if (t < T) keys[t] = kv[i]; } }
        unsigned prefix = 0u, pmask = 0u; int need = CAP;
        for (int p = 3; p >= 0; --p) {
            if (tid < 256) hist[tid] = 0;
            __syncthreads();
            for (int t = tid; t < T; t += 512) { const unsigned k = keys[t]; if ((k & pmask) == prefix) __hip_atomic_fetch_add(&hist[(k >> (8 * p)) & 255u], 1, __ATOMIC_RELAXED, __HIP_MEMORY_SCOPE_WORKGROUP); }
            __syncthreads();
            if (wave == 0) {
                int c[4]; int tot = 0;
#pragma unroll
                for (int q = 0; q < 4; ++q) { c[q] = hist[4 * lane + q]; tot += c[q]; }
                int s = tot;
#pragma unroll
                for (int o = 1; o < 64; o <<= 1) { const int x = __shfl_down(s, o); if (lane + o < 64) s += x; }
                int above = s - tot;
                if (above < need && need <= s) {
                    int a = above;
#pragma unroll
                    for (int q = 3; q >= 0; --q) { if (need <= a + c[q] && need > a) { misc[0] = 4 * lane + q; misc[1] = need - a; } a += c[q]; }
                }
            }
            __syncthreads();
            prefix |= (unsigned)misc[0] << (8 * p); pmask |= 0xFFu << (8 * p); need = misc[1];
            __syncthreads();
        }
        const unsigned vstar = prefix;
        const int t0 = tid * 9, t1 = (t0 + 9 < T) ? t0 + 9 : T;
        int neq = 0;
        for (int t = t0; t < t1; ++t) neq += (keys[t] == vstar) ? 1 : 0;
        int toteq; int eqbase = block_excl_scan(neq, misc + 8, tid, lane, wave, toteq);
        int nsel = 0; unsigned selmask = 0u; { int er = eqbase;
            for (int t = t0; t < t1; ++t) { const unsigned k = keys[t]; bool s = k > vstar; if (k == vstar) { s = er < need; ++er; } if (s) { selmask |= 1u << (t - t0); ++nsel; } } }
        int totsel; int sbase = block_excl_scan(nsel, misc + 8, tid, lane, wave, totsel);
        for (int t = t0; t < t1; ++t) {
            const int row = row_of(b, t);
            if ((selmask >> (t - t0)) & 1u) { const int pos = b * CAP + sbase; ++sbase;
                F.ROWL[e * EPAD + pos] = row; F.SLOT[(size_t)row * 16 + e] = pos; F.GMAP[(size_t)row * 16 + e] = __uint_as_float(keys[t]); }
            else F.SLOT[(size_t)row * 16 + e] = -1;
        }
        if (b == 0 && tid < EPAD - EROWS) F.ROWL[e * EPAD + EROWS + tid] = 0;
    }
    __syncthreads();
}

__device__ __forceinline__ void phase_poolwin(const Frame& F, int layer) {
    const int gw = F.vcu * 8 + F.wave, NGW = F.G * 8, lane = F.lane;
    constexpr int CHS = 33, NTC = (T + CHS - 1) / CHS;
    for (int it = gw; it < NB * NTC * 2; it += NGW) {
        const int half = it & 1, tc = (it >> 1) % NTC, b = (it >> 1) / NTC;
        const int col = half * 512 + lane * 8, g = col >> 8, hw = 1 << g;
        const int t0 = tc * CHS, t1 = (t0 + CHS < T) ? t0 + CHS : T;
        float sum[8];
#pragma unroll
        for (int q = 0; q < 8; ++q) sum[q] = 0.f;
        const u32x4 zero4 = (u32x4){0u, 0u, 0u, 0u};
        const bf16* ucol = F.H + col;
        float gnv[8];
        { const float* gp = F.norm_mix + (size_t)layer * D + col; const f32x4 g0 = *(const f32x4*)gp, g1 = *(const f32x4*)(gp + 4); gnv[0] = g0.x; gnv[1] = g0.y; gnv[2] = g0.z; gnv[3] = g0.w; gnv[4] = g1.x; gnv[5] = g1.y; gnv[6] = g1.z; gnv[7] = g1.w; }
#define PW_FMA(V_, S_) do { sum[0] += bflo(V_.x) * (S_); sum[1] += bfhi(V_.x) * (S_); sum[2] += bflo(V_.y) * (S_); sum[3] += bfhi(V_.y) * (S_); sum[4] += bflo(V_.z) * (S_); sum[5] += bfhi(V_.z) * (S_); sum[6] += bflo(V_.w) * (S_); sum[7] += bfhi(V_.w) * (S_); } while (0)
        {
            u32x4 iw[16]; float ir[16];
#pragma unroll
            for (int q = 0; q < 16; ++q) { const int dt = q - 8, tt = t0 + dt; const bool v = dt >= -hw && dt < hw && tt >= 0 && tt < T; const int row = row_of(b, v ? tt : t0); iw[q] = *(const u32x4*)(ucol + (size_t)row * D); ir[q] = F.RSTD[row]; }
#pragma unroll
            for (int q = 0; q < 16; ++q) { const int dt = q - 8, tt = t0 + dt; const bool v = dt >= -hw && dt < hw && tt >= 0 && tt < T; const float sc = v ? ir[q] : 0.f; PW_FMA(iw[q], sc); }
        }
        for (int tb = t0; tb < t1; tb += 11) {
            u32x4 c[11], wp[11], wm[11]; float rc[11], rp[11], rm[11];
#pragma unroll
            for (int q = 0; q < 11; ++q) { const int t = (tb + q < t1) ? tb + q : t1 - 1; const bool vp = t + hw < T, vm = t - hw >= 0;
                const int r0_ = row_of(b, t), r1_ = row_of(b, vp ? t + hw : t), r2_ = row_of(b, vm ? t - hw : t);
                c[q] = *(const u32x4*)(ucol + (size_t)r0_ * D); wp[q] = *(const u32x4*)(ucol + (size_t)r1_ * D); wm[q] = *(const u32x4*)(ucol + (size_t)r2_ * D);
                rc[q] = F.RSTD[r0_]; rp[q] = F.RSTD[r1_]; rm[q] = F.RSTD[r2_]; }
#pragma unroll
            for (int q = 0; q < 11; ++q) { const int t = tb + q;
                if (t < t1) {
                    const int lo = (t - hw > 0) ? t - hw : 0, hi = (t + hw < T) ? t + hw : T;
                    const float inv = 1.0f / (float)(hi - lo), cs = rc[q];
                    u32x4 o;
                    o.x = cvt_pk_bf16((sum[0] * inv - bflo(c[q].x) * cs) * gnv[0], (sum[1] * inv - bfhi(c[q].x) * cs) * gnv[1]); o.y = cvt_pk_bf16((sum[2] * inv - bflo(c[q].y) * cs) * gnv[2], (sum[3] * inv - bfhi(c[q].y) * cs) * gnv[3]);
                    o.z = cvt_pk_bf16((sum[4] * inv - bflo(c[q].z) * cs) * gnv[4], (sum[5] * inv - bfhi(c[q].z) * cs) * gnv[5]); o.w = cvt_pk_bf16((sum[6] * inv - bflo(c[q].w) * cs) * gnv[6], (sum[7] * inv - bfhi(c[q].w) * cs) * gnv[7]);
                    *(u32x4*)(F.P + (size_t)row_of(b, t) * D + col) = o;
                    const float sa = (t + hw < T) ? rp[q] : 0.f, sm = (t - hw >= 0) ? -rm[q] : 0.f;
                    PW_FMA(wp[q], sa); PW_FMA(wm[q], sm);
                }
            }
        }
#undef PW_FMA
    }
}
__device__ __forceinline__ void phase_conv(const Frame& F, int j) {
    const int gw = F.vcu * 8 + F.wave, NGW = F.G * 8, lane = F.lane;
    constexpr int CHS = 33, NTC = (T + CHS - 1) / CHS;
    const float* cw = F.conv_w + (size_t)j * 4 * D; const float* cb = F.conv_b + (size_t)j * D;
    for (int it = gw; it < NB * NTC * 2; it += NGW) {
        const int half = it & 1, tc = (it >> 1) % NTC, b = (it >> 1) / NTC;
        const int col = half * 512 + lane * 8;
        const int t0 = tc * CHS, t1 = (t0 + CHS < T) ? t0 + CHS : T;
        float w[4][8], bias[8];
#pragma unroll
        for (int k = 0; k < 4; ++k) { const f32x4 a = *(const f32x4*)(cw + k * D + col), c = *(const f32x4*)(cw + k * D + col + 4);
            w[k][0] = a.x; w[k][1] = a.y; w[k][2] = a.z; w[k][3] = a.w; w[k][4] = c.x; w[k][5] = c.y; w[k][6] = c.z; w[k][7] = c.w; }
        { const f32x4 a = *(const f32x4*)(cb + col), c = *(const f32x4*)(cb + col + 4); bias[0] = a.x; bias[1] = a.y; bias[2] = a.z; bias[3] = a.w; bias[4] = c.x; bias[5] = c.y; bias[6] = c.z; bias[7] = c.w; }
        u32x4 xm1 = (u32x4){0u, 0u, 0u, 0u}, x0 = xm1, xp1 = xm1, xp2 = xm1;
        if (t0 - 1 >= 0) xm1 = *(const u32x4*)(F.XB + (size_t)row_of(b, t0 - 1) * D + col);
        x0 = *(const u32x4*)(F.XB + (size_t)row_of(b, t0) * D + col);
        if (t0 + 1 < T) xp1 = *(const u32x4*)(F.XB + (size_t)row_of(b, t0 + 1) * D + col);
        for (int tb = t0; tb < t1; tb += 11) {
            u32x4 xn[11];
#pragma unroll
            for (int q = 0; q < 11; ++q) { const int tt = tb + q + 2; xn[q] = *(const u32x4*)(F.XB + (size_t)row_of(b, tt < T ? tt : T - 1) * D + col); }
#pragma unroll
            for (int q = 0; q < 11; ++q) { const int t = tb + q;
                if (t < t1) {
                    xp2 = (t + 2 < T) ? xn[q] : (u32x4){0u, 0u, 0u, 0u};
                    float o[8];
#define CONV2(q_, m) o[2 * q_] = bias[2 * q_] + w[0][2 * q_] * bflo(xm1.m) + w[1][2 * q_] * bflo(x0.m) + w[2][2 * q_] * bflo(xp1.m) + w[3][2 * q_] * bflo(xp2.m); \
                     o[2 * q_ + 1] = bias[2 * q_ + 1] + w[0][2 * q_ + 1] * bfhi(xm1.m) + w[1][2 * q_ + 1] * bfhi(x0.m) + w[2][2 * q_ + 1] * bfhi(xp1.m) + w[3][2 * q_ + 1] * bfhi(xp2.m);
                    CONV2(0, x) CONV2(1, y) CONV2(2, z) CONV2(3, w)
#undef CONV2
                    u32x4 ov; ov.x = cvt_pk_bf16(o[0], o[1]); ov.y = cvt_pk_bf16(o[2], o[3]); ov.z = cvt_pk_bf16(o[4], o[5]); ov.w = cvt_pk_bf16(o[6], o[7]);
                    *(u32x4*)(F.P + (size_t)row_of(b, t) * D + col) = ov;
                    xm1 = x0; x0 = xp1; xp1 = xp2;
                }
            }
        }
    }
}
__device__ __forceinline__ void chunk_rows(int b, int k, int& r0, int& n) { if (k == 0) { r0 = MMAIN + b * NMETA; n = NMETA; } else { r0 = b * SEQ + (k - 1) * 256; n = 256; } }
__device__ __forceinline__ void phase_scan1(const Frame& F) {
    const int lane = F.lane;
    for (int it = F.wave * F.G + F.vcu; it < 2 * NB * NCHUNK * 8; it += 8 * F.G) {
        int cq, k, b, d;
        if (it < 2048) { cq = it & 7; k = 1 + ((it >> 3) & 15); b = (it >> 7) & 7; d = it >> 10; } else { const int u = it - 2048; cq = u & 7; k = 0; b = (u >> 3) & 7; d = u >> 6; }
        const int c0 = cq * 128 + lane * 2;
        int r0, n; chunk_rows(b, k, r0, n);
        const bf16* la = F.LA + (size_t)d * MPAD * D + c0; const bf16* bv = F.BV + (size_t)d * MPAD * D + c0;
        float h0 = 0.f, h1 = 0.f, s0 = 0.f, s1 = 0.f;
        for (int s = 0; s < n; s += 32) {
            unsigned lw[32], bw[32];
#pragma unroll
            for (int q = 0; q < 32; ++q) { const int sq = (s + q < n) ? s + q : n - 1; const int r = d ? (r0 + n - 1 - sq) : (r0 + sq); lw[q] = *(const unsigned*)(la + (size_t)r * D); bw[q] = *(const unsigned*)(bv + (size_t)r * D); }
#pragma unroll
            for (int q = 0; q < 32; ++q) { const bool ok = s + q < n; const unsigned lq = ok ? lw[q] : 0u, bq = ok ? bw[q] : 0u;
                const float l0 = bflo(lq), l1 = bfhi(lq); s0 += l0; s1 += l1; h0 = fast_exp(l0) * h0 + bflo(bq); h1 = fast_exp(l1) * h1 + bfhi(bq); }
        }
        float* agg = F.AGG + ((size_t)(d * NB + b) * NCHUNK + k) * D + c0;
        *(f32x2*)agg = (f32x2){s0, s1};
        *(f32x2*)(agg + (size_t)2 * NB * NCHUNK * D) = (f32x2){h0, h1};
    }
}
__device__ __forceinline__ void phase_scan3(const Frame& F) {
    const int lane = F.lane;
    constexpr size_t HOFF = (size_t)2 * NB * NCHUNK * D;
    bf16* HX = (bf16*)F.HF;
    for (int it = F.wave * F.G + F.vcu; it < NB * NCHUNK * 8; it += 8 * F.G) {
        const int cq = it & 7, k = (it >> 3) % NCHUNK, b = (it >> 3) / NCHUNK;
        const int c0 = cq * 128 + lane * 2;
        int r0, n; chunk_rows(b, k, r0, n);
        const int half = n >> 1;
        float hf0 = 0.f, hf1 = 0.f, hb0 = 0.f, hb1 = 0.f;
        for (int jx = 0; jx < k; ++jx) { const float* agg = F.AGG + ((size_t)(0 * NB + b) * NCHUNK + jx) * D + c0; const f32x2 al = *(const f32x2*)agg, he = *(const f32x2*)(agg + HOFF);
            hf0 = fast_exp(al.x) * hf0 + he.x; hf1 = fast_exp(al.y) * hf1 + he.y; }
        for (int jx = NCHUNK - 1; jx > k; --jx) { const float* agg = F.AGG + ((size_t)(1 * NB + b) * NCHUNK + jx) * D + c0; const f32x2 al = *(const f32x2*)agg, he = *(const f32x2*)(agg + HOFF);
            hb0 = fast_exp(al.x) * hb0 + he.x; hb1 = fast_exp(al.y) * hb1 + he.y; }
        const bf16* laf = F.LA + c0; const bf16* bvf = F.BV + c0; const bf16* lab = laf + (size_t)MPAD * D; const bf16* bvb = bvf + (size_t)MPAD * D;
        for (int s = 0; s < half; s += 8) {
            unsigned lf[8], bf_[8], lb[8], bb[8];
#pragma unroll
            for (int q = 0; q < 8; ++q) { const size_t rf = (size_t)(r0 + s + q) * D, rb = (size_t)(r0 + n - 1 - s - q) * D;
                lf[q] = *(const unsigned*)(laf + rf); bf_[q] = *(const unsigned*)(bvf + rf); lb[q] = *(const unsigned*)(lab + rb); bb[q] = *(const unsigned*)(bvb + rb); }
#pragma unroll
            for (int q = 0; q < 8; ++q) { const size_t rf = (size_t)(r0 + s + q) * D, rb = (size_t)(r0 + n - 1 - s - q) * D;
                hf0 = fast_exp(bflo(lf[q])) * hf0 + bflo(bf_[q]); hf1 = fast_exp(bfhi(lf[q])) * hf1 + bfhi(bf_[q]); *(unsigned*)(HX + rf + c0) = cvt_pk_bf16(hf0, hf1);
                hb0 = fast_exp(bflo(lb[q])) * hb0 + bflo(bb[q]); hb1 = fast_exp(bfhi(lb[q])) * hb1 + bfhi(bb[q]); *(unsigned*)(HX + rb + c0) = cvt_pk_bf16(hb0, hb1); }
        }
        asm volatile("s_waitcnt vmcnt(0)" ::: "memory");
        for (int s = half; s < n; s += 8) {
            unsigned lf[8], bf_[8], lb[8], bb[8], xf[8], gf[8], xb[8], gb[8];
#pragma unroll
            for (int q = 0; q < 8; ++q) { const size_t rf = (size_t)(r0 + s + q) * D, rb = (size_t)(r0 + n - 1 - s - q) * D;
                lf[q] = *(const unsigned*)(laf + rf); bf_[q] = *(const unsigned*)(bvf + rf); lb[q] = *(const unsigned*)(lab + rb); bb[q] = *(const unsigned*)(bvb + rb);
                xf[q] = *(const unsigned*)(HX + rf + c0); gf[q] = *(const unsigned*)(F.GY + rf + c0); xb[q] = *(const unsigned*)(HX + rb + c0); gb[q] = *(const unsigned*)(F.GY + rb + c0); }
#pragma unroll
            for (int q = 0; q < 8; ++q) { const size_t rf = (size_t)(r0 + s + q) * D, rb = (size_t)(r0 + n - 1 - s - q) * D;
                hf0 = fast_exp(bflo(lf[q])) * hf0 + bflo(bf_[q]); hf1 = fast_exp(bfhi(lf[q])) * hf1 + bfhi(bf_[q]);
                *(unsigned*)(F.HG + rf + c0) = cvt_pk_bf16((hf0 + bflo(xf[q])) * bflo(gf[q]), (hf1 + bfhi(xf[q])) * bfhi(gf[q]));
                hb0 = fast_exp(bflo(lb[q])) * hb0 + bflo(bb[q]); hb1 = fast_exp(bfhi(lb[q])) * hb1 + bfhi(bb[q]);
                *(unsigned*)(F.HG + rb + c0) = cvt_pk_bf16((bflo(xb[q]) + hb0) * bflo(gb[q]), (bfhi(xb[q]) + hb1) * bfhi(gb[q])); }
        }
    }
}

struct TaskMap { int ntask, ncb, rb0, rbstride; };
template <class Fn>
__device__ __forceinline__ void wave_gemm(const Fn& fn, const TaskMap tm, int gw, int ngw, int lane_) {
    const int lane = opaque(lane_), fr = lane & 15, fq = lane >> 4;
    for (int task = gw; task < tm.ntask; task += ngw) {
        const int cb = task % tm.ncb, rb = tm.rb0 + (task / tm.ncb) * tm.rbstride;
        const bf16* ap[2]; const bf16* bp[4];
#pragma unroll
        for (int mi = 0; mi < 2; ++mi) ap[mi] = fn.arow(rb, cb, mi * 16 + fr) + 8 * fq;
#pragma unroll
        for (int nb = 0; nb < 4; ++nb) bp[nb] = fn.brow(rb, cb, nb * 16 + fr) + 8 * fq;
        f32x4 acc[2][4];
#pragma unroll
        for (int mi = 0; mi < 2; ++mi)
#pragma unroll
            for (int nb = 0; nb < 4; ++nb) acc[mi][nb] = (f32x4){0.f, 0.f, 0.f, 0.f};
#pragma unroll 2
        for (int k0 = 0; k0 < fn.K; k0 += 32) {
            bf16x8 a[2], bb[4];
#pragma unroll
            for (int mi = 0; mi < 2; ++mi) a[mi] = *(const bf16x8*)(ap[mi] + k0);
#pragma unroll
            for (int nb = 0; nb < 4; ++nb) bb[nb] = *(const bf16x8*)(bp[nb] + k0);
#pragma unroll
            for (int mi = 0; mi < 2; ++mi)
#pragma unroll
                for (int nb = 0; nb < 4; ++nb) acc[mi][nb] = __builtin_amdgcn_mfma_f32_16x16x32_bf16(bb[nb], a[mi], acc[mi][nb], 0, 0, 0);
        }
#pragma unroll
        for (int mi = 0; mi < 2; ++mi)
#pragma unroll
            for (int nb = 0; nb < (Fn::PAIRED ? 2 : 4); ++nb) fn.epi_blk(rb, cb, mi, nb, acc[mi][nb], acc[mi][Fn::PAIRED ? nb + 2 : nb], fr, fq);
    }
}
struct FnPool {
    static constexpr int nrb = MROWS / 32, ncb = 16, K = 256; static constexpr bool PAIRED = false;
    const bf16* P; const bf16* W; bf16* H; const float* scale;
    __device__ __forceinline__ const bf16* arow(int rb, int cb, int r) const { return P + (size_t)(rb * 32 + r) * D + (cb >> 2) * 256; }
    __device__ __forceinline__ const bf16* brow(int rb, int cb, int n) const { return W + (size_t)(cb * 64 + n) * 256; }
    __device__ __forceinline__ void epi_blk(int rb, int cb, int mi, int nb, const f32x4& v, const f32x4&, int fr, int fq) const {
        const int c = cb * 64 + nb * 16 + 4 * fq; bf16* p = H + (size_t)(rb * 32 + mi * 16 + fr) * D + c; const u32x2 w = *(const u32x2*)p; const f32x4 o = (f32x4){bflo(w.x), bfhi(w.x), bflo(w.y), bfhi(w.y)} + v * *(const f32x4*)(scale + c);
        u32x2 ow; ow.x = cvt_pk_bf16(o.x, o.y); ow.y = cvt_pk_bf16(o.z, o.w); *(u32x2*)p = ow; }
};
struct FnIn {
    static constexpr int nrb = MROWS / 32, ncb = 32, K = 1024; static constexpr bool PAIRED = false;
    const bf16* U; const bf16* W; bf16* XB; bf16* GY; const float* RS;
    __device__ __forceinline__ const bf16* arow(int rb, int cb, int r) const { return U + (size_t)(rb * 32 + r) * D; }
    __device__ __forceinline__ const bf16* brow(int rb, int cb, int n) const { return W + (size_t)(cb * 64 + n) * 1024; }
    __device__ __forceinline__ void epi_blk(int rb, int cb, int mi, int nb, const f32x4& v_, const f32x4&, int fr, int fq) const {
        const int c = cb * 64 + nb * 16 + 4 * fq; const size_t ro = (size_t)(rb * 32 + mi * 16 + fr) * D; u32x2 w; const f32x4 v = v_ * RS[rb * 32 + mi * 16 + fr];
        if (cb < 16) { w.x = cvt_pk_bf16(v.x, v.y); w.y = cvt_pk_bf16(v.z, v.w); *(u32x2*)(XB + ro + c) = w; }
        else { w.x = cvt_pk_bf16(gelu_tanh(v.x), gelu_tanh(v.y)); w.y = cvt_pk_bf16(gelu_tanh(v.z), gelu_tanh(v.w)); *(u32x2*)(GY + ro + c - 1024) = w; } }
};
__device__ __forceinline__ void lru_gate2(f32x2 zr, f32x2 zi, f32x2 sp, f32x2 x, bool slow, f32x2& la, f32x2& bv) {
    const f32x2 tr = zr * (-1.44269504089f), ti = zi * (-1.44269504089f);
    f32x2 e1, e2; e1.x = __builtin_amdgcn_exp2f(tr.x); e1.y = __builtin_amdgcn_exp2f(tr.y); e2.x = __builtin_amdgcn_exp2f(ti.x); e2.y = __builtin_amdgcn_exp2f(ti.y);
    const f32x2 d1 = e1 + 1.0f, d2 = e2 + 1.0f, dd = d1 * d2;
    f32x2 inv; inv.x = fast_rcp(dd.x); inv.y = fast_rcp(dd.y);
    const f32x2 l = (inv * d2) * sp, x2 = l * 2.0f;
    f32x2 q = x2 * 0.0001984127f + 0.0013888889f; q = q * x2 + 0.0083333333f; q = q * x2 + 0.041666667f; q = q * x2 + 0.16666667f; q = q * x2 + 0.5f; q = q * x2 + 1.0f;
    f32x2 em = -x2 * q;
    if (__builtin_expect(slow, 0)) { asm volatile("" ::: "memory"); em.x = 1.0f - fast_exp(x2.x); em.y = 1.0f - fast_exp(x2.y); }
    f32x2 sq; sq.x = __builtin_amdgcn_sqrtf(em.x); sq.y = __builtin_amdgcn_sqrtf(em.y);
    la = l; bv = sq * (inv * d1) * x;
}
struct FnGates {
    static constexpr int nrb = MROWS / 32, ncb = 64, K = 256; static constexpr bool PAIRED = true;
    const bf16* XC; const bf16* W; bf16* LA; bf16* BV; const float* bg; const float* lam;
    __device__ __forceinline__ const bf16* arow(int rb, int cb, int r) const { return XC + (size_t)(rb * 32 + r) * D + (((cb & 31) * 32) >> 8) * 256; }
    __device__ __forceinline__ const bf16* brow(int rb, int cb, int n) const {
        const int d = cb >> 5, nb = n >> 4, frn = n & 15, ch = (cb & 31) * 32 + (nb & 1) * 16 + frn, g = nb >> 1, h = ch >> 8, jl = ch & 255;
        return W + (((size_t)(d * 8 + h * 2 + (jl >> 7)) * 256) + g * 128 + (jl & 127)) * 256; }
    __device__ __forceinline__ void epi_blk(int rb, int cb, int mi, int nb, const f32x4& vr, const f32x4& vi, int fr, int fq) const {
        const int d = cb >> 5, ch = (cb & 31) * 32 + nb * 16 + 4 * fq;
        const f32x4 br = *(const f32x4*)(bg + (d * 2 + 0) * D + ch), bi = *(const f32x4*)(bg + (d * 2 + 1) * D + ch), lm = *(const f32x4*)(lam + d * D + ch);
        const size_t ro = (size_t)(rb * 32 + mi * 16 + fr) * D + ch;
        const u32x2 xw = *(const u32x2*)(XC + ro); const float xv[4] = {bflo(xw.x), bfhi(xw.x), bflo(xw.y), bfhi(xw.y)};
        float la[4], bvv[4];
        const bool slow = __any((lm.x < -0.25f) | (lm.y < -0.25f) | (lm.z < -0.25f) | (lm.w < -0.25f));
#pragma unroll
        for (int q = 0; q < 4; q += 2) { f32x2 l2, b2; lru_gate2((f32x2){vr[q] + br[q], vr[q + 1] + br[q + 1]}, (f32x2){vi[q] + bi[q], vi[q + 1] + bi[q + 1]}, (f32x2){lm[q], lm[q + 1]}, (f32x2){xv[q], xv[q + 1]}, slow, l2, b2);
            la[q] = l2.x; la[q + 1] = l2.y; bvv[q] = b2.x; bvv[q + 1] = b2.y; }
        u32x2 w; w.x = cvt_pk_bf16(la[0], la[1]); w.y = cvt_pk_bf16(la[2], la[3]); *(u32x2*)(LA + (size_t)d * MPAD * D + ro) = w;
        w.x = cvt_pk_bf16(bvv[0], bvv[1]); w.y = cvt_pk_bf16(bvv[2], bvv[3]); *(u32x2*)(BV + (size_t)d * MPAD * D + ro) = w; }
};
struct FnOut {
    static constexpr int nrb = MROWS / 32, ncb = 16, K = 1024; static constexpr bool PAIRED = false;
    const bf16* A; const bf16* W; bf16* H;
    __device__ __forceinline__ const bf16* arow(int rb, int cb, int r) const { return A + (size_t)(rb * 32 + r) * D; }
    __device__ __forceinline__ const bf16* brow(int rb, int cb, int n) const { return W + (size_t)(cb * 64 + n) * 1024; }
    __device__ __forceinline__ void epi_blk(int rb, int cb, int mi, int nb, const f32x4& v, const f32x4&, int fr, int fq) const {
        bf16* p = H + (size_t)(rb * 32 + mi * 16 + fr) * D + cb * 64 + nb * 16 + 4 * fq; const u32x2 w = *(const u32x2*)p; const f32x4 o = (f32x4){bflo(w.x), bfhi(w.x), bflo(w.y), bfhi(w.y)} + v;
        u32x2 ow; ow.x = cvt_pk_bf16(o.x, o.y); ow.y = cvt_pk_bf16(o.z, o.w); *(u32x2*)p = ow; }
};
constexpr int ERB = (EROWS + 31) / 32;
constexpr int ERB16 = (EROWS + 15) / 16;
struct FnM1f8 {
    static constexpr int KB = 1024; static constexpr bool PAIRED = true;
    const unsigned char* U; const unsigned char* W; const int* ROWL; unsigned char* HID;
    __device__ __forceinline__ const unsigned char* arow(int rb, int cb, int r) const { const int e = rb / ERB16, pos = (rb % ERB16) * 16 + r; return U + (size_t)ROWL[e * EPAD + pos] * 1024; }
    __device__ __forceinline__ const unsigned char* brow(int rb, int cb, int n) const { const int e = rb / ERB16, nb = n >> 4, f = cb * 32 + (nb & 1) * 16 + (n & 15);
        return W + ((size_t)e * 4096 + (f >> 7) * 256 + (nb >> 1) * 128 + (f & 127)) * 1024; }
    __device__ __forceinline__ void epi_blk(int rb, int cb, int nb, const f32x4& gs, const f32x4& us, int fr, int fq) const {
        const int e = rb / ERB16, pos = (rb % ERB16) * 16 + fr, f = cb * 32 + nb * 16 + 4 * fq; const f32x4 g = gs * WINV, u = us * WINV;
        *(unsigned*)(HID + ((size_t)e * EPAD + pos) * HIDP8 + f) = pk4_fp8(siluf_(g.x) * u.x, siluf_(g.y) * u.y, siluf_(g.z) * u.z, siluf_(g.w) * u.w); }
};
struct FnM2f8 {
    static constexpr int KB = 2048; static constexpr bool PAIRED = false;
    const unsigned char* HID; const unsigned char* W; bf16* Y;
    __device__ __forceinline__ const unsigned char* arow(int rb, int cb, int r) const { const int e = rb / ERB16, pos = (rb % ERB16) * 16 + r; return HID + ((size_t)e * EPAD + pos) * HIDP8; }
    __device__ __forceinline__ const unsigned char* brow(int rb, int cb, int n) const { const int e = rb / ERB16; return W + ((size_t)e * 1024 + cb * 64 + n) * WDP8; }
    __device__ __forceinline__ void epi_blk(int rb, int cb, int nb, const f32x4& vs, const f32x4&, int fr, int fq) const {
        const int e = rb / ERB16, pos = (rb % ERB16) * 16 + fr; const f32x4 v = vs * WINV;
        *(unsigned*)((unsigned char*)Y + ((size_t)e * EPAD + pos) * D + cb * 64 + nb * 16 + 4 * fq) = pk4_fp8(v.x, v.y, v.z, v.w); }
};
template <class Fn>
__device__ __forceinline__ void wg_gemm_ksplit8(const Fn& fn, const TaskMap tm, LAS unsigned char* lds, int vcu, int G, int tid_) {
    const int tid = opaque(tid_), lane = tid & 63, wave = __builtin_amdgcn_readfirstlane(tid >> 6), fr = lane & 15, fq = lane >> 4;
    constexpr int KW = Fn::KB / 8, NS = KW / 128;
    LAS f32x4* part = (LAS f32x4*)lds;
    for (int task = vcu; task < tm.ntask; task += G) {
        const int cb = task % tm.ncb, rb = tm.rb0 + (task / tm.ncb) * tm.rbstride;
        const unsigned char* ap = fn.arow(rb, cb, fr) + wave * KW + 32 * fq; const unsigned char* bp[4];
#pragma unroll
        for (int nb = 0; nb < 4; ++nb) bp[nb] = fn.brow(rb, cb, nb * 16 + fr) + wave * KW + 32 * fq;
        v4i a[NS][2], bb[NS][4][2];
#pragma unroll
        for (int s = 0; s < NS; ++s) { a[s][0] = *(const v4i*)(ap + s * 128); a[s][1] = *(const v4i*)(ap + s * 128 + 16);
#pragma unroll
            for (int nb = 0; nb < 4; ++nb) { bb[s][nb][0] = *(const v4i*)(bp[nb] + s * 128); bb[s][nb][1] = *(const v4i*)(bp[nb] + s * 128 + 16); } }
        f32x4 acc[4];
#pragma unroll
        for (int nb = 0; nb < 4; ++nb) acc[nb] = (f32x4){0.f, 0.f, 0.f, 0.f};
#pragma unroll
        for (int s = 0; s < NS; ++s)
#pragma unroll
            for (int nb = 0; nb < 4; ++nb) acc[nb] = __builtin_amdgcn_mfma_scale_f32_16x16x128_f8f6f4(__builtin_shufflevector(bb[s][nb][0], bb[s][nb][1], 0, 1, 2, 3, 4, 5, 6, 7),
                                                                                                     __builtin_shufflevector(a[s][0], a[s][1], 0, 1, 2, 3, 4, 5, 6, 7), acc[nb], 0, 0, 0, 0, 0, 0);
#pragma unroll
        for (int nb = 0; nb < 4; ++nb) part[(wave * 4 + nb) * 64 + lane] = acc[nb];
        __syncthreads();
        if (wave < 4 && (!Fn::PAIRED || wave < 2)) {
            const int nb = wave;
            f32x4 v = (f32x4){0.f, 0.f, 0.f, 0.f}, v2 = v;
#pragma unroll
            for (int w = 0; w < 8; ++w) { v += part[(w * 4 + nb) * 64 + lane]; if (Fn::PAIRED) v2 += part[(w * 4 + nb + 2) * 64 + lane]; }
            fn.epi_blk(rb, cb, nb, v, v2, fr, fq);
        }
        __syncthreads();
    }
}

template <int MI, class Fn>
__device__ __forceinline__ void wg_gemm_ksplit(const Fn& fn, const TaskMap tm, LAS unsigned char* lds, int vcu, int G, int tid_) {
    const int tid = opaque(tid_), lane = tid & 63, wave = __builtin_amdgcn_readfirstlane(tid >> 6), fr = lane & 15, fq = lane >> 4;
    constexpr int KW = Fn::K / 8, NS = KW / 32;
    LAS f32x4* part = (LAS f32x4*)lds;
    for (int task = vcu; task < tm.ntask; task += G) {
        const int cb = task % tm.ncb, rb = tm.rb0 + (task / tm.ncb) * tm.rbstride;
        const bf16* ap[MI]; const bf16* bp[4];
#pragma unroll
        for (int mi = 0; mi < MI; ++mi) ap[mi] = fn.arow(rb, cb, mi * 16 + fr) + wave * KW + 8 * fq;
#pragma unroll
        for (int nb = 0; nb < 4; ++nb) bp[nb] = fn.brow(rb, cb, nb * 16 + fr) + wave * KW + 8 * fq;
        f32x4 acc[MI][4];
#pragma unroll
        for (int mi = 0; mi < MI; ++mi)
#pragma unroll
            for (int nb = 0; nb < 4; ++nb) acc[mi][nb] = (f32x4){0.f, 0.f, 0.f, 0.f};
#pragma unroll
        for (int s0 = 0; s0 < NS; s0 += 4) {
            bf16x8 a[4][MI], bb[4][4];
#pragma unroll
            for (int s = 0; s < 4; ++s) if (s0 + s < NS) {
#pragma unroll
                for (int mi = 0; mi < MI; ++mi) a[s][mi] = *(const bf16x8*)(ap[mi] + (s0 + s) * 32);
#pragma unroll
                for (int nb = 0; nb < 4; ++nb) bb[s][nb] = *(const bf16x8*)(bp[nb] + (s0 + s) * 32); }
#pragma unroll
            for (int s = 0; s < 4; ++s) if (s0 + s < NS) {
#pragma unroll
                for (int mi = 0; mi < MI; ++mi)
#pragma unroll
                    for (int nb = 0; nb < 4; ++nb) acc[mi][nb] = __builtin_amdgcn_mfma_f32_16x16x32_bf16(bb[s][nb], a[s][mi], acc[mi][nb], 0, 0, 0); }
        }
#pragma unroll
        for (int mi = 0; mi < MI; ++mi)
#pragma unroll
            for (int nb = 0; nb < 4; ++nb) part[((wave * MI + mi) * 4 + nb) * 64 + lane] = acc[mi][nb];
        __syncthreads();
        if (wave < MI * 4) {
            const int mi = wave >> 2, nb = wave & 3;
            if (!Fn::PAIRED || nb < 2) {
                f32x4 v = (f32x4){0.f, 0.f, 0.f, 0.f}, v2 = v;
#pragma unroll
                for (int w = 0; w < 8; ++w) { v += part[((w * MI + mi) * 4 + nb) * 64 + lane]; if (Fn::PAIRED) v2 += part[((w * MI + mi) * 4 + nb + 2) * 64 + lane]; }
                fn.epi_blk(rb, cb, mi, nb, v, v2, fr, fq);
            }
        }
        __syncthreads();
    }
}

namespace pg8 {
constexpr int BM = 256, BK = 64, HALF = 128, HTB = HALF * BK * 2, STAGE_BYTES = 8 * HTB;
__device__ __forceinline__ int lds_byte(int r, int c) { const int st = (r >> 4) * 2 + (c >> 5), rr = r & 15, cc = c & 31, ob = rr * 64 + cc * 2; return st * 1024 + (ob ^ (((ob >> 9) & 1) << 5)); }
__device__ __forceinline__ void stage_rc(int b, int& R, int& C) { const int st = b / 1024, sb = b % 1024, swz = sb ^ (((sb >> 9) & 1) << 5); R = (st >> 1) * 16 + swz / 64; C = (st & 1) * 32 + (swz % 64) / 2; }
__device__ __forceinline__ int perm32(int rho) { const int n = rho >> 4, i = rho & 15; return 8 * (i >> 2) + 4 * n + (i & 3); }
struct Unit { int pm, pn, e; };
struct SchedStd {
    int nM, nN, nwg, G, c;
    __device__ __forceinline__ void init(int nM_, int nN_, int G_, int c_) { nM = nM_; nN = nN_; nwg = nM * nN; G = G_; c = c_; }
    __device__ __forceinline__ bool next(int i, Unit& u) const {
        const int L = i * G + c; if (L >= nwg) return false;
        int wgid = L; { const int q = nwg / 8, r = nwg % 8, xcd = wgid % 8, off = wgid / 8; wgid = (xcd < r ? xcd * (q + 1) : r * (q + 1) + (xcd - r) * q) + off; }
        const int nig = 8 * nN, gid = wgid / nig, fm = gid * 8, gsz = (nM - fm) < 8 ? (nM - fm) : 8;
        u.pm = fm + ((wgid % nig) % gsz); u.pn = (wgid % nig) / gsz; u.e = 0; return true;
    }
};
struct SchedMoe {
    int nN, total, G, c, rev, gm;
    __device__ __forceinline__ void init(int nN_, int G_, int c_, int rev_ = 0, int gm_ = 8) { nN = nN_; total = 16 * 16 * nN_; G = G_; c = c_; rev = rev_; gm = gm_; }
    __device__ __forceinline__ bool next(int i, Unit& u) const {
        const int L = i * G + c; if (L >= total) return false;
        const int off = rev ? (total / 8 - 1 - L / 8) : L / 8;
        const int wgid = (L % 8) * (total / 8) + off, per = 16 * nN, w = wgid % per, nig = gm * nN;
        u.e = wgid / per; u.pm = (w / nig) * gm + (w % nig) % gm; u.pn = (w % nig) / gm; return true;
    }
};
template <class Cfg>
__device__ __forceinline__ void gemm_phase(LAS unsigned char* lds, const Cfg& cfg) {
    const int tid = opaque((int)threadIdx.x), wid = __builtin_amdgcn_readfirstlane(tid >> 6), lane = tid & 63, wr = wid >> 2, wc = wid & 3, fr = lane & 15, fq = lane >> 4;
    constexpr bool F8 = Cfg::FP8;
    constexpr int nt = Cfg::KB / 128;
    int Rr[2], Cc[2]; unsigned voffB[2];
#pragma unroll
    for (int i = 0; i < 2; ++i) { stage_rc(tid * 16 + i * 8192, Rr[i], Cc[i]); const int R = Rr[i];
        const int Rb = Cfg::PERMX ? (((R >> 5) & 3) * 64 + 16 * ((R & 15) >> 2) + 4 * ((R >> 4) & 1) + (R & 3)) : (Cfg::PERM ? ((R & ~31) + perm32(R & 31)) : R);
        voffB[i] = (unsigned)Rb * (unsigned)Cfg::ldb + (unsigned)Cc[i] * 2u; }
    const size_t kstep = (size_t)(BK * 2);
    const size_t hstepB = (size_t)(Cfg::PERMX ? 8 : HALF) * Cfg::ldb;
    const unsigned ldsw = (unsigned)wid * 1024u;
    const int aoff = lds_byte(wr * 64 + fr, F8 ? fq * 16 : fq * 8), boff = lds_byte(wc * 32 + fr, F8 ? fq * 16 : fq * 8);

#define PG8_SA(b, h) (((b) * 2 + (h)) * HTB)
#define PG8_SB(b, h) ((4 + (b) * 2 + (h)) * HTB)
#define PG8_STAGE(bufoff, gbase, voff) do { _Pragma("unroll") for (int _i = 0; _i < 2; ++_i) \
        __builtin_amdgcn_global_load_lds((const unsigned*)((const char*)(gbase) + (voff)[_i]), (LAS unsigned*)(lds + (bufoff) + ldsw + _i * 8192), 16, 0, 0); } while (0)
typedef v8i v8i_a16 __attribute__((aligned(16)));
#define PG8_LD32(p) (*(const LAS v8i_a16*)(p))
#define PG8_LDA(dst, b, h) do { if constexpr (F8) { _Pragma("unroll") for (int m = 0; m < 4; ++m) dst##8[m] = PG8_LD32(lds + PG8_SA(b, h) + aoff + m * 2048); } \
        else { _Pragma("unroll") for (int m = 0; m < 4; ++m) _Pragma("unroll") for (int k = 0; k < 2; ++k) dst[m][k] = *(const LAS bf16x8*)(lds + PG8_SA(b, h) + aoff + m * 2048 + k * 1024); } } while (0)
#define PG8_LDB(dst, b, h) do { if constexpr (F8) { _Pragma("unroll") for (int n = 0; n < 2; ++n) dst##8[n] = PG8_LD32(lds + PG8_SB(b, h) + boff + n * 2048); } \
        else { _Pragma("unroll") for (int n = 0; n < 2; ++n) _Pragma("unroll") for (int k = 0; k < 2; ++k) dst[n][k] = *(const LAS bf16x8*)(lds + PG8_SB(b, h) + boff + n * 2048 + k * 1024); } } while (0)
#define PG8_MMA(ai, bj, At, Bt) do { __builtin_amdgcn_s_setprio(1); _Pragma("unroll") for (int m = 0; m < 4; ++m) _Pragma("unroll") for (int n = 0; n < 2; ++n) { \
        if constexpr (F8) asm volatile("v_mfma_f32_16x16x128_f8f6f4 %0, %1, %2, %0" : "+v"(acc[ai][bj][m][n]) : "v"(Bt##8[n]), "v"(At##8[m]));   \
        else { _Pragma("unroll") for (int k = 0; k < 2; ++k) acc[ai][bj][m][n] = __builtin_amdgcn_mfma_f32_16x16x32_bf16(Bt[n][k], At[m][k], acc[ai][bj][m][n], 0, 0, 0); } } __builtin_amdgcn_s_setprio(0); } while (0)
#define PG8_WAIT_V(n) asm volatile("s_waitcnt vmcnt(" #n ")" ::: "memory")
#define PG8_WAIT_L(n) asm volatile("s_waitcnt lgkmcnt(" #n ")" ::: "memory")
#define PG8_BAR __builtin_amdgcn_s_barrier()
#define PG8_SCHED __builtin_amdgcn_sched_barrier(0)
    Unit cur, nxt; int ui = 0;
    if (!cfg.next(0, cur)) return;
    f32x4 acc[2][2][4][2];
#pragma unroll
    for (int a = 0; a < 2; ++a)
#pragma unroll
        for (int b = 0; b < 2; ++b)
#pragma unroll
            for (int m = 0; m < 4; ++m)
#pragma unroll
                for (int n = 0; n < 2; ++n) acc[a][b][m][n] = (f32x4){0.f, 0.f, 0.f, 0.f};
    bf16x8 At[4][2], B0[2][2], B1[2][2]; v8i At8[4], B08[2], B18[2];
    unsigned voffA[2][2], voffAn[2][2];
    cfg.a_offs(cur, 0, Rr, Cc, voffA);
    const char* cA = cfg.a_base(cur); const char* cB = cfg.b_base(cur);
    PG8_STAGE(PG8_SB(0, 0), cB, voffB); PG8_STAGE(PG8_SB(0, 1), cB + hstepB, voffB); PG8_STAGE(PG8_SA(0, 0), cA, voffA[0]); PG8_STAGE(PG8_SA(0, 1), cA, voffA[1]);
    if (wr == 1) PG8_BAR;
    PG8_WAIT_V(2); PG8_BAR;
    PG8_STAGE(PG8_SB(1, 0), cB + kstep, voffB); PG8_STAGE(PG8_SA(1, 0), cA + kstep, voffA[0]); PG8_STAGE(PG8_SB(1, 1), cB + hstepB + kstep, voffB);
    PG8_WAIT_V(6); PG8_BAR;
    for (;;) {
        const bool has_next = cfg.next(ui + 1, nxt);
        const char* nA = has_next ? cfg.a_base(nxt) : cA; const char* nB = has_next ? cfg.b_base(nxt) : cB;
#pragma unroll 1
        for (int t = 0; t < nt; t += 2) {
            const bool last = (t == nt - 2);
            const char* a1 = cA + (size_t)(t + 1) * kstep;
            const char* a2 = last ? nA : cA + (size_t)(t + 2) * kstep; const char* b2 = last ? nB : cB + (size_t)(t + 2) * kstep;
            const char* a3 = a2 + kstep; const char* b3 = b2 + kstep;
            unsigned o2[2][2];
            if constexpr (Cfg::GATHER) {
                if (last) { if (has_next) { int R2[2], C2[2]; stage_rc(tid * 16, R2[0], C2[0]); stage_rc(tid * 16 + 8192, R2[1], C2[1]); cfg.a_offs(nxt, ui + 1, R2, C2, voffAn); } else {
#pragma unroll
                    for (int h = 0; h < 2; ++h) { voffAn[h][0] = voffA[h][0]; voffAn[h][1] = voffA[h][1]; } } }
#pragma unroll
                for (int h = 0; h < 2; ++h) { o2[h][0] = last ? voffAn[h][0] : voffA[h][0]; o2[h][1] = last ? voffAn[h][1] : voffA[h][1]; }
            } else {
#pragma unroll
                for (int h = 0; h < 2; ++h) { o2[h][0] = voffA[h][0]; o2[h][1] = voffA[h][1]; }
            }
            PG8_LDB(B0, 0, 0); PG8_LDB(B1, 0, 1); PG8_SCHED; PG8_LDA(At, 0, 0); PG8_STAGE(PG8_SA(1, 1), a1, voffA[1]);
            PG8_WAIT_V(8); PG8_WAIT_L(0); PG8_BAR; PG8_MMA(0, 0, At, B0); PG8_MMA(0, 1, At, B1); PG8_BAR; PG8_SCHED;
            PG8_LDA(At, 0, 1); PG8_STAGE(PG8_SB(0, 0), b2, voffB); PG8_STAGE(PG8_SB(0, 1), b2 + hstepB, voffB); PG8_STAGE(PG8_SA(0, 0), a2, o2[0]);
            PG8_WAIT_V(8); PG8_WAIT_L(0); PG8_BAR; PG8_MMA(1, 0, At, B0); PG8_MMA(1, 1, At, B1); PG8_BAR; PG8_SCHED;
            PG8_LDB(B0, 1, 0); PG8_LDB(B1, 1, 1); PG8_SCHED; PG8_LDA(At, 1, 0); PG8_STAGE(PG8_SA(0, 1), a2, o2[1]);
            PG8_WAIT_V(8); PG8_WAIT_L(0); PG8_BAR; PG8_MMA(0, 0, At, B0); PG8_MMA(0, 1, At, B1); PG8_BAR; PG8_SCHED;
            PG8_LDA(At, 1, 1); PG8_STAGE(PG8_SB(1, 0), b3, voffB); PG8_STAGE(PG8_SB(1, 1), b3 + hstepB, voffB); PG8_STAGE(PG8_SA(1, 0), a3, o2[0]);
            PG8_WAIT_V(8); PG8_WAIT_L(0); PG8_BAR; PG8_MMA(1, 0, At, B0); PG8_MMA(1, 1, At, B1); PG8_BAR; PG8_SCHED;
        }
        if (wr == 0) PG8_BAR;
        if constexpr (F8) asm volatile("s_nop 15\n\ts_nop 15" ::: "memory");
        cfg.epi(acc, cur, wr, wc, fr, fq);
        if (!has_next) break;
#pragma unroll
        for (int a = 0; a < 2; ++a)
#pragma unroll
            for (int b = 0; b < 2; ++b)
#pragma unroll
                for (int m = 0; m < 4; ++m)
#pragma unroll
                    for (int n = 0; n < 2; ++n) acc[a][b][m][n] = (f32x4){0.f, 0.f, 0.f, 0.f};
        cur = nxt; cA = nA; cB = nB; ++ui;
        if constexpr (Cfg::GATHER) {
#pragma unroll
            for (int h = 0; h < 2; ++h) { voffA[h][0] = voffAn[h][0]; voffA[h][1] = voffAn[h][1]; } }
        if (wr == 1) PG8_BAR;
    }
    PG8_WAIT_V(0);
    PG8_BAR;
#undef PG8_SA
#undef PG8_SB
#undef PG8_STAGE
#undef PG8_LDA
#undef PG8_LDB
#undef PG8_MMA
#undef PG8_LD32
#undef PG8_WAIT_V
#undef PG8_WAIT_L
#undef PG8_BAR
#undef PG8_SCHED
}
template <int LDA> __device__ __forceinline__ void lin_offs(const int (&R)[2], const int (&C)[2], unsigned (&off)[2][2]) {
#pragma unroll
    for (int h = 0; h < 2; ++h)
#pragma unroll
        for (int i = 0; i < 2; ++i) off[h][i] = (unsigned)(h * HALF + R[i]) * (unsigned)LDA + (unsigned)C[i] * 2u;
}
struct CfgPool {
    static constexpr bool PERMX = false; static constexpr bool GATHER = false; static constexpr bool FP8 = false; static constexpr int KB = 256 * 2; static constexpr bool PERM = true; static constexpr int K = 256, ldb = 512;
    SchedStd S; const bf16* P; const bf16* W; bf16* H; const float* scale;
    __device__ __forceinline__ bool next(int i, Unit& u) const { return S.next(i, u); }
    __device__ __forceinline__ const char* a_base(const Unit& u) const { return (const char*)(P + (size_t)u.pm * 256 * D + u.pn * 256); }
    __device__ __forceinline__ void a_offs(const Unit&, int, const int (&R)[2], const int (&C)[2], unsigned (&off)[2][2]) const { lin_offs<2048>(R, C, off); }
    __device__ __forceinline__ const char* b_base(const Unit& u) const { return (const char*)(W + (size_t)u.pn * 65536); }
    __device__ __forceinline__ void epi(const f32x4 (&acc)[2][2][4][2], const Unit& u, int wr, int wc, int fr, int fq) const {
        const int row0 = u.pm * 256 + wr * 64 + fr, col0 = u.pn * 256 + wc * 32 + 8 * fq;
        f32x4 sc[2][2];
#pragma unroll
        for (int bj = 0; bj < 2; ++bj)
#pragma unroll
            for (int n = 0; n < 2; ++n) sc[bj][n] = *(const f32x4*)(scale + col0 + bj * 128 + n * 4);
#pragma unroll
        for (int ai = 0; ai < 2; ++ai) {
            u32x4 hw[4][2];
#pragma unroll
            for (int m = 0; m < 4; ++m)
#pragma unroll
                for (int bj = 0; bj < 2; ++bj) hw[m][bj] = *(const u32x4*)(H + (size_t)(row0 + ai * 128 + m * 16) * D + col0 + bj * 128);
            asm volatile("" ::: "memory");
#pragma unroll
            for (int m = 0; m < 4; ++m) { bf16* rowp = H + (size_t)(row0 + ai * 128 + m * 16) * D + col0;
#pragma unroll
                for (int bj = 0; bj < 2; ++bj) { const u32x4 w = hw[m][bj];
                    const f32x4 o0 = (f32x4){bflo(w.x), bfhi(w.x), bflo(w.y), bfhi(w.y)} + acc[ai][bj][m][0] * sc[bj][0], o1 = (f32x4){bflo(w.z), bfhi(w.z), bflo(w.w), bfhi(w.w)} + acc[ai][bj][m][1] * sc[bj][1];
                    u32x4 ow; ow.x = cvt_pk_bf16(o0.x, o0.y); ow.y = cvt_pk_bf16(o0.z, o0.w); ow.z = cvt_pk_bf16(o1.x, o1.y); ow.w = cvt_pk_bf16(o1.z, o1.w);
                    *(u32x4*)(rowp + bj * 128) = ow; } }
            asm volatile("" ::: "memory");
        }
    }
};
struct CfgOut {
    static constexpr bool PERMX = false; static constexpr bool GATHER = false; static constexpr bool FP8 = false; static constexpr int KB = 1024 * 2; static constexpr bool PERM = true; static constexpr int K = 1024, ldb = 2048;
    SchedStd S; const bf16* A; const bf16* W; bf16* H;
    __device__ __forceinline__ bool next(int i, Unit& u) const { return S.next(i, u); }
    __device__ __forceinline__ const char* a_base(const Unit& u) const { return (const char*)(A + (size_t)u.pm * 256 * D); }
    __device__ __forceinline__ void a_offs(const Unit&, int, const int (&R)[2], const int (&C)[2], unsigned (&off)[2][2]) const { lin_offs<2048>(R, C, off); }
    __device__ __forceinline__ const char* b_base(const Unit& u) const { return (const char*)(W + (size_t)u.pn * 256 * 1024); }
    __device__ __forceinline__ void epi(const f32x4 (&acc)[2][2][4][2], const Unit& u, int wr, int wc, int fr, int fq) const {
        const int row0 = u.pm * 256 + wr * 64 + fr, col0 = u.pn * 256 + wc * 32 + 8 * fq;
#pragma unroll
        for (int ai = 0; ai < 2; ++ai) {
            u32x4 hw[4][2];
#pragma unroll
            for (int m = 0; m < 4; ++m)
#pragma unroll
                for (int bj = 0; bj < 2; ++bj) hw[m][bj] = *(const u32x4*)(H + (size_t)(row0 + ai * 128 + m * 16) * D + col0 + bj * 128);
            asm volatile("" ::: "memory");
#pragma unroll
            for (int m = 0; m < 4; ++m) { bf16* rowp = H + (size_t)(row0 + ai * 128 + m * 16) * D + col0;
#pragma unroll
                for (int bj = 0; bj < 2; ++bj) { const u32x4 w = hw[m][bj];
                    const f32x4 o0 = (f32x4){bflo(w.x), bfhi(w.x), bflo(w.y), bfhi(w.y)} + acc[ai][bj][m][0], o1 = (f32x4){bflo(w.z), bfhi(w.z), bflo(w.w), bfhi(w.w)} + acc[ai][bj][m][1];
                    u32x4 ow; ow.x = cvt_pk_bf16(o0.x, o0.y); ow.y = cvt_pk_bf16(o0.z, o0.w); ow.z = cvt_pk_bf16(o1.x, o1.y); ow.w = cvt_pk_bf16(o1.z, o1.w);
                    *(u32x4*)(rowp + bj * 128) = ow; } }
            asm volatile("" ::: "memory");
        }
    }
};
struct CfgIn {
    static constexpr bool PERMX = false; static constexpr bool GATHER = false; static constexpr bool FP8 = false; static constexpr int KB = 1024 * 2; static constexpr bool PERM = true; static constexpr int K = 1024, ldb = 2048;
    SchedStd S; const bf16* U; const bf16* W; bf16* XB; bf16* GY; const float* RS;
    __device__ __forceinline__ bool next(int i, Unit& u) const { return S.next(i, u); }
    __device__ __forceinline__ const char* a_base(const Unit& u) const { return (const char*)(U + (size_t)u.pm * 256 * D); }
    __device__ __forceinline__ void a_offs(const Unit&, int, const int (&R)[2], const int (&C)[2], unsigned (&off)[2][2]) const { lin_offs<2048>(R, C, off); }
    __device__ __forceinline__ const char* b_base(const Unit& u) const { return (const char*)(W + (size_t)u.pn * 256 * 1024); }
    __device__ __forceinline__ void epi(const f32x4 (&acc)[2][2][4][2], const Unit& u, int wr, int wc, int fr, int fq) const {
        const int row0 = u.pm * 256 + wr * 64 + fr, col0 = (u.pn & 3) * 256 + wc * 32 + 8 * fq; const bool act = u.pn >= 4; bf16* base = act ? GY : XB;
        float rs[2][4];
#pragma unroll
        for (int ai = 0; ai < 2; ++ai)
#pragma unroll
            for (int m = 0; m < 4; ++m) rs[ai][m] = RS[row0 + ai * 128 + m * 16];
#pragma unroll
        for (int ai = 0; ai < 2; ++ai)
#pragma unroll
            for (int m = 0; m < 4; ++m) { bf16* rowp = base + (size_t)(row0 + ai * 128 + m * 16) * D + col0;
#pragma unroll
                for (int bj = 0; bj < 2; ++bj) { f32x4 v0 = acc[ai][bj][m][0] * rs[ai][m], v1 = acc[ai][bj][m][1] * rs[ai][m];
                    if (act) { v0.x = gelu_tanh(v0.x); v0.y = gelu_tanh(v0.y); v0.z = gelu_tanh(v0.z); v0.w = gelu_tanh(v0.w); v1.x = gelu_tanh(v1.x); v1.y = gelu_tanh(v1.y); v1.z = gelu_tanh(v1.z); v1.w = gelu_tanh(v1.w); }
                    u32x4 w; w.x = cvt_pk_bf16(v0.x, v0.y); w.y = cvt_pk_bf16(v0.z, v0.w); w.z = cvt_pk_bf16(v1.x, v1.y); w.w = cvt_pk_bf16(v1.z, v1.w);
                    *(u32x4*)(rowp + bj * 128) = w; } }
    }
};
struct CfgGates {
    static constexpr bool PERMX = false; static constexpr bool GATHER = false; static constexpr bool FP8 = false; static constexpr int KB = 256 * 2; static constexpr bool PERM = true; static constexpr int K = 256, ldb = 512;
    SchedStd S; const bf16* XC; const bf16* W; bf16* LA; bf16* BV; const float* bg; const float* lam;
    __device__ __forceinline__ bool next(int i, Unit& u) const { return S.next(i, u); }
    __device__ __forceinline__ const char* a_base(const Unit& u) const { return (const char*)(XC + (size_t)u.pm * 256 * D + ((u.pn & 7) >> 1) * 256); }
    __device__ __forceinline__ void a_offs(const Unit&, int, const int (&R)[2], const int (&C)[2], unsigned (&off)[2][2]) const { lin_offs<2048>(R, C, off); }
    __device__ __forceinline__ const char* b_base(const Unit& u) const { return (const char*)(W + (size_t)u.pn * 65536); }
    __device__ __forceinline__ void epi(const f32x4 (&acc)[2][2][4][2], const Unit& u, int wr, int wc, int fr, int fq) const {
        const int d = u.pn >> 3, ch0 = (u.pn & 7) * 128 + wc * 32 + 8 * fq, row0 = u.pm * 256 + wr * 64 + fr;
        float br[8], bi[8], sp[8];
#pragma unroll
        for (int q = 0; q < 2; ++q) { const f32x4 a = *(const f32x4*)(bg + (d * 2 + 0) * D + ch0 + 4 * q), b = *(const f32x4*)(bg + (d * 2 + 1) * D + ch0 + 4 * q), l = *(const f32x4*)(lam + d * D + ch0 + 4 * q);
#pragma unroll
            for (int x = 0; x < 4; ++x) { br[4 * q + x] = a[x]; bi[4 * q + x] = b[x]; sp[4 * q + x] = l[x]; } }
        bool sl = false;
#pragma unroll
        for (int q = 0; q < 8; ++q) sl |= sp[q] < -0.25f;
        const bool slow = __any(sl);
        u32x4 xin[2][4];
#pragma unroll
        for (int ai = 0; ai < 2; ++ai)
#pragma unroll
            for (int m = 0; m < 4; ++m) xin[ai][m] = *(const u32x4*)(XC + (size_t)(row0 + ai * 128 + m * 16) * D + ch0);
        asm volatile("" ::: "memory");
#pragma unroll
        for (int ai = 0; ai < 2; ++ai)
#pragma unroll
            for (int m = 0; m < 4; ++m) { const size_t ro = (size_t)(row0 + ai * 128 + m * 16) * D + ch0;
                const u32x4 xw = xin[ai][m];
                const float xv[8] = {bflo(xw.x), bfhi(xw.x), bflo(xw.y), bfhi(xw.y), bflo(xw.z), bfhi(xw.z), bflo(xw.w), bfhi(xw.w)};
                float la[8], bv[8];
#pragma unroll
                for (int q = 0; q < 8; q += 2) { f32x2 l2, b2;
                    lru_gate2((f32x2){acc[ai][0][m][q >> 2][q & 3] + br[q], acc[ai][0][m][q >> 2][(q & 3) + 1] + br[q + 1]}, (f32x2){acc[ai][1][m][q >> 2][q & 3] + bi[q], acc[ai][1][m][q >> 2][(q & 3) + 1] + bi[q + 1]},
                              (f32x2){sp[q], sp[q + 1]}, (f32x2){xv[q], xv[q + 1]}, slow, l2, b2);
                    la[q] = l2.x; la[q + 1] = l2.y; bv[q] = b2.x; bv[q + 1] = b2.y; }
                u32x4 w; w.x = cvt_pk_bf16(la[0], la[1]); w.y = cvt_pk_bf16(la[2], la[3]); w.z = cvt_pk_bf16(la[4], la[5]); w.w = cvt_pk_bf16(la[6], la[7]);
                *(u32x4*)(LA + (size_t)d * MPAD * D + ro) = w;
                w.x = cvt_pk_bf16(bv[0], bv[1]); w.y = cvt_pk_bf16(bv[2], bv[3]); w.z = cvt_pk_bf16(bv[4], bv[5]); w.w = cvt_pk_bf16(bv[6], bv[7]);
                *(u32x4*)(BV + (size_t)d * MPAD * D + ro) = w; }
    }
};
struct CfgM1 {
    static constexpr bool PERMX = false; static constexpr bool GATHER = true; static constexpr bool FP8 = true; static constexpr int KB = 1024; static constexpr bool PERM = true; static constexpr int K = 1024, ldb = 1024;
    SchedMoe S; const unsigned char* U; const unsigned char* W; unsigned char* HID; const LAS unsigned short* idx;
    __device__ __forceinline__ bool next(int i, Unit& u) const { return S.next(i, u); }
    __device__ __forceinline__ const char* a_base(const Unit&) const { return (const char*)U; }
    __device__ __forceinline__ void a_offs(const Unit&, int ui, const int (&R)[2], const int (&C)[2], unsigned (&off)[2][2]) const {
#pragma unroll
        for (int h = 0; h < 2; ++h)
#pragma unroll
            for (int i = 0; i < 2; ++i) off[h][i] = (unsigned)idx[ui * 256 + h * HALF + R[i]] * 1024u + (unsigned)C[i] * 2u;
    }
    __device__ __forceinline__ const char* b_base(const Unit& u) const { return (const char*)(W + ((size_t)u.e * 4096 + u.pn * 256) * 1024); }
    __device__ __forceinline__ void epi(const f32x4 (&acc)[2][2][4][2], const Unit& u, int wr, int wc, int fr, int fq) const {
        const int row0 = u.e * EPAD + u.pm * 256 + wr * 64 + fr, col0 = u.pn * 128 + wc * 32 + 8 * fq;
#pragma unroll
        for (int ai = 0; ai < 2; ++ai)
#pragma unroll
            for (int m = 0; m < 4; ++m) { const f32x4 g0 = acc[ai][0][m][0], g1 = acc[ai][0][m][1], u0 = acc[ai][1][m][0], u1 = acc[ai][1][m][1];
                u32x2 w; w.x = pk4_fp8(silu_mul_s(g0.x, u0.x), silu_mul_s(g0.y, u0.y), silu_mul_s(g0.z, u0.z), silu_mul_s(g0.w, u0.w));
                w.y = pk4_fp8(silu_mul_s(g1.x, u1.x), silu_mul_s(g1.y, u1.y), silu_mul_s(g1.z, u1.z), silu_mul_s(g1.w, u1.w));
                *(u32x2*)(HID + (size_t)(row0 + ai * 128 + m * 16) * HIDP8 + col0) = w; }
    }
};
struct CfgM2 {
    static constexpr bool PERMX = true; static constexpr bool GATHER = false; static constexpr bool FP8 = true; static constexpr int KB = 2048; static constexpr bool PERM = true; static constexpr int K = 2048, ldb = WDP8;
    SchedMoe S; const unsigned char* HID; const unsigned char* W; bf16* Y;
    __device__ __forceinline__ bool next(int i, Unit& u) const { return S.next(i, u); }
    __device__ __forceinline__ const char* a_base(const Unit& u) const { return (const char*)(HID + ((size_t)u.e * EPAD + u.pm * 256) * HIDP8); }
    __device__ __forceinline__ void a_offs(const Unit&, int, const int (&R)[2], const int (&C)[2], unsigned (&off)[2][2]) const { lin_offs<HIDP8>(R, C, off); }
    __device__ __forceinline__ const char* b_base(const Unit& u) const { return (const char*)(W + ((size_t)u.e * 1024 + u.pn * 256) * WDP8); }
    __device__ __forceinline__ void epi(const f32x4 (&acc)[2][2][4][2], const Unit& u, int wr, int wc, int fr, int fq) const {
        const int row0 = u.e * EPAD + u.pm * 256 + wr * 64 + fr, col0 = u.pn * 256 + wc * 64 + 16 * fq;
#pragma unroll
        for (int ai = 0; ai < 2; ++ai)
#pragma unroll
            for (int m = 0; m < 4; ++m) { const f32x4 v0 = acc[ai][0][m][0] * WINV, v1 = acc[ai][0][m][1] * WINV, v2 = acc[ai][1][m][0] * WINV, v3 = acc[ai][1][m][1] * WINV;
                u32x4 w; w.x = pk4_fp8(v0.x, v0.y, v0.z, v0.w); w.y = pk4_fp8(v1.x, v1.y, v1.z, v1.w); w.z = pk4_fp8(v2.x, v2.y, v2.z, v2.w); w.w = pk4_fp8(v3.x, v3.y, v3.z, v3.w);
                *(u32x4*)((unsigned char*)Y + (size_t)(row0 + ai * 128 + m * 16) * D + col0) = w; }
    }
};
}

#ifndef FAST_PG
#define FAST_PG 1
#endif
#ifndef FAST_LIN
#define FAST_LIN 1
#endif
#ifndef FAST_LGT
#define FAST_LGT 1
#endif
#ifndef FAST_LOUT
#define FAST_LOUT 1
#endif
#ifndef FAST_M1
#define FAST_M1 1
#endif
#ifndef FAST_M2
#define FAST_M2 1
#endif
constexpr int IDX_OFF = RING_BYTES + 1024;

#ifndef REP_PRO
#define REP_PRO 1
#endif
#ifndef REP_PP
#define REP_PP 1
#endif
#ifndef REP_LIN
#define REP_LIN 1
#endif
#ifndef REP_LCV
#define REP_LCV 1
#endif
#ifndef REP_LGT
#define REP_LGT 1
#endif
#ifndef REP_LS1
#define REP_LS1 1
#endif
#ifndef REP_LS3
#define REP_LS3 1
#endif
#ifndef REP_RB
#define REP_RB 1
#endif
#ifndef REP_TK
#define REP_TK 1
#endif
#ifndef REP_M1
#define REP_M1 1
#endif
#ifndef REP_M2
#define REP_M2 1
#endif
#ifndef REP_RA
#define REP_RA 1
#endif
#ifndef REP_LOUT
#define REP_LOUT 1
#endif
#ifndef REP_PG
#define REP_PG 1
#endif
#define REPEAT(n) _Pragma("unroll") for (int rep_ = 0; rep_ < (n); ++rep_)
#define IN(k) (lo <= (k) && (k) < hi)
#define SEAM(k) do { if ((k) + 1 < hi) xcd_barrier(bar); } while (0)
template <int layer>
__device__ __forceinline__ void run_layer(const Frame& F, const int lo, const int hi, const XcdBarrier& bar) {
    const int gw = F.vcu * 8 + F.wave, NGW = F.G * 8;
    const bool fast = (F.G == 256);
    {
        const int pb = layer * 16, j = layer >> 1;
        if (IN(pb + 0)) { if constexpr (layer == 0) REPEAT(REP_PRO) phase_prologue(F); if (REP_RA > 1) phase_rowA<false, layer == 0, true>(F, layer); phase_rowA<false, layer == 0>(F, layer); SEAM(pb + 0); }
        if constexpr ((layer & 1) == 0) {
            if (IN(pb + 1)) { REPEAT(REP_PP) phase_poolwin(F, layer); SEAM(pb + 1); }
            if (IN(pb + 2)) { FnPool fn{F.P, F.WPOOL + (size_t)j * 4 * 65536, F.H, F.pool_scale + (size_t)j * D};
                if (FAST_PG && fast) { pg8::CfgPool cfg; cfg.S.init(128, 4, F.G, (int)blockIdx.x); cfg.P = F.P; cfg.W = fn.W; cfg.scale = fn.scale; if (REP_PG > 1) { cfg.H = (bf16*)F.HF; pg8::gemm_phase(F.lds, cfg); } cfg.H = F.H; pg8::gemm_phase(F.lds, cfg);
                    wg_gemm_ksplit<2>(fn, TaskMap{4 * 16, 16, 1024, 1}, F.lds, F.vcu, F.G, F.tid); }
                else wave_gemm(fn, TaskMap{FnPool::nrb * 16, 16, 0, 1}, gw, NGW, F.lane);
                SEAM(pb + 2); }
        } else {
            if (IN(pb + 3)) { REPEAT(REP_LIN) { FnIn fn{F.H, F.WIN + (size_t)j * 2048 * 1024, F.XB, F.GY, F.RSTD};
                if (FAST_LIN && fast) { pg8::CfgIn cfg; cfg.S.init(128, 8, F.G, (int)blockIdx.x); cfg.U = F.H; cfg.W = fn.W; cfg.XB = F.XB; cfg.GY = F.GY; cfg.RS = F.RSTD; pg8::gemm_phase(F.lds, cfg);
                    wg_gemm_ksplit<2>(fn, TaskMap{4 * 32, 32, 1024, 1}, F.lds, F.vcu, F.G, F.tid); }
                else wave_gemm(fn, TaskMap{FnIn::nrb * 32, 32, 0, 1}, gw, NGW, F.lane);
                } SEAM(pb + 3); }
            if (IN(pb + 4)) { REPEAT(REP_LCV) phase_conv(F, j); SEAM(pb + 4); }
            if (IN(pb + 5)) { REPEAT(REP_LGT) { FnGates fn{F.P, F.WGT + (size_t)j * 16 * 65536, F.LA, F.BV, F.b_gates + (size_t)j * 4 * D, F.SPT + (size_t)j * 2 * D};
                if (FAST_LGT && fast) { pg8::CfgGates cfg; cfg.S.init(128, 16, F.G, (int)blockIdx.x); cfg.XC = F.P; cfg.W = fn.W; cfg.LA = F.LA; cfg.BV = F.BV; cfg.bg = fn.bg; cfg.lam = fn.lam; pg8::gemm_phase(F.lds, cfg);
                    wg_gemm_ksplit<2>(fn, TaskMap{4 * 64, 64, 1024, 1}, F.lds, F.vcu, F.G, F.tid); }
                else wave_gemm(fn, TaskMap{FnGates::nrb * 64, 64, 0, 1}, gw, NGW, F.lane);
                } SEAM(pb + 5); }
            if (IN(pb + 6)) { REPEAT(REP_LS1) phase_scan1(F); SEAM(pb + 6); }
            if (IN(pb + 7)) { REPEAT(REP_LS3) phase_scan3(F); SEAM(pb + 7); }
            if (IN(pb + 8)) { FnOut fn{F.HG, F.WOUT + (size_t)j * 1024 * 1024, F.H};
                if (FAST_LOUT && fast) { pg8::CfgOut cfg; cfg.S.init(128, 4, F.G, (int)blockIdx.x); cfg.A = F.HG; cfg.W = fn.W; if (REP_LOUT > 1) { cfg.H = (bf16*)F.HF; pg8::gemm_phase(F.lds, cfg); } cfg.H = F.H; pg8::gemm_phase(F.lds, cfg);
                    wg_gemm_ksplit<2>(fn, TaskMap{4 * 16, 16, 1024, 1}, F.lds, F.vcu, F.G, F.tid); }
                else wave_gemm(fn, TaskMap{FnOut::nrb * 16, 16, 0, 1}, gw, NGW, F.lane);
                SEAM(pb + 8); }
        }
        if (IN(pb + 9)) { REPEAT(REP_RB) phase_rowB(F, layer); SEAM(pb + 9); }
        if (IN(pb + 10)) { REPEAT(REP_TK) phase_topk(F); SEAM(pb + 10); }
        if (IN(pb + 11)) { REPEAT(REP_M1) { FnM1f8 fn{(const unsigned char*)F.U, (const unsigned char*)F.WG1 + (size_t)layer * NE * 4096 * 1024, F.ROWL, (unsigned char*)F.HID};
            if (FAST_M1 && fast) { pg8::CfgM1 cfg; cfg.S.init(16, F.G, (int)blockIdx.x, 0, 4); cfg.U = fn.U; cfg.W = fn.W; cfg.HID = fn.HID;
                LAS unsigned short* idx = (LAS unsigned short*)(F.lds + IDX_OFF); cfg.idx = idx;
                {
                    int rl[16];
#pragma unroll
                    for (int ui = 0; ui < 16; ++ui) { pg8::Unit u; const bool ok = cfg.S.next(ui, u); rl[ui] = F.ROWL[(ok ? u.e * EPAD + u.pm * 256 : 0) + (F.tid & 255)]; }
#pragma unroll
                    for (int ui = 0; ui < 16; ++ui) if (F.tid < 256) idx[ui * 256 + F.tid] = (unsigned short)rl[ui];
                }
                __syncthreads();
                pg8::gemm_phase(F.lds, cfg);
                wg_gemm_ksplit8(fn, TaskMap{16 * 64, 64, ERB16 - 1, ERB16}, F.lds, F.vcu, F.G, F.tid); }
            else wg_gemm_ksplit8(fn, TaskMap{NE * ERB16 * 64, 64, 0, 1}, F.lds, F.vcu, F.G, F.tid);
            } SEAM(pb + 11); }
        if (IN(pb + 12)) { REPEAT(REP_M2) { FnM2f8 fn{(const unsigned char*)F.HID, (const unsigned char*)F.WD + (size_t)layer * NE * 1024 * WDP8, F.Y};
            if (FAST_M2 && fast) { pg8::CfgM2 cfg; cfg.S.init(4, F.G, (int)blockIdx.x); cfg.HID = fn.HID; cfg.W = fn.W; cfg.Y = F.Y; pg8::gemm_phase(F.lds, cfg);
                wg_gemm_ksplit8(fn, TaskMap{16 * 16, 16, ERB16 - 1, ERB16}, F.lds, F.vcu, F.G, F.tid); }
            else wg_gemm_ksplit8(fn, TaskMap{NE * ERB16 * 16, 16, 0, 1}, F.lds, F.vcu, F.G, F.tid);
            } SEAM(pb + 12); }
    }
}
#undef IN
#undef SEAM

__global__ void __launch_bounds__(512, 2) mega(Args args) {
    extern __shared__ __attribute__((aligned(16))) unsigned char lds_raw[];
    Frame F;
    F.lds = (LAS unsigned char*)lds_raw;
    F.tid = threadIdx.x; F.lane = F.tid & 63; F.wave = __builtin_amdgcn_readfirstlane(F.tid >> 6);
    F.G = gridDim.x; { const int bx = blockIdx.x; F.vcu = (F.G % 8 == 0) ? (bx % 8) * (F.G / 8) + bx / 8 : bx; }
    F.x = args.in[0]; F.meta = args.in[1]; F.norm_mix = args.in[2]; F.norm_ffn = args.in[3]; F.norm_final = args.in[4]; F.pool_w = args.in[5]; F.pool_scale = args.in[6]; F.w_in = args.in[7]; F.conv_w = args.in[8];
    F.conv_b = args.in[9]; F.w_gates = args.in[10]; F.b_gates = args.in[11]; F.lam = args.in[12]; F.w_out = args.in[13]; F.router_w = args.in[14]; F.moe_g = args.in[15]; F.moe_u = args.in[16]; F.moe_d = args.in[17];
    F.out = args.out; F.ws = args.ws;
    unsigned char* ws = args.ws;
    F.WG1 = (bf16*)(ws + WS_WG1); F.WD = (bf16*)(ws + WS_WD); F.WIN = (bf16*)(ws + WS_WIN); F.WGT = (bf16*)(ws + WS_WGT); F.WOUT = (bf16*)(ws + WS_WOUT); F.WPOOL = (bf16*)(ws + WS_WPOOL);
    F.H = (bf16*)(ws + WS_H); F.U = (bf16*)(ws + WS_U); F.P = (bf16*)(ws + WS_P); F.XB = (bf16*)(ws + WS_XB); F.GY = (bf16*)(ws + WS_GY); F.HG = (bf16*)(ws + WS_HG); F.HF = (float*)(ws + WS_Y);
    F.LA = (bf16*)(ws + WS_BIG); F.BV = (bf16*)(ws + WS_BIG + 2 * LA_BYTES); F.HID = (bf16*)(ws + WS_BIG); F.Y = (bf16*)(ws + WS_Y);
    F.AFF = (float*)(ws + WS_AFF); F.SLOT = (int*)(ws + WS_SLOT); F.GMAP = (float*)(ws + WS_GMAP); F.ROWL = (int*)(ws + WS_ROWL); F.AGG = (float*)(ws + WS_AGG); F.SPT = (float*)(ws + WS_SPT); F.RSTD = (float*)(ws + WS_RSTD);
    volatile LAS unsigned* MISC = (volatile LAS unsigned*)(F.lds + MISC_OFF);
    if (F.tid < 32) MISC[F.tid] = 0u;
    __syncthreads();
    const int lo = args.lo, hi = args.hi;
    const bool multi = (hi - lo) > 1;
    XcdBarrier bar; bar.bar = (unsigned*)(ws + WS_CTL) + CW_BAR; bar.x = 0; bar.st = nullptr;
    if (multi) bar = xcd_barrier_post((unsigned*)(ws + WS_CTL) + CW_BAR, MISC + 8);
#define IN(k) (lo <= (k) && (k) < hi)
#define SEAM(k) do { if ((k) + 1 < hi) xcd_barrier(bar); } while (0)
    run_layer<0>(F, lo, hi, bar); run_layer<1>(F, lo, hi, bar); run_layer<2>(F, lo, hi, bar); run_layer<3>(F, lo, hi, bar);
    if (IN(64)) { if (REP_RA > 1) phase_rowA<true, false>(F, DEPTH); phase_rowA<true, false>(F, DEPTH); }
#undef IN
#undef SEAM
}

extern "C" void kernel_launch(void* const* d_in, const int* in_sizes, int n_in, void* d_out, int out_size, void* d_ws, size_t ws_size, hipStream_t stream) {
    static int grid = 0;
    if (grid == 0) {
        if (n_in != 18 || in_sizes[0] != NB * SEQ * D || out_size != NB * SEQ * D || ws_size < WS_END) {
            fprintf(stderr, "kernel_launch: unexpected shapes (n_in %d, in0 %d, out %d, ws %zu < %zu)\n", n_in, n_in > 0 ? in_sizes[0] : -1, out_size, ws_size, (size_t)WS_END); grid = -1; return; }
        int dev = 0, cus = 0;
        if (hipGetDevice(&dev) != hipSuccess || hipDeviceGetAttribute(&cus, hipDeviceAttributeMultiprocessorCount, dev) != hipSuccess) { grid = -1; return; }
        if (hipFuncSetAttribute((const void*)mega, hipFuncAttributeMaxDynamicSharedMemorySize, LDS_BYTES) != hipSuccess) { fprintf(stderr, "kernel_launch: hipFuncSetAttribute failed\n"); grid = -1; return; }
        int per_cu = 0;
        if (hipOccupancyMaxActiveBlocksPerMultiprocessor(&per_cu, (const void*)mega, 512, LDS_BYTES) != hipSuccess || per_cu < 1) fprintf(stderr, "kernel_launch: occupancy query reports %d\n", per_cu);
        (void)hipGetLastError();
        grid = cus;
    }
    if (grid < 0) return;
    if (hipMemsetAsync((char*)d_ws + WS_CTL, 0, CTL_ZERO_BYTES, stream) != hipSuccess) return;
    Args a{};
    for (int i = 0; i < 18; ++i) a.in[i] = (const float*)d_in[i];
    a.out = (float*)d_out; a.ws = (unsigned char*)d_ws;
#if SINGLE_LAUNCH
    a.lo = 0; a.hi = 65;
    hipLaunchKernelGGL(mega, dim3(grid), dim3(512), LDS_BYTES, stream, a);
#else
    for (int layer = 0; layer < DEPTH; ++layer) {
        static const int pool_ph[] = {0, 1, 2, 9, 10, 11, 12}, lru_ph[] = {0, 3, 4, 5, 6, 7, 8, 9, 10, 11, 12};
        const int* ph = (layer & 1) ? lru_ph : pool_ph; const int n = (layer & 1) ? 11 : 7;
        for (int q = 0; q < n; ++q) { a.lo = layer * 16 + ph[q]; a.hi = a.lo + 1; hipLaunchKernelGGL(mega, dim3(grid), dim3(512), LDS_BYTES, stream, a); }
    }
    a.lo = 64; a.hi = 65; hipLaunchKernelGGL(mega, dim3(grid), dim3(512), LDS_BYTES, stream, a);
#endif
}
```

```cpp
#include <hip/hip_runtime.h>
#include <cstdio>
#include <cstdint>

#ifndef SINGLE_LAUNCH
#define SINGLE_LAUNCH 1
#endif

constexpr int NB = 8, SEQ = 4096, NMETA = 16, T = SEQ + NMETA, D = 1024, NE = 16, CAP = 2 * T / NE, DF = 2048, DEPTH = 4;
constexpr int MMAIN = NB * SEQ;
constexpr int MROWS = NB * T;
constexpr int MPAD = 33024;
constexpr int EROWS = NB * CAP;
constexpr int EPAD = 4352;
constexpr int HIDP8 = 2112, WDP8 = 2112;
constexpr float WSCALE = 32.0f, WINV = 1.0f / 32.0f;
constexpr int NCHUNK = 33, CHL = 128;
static_assert(CAP == 514 && T == 4112 && EROWS == 4112, "shapes");
constexpr float RMS_EPS = 1e-6f;

constexpr size_t MiB = 1u << 20;
constexpr size_t WS_CTL = 0, CTL_ZERO_BYTES = 1 * MiB;
constexpr size_t WS_WG1 = 1 * MiB;
constexpr size_t WS_WD = WS_WG1 + 512 * MiB;
constexpr size_t WS_WIN = WS_WD + 264 * MiB;
constexpr size_t WS_WGT = WS_WIN + 8 * MiB;
constexpr size_t WS_WOUT = WS_WGT + 4 * MiB;
constexpr size_t WS_WPOOL = WS_WOUT + 4 * MiB;
constexpr size_t WS_H = WS_WPOOL + 1 * MiB;
constexpr size_t WS_U = WS_H + 129 * MiB;
constexpr size_t WS_P = WS_U + 65 * MiB;
constexpr size_t WS_XB = WS_P + 65 * MiB;
constexpr size_t WS_GY = WS_XB + 65 * MiB;
constexpr size_t WS_HG = WS_GY + 65 * MiB;
constexpr size_t WS_BIG = WS_HG + 65 * MiB;
constexpr size_t WS_Y = WS_BIG + 282 * MiB;
constexpr size_t WS_AFF = WS_Y + 136 * MiB;
constexpr size_t WS_SLOT = WS_AFF + 3 * MiB;
constexpr size_t WS_GMAP = WS_SLOT + 3 * MiB;
constexpr size_t WS_ROWL = WS_GMAP + 3 * MiB;
constexpr size_t WS_AGG = WS_ROWL + 1 * MiB;
constexpr size_t WS_SPT = WS_AGG + 9 * MiB / 2;
constexpr size_t WS_RSTD = WS_SPT + 64 * 1024;
constexpr size_t WS_END = WS_AGG + 5 * MiB;
constexpr size_t LA_BYTES = (size_t)MPAD * 1024 * 2;

constexpr int CW_BAR = 4096;

constexpr int RING_BYTES = 131072;
constexpr int MISC_OFF = RING_BYTES + 320;
constexpr int LDS_BYTES = 147456;

#define LAS __attribute__((address_space(3)))
typedef unsigned short bf16;
typedef short bf16x8 __attribute__((ext_vector_type(8)));
typedef float f32x4 __attribute__((ext_vector_type(4)));
typedef float f32x2 __attribute__((ext_vector_type(2)));
typedef unsigned u32x4 __attribute__((ext_vector_type(4)));
typedef unsigned u32x2 __attribute__((ext_vector_type(2)));

__device__ __forceinline__ unsigned cvt_pk_bf16(float lo, float hi) { unsigned r; asm volatile("v_cvt_pk_bf16_f32 %0, %1, %2" : "=v"(r) : "v"(lo), "v"(hi)); return r; }
__device__ __forceinline__ float bflo(unsigned w) { return __uint_as_float(w << 16); }
__device__ __forceinline__ float bfhi(unsigned w) { return __uint_as_float(w & 0xffff0000u); }
__device__ __forceinline__ float fast_exp(float x) { return __builtin_amdgcn_exp2f(x * 1.44269504089f); }
__device__ __forceinline__ float fast_rcp(float x) { return __builtin_amdgcn_rcpf(x); }
__device__ __forceinline__ float sigmoidf_(float x) { return fast_rcp(1.0f + fast_exp(-x)); }
__device__ __forceinline__ float siluf_(float x) { return x * sigmoidf_(x); }
typedef int v4i __attribute__((ext_vector_type(4)));
typedef int v8i __attribute__((ext_vector_type(8)));
__device__ __forceinline__ unsigned pk4_fp8(float a, float b, float c, float d) {
    a = __builtin_amdgcn_fmed3f(a, -448.f, 448.f); b = __builtin_amdgcn_fmed3f(b, -448.f, 448.f); c = __builtin_amdgcn_fmed3f(c, -448.f, 448.f); d = __builtin_amdgcn_fmed3f(d, -448.f, 448.f);
    unsigned r = 0; r = (unsigned)__builtin_amdgcn_cvt_pk_fp8_f32(a, b, (int)r, false); r = (unsigned)__builtin_amdgcn_cvt_pk_fp8_f32(c, d, (int)r, true); return r; }
__device__ __forceinline__ f32x4 fp8x4_to_f32(unsigned w) { const f32x2 lo = __builtin_amdgcn_cvt_pk_f32_fp8((int)w, false), hi = __builtin_amdgcn_cvt_pk_f32_fp8((int)w, true); return (f32x4){lo.x, lo.y, hi.x, hi.y}; }
__device__ __forceinline__ float silu_mul_s(float G, float U) { const float e = __builtin_amdgcn_exp2f(G * (-1.44269504089f * WINV)); return (G * U) * fast_rcp(__builtin_fmaf(e, 1024.0f, 1024.0f)); }
__device__ __forceinline__ float gelu_tanh(float x) { const float z = 0.7978845608f * (x + 0.044715f * x * x * x); return x * sigmoidf_(2.0f * z); }
__device__ __forceinline__ float wave_sum(float v) {
#pragma unroll
    for (int o = 1; o < 64; o <<= 1) v += __shfl_xor(v, o);
    return v;
}
__device__ __forceinline__ int opaque(int v) { asm volatile("" : "+v"(v)); return v; }
__device__ __forceinline__ int row_of(int b, int t) { return t >= NMETA ? b * SEQ + (t - NMETA) : MMAIN + b * NMETA + t; }

#define XB_TMO      128
#define XB_XCNT(j)  (256  + 64 * (j))
#define XB_XSUB(j)  (1280 + 64 * (j))
#define XB_XGEN(j)  (2304 + 64 * (j))
#define XB_TOP      3328
#define XB_TOPGEN   3392
#define XCD_BAR_WORDS 3456
#define XB_SPIN_CAP (1u << 18)
__device__ __forceinline__ unsigned xb_ld(unsigned* p)              { return __hip_atomic_load(p, __ATOMIC_RELAXED, __HIP_MEMORY_SCOPE_AGENT); }
__device__ __forceinline__ unsigned xb_add(unsigned* p, unsigned v) { return __hip_atomic_fetch_add(p, v, __ATOMIC_RELAXED, __HIP_MEMORY_SCOPE_AGENT); }
__device__ __forceinline__ unsigned xb_xcc_id() { return (unsigned)__builtin_amdgcn_s_getreg((3 << 11) | 20) & 0xFu; }
#define XB_SPIN(cond, bar) do { unsigned _sp = 0; while (cond) { __builtin_amdgcn_s_sleep(1); \
    if ((++_sp & 255u) == 0u) { if (xb_ld(&(bar)[XB_TMO])) break; if (_sp > XB_SPIN_CAP) { atomicAdd(&(bar)[XB_TMO], 1u); break; } } } } while (0)
struct XcdBarrier { unsigned* bar; unsigned x; volatile LAS unsigned* st; };
__device__ __forceinline__ XcdBarrier xcd_barrier_post(unsigned* bar, volatile LAS unsigned* st) {
    XcdBarrier b; b.bar = bar; b.x = xb_xcc_id(); b.st = st;
    if (threadIdx.x == 0) (void)xb_add(&bar[XB_XCNT(b.x)], 1u);
    return b;
}
__device__ __forceinline__ void xcd_barrier_complete(unsigned* bar, unsigned x, unsigned& nloc, unsigned& nx) {
    const unsigned G = gridDim.x * gridDim.y * gridDim.z;
    unsigned sum, cnt, mine, sp = 0u;
    for (;;) {
        sum = 0u; cnt = 0u; mine = 0u;
#pragma unroll
        for (unsigned j = 0; j < 16; ++j) { const unsigned c = xb_ld(&bar[XB_XCNT(j)]); sum += c; cnt += (c > 0u) ? 1u : 0u; mine = (j == x) ? c : mine; }
        if (sum == G) break;
        __builtin_amdgcn_s_sleep(1);
        if ((++sp & 255u) == 0u) { if (xb_ld(&bar[XB_TMO])) break; if (sp > XB_SPIN_CAP) { atomicAdd(&bar[XB_TMO], 1u); break; } }
    }
    nloc = mine > 0u ? mine : 1u; nx = cnt > 0u ? cnt : 1u;
}
__device__ __forceinline__ void xcd_barrier(const XcdBarrier& b) {
    asm volatile("s_waitcnt vmcnt(0)" ::: "memory");
    __syncthreads();
    if (threadIdx.x == 0) {
        unsigned* bar = b.bar;
        __builtin_amdgcn_s_waitcnt(0);
        unsigned nloc = b.st[0], nx = b.st[1];
        if (nloc == 0u) { xcd_barrier_complete(bar, b.x, nloc, nx); b.st[0] = nloc; b.st[1] = nx; }
        const unsigned old = xb_add(&bar[XB_XSUB(b.x)], 1u);
        const unsigned gen = old / nloc;
        if (old + 1u == (gen + 1u) * nloc) {
            __builtin_amdgcn_fence(__ATOMIC_RELEASE, "agent");
            asm volatile("s_waitcnt vmcnt(0)" ::: "memory");
            const unsigned og = xb_add(&bar[XB_TOP], 1u);
            const unsigned tg = og / nx;
            if (og + 1u == (tg + 1u) * nx) xb_add(&bar[XB_TOPGEN], 1u);
            else XB_SPIN(xb_ld(&bar[XB_TOPGEN]) == tg, bar);
            __builtin_amdgcn_fence(__ATOMIC_ACQUIRE, "agent");
            xb_add(&bar[XB_XGEN(b.x)], 1u);
            asm volatile("s_waitcnt vmcnt(0)" ::: "memory");
        } else {
            XB_SPIN(xb_ld(&bar[XB_XGEN(b.x)]) == gen, bar);
            __builtin_amdgcn_fence(__ATOMIC_ACQUIRE, "agent");
            asm volatile("s_waitcnt vmcnt(0)" ::: "memory");
        }
    }
    __syncthreads();
}

struct Args { const float* in[18]; float* out; unsigned char* ws; int lo, hi; };
struct Frame {
    LAS unsigned char* lds;
    int tid, lane, wave, vcu, G;
    const float *x, *meta, *norm_mix, *norm_ffn, *norm_final, *pool_w, *pool_scale, *w_in, *conv_w, *conv_b, *w_gates, *b_gates, *lam, *w_out, *router_w, *moe_g, *moe_u, *moe_d;
    float* out; unsigned char* ws;
    bf16 *WG1, *WD, *WIN, *WGT, *WOUT, *WPOOL;
    bf16* H; float* HF; bf16 *U, *P, *XB, *GY, *HG, *LA, *BV, *HID, *Y;
    float* AFF; int* SLOT; float* GMAP; int* ROWL; float* AGG; float* SPT; float* RSTD;
};

struct ProItem { const float* src; unsigned char* dst; const float* ks; int ldw, ldt, f8; };
__device__ __forceinline__ ProItem pro_decode(const Frame& F, int it) {
    constexpr int I_MOE = 64 * 512, I_IN = 2 * 512, I_OUT = 2 * 256, I_GT = 32 * 16;
    ProItem p; p.ks = nullptr; int r = it;
    if (r < 2 * I_MOE) {
        const int up = r >= I_MOE; if (up) r -= I_MOE;
        const int le = r >> 9, q = r & 511, k0 = (q >> 6) * 128, n0 = (q & 63) * 32;
        p.src = (up ? F.moe_u : F.moe_g) + (size_t)le * 1024 * 2048 + (size_t)k0 * 2048 + n0; p.ldw = 2048;
        p.dst = (unsigned char*)F.WG1 + ((size_t)le * 4096 + (n0 >> 7) * 256 + up * 128 + (n0 & 127)) * 1024 + k0; p.ldt = 1024; p.f8 = 1; return p; }
    r -= 2 * I_MOE;
    if (r < I_MOE) {
        const int le = r >> 9, q = r & 511, k0 = (q >> 5) * 128, n0 = (q & 31) * 32;
        p.src = F.moe_d + (size_t)le * 2048 * 1024 + (size_t)k0 * 1024 + n0; p.ldw = 1024;
        p.dst = (unsigned char*)F.WD + ((size_t)le * 1024 + n0) * WDP8 + k0; p.ldt = WDP8; p.f8 = 1; return p; }
    r -= I_MOE; p.f8 = 0;
    if (r < I_IN) {
        const int j = r >> 9, q = r & 511, k0 = (q >> 6) * 128, n0 = (q & 63) * 32;
        p.src = F.w_in + (size_t)j * 1024 * 2048 + (size_t)k0 * 2048 + n0; p.ldw = 2048; p.dst = (unsigned char*)(F.WIN + ((size_t)j * 2048 + n0) * 1024 + k0); p.ldt = 2048; p.ks = F.norm_mix + (size_t)(2 * j + 1) * D + k0; return p; }
    r -= I_IN;
    if (r < I_OUT) {
        const int j = r >> 8, q = r & 255, k0 = (q >> 5) * 128, n0 = (q & 31) * 32;
        p.src = F.w_out + (size_t)j * 1024 * 1024 + (size_t)k0 * 1024 + n0; p.ldw = 1024; p.dst = (unsigned char*)(F.WOUT + ((size_t)j * 1024 + n0) * 1024 + k0); p.ldt = 2048; return p; }
    r -= I_OUT;
    if (r < I_GT) {
        const int mat = r >> 4, q = r & 15, k0 = (q >> 3) * 128, n0 = (q & 7) * 32;
        const int j = mat >> 4, d = (mat >> 3) & 1, g = (mat >> 2) & 1, h = mat & 3, nt = d * 8 + h * 2 + (n0 >> 7);
        p.src = F.w_gates + (size_t)mat * 65536 + (size_t)k0 * 256 + n0; p.ldw = 256; p.dst = (unsigned char*)(F.WGT + (((size_t)j * 16 + nt) * 256 + g * 128 + (n0 & 127)) * 256 + k0); p.ldt = 512; return p; }
    r -= I_GT;
    {
        const int mat = r >> 4, q = r & 15, k0 = (q >> 3) * 128, n0 = (q & 7) * 32;
        p.src = F.pool_w + (size_t)mat * 65536 + (size_t)k0 * 256 + n0; p.ldw = 256; p.dst = (unsigned char*)(F.WPOOL + ((size_t)mat * 256 + n0) * 256 + k0); p.ldt = 512; return p; }
}
__device__ __forceinline__ void pro_load(const ProItem& p, f32x4 (&v)[16], int lane) {
    const int rr = lane >> 3, sg = lane & 7;
#pragma unroll
    for (int i = 0; i < 16; ++i) v[i] = __builtin_nontemporal_load((const f32x4*)(p.src + (size_t)(8 * i + rr) * p.ldw + 4 * sg));
}
__device__ __forceinline__ void pro_finish(const ProItem& p, const f32x4 (&v)[16], LAS float* scr, int lane) {
    { const int rr = lane >> 3, sg = lane & 7;
#pragma unroll
        for (int i = 0; i < 16; ++i) *(LAS f32x4*)(scr + (8 * i + rr) * 32 + ((4 * sg) ^ (((i >> 1) & 3) << 3))) = v[i]; }
    asm volatile("s_waitcnt lgkmcnt(0)" ::: "memory");
    const int c = lane & 7;
#pragma unroll
    for (int j = 0; j < 4; ++j) { const int n = (lane >> 3) + 8 * j; const LAS float* s = scr + (16 * c) * 32 + (n ^ ((c & 3) << 3));
        float t[16];
#pragma unroll
        for (int q = 0; q < 16; ++q) t[q] = s[q * 32];
        if (p.f8) { u32x4 o; o.x = pk4_fp8(t[0] * WSCALE, t[1] * WSCALE, t[2] * WSCALE, t[3] * WSCALE); o.y = pk4_fp8(t[4] * WSCALE, t[5] * WSCALE, t[6] * WSCALE, t[7] * WSCALE);
            o.z = pk4_fp8(t[8] * WSCALE, t[9] * WSCALE, t[10] * WSCALE, t[11] * WSCALE); o.w = pk4_fp8(t[12] * WSCALE, t[13] * WSCALE, t[14] * WSCALE, t[15] * WSCALE);
            __builtin_nontemporal_store(o, (u32x4*)(p.dst + (size_t)n * p.ldt + 16 * c)); }
        else { if (p.ks) { const float* ks = p.ks + 16 * c;
#pragma unroll
                for (int q4 = 0; q4 < 4; ++q4) { const f32x4 g4 = *(const f32x4*)(ks + 4 * q4); t[4 * q4] *= g4.x; t[4 * q4 + 1] *= g4.y; t[4 * q4 + 2] *= g4.z; t[4 * q4 + 3] *= g4.w; } }
            u32x4 o0, o1; o0.x = cvt_pk_bf16(t[0], t[1]); o0.y = cvt_pk_bf16(t[2], t[3]); o0.z = cvt_pk_bf16(t[4], t[5]); o0.w = cvt_pk_bf16(t[6], t[7]);
            o1.x = cvt_pk_bf16(t[8], t[9]); o1.y = cvt_pk_bf16(t[10], t[11]); o1.z = cvt_pk_bf16(t[12], t[13]); o1.w = cvt_pk_bf16(t[14], t[15]);
            unsigned char* d = p.dst + (size_t)n * p.ldt + 32 * c; __builtin_nontemporal_store(o0, (u32x4*)d); __builtin_nontemporal_store(o1, (u32x4*)(d + 16)); } }
    asm volatile("s_waitcnt lgkmcnt(0)" ::: "memory");
}
__device__ __forceinline__ void phase_prologue(const Frame& F) {
    LAS float* scr = (LAS float*)(F.lds + F.wave * 16384);
    const int gw = F.vcu * 8 + F.wave, NGW = F.G * 8, lane = F.lane;
    for (int i = gw * 64 + lane; i < 4 * D; i += NGW * 64) F.SPT[i] = -8.0f * log1pf(expf(-F.lam[i]));
    constexpr int NITEMS = 3 * 64 * 512 + 2 * 512 + 2 * 256 + 32 * 16 + 8 * 16;
    int it = gw; if (it >= NITEMS) return;
    ProItem cur = pro_decode(F, it); f32x4 v[16], w[16]; pro_load(cur, v, lane);
    for (;;) {
        const int nit = it + NGW; const bool more = nit < NITEMS; ProItem nxt = cur;
        if (more) nxt = pro_decode(F, nit);
        pro_load(nxt, w, lane);
        pro_finish(cur, v, scr, lane);
        if (!more) break;
        cur = nxt; it = nit;
#pragma unroll
        for (int i = 0; i < 16; ++i) v[i] = w[i];
    }
}

template <bool FINAL, bool FIRST, bool DRY = false>
__device__ __forceinline__ void phase_rowA(const Frame& F, int layer) {
    const int gw = F.vcu * 8 + F.wave, NGW = F.G * 8, lane = F.lane;
    const float* gain = FINAL ? F.norm_final : F.norm_mix + layer * D;
    f32x4 gn[4];
#pragma unroll
    for (int j = 0; j < 4; ++j) gn[j] = *(const f32x4*)(gain + 4 * lane + 256 * j);
    const int rend = FINAL ? MMAIN : MROWS;
    int sl_n = -1; float gg_n = 0.f;
    if (!FIRST) { if (lane < 16 && gw < rend) { sl_n = F.SLOT[(size_t)gw * 16 + lane]; gg_n = F.GMAP[(size_t)gw * 16 + lane]; } }
    for (int r = gw; r < rend; r += NGW) {
        f32x4 v[4];
        if (FIRST) {
            const float* src = r < MMAIN ? F.x + (size_t)r * D : F.meta + (size_t)((r - MMAIN) & 15) * D;
#pragma unroll
            for (int j = 0; j < 4; ++j) v[j] = *(const f32x4*)(src + 4 * lane + 256 * j);
        } else {
            const int sl = sl_n; const float gg = gg_n;
            const bf16* src = F.H + (size_t)r * D;
#pragma unroll
            for (int j = 0; j < 4; ++j) { const u32x2 w = *(const u32x2*)(src + 4 * lane + 256 * j); v[j] = (f32x4){bflo(w.x), bfhi(w.x), bflo(w.y), bfhi(w.y)}; }
            { const int rn = r + NGW; sl_n = -1; if (lane < 16 && rn < rend) { sl_n = F.SLOT[(size_t)rn * 16 + lane]; gg_n = F.GMAP[(size_t)rn * 16 + lane]; } }
            unsigned mask = (unsigned)__ballot(sl >= 0) & 0xffffu;
            while (mask) {
                int ee[4]; float gq[4]; const unsigned char* yr[4];
#pragma unroll
                for (int q = 0; q < 4; ++q) { const bool on = mask != 0u; const int e = on ? (__builtin_ffs((int)mask) - 1) : 0; mask &= mask - 1u;
                    const int s = __builtin_amdgcn_readlane(sl, e); const float g = __uint_as_float(__builtin_amdgcn_readlane(__float_as_uint(gg), e));
                    ee[q] = e; gq[q] = on ? g : 0.f; yr[q] = (const unsigned char*)F.Y + ((size_t)e * EPAD + (on ? s : 0)) * D; }
                unsigned w[4][4];
#pragma unroll
                for (int q = 0; q < 4; ++q)
#pragma unroll
                    for (int j = 0; j < 4; ++j) w[q][j] = *(const unsigned*)(yr[q] + 4 * lane + 256 * j);
#pragma unroll
                for (int q = 0; q < 4; ++q)
#pragma unroll
                    for (int j = 0; j < 4; ++j) v[j] += fp8x4_to_f32(w[q][j]) * gq[q];
                (void)ee;
            }
        }
        if (!FINAL && !DRY) {
            bf16* dst = F.H + (size_t)r * D;
#pragma unroll
            for (int j = 0; j < 4; ++j) { u32x2 w; w.x = cvt_pk_bf16(v[j].x, v[j].y); w.y = cvt_pk_bf16(v[j].z, v[j].w); *(u32x2*)(dst + 4 * lane + 256 * j) = w; }
        }
        float ss = 0.f;
#pragma unroll
        for (int j = 0; j < 4; ++j) ss += (v[j].x * v[j].x + v[j].y * v[j].y) + (v[j].z * v[j].z + v[j].w * v[j].w);
        const float rstd = 1.0f / sqrtf(wave_sum(ss) * (1.0f / D) + RMS_EPS);
        if (FINAL) {
            float* dst = F.out + (size_t)r * D;
#pragma unroll
            for (int j = 0; j < 4; ++j) *(f32x4*)(dst + 4 * lane + 256 * j) = v[j] * rstd * gn[j];
        } else {
            if (lane == 0) F.RSTD[r] = rstd;
        }
    }
}
__device__ __forceinline__ void phase_rowB(const Frame& F, int layer) {
    const int gw = F.vcu * 8 + F.wave, NGW = F.G * 8, lane = F.lane;
    LAS float* wT = (LAS float*)F.lds;
    const float* rw = F.router_w + (size_t)layer * D * NE;
    const float* gain = F.norm_ffn + layer * D;
    f32x4 gn[4];
#pragma unroll
    for (int j = 0; j < 4; ++j) gn[j] = *(const f32x4*)(gain + 4 * lane + 256 * j);
    f32x4 nx[2][4];
#pragma unroll
    for (int q = 0; q < 2; ++q) { const int r = gw + q * NGW; const bf16* src = F.H + (size_t)(r < MROWS ? r : gw) * D;
#pragma unroll
        for (int j = 0; j < 4; ++j) { const u32x2 w = *(const u32x2*)(src + 4 * lane + 256 * j); nx[q][j] = (f32x4){bflo(w.x), bfhi(w.x), bflo(w.y), bfhi(w.y)}; } }
    {
        f32x4 rv[8];
#pragma unroll
        for (int i = 0; i < 8; ++i) rv[i] = *(const f32x4*)(rw + 4 * (F.tid + 512 * i));
#pragma unroll
        for (int i = 0; i < 8; ++i) { const int i4 = F.tid + 512 * i, c = i4 >> 2, e = (i4 & 3) * 4; wT[e * 1024 + c] = rv[i].x; wT[(e + 1) * 1024 + c] = rv[i].y; wT[(e + 2) * 1024 + c] = rv[i].z; wT[(e + 3) * 1024 + c] = rv[i].w; }
    }
    __syncthreads();
    for (int r0 = gw; r0 < MROWS; r0 += 2 * NGW) {
        f32x4 v[2][4];
#pragma unroll
        for (int q = 0; q < 2; ++q)
#pragma unroll
            for (int j = 0; j < 4; ++j) v[q][j] = nx[q][j];
#pragma unroll
        for (int q = 0; q < 2; ++q) { const int r = r0 + (2 + q) * NGW; const bf16* src = F.H + (size_t)(r < MROWS ? r : gw) * D;
#pragma unroll
            for (int j = 0; j < 4; ++j) { const u32x2 w = *(const u32x2*)(src + 4 * lane + 256 * j); nx[q][j] = (f32x4){bflo(w.x), bfhi(w.x), bflo(w.y), bfhi(w.y)}; } }
        const bool has1 = (r0 + NGW) < MROWS;
#pragma unroll
        for (int q = 0; q < 2; ++q) {
            float ss = 0.f;
#pragma unroll
            for (int j = 0; j < 4; ++j) ss += (v[q][j].x * v[q][j].x + v[q][j].y * v[q][j].y) + (v[q][j].z * v[q][j].z + v[q][j].w * v[q][j].w);
            const float rstd = 1.0f / sqrtf(wave_sum(ss) * (1.0f / D) + RMS_EPS);
            const int r = r0 + q * NGW;
#pragma unroll
            for (int j = 0; j < 4; ++j) v[q][j] = v[q][j] * rstd * gn[j];
            if (q == 0 || has1) { unsigned char* dst = (unsigned char*)F.U + (size_t)r * D;
#pragma unroll
                for (int j = 0; j < 4; ++j) *(unsigned*)(dst + 4 * lane + 256 * j) = pk4_fp8(v[q][j].x, v[q][j].y, v[q][j].z, v[q][j].w); }
        }
        float val[32];
        const int woff = opaque(4 * lane);
#pragma unroll
        for (int e = 0; e < 16; ++e) { f32x2 p0 = (f32x2){0.f, 0.f}, p1 = p0;
#pragma unroll
            for (int j = 0; j < 4; ++j) { const f32x4 w = *(const LAS f32x4*)(wT + e * 1024 + woff + 256 * j); const f32x2 wl = (f32x2){w.x, w.y}, wh = (f32x2){w.z, w.w};
                p0 += (f32x2){v[0][j].x, v[0][j].y} * wl; p0 += (f32x2){v[0][j].z, v[0][j].w} * wh; p1 += (f32x2){v[1][j].x, v[1][j].y} * wl; p1 += (f32x2){v[1][j].z, v[1][j].w} * wh; }
            val[e] = p0.x + p0.y; val[16 + e] = p1.x + p1.y; }
#define BFLY(S, HH) { const bool up = (lane >> (S)) & 1; _Pragma("unroll") for (int i = 0; i < (HH); ++i) { const float keep = up ? val[(HH) + i] : val[i], send = up ? val[i] : val[(HH) + i]; val[i] = keep + __shfl_xor(send, 1 << (S)); } }
        BFLY(0, 16) BFLY(1, 8) BFLY(2, 4) BFLY(3, 2) BFLY(4, 1)
#undef BFLY
        float lg = val[0] + __shfl_xor(val[0], 32);
        const int vi = ((lane & 1) << 4) | ((lane & 2) << 2) | (lane & 4) | ((lane & 8) >> 2) | ((lane & 16) >> 4);
        float mx = lg;
#pragma unroll
        for (int o = 2; o <= 16; o <<= 1) mx = fmaxf(mx, __shfl_xor(mx, o));
        const float p = expf(lg - mx); float sum = p;
#pragma unroll
        for (int o = 2; o <= 16; o <<= 1) sum += __shfl_xor(sum, o);
        const int q = vi >> 4, e = vi & 15, r = r0 + q * NGW;
        if (lane < 32 && (q == 0 || has1)) {
            int b, t; if (r < MMAIN) { b = r >> 12; t = (r & 4095) + NMETA; } else { b = (r - MMAIN) >> 4; t = (r - MMAIN) & 15; }
            F.AFF[((size_t)b * NE + e) * T + t] = p / sum;
        }
    }
    __syncthreads();
}

__device__ __forceinline__ int block_excl_scan(int v, LAS int* wsum, int tid, int lane, int wave, int& total) {
    int s = v;
#pragma unroll
    for (int o = 1; o < 64; o <<= 1) { const int t = __shfl_up(s, o); if (lane >= o) s += t; }
    __syncthreads();
    if (lane == 63) wsum[wave] = s;
    __syncthreads();
    int base = 0, tot = 0;
#pragma unroll
    for (int w = 0; w < 8; ++w) { const int x = wsum[w]; if (w < wave) base += x; tot += x; }
    total = tot;
    return base + s - v;
}
__device__ __forceinline__ void phase_topk(const Frame& F) {
    LAS unsigned* keys = (LAS unsigned*)F.lds;
    LAS int* hist = (LAS int*)(F.lds + 20480);
    LAS int* misc = (LAS int*)(F.lds + 20480 + 1024);
    const int tid = F.tid, lane = F.lane, wave = F.wave;
    for (int task = blockIdx.x; task < NB * NE; task += F.G) {
        const int b = task >> 4, e = task & 15;
        const float* aff = F.AFF + ((size_t)b * NE + e) * T;
        __syncthreads();
        {   unsigned kv[9];
#pragma unroll
            for (int i = 0; i < 9; ++i) { const int t = tid + 512 * i; kv[i] = __float_as_uint(aff[t < T ? t : T - 1]); }
#pragma unroll
            for (int i = 0; i < 9; ++i) { const int t = tid + 512 * i; if (t < T) keys[t] = kv[i]; } }
        unsigned prefix = 0u, pmask = 0u; int need = CAP;
        for (int p = 3; p >= 0; --p) {
            if (tid < 256) hist[tid] = 0;
            __syncthreads();
            for (int t = tid; t < T; t += 512) { const unsigned k = keys[t]; if ((k & pmask) == prefix) __hip_atomic_fetch_add(&hist[(k >> (8 * p)) & 255u], 1, __ATOMIC_RELAXED, __HIP_MEMORY_SCOPE_WORKGROUP); }
            __syncthreads();
            if (wave == 0) {
                int c[4]; int tot = 0;
#pragma unroll
                for (int q = 0; q < 4; ++q) { c[q] = hist[4 * lane + q]; tot += c[q]; }
                int s = tot;
#pragma unroll
                for (int o = 1; o < 64; o <<= 1) { const int x = __shfl_down(s, o); if (lane + o < 64) s += x; }
                int above = s - tot;
                if (above < need && need <= s) {
                    int a = above;
#pragma unroll
                    for (int q = 3; q >= 0; --q) { if (need <= a + c[q] && need > a) { misc[0] = 4 * lane + q; misc[1] = need - a; } a += c[q]; }
                }
            }
            __syncthreads();
            prefix |= (unsigned)misc[0] << (8 * p); pmask |= 0xFFu << (8 * p); need = misc[1];
            __syncthreads();
        }
        const unsigned vstar = prefix;
        const int t0 = tid * 9, t1 = (t0 + 9 < T) ? t0 + 9 : T;
        int neq = 0;
        for (int t = t0; t < t1; ++t) neq += (keys[t] == vstar) ? 1 : 0;
        int toteq; int eqbase = block_excl_scan(neq, misc + 8, tid, lane, wave, toteq);
        int nsel = 0; unsigned selmask = 0u; { int er = eqbase;
            for (int t = t0; t < t1; ++t) { const unsigned k = keys[t]; bool s = k > vstar; if (k == vstar) { s = er < need; ++er; } if (s) { selmask |= 1u << (t - t0); ++nsel; } } }
        int totsel; int sbase = block_excl_scan(nsel, misc + 8, tid, lane, wave, totsel);
        for (int t = t0; t < t1; ++t) {
            const int row = row_of(b, t);
            if ((selmask >> (t - t0)) & 1u) { const int pos = b * CAP + sbase; ++sbase;
                F.ROWL[e * EPAD + pos] = row; F.SLOT[(size_t)row * 16 + e] = pos; F.GMAP[(size_t)row * 16 + e] = __uint_as_float(keys[t]); }
            else F.SLOT[(size_t)row * 16 + e] = -1;
        }
        if (b == 0 && tid < EPAD - EROWS) F.ROWL[e * EPAD + EROWS + tid] = 0;
    }
    __syncthreads();
}

__device__ __forceinline__ void phase_poolwin(const Frame& F, int layer) {
    const int gw = F.vcu * 8 + F.wave, NGW = F.G * 8, lane = F.lane;
    constexpr int CHS = 33, NTC = (T + CHS - 1) / CHS;
    for (int it = gw; it < NB * NTC * 2; it += NGW) {
        const int half = it & 1, tc = (it >> 1) % NTC, b = (it >> 1) / NTC;
        const int col = half * 512 + lane * 8, g = col >> 8, hw = 1 << g;
        const int t0 = tc * CHS, t1 = (t0 + CHS < T) ? t0 + CHS : T;
        float sum[8];
#pragma unroll
        for (int q = 0; q < 8; ++q) sum[q] = 0.f;
        const u32x4 zero4 = (u32x4){0u, 0u, 0u, 0u};
        const bf16* ucol = F.H + col;
        float gnv[8];
        { const float* gp = F.norm_mix + (size_t)layer * D + col; const f32x4 g0 = *(const f32x4*)gp, g1 = *(const f32x4*)(gp + 4); gnv[0] = g0.x; gnv[1] = g0.y; gnv[2] = g0.z; gnv[3] = g0.w; gnv[4] = g1.x; gnv[5] = g1.y; gnv[6] = g1.z; gnv[7] = g1.w; }
#define PW_FMA(V_, S_) do { sum[0] += bflo(V_.x) * (S_); sum[1] += bfhi(V_.x) * (S_); sum[2] += bflo(V_.y) * (S_); sum[3] += bfhi(V_.y) * (S_); sum[4] += bflo(V_.z) * (S_); sum[5] += bfhi(V_.z) * (S_); sum[6] += bflo(V_.w) * (S_); sum[7] += bfhi(V_.w) * (S_); } while (0)
        {
            u32x4 iw[16]; float ir[16];
#pragma unroll
            for (int q = 0; q < 16; ++q) { const int dt = q - 8, tt = t0 + dt; const bool v = dt >= -hw && dt < hw && tt >= 0 && tt < T; const int row = row_of(b, v ? tt : t0); iw[q] = *(const u32x4*)(ucol + (size_t)row * D); ir[q] = F.RSTD[row]; }
#pragma unroll
            for (int q = 0; q < 16; ++q) { const int dt = q - 8, tt = t0 + dt; const bool v = dt >= -hw && dt < hw && tt >= 0 && tt < T; const float sc = v ? ir[q] : 0.f; PW_FMA(iw[q], sc); }
        }
        for (int tb = t0; tb < t1; tb += 11) {
            u32x4 c[11], wp[11], wm[11]; float rc[11], rp[11], rm[11];
#pragma unroll
            for (int q = 0; q < 11; ++q) { const int t = (tb + q < t1) ? tb + q : t1 - 1; const bool vp = t + hw < T, vm = t - hw >= 0;
                const int r0_ = row_of(b, t), r1_ = row_of(b, vp ? t + hw : t), r2_ = row_of(b, vm ? t - hw : t);
                c[q] = *(const u32x4*)(ucol + (size_t)r0_ * D); wp[q] = *(const u32x4*)(ucol + (size_t)r1_ * D); wm[q] = *(const u32x4*)(ucol + (size_t)r2_ * D);
                rc[q] = F.RSTD[r0_]; rp[q] = F.RSTD[r1_]; rm[q] = F.RSTD[r2_]; }
#pragma unroll
            for (int q = 0; q < 11; ++q) { const int t = tb + q;
                if (t < t1) {
                    const int lo = (t - hw > 0) ? t - hw : 0, hi = (t + hw < T) ? t + hw : T;
                    const float inv = 1.0f / (float)(hi - lo), cs = rc[q];
                    u32x4 o;
                    o.x = cvt_pk_bf16((sum[0] * inv - bflo(c[q].x) * cs) * gnv[0], (sum[1] * inv - bfhi(c[q].x) * cs) * gnv[1]); o.y = cvt_pk_bf16((sum[2] * inv - bflo(c[q].y) * cs) * gnv[2], (sum[3] * inv - bfhi(c[q].y) * cs) * gnv[3]);
                    o.z = cvt_pk_bf16((sum[4] * inv - bflo(c[q].z) * cs) * gnv[4], (sum[5] * inv - bfhi(c[q].z) * cs) * gnv[5]); o.w = cvt_pk_bf16((sum[6] * inv - bflo(c[q].w) * cs) * gnv[6], (sum[7] * inv - bfhi(c[q].w) * cs) * gnv[7]);
                    *(u32x4*)(F.P + (size_t)row_of(b, t) * D + col) = o;
                    const float sa = (t + hw < T) ? rp[q] : 0.f, sm = (t - hw >= 0) ? -rm[q] : 0.f;
                    PW_FMA(wp[q], sa); PW_FMA(wm[q], sm);
                }
            }
        }
#undef PW_FMA
    }
}
__device__ __forceinline__ void phase_conv(const Frame& F, int j) {
    const int gw = F.vcu * 8 + F.wave, NGW = F.G * 8, lane = F.lane;
    constexpr int CHS = 33, NTC = (T + CHS - 1) / CHS;
    const float* cw = F.conv_w + (size_t)j * 4 * D; const float* cb = F.conv_b + (size_t)j * D;
    for (int it = gw; it < NB * NTC * 2; it += NGW) {
        const int half = it & 1, tc = (it >> 1) % NTC, b = (it >> 1) / NTC;
        const int col = half * 512 + lane * 8;
        const int t0 = tc * CHS, t1 = (t0 + CHS < T) ? t0 + CHS : T;
        float w[4][8], bias[8];
#pragma unroll
        for (int k = 0; k < 4; ++k) { const f32x4 a = *(const f32x4*)(cw + k * D + col), c = *(const f32x4*)(cw + k * D + col + 4);
            w[k][0] = a.x; w[k][1] = a.y; w[k][2] = a.z; w[k][3] = a.w; w[k][4] = c.x; w[k][5] = c.y; w[k][6] = c.z; w[k][7] = c.w; }
        { const f32x4 a = *(const f32x4*)(cb + col), c = *(const f32x4*)(cb + col + 4); bias[0] = a.x; bias[1] = a.y; bias[2] = a.z; bias[3] = a.w; bias[4] = c.x; bias[5] = c.y; bias[6] = c.z; bias[7] = c.w; }
        u32x4 xm1 = (u32x4){0u, 0u, 0u, 0u}, x0 = xm1, xp1 = xm1, xp2 = xm1;
        if (t0 - 1 >= 0) xm1 = *(const u32x4*)(F.XB + (size_t)row_of(b, t0 - 1) * D + col);
        x0 = *(const u32x4*)(F.XB + (size_t)row_of(b, t0) * D + col);
        if (t0 + 1 < T) xp1 = *(const u32x4*)(F.XB + (size_t)row_of(b, t0 + 1) * D + col);
        for (int tb = t0; tb < t1; tb += 11) {
            u32x4 xn[11];
#pragma unroll
            for (int q = 0; q < 11; ++q) { const int tt = tb + q + 2; xn[q] = *(const u32x4*)(F.XB + (size_t)row_of(b, tt < T ? tt : T - 1) * D + col); }
#pragma unroll
            for (int q = 0; q < 11; ++q) { const int t = tb + q;
                if (t < t1) {
                    xp2 = (t + 2 < T) ? xn[q] : (u32x4){0u, 0u, 0u, 0u};
                    float o[8];
#define CONV2(q_, m) o[2 * q_] = bias[2 * q_] + w[0][2 * q_] * bflo(xm1.m) + w[1][2 * q_] * bflo(x0.m) + w[2][2 * q_] * bflo(xp1.m) + w[3][2 * q_] * bflo(xp2.m); \
                     o[2 * q_ + 1] = bias[2 * q_ + 1] + w[0][2 * q_ + 1] * bfhi(xm1.m) + w[1][2 * q_ + 1] * bfhi(x0.m) + w[2][2 * q_ + 1] * bfhi(xp1.m) + w[3][2 * q_ + 1] * bfhi(xp2.m);
                    CONV2(0, x) CONV2(1, y) CONV2(2, z) CONV2(3, w)
#undef CONV2
                    u32x4 ov; ov.x = cvt_pk_bf16(o[0], o[1]); ov.y = cvt_pk_bf16(o[2], o[3]); ov.z = cvt_pk_bf16(o[4], o[5]); ov.w = cvt_pk_bf16(o[6], o[7]);
                    *(u32x4*)(F.P + (size_t)row_of(b, t) * D + col) = ov;
                    xm1 = x0; x0 = xp1; xp1 = xp2;
                }
            }
        }
    }
}
__device__ __forceinline__ void chunk_rows(int b, int k, int& r0, int& n) { if (k == 0) { r0 = MMAIN + b * NMETA; n = NMETA; } else { r0 = b * SEQ + (k - 1) * CHL; n = CHL; } }
__device__ __forceinline__ void phase_scan1(const Frame& F) {
    const int lane = F.lane;
    for (int it = F.wave * F.G + F.vcu; it < 2 * NB * NCHUNK * 8; it += 8 * F.G) {
        int cq, k, b, d;
        if (it < 4096) { cq = it & 7; k = 1 + ((it >> 3) & 31); b = (it >> 8) & 7; d = it >> 11; } else { const int u = it - 4096; cq = u & 7; k = 0; b = (u >> 3) & 7; d = u >> 6; }
        const int c0 = cq * 128 + lane * 2;
        int r0, n; chunk_rows(b, k, r0, n);
        const bf16* la = F.LA + (size_t)d * MPAD * D + c0; const bf16* bv = F.BV + (size_t)d * MPAD * D + c0;
        float h0 = 0.f, h1 = 0.f, s0 = 0.f, s1 = 0.f;
        for (int s = 0; s < n; s += 32) {
            unsigned lw[32], bw[32];
#pragma unroll
            for (int q = 0; q < 32; ++q) { const int sq = (s + q < n) ? s + q : n - 1; const int r = d ? (r0 + n - 1 - sq) : (r0 + sq); lw[q] = *(const unsigned*)(la + (size_t)r * D); bw[q] = *(const unsigned*)(bv + (size_t)r * D); }
#pragma unroll
            for (int q = 0; q < 32; ++q) { const bool ok = s + q < n; const unsigned lq = ok ? lw[q] : 0u, bq = ok ? bw[q] : 0u;
                const float l0 = bflo(lq), l1 = bfhi(lq); s0 += l0; s1 += l1; h0 = fast_exp(l0) * h0 + bflo(bq); h1 = fast_exp(l1) * h1 + bfhi(bq); }
        }
        float* agg = F.AGG + ((size_t)(d * NB + b) * NCHUNK + k) * D + c0;
        *(f32x2*)agg = (f32x2){s0, s1};
        *(f32x2*)(agg + (size_t)2 * NB * NCHUNK * D) = (f32x2){h0, h1};
    }
}
template <int N>
__device__ __forceinline__ void scan3_rows(const Frame& F, int r0, int c0, float hf0, float hf1, float hb0, float hb1) {
    constexpr int HALF = N / 2;
    const bf16* laf = F.LA + c0; const bf16* bvf = F.BV + c0; const bf16* lab = laf + (size_t)MPAD * D; const bf16* bvb = bvf + (size_t)MPAD * D;
    unsigned sf[HALF], sb[HALF];
#pragma unroll
    for (int s = 0; s < HALF; s += 8) {
        unsigned lf[8], bf_[8], lb[8], bb[8];
#pragma unroll
        for (int q = 0; q < 8; ++q) { const size_t rf = (size_t)(r0 + s + q) * D, rb = (size_t)(r0 + N - 1 - s - q) * D;
            lf[q] = *(const unsigned*)(laf + rf); bf_[q] = *(const unsigned*)(bvf + rf); lb[q] = *(const unsigned*)(lab + rb); bb[q] = *(const unsigned*)(bvb + rb); }
#pragma unroll
        for (int q = 0; q < 8; ++q) {
            hf0 = fast_exp(bflo(lf[q])) * hf0 + bflo(bf_[q]); hf1 = fast_exp(bfhi(lf[q])) * hf1 + bfhi(bf_[q]); sf[s + q] = cvt_pk_bf16(hf0, hf1);
            hb0 = fast_exp(bflo(lb[q])) * hb0 + bflo(bb[q]); hb1 = fast_exp(bfhi(lb[q])) * hb1 + bfhi(bb[q]); sb[s + q] = cvt_pk_bf16(hb0, hb1); }
    }
#pragma unroll
    for (int s = HALF; s < N; s += 8) {
        unsigned lf[8], bf_[8], lb[8], bb[8], gf[8], gb[8];
#pragma unroll
        for (int q = 0; q < 8; ++q) { const size_t rf = (size_t)(r0 + s + q) * D, rb = (size_t)(r0 + N - 1 - s - q) * D;
            lf[q] = *(const unsigned*)(laf + rf); bf_[q] = *(const unsigned*)(bvf + rf); lb[q] = *(const unsigned*)(lab + rb); bb[q] = *(const unsigned*)(bvb + rb);
            gf[q] = *(const unsigned*)(F.GY + rf + c0); gb[q] = *(const unsigned*)(F.GY + rb + c0); }
#pragma unroll
        for (int q = 0; q < 8; ++q) { const size_t rf = (size_t)(r0 + s + q) * D, rb = (size_t)(r0 + N - 1 - s - q) * D;
            const unsigned xf = sb[N - 1 - s - q], xb = sf[N - 1 - s - q];
            hf0 = fast_exp(bflo(lf[q])) * hf0 + bflo(bf_[q]); hf1 = fast_exp(bfhi(lf[q])) * hf1 + bfhi(bf_[q]);
            *(unsigned*)(F.HG + rf + c0) = cvt_pk_bf16((hf0 + bflo(xf)) * bflo(gf[q]), (hf1 + bfhi(xf)) * bfhi(gf[q]));
            hb0 = fast_exp(bflo(lb[q])) * hb0 + bflo(bb[q]); hb1 = fast_exp(bfhi(lb[q])) * hb1 + bfhi(bb[q]);
            *(unsigned*)(F.HG + rb + c0) = cvt_pk_bf16((bflo(xb) + hb0) * bflo(gb[q]), (bfhi(xb) + hb1) * bfhi(gb[q])); }
    }
}
__device__ __forceinline__ void phase_scan3(const Frame& F) {
    const int lane = F.lane;
    constexpr size_t HOFF = (size_t)2 * NB * NCHUNK * D;
    for (int it = F.wave * F.G + F.vcu; it < NB * NCHUNK * 8; it += 8 * F.G) {
        int cq, k, b;
        if (it < 2048) { cq = it & 7; k = 1 + ((it >> 3) & 31); b = it >> 8; } else { const int u = it - 2048; cq = u & 7; k = 0; b = u >> 3; }
        const int c0 = cq * 128 + lane * 2;
        int r0, n; chunk_rows(b, k, r0, n);
        float hf0 = 0.f, hf1 = 0.f, hb0 = 0.f, hb1 = 0.f;
        for (int j0 = 0; j0 < k; j0 += 8) {
            f32x2 al[8], he[8];
#pragma unroll
            for (int q = 0; q < 8; ++q) { const int jx = (j0 + q < k) ? j0 + q : 0; const float* agg = F.AGG + ((size_t)(0 * NB + b) * NCHUNK + jx) * D + c0; al[q] = *(const f32x2*)agg; he[q] = *(const f32x2*)(agg + HOFF); }
#pragma unroll
            for (int q = 0; q < 8; ++q) if (j0 + q < k) { hf0 = fast_exp(al[q].x) * hf0 + he[q].x; hf1 = fast_exp(al[q].y) * hf1 + he[q].y; }
        }
        for (int j0 = NCHUNK - 1; j0 > k; j0 -= 8) {
            f32x2 al[8], he[8];
#pragma unroll
            for (int q = 0; q < 8; ++q) { const int jx = (j0 - q > k) ? j0 - q : NCHUNK - 1; const float* agg = F.AGG + ((size_t)(1 * NB + b) * NCHUNK + jx) * D + c0; al[q] = *(const f32x2*)agg; he[q] = *(const f32x2*)(agg + HOFF); }
#pragma unroll
            for (int q = 0; q < 8; ++q) if (j0 - q > k) { hb0 = fast_exp(al[q].x) * hb0 + he[q].x; hb1 = fast_exp(al[q].y) * hb1 + he[q].y; }
        }
        if (k == 0) scan3_rows<NMETA>(F, r0, c0, hf0, hf1, hb0, hb1); else scan3_rows<CHL>(F, r0, c0, hf0, hf1, hb0, hb1);
    }
}

struct TaskMap { int ntask, ncb, rb0, rbstride; };
template <class Fn>
__device__ __forceinline__ void wave_gemm(const Fn& fn, const TaskMap tm, int gw, int ngw, int lane_) {
    const int lane = opaque(lane_), fr = lane & 15, fq = lane >> 4;
    for (int task = gw; task < tm.ntask; task += ngw) {
        const int cb = task % tm.ncb, rb = tm.rb0 + (task / tm.ncb) * tm.rbstride;
        const bf16* ap[2]; const bf16* bp[4];
#pragma unroll
        for (int mi = 0; mi < 2; ++mi) ap[mi] = fn.arow(rb, cb, mi * 16 + fr) + 8 * fq;
#pragma unroll
        for (int nb = 0; nb < 4; ++nb) bp[nb] = fn.brow(rb, cb, nb * 16 + fr) + 8 * fq;
        f32x4 acc[2][4];
#pragma unroll
        for (int mi = 0; mi < 2; ++mi)
#pragma unroll
            for (int nb = 0; nb < 4; ++nb) acc[mi][nb] = (f32x4){0.f, 0.f, 0.f, 0.f};
#pragma unroll 2
        for (int k0 = 0; k0 < fn.K; k0 += 32) {
            bf16x8 a[2], bb[4];
#pragma unroll
            for (int mi = 0; mi < 2; ++mi) a[mi] = *(const bf16x8*)(ap[mi] + k0);
#pragma unroll
            for (int nb = 0; nb < 4; ++nb) bb[nb] = *(const bf16x8*)(bp[nb] + k0);
#pragma unroll
            for (int mi = 0; mi < 2; ++mi)
#pragma unroll
                for (int nb = 0; nb < 4; ++nb) acc[mi][nb] = __builtin_amdgcn_mfma_f32_16x16x32_bf16(bb[nb], a[mi], acc[mi][nb], 0, 0, 0);
        }
#pragma unroll
        for (int mi = 0; mi < 2; ++mi)
#pragma unroll
            for (int nb = 0; nb < (Fn::PAIRED ? 2 : 4); ++nb) fn.epi_blk(rb, cb, mi, nb, acc[mi][nb], acc[mi][Fn::PAIRED ? nb + 2 : nb], fr, fq);
    }
}
struct FnPool {
    static constexpr int nrb = MROWS / 32, ncb = 16, K = 256; static constexpr bool PAIRED = false;
    const bf16* P; const bf16* W; bf16* H; const float* scale;
    __device__ __forceinline__ const bf16* arow(int rb, int cb, int r) const { return P + (size_t)(rb * 32 + r) * D + (cb >> 2) * 256; }
    __device__ __forceinline__ const bf16* brow(int rb, int cb, int n) const { return W + (size_t)(cb * 64 + n) * 256; }
    __device__ __forceinline__ void epi_blk(int rb, int cb, int mi, int nb, const f32x4& v, const f32x4&, int fr, int fq) const {
        const int c = cb * 64 + nb * 16 + 4 * fq; bf16* p = H + (size_t)(rb * 32 + mi * 16 + fr) * D + c; const u32x2 w = *(const u32x2*)p; const f32x4 o = (f32x4){bflo(w.x), bfhi(w.x), bflo(w.y), bfhi(w.y)} + v * *(const f32x4*)(scale + c);
        u32x2 ow; ow.x = cvt_pk_bf16(o.x, o.y); ow.y = cvt_pk_bf16(o.z, o.w); *(u32x2*)p = ow; }
};
struct FnIn {
    static constexpr int nrb = MROWS / 32, ncb = 32, K = 1024; static constexpr bool PAIRED = false;
    const bf16* U; const bf16* W; bf16* XB; bf16* GY; const float* RS;
    __device__ __forceinline__ const bf16* arow(int rb, int cb, int r) const { return U + (size_t)(rb * 32 + r) * D; }
    __device__ __forceinline__ const bf16* brow(int rb, int cb, int n) const { return W + (size_t)(cb * 64 + n) * 1024; }
    __device__ __forceinline__ void epi_blk(int rb, int cb, int mi, int nb, const f32x4& v_, const f32x4&, int fr, int fq) const {
        const int c = cb * 64 + nb * 16 + 4 * fq; const size_t ro = (size_t)(rb * 32 + mi * 16 + fr) * D; u32x2 w; const f32x4 v = v_ * RS[rb * 32 + mi * 16 + fr];
        if (cb < 16) { w.x = cvt_pk_bf16(v.x, v.y); w.y = cvt_pk_bf16(v.z, v.w); *(u32x2*)(XB + ro + c) = w; }
        else { w.x = cvt_pk_bf16(gelu_tanh(v.x), gelu_tanh(v.y)); w.y = cvt_pk_bf16(gelu_tanh(v.z), gelu_tanh(v.w)); *(u32x2*)(GY + ro + c - 1024) = w; } }
};
__device__ __forceinline__ void lru_gate2(f32x2 zr, f32x2 zi, f32x2 sp, f32x2 x, bool slow, f32x2& la, f32x2& bv) {
    const f32x2 tr = zr * (-1.44269504089f), ti = zi * (-1.44269504089f);
    f32x2 e1, e2; e1.x = __builtin_amdgcn_exp2f(tr.x); e1.y = __builtin_amdgcn_exp2f(tr.y); e2.x = __builtin_amdgcn_exp2f(ti.x); e2.y = __builtin_amdgcn_exp2f(ti.y);
    const f32x2 d1 = e1 + 1.0f, d2 = e2 + 1.0f, dd = d1 * d2;
    f32x2 inv; inv.x = fast_rcp(dd.x); inv.y = fast_rcp(dd.y);
    const f32x2 l = (inv * d2) * sp, x2 = l * 2.0f;
    f32x2 q = x2 * 0.0001984127f + 0.0013888889f; q = q * x2 + 0.0083333333f; q = q * x2 + 0.041666667f; q = q * x2 + 0.16666667f; q = q * x2 + 0.5f; q = q * x2 + 1.0f;
    f32x2 em = -x2 * q;
    if (__builtin_expect(slow, 0)) { asm volatile("" ::: "memory"); em.x = 1.0f - fast_exp(x2.x); em.y = 1.0f - fast_exp(x2.y); }
    f32x2 sq; sq.x = __builtin_amdgcn_sqrtf(em.x); sq.y = __builtin_amdgcn_sqrtf(em.y);
    la = l; bv = sq * (inv * d1) * x;
}
struct FnGates {
    static constexpr int nrb = MROWS / 32, ncb = 64, K = 256; static constexpr bool PAIRED = true;
    const bf16* XC; const bf16* W; bf16* LA; bf16* BV; const float* bg; const float* lam;
    __device__ __forceinline__ const bf16* arow(int rb, int cb, int r) const { return XC + (size_t)(rb * 32 + r) * D + (((cb & 31) * 32) >> 8) * 256; }
    __device__ __forceinline__ const bf16* brow(int rb, int cb, int n) const {
        const int d = cb >> 5, nb = n >> 4, frn = n & 15, ch = (cb & 31) * 32 + (nb & 1) * 16 + frn, g = nb >> 1, h = ch >> 8, jl = ch & 255;
        return W + (((size_t)(d * 8 + h * 2 + (jl >> 7)) * 256) + g * 128 + (jl & 127)) * 256; }
    __device__ __forceinline__ void epi_blk(int rb, int cb, int mi, int nb, const f32x4& vr, const f32x4& vi, int fr, int fq) const {
        const int d = cb >> 5, ch = (cb & 31) * 32 + nb * 16 + 4 * fq;
        const f32x4 br = *(const f32x4*)(bg + (d * 2 + 0) * D + ch), bi = *(const f32x4*)(bg + (d * 2 + 1) * D + ch), lm = *(const f32x4*)(lam + d * D + ch);
        const size_t ro = (size_t)(rb * 32 + mi * 16 + fr) * D + ch;
        const u32x2 xw = *(const u32x2*)(XC + ro); const float xv[4] = {bflo(xw.x), bfhi(xw.x), bflo(xw.y), bfhi(xw.y)};
        float la[4], bvv[4];
        const bool slow = __any((lm.x < -0.25f) | (lm.y < -0.25f) | (lm.z < -0.25f) | (lm.w < -0.25f));
#pragma unroll
        for (int q = 0; q < 4; q += 2) { f32x2 l2, b2; lru_gate2((f32x2){vr[q] + br[q], vr[q + 1] + br[q + 1]}, (f32x2){vi[q] + bi[q], vi[q + 1] + bi[q + 1]}, (f32x2){lm[q], lm[q + 1]}, (f32x2){xv[q], xv[q + 1]}, slow, l2, b2);
            la[q] = l2.x; la[q + 1] = l2.y; bvv[q] = b2.x; bvv[q + 1] = b2.y; }
        u32x2 w; w.x = cvt_pk_bf16(la[0], la[1]); w.y = cvt_pk_bf16(la[2], la[3]); *(u32x2*)(LA + (size_t)d * MPAD * D + ro) = w;
        w.x = cvt_pk_bf16(bvv[0], bvv[1]); w.y = cvt_pk_bf16(bvv[2], bvv[3]); *(u32x2*)(BV + (size_t)d * MPAD * D + ro) = w; }
};
struct FnOut {
    static constexpr int nrb = MROWS / 32, ncb = 16, K = 1024; static constexpr bool PAIRED = false;
    const bf16* A; const bf16* W; bf16* H;
    __device__ __forceinline__ const bf16* arow(int rb, int cb, int r) const { return A + (size_t)(rb * 32 + r) * D; }
    __device__ __forceinline__ const bf16* brow(int rb, int cb, int n) const { return W + (size_t)(cb * 64 + n) * 1024; }
    __device__ __forceinline__ void epi_blk(int rb, int cb, int mi, int nb, const f32x4& v, const f32x4&, int fr, int fq) const {
        bf16* p = H + (size_t)(rb * 32 + mi * 16 + fr) * D + cb * 64 + nb * 16 + 4 * fq; const u32x2 w = *(const u32x2*)p; const f32x4 o = (f32x4){bflo(w.x), bfhi(w.x), bflo(w.y), bfhi(w.y)} + v;
        u32x2 ow; ow.x = cvt_pk_bf16(o.x, o.y); ow.y = cvt_pk_bf16(o.z, o.w); *(u32x2*)p = ow; }
};
constexpr int ERB = (EROWS + 31) / 32;
constexpr int ERB16 = (EROWS + 15) / 16;
struct FnM1f8 {
    static constexpr int KB = 1024; static constexpr bool PAIRED = true;
    const unsigned char* U; const unsigned char* W; const int* ROWL; unsigned char* HID;
    __device__ __forceinline__ const unsigned char* arow(int rb, int cb, int r) const { const int e = rb / ERB16, pos = (rb % ERB16) * 16 + r; return U + (size_t)ROWL[e * EPAD + pos] * 1024; }
    __device__ __forceinline__ const unsigned char* brow(int rb, int cb, int n) const { const int e = rb / ERB16, nb = n >> 4, f = cb * 32 + (nb & 1) * 16 + (n & 15);
        return W + ((size_t)e * 4096 + (f >> 7) * 256 + (nb >> 1) * 128 + (f & 127)) * 1024; }
    __device__ __forceinline__ void epi_blk(int rb, int cb, int nb, const f32x4& gs, const f32x4& us, int fr, int fq) const {
        const int e = rb / ERB16, pos = (rb % ERB16) * 16 + fr, f = cb * 32 + nb * 16 + 4 * fq; const f32x4 g = gs * WINV, u = us * WINV;
        *(unsigned*)(HID + ((size_t)e * EPAD + pos) * HIDP8 + f) = pk4_fp8(siluf_(g.x) * u.x, siluf_(g.y) * u.y, siluf_(g.z) * u.z, siluf_(g.w) * u.w); }
};
struct FnM2f8 {
    static constexpr int KB = 2048; static constexpr bool PAIRED = false;
    const unsigned char* HID; const unsigned char* W; bf16* Y;
    __device__ __forceinline__ const unsigned char* arow(int rb, int cb, int r) const { const int e = rb / ERB16, pos = (rb % ERB16) * 16 + r; return HID + ((size_t)e * EPAD + pos) * HIDP8; }
    __device__ __forceinline__ const unsigned char* brow(int rb, int cb, int n) const { const int e = rb / ERB16; return W + ((size_t)e * 1024 + cb * 64 + n) * WDP8; }
    __device__ __forceinline__ void epi_blk(int rb, int cb, int nb, const f32x4& vs, const f32x4&, int fr, int fq) const {
        const int e = rb / ERB16, pos = (rb % ERB16) * 16 + fr; const f32x4 v = vs * WINV;
        *(unsigned*)((unsigned char*)Y + ((size_t)e * EPAD + pos) * D + cb * 64 + nb * 16 + 4 * fq) = pk4_fp8(v.x, v.y, v.z, v.w); }
};
template <class Fn>
__device__ __forceinline__ void wg_gemm_ksplit8(const Fn& fn, const TaskMap tm, LAS unsigned char* lds, int vcu, int G, int tid_) {
    const int tid = opaque(tid_), lane = tid & 63, wave = __builtin_amdgcn_readfirstlane(tid >> 6), fr = lane & 15, fq = lane >> 4;
    constexpr int KW = Fn::KB / 8, NS = KW / 128;
    LAS f32x4* part = (LAS f32x4*)lds;
    for (int task = vcu; task < tm.ntask; task += G) {
        const int cb = task % tm.ncb, rb = tm.rb0 + (task / tm.ncb) * tm.rbstride;
        const unsigned char* ap = fn.arow(rb, cb, fr) + wave * KW + 32 * fq; const unsigned char* bp[4];
#pragma unroll
        for (int nb = 0; nb < 4; ++nb) bp[nb] = fn.brow(rb, cb, nb * 16 + fr) + wave * KW + 32 * fq;
        v4i a[NS][2], bb[NS][4][2];
#pragma unroll
        for (int s = 0; s < NS; ++s) { a[s][0] = *(const v4i*)(ap + s * 128); a[s][1] = *(const v4i*)(ap + s * 128 + 16);
#pragma unroll
            for (int nb = 0; nb < 4; ++nb) { bb[s][nb][0] = *(const v4i*)(bp[nb] + s * 128); bb[s][nb][1] = *(const v4i*)(bp[nb] + s * 128 + 16); } }
        f32x4 acc[4];
#pragma unroll
        for (int nb = 0; nb < 4; ++nb) acc[nb] = (f32x4){0.f, 0.f, 0.f, 0.f};
#pragma unroll
        for (int s = 0; s < NS; ++s)
#pragma unroll
            for (int nb = 0; nb < 4; ++nb) acc[nb] = __builtin_amdgcn_mfma_scale_f32_16x16x128_f8f6f4(__builtin_shufflevector(bb[s][nb][0], bb[s][nb][1], 0, 1, 2, 3, 4, 5, 6, 7),
                                                                                                     __builtin_shufflevector(a[s][0], a[s][1], 0, 1, 2, 3, 4, 5, 6, 7), acc[nb], 0, 0, 0, 0, 0, 0);
#pragma unroll
        for (int nb = 0; nb < 4; ++nb) part[(wave * 4 + nb) * 64 + lane] = acc[nb];
        __syncthreads();
        if (wave < 4 && (!Fn::PAIRED || wave < 2)) {
            const int nb = wave;
            f32x4 v = (f32x4){0.f, 0.f, 0.f, 0.f}, v2 = v;
#pragma unroll
            for (int w = 0; w < 8; ++w) { v += part[(w * 4 + nb) * 64 + lane]; if (Fn::PAIRED) v2 += part[(w * 4 + nb + 2) * 64 + lane]; }
            fn.epi_blk(rb, cb, nb, v, v2, fr, fq);
        }
        __syncthreads();
    }
}

template <int MI, class Fn>
__device__ __forceinline__ void wg_gemm_ksplit(const Fn& fn, const TaskMap tm, LAS unsigned char* lds, int vcu, int G, int tid_) {
    const int tid = opaque(tid_), lane = tid & 63, wave = __builtin_amdgcn_readfirstlane(tid >> 6), fr = lane & 15, fq = lane >> 4;
    constexpr int KW = Fn::K / 8, NS = KW / 32;
    LAS f32x4* part = (LAS f32x4*)lds;
    for (int task = vcu; task < tm.ntask; task += G) {
        const int cb = task % tm.ncb, rb = tm.rb0 + (task / tm.ncb) * tm.rbstride;
        const bf16* ap[MI]; const bf16* bp[4];
#pragma unroll
        for (int mi = 0; mi < MI; ++mi) ap[mi] = fn.arow(rb, cb, mi * 16 + fr) + wave * KW + 8 * fq;
#pragma unroll
        for (int nb = 0; nb < 4; ++nb) bp[nb] = fn.brow(rb, cb, nb * 16 + fr) + wave * KW + 8 * fq;
        f32x4 acc[MI][4];
#pragma unroll
        for (int mi = 0; mi < MI; ++mi)
#pragma unroll
            for (int nb = 0; nb < 4; ++nb) acc[mi][nb] = (f32x4){0.f, 0.f, 0.f, 0.f};
#pragma unroll
        for (int s0 = 0; s0 < NS; s0 += 4) {
            bf16x8 a[4][MI], bb[4][4];
#pragma unroll
            for (int s = 0; s < 4; ++s) if (s0 + s < NS) {
#pragma unroll
                for (int mi = 0; mi < MI; ++mi) a[s][mi] = *(const bf16x8*)(ap[mi] + (s0 + s) * 32);
#pragma unroll
                for (int nb = 0; nb < 4; ++nb) bb[s][nb] = *(const bf16x8*)(bp[nb] + (s0 + s) * 32); }
#pragma unroll
            for (int s = 0; s < 4; ++s) if (s0 + s < NS) {
#pragma unroll
                for (int mi = 0; mi < MI; ++mi)
#pragma unroll
                    for (int nb = 0; nb < 4; ++nb) acc[mi][nb] = __builtin_amdgcn_mfma_f32_16x16x32_bf16(bb[s][nb], a[s][mi], acc[mi][nb], 0, 0, 0); }
        }
#pragma unroll
        for (int mi = 0; mi < MI; ++mi)
#pragma unroll
            for (int nb = 0; nb < 4; ++nb) part[((wave * MI + mi) * 4 + nb) * 64 + lane] = acc[mi][nb];
        __syncthreads();
        if (wave < MI * 4) {
            const int mi = wave >> 2, nb = wave & 3;
            if (!Fn::PAIRED || nb < 2) {
                f32x4 v = (f32x4){0.f, 0.f, 0.f, 0.f}, v2 = v;
#pragma unroll
                for (int w = 0; w < 8; ++w) { v += part[((w * MI + mi) * 4 + nb) * 64 + lane]; if (Fn::PAIRED) v2 += part[((w * MI + mi) * 4 + nb + 2) * 64 + lane]; }
                fn.epi_blk(rb, cb, mi, nb, v, v2, fr, fq);
            }
        }
        __syncthreads();
    }
}

namespace pg8 {
constexpr int BM = 256, BK = 64, HALF = 128, HTB = HALF * BK * 2, STAGE_BYTES = 8 * HTB;
__device__ __forceinline__ int lds_byte(int r, int c) { const int st = (r >> 4) * 2 + (c >> 5), rr = r & 15, cc = c & 31, ob = rr * 64 + cc * 2; return st * 1024 + (ob ^ (((ob >> 9) & 1) << 5)); }
__device__ __forceinline__ void stage_rc(int b, int& R, int& C) { const int st = b / 1024, sb = b % 1024, swz = sb ^ (((sb >> 9) & 1) << 5); R = (st >> 1) * 16 + swz / 64; C = (st & 1) * 32 + (swz % 64) / 2; }
__device__ __forceinline__ int perm32(int rho) { const int n = rho >> 4, i = rho & 15; return 8 * (i >> 2) + 4 * n + (i & 3); }
struct Unit { int pm, pn, e; };
struct SchedStd {
    int nM, nN, nwg, G, c;
    __device__ __forceinline__ void init(int nM_, int nN_, int G_, int c_) { nM = nM_; nN = nN_; nwg = nM * nN; G = G_; c = c_; }
    __device__ __forceinline__ bool next(int i, Unit& u) const {
        const int L = i * G + c; if (L >= nwg) return false;
        int wgid = L; { const int q = nwg / 8, r = nwg % 8, xcd = wgid % 8, off = wgid / 8; wgid = (xcd < r ? xcd * (q + 1) : r * (q + 1) + (xcd - r) * q) + off; }
        const int nig = 8 * nN, gid = wgid / nig, fm = gid * 8, gsz = (nM - fm) < 8 ? (nM - fm) : 8;
        u.pm = fm + ((wgid % nig) % gsz); u.pn = (wgid % nig) / gsz; u.e = 0; return true;
    }
};
struct SchedMoe {
    int nN, total, G, c, rev, gm;
    __device__ __forceinline__ void init(int nN_, int G_, int c_, int rev_ = 0, int gm_ = 8) { nN = nN_; total = 16 * 16 * nN_; G = G_; c = c_; rev = rev_; gm = gm_; }
    __device__ __forceinline__ bool next(int i, Unit& u) const {
        const int L = i * G + c; if (L >= total) return false;
        const int off = rev ? (total / 8 - 1 - L / 8) : L / 8;
        const int wgid = (L % 8) * (total / 8) + off, per = 16 * nN, w = wgid % per, nig = gm * nN;
        u.e = wgid / per; u.pm = (w / nig) * gm + (w % nig) % gm; u.pn = (w % nig) / gm; return true;
    }
};
template <class Cfg>
__device__ __forceinline__ void gemm_phase(LAS unsigned char* lds, const Cfg& cfg) {
    const int tid = opaque((int)threadIdx.x), wid = __builtin_amdgcn_readfirstlane(tid >> 6), lane = tid & 63, wr = wid >> 2, wc = wid & 3, fr = lane & 15, fq = lane >> 4;
    constexpr bool F8 = Cfg::FP8;
    constexpr int nt = Cfg::KB / 128;
    int Rr[2], Cc[2]; unsigned voffB[2];
#pragma unroll
    for (int i = 0; i < 2; ++i) { stage_rc(tid * 16 + i * 8192, Rr[i], Cc[i]); const int R = Rr[i];
        const int Rb = Cfg::PERMX ? (((R >> 5) & 3) * 64 + 16 * ((R & 15) >> 2) + 4 * ((R >> 4) & 1) + (R & 3)) : (Cfg::PERM ? ((R & ~31) + perm32(R & 31)) : R);
        voffB[i] = (unsigned)Rb * (unsigned)Cfg::ldb + (unsigned)Cc[i] * 2u; }
    const size_t kstep = (size_t)(BK * 2);
    const size_t hstepB = (size_t)(Cfg::PERMX ? 8 : HALF) * Cfg::ldb;
    const unsigned ldsw = (unsigned)wid * 1024u;
    const int aoff = lds_byte(wr * 64 + fr, F8 ? fq * 16 : fq * 8), boff = lds_byte(wc * 32 + fr, F8 ? fq * 16 : fq * 8);

#define PG8_SA(b, h) (((b) * 2 + (h)) * HTB)
#define PG8_SB(b, h) ((4 + (b) * 2 + (h)) * HTB)
#define PG8_STAGE(bufoff, gbase, voff) do { _Pragma("unroll") for (int _i = 0; _i < 2; ++_i) \
        __builtin_amdgcn_global_load_lds((const unsigned*)((const char*)(gbase) + (voff)[_i]), (LAS unsigned*)(lds + (bufoff) + ldsw + _i * 8192), 16, 0, 0); } while (0)
typedef v8i v8i_a16 __attribute__((aligned(16)));
#define PG8_LD32(p) (*(const LAS v8i_a16*)(p))
#define PG8_LDA(dst, b, h) do { if constexpr (F8) { _Pragma("unroll") for (int m = 0; m < 4; ++m) dst##8[m] = PG8_LD32(lds + PG8_SA(b, h) + aoff + m * 2048); } \
        else { _Pragma("unroll") for (int m = 0; m < 4; ++m) _Pragma("unroll") for (int k = 0; k < 2; ++k) dst[m][k] = *(const LAS bf16x8*)(lds + PG8_SA(b, h) + aoff + m * 2048 + k * 1024); } } while (0)
#define PG8_LDB(dst, b, h) do { if constexpr (F8) { _Pragma("unroll") for (int n = 0; n < 2; ++n) dst##8[n] = PG8_LD32(lds + PG8_SB(b, h) + boff + n * 2048); } \
        else { _Pragma("unroll") for (int n = 0; n < 2; ++n) _Pragma("unroll") for (int k = 0; k < 2; ++k) dst[n][k] = *(const LAS bf16x8*)(lds + PG8_SB(b, h) + boff + n * 2048 + k * 1024); } } while (0)
#define PG8_MMA(ai, bj, At, Bt) do { __builtin_amdgcn_s_setprio(1); _Pragma("unroll") for (int m = 0; m < 4; ++m) _Pragma("unroll") for (int n = 0; n < 2; ++n) { \
        if constexpr (F8) asm volatile("v_mfma_f32_16x16x128_f8f6f4 %0, %1, %2, %0" : "+v"(acc[ai][bj][m][n]) : "v"(Bt##8[n]), "v"(At##8[m]));   \
        else { _Pragma("unroll") for (int k = 0; k < 2; ++k) acc[ai][bj][m][n] = __builtin_amdgcn_mfma_f32_16x16x32_bf16(Bt[n][k], At[m][k], acc[ai][bj][m][n], 0, 0, 0); } } __builtin_amdgcn_s_setprio(0); } while (0)
#define PG8_WAIT_V(n) asm volatile("s_waitcnt vmcnt(" #n ")" ::: "memory")
#define PG8_WAIT_L(n) asm volatile("s_waitcnt lgkmcnt(" #n ")" ::: "memory")
#define PG8_BAR __builtin_amdgcn_s_barrier()
#define PG8_SCHED __builtin_amdgcn_sched_barrier(0)
    Unit cur, nxt; int ui = 0;
    if (!cfg.next(0, cur)) return;
    f32x4 acc[2][2][4][2];
#pragma unroll
    for (int a = 0; a < 2; ++a)
#pragma unroll
        for (int b = 0; b < 2; ++b)
#pragma unroll
            for (int m = 0; m < 4; ++m)
#pragma unroll
                for (int n = 0; n < 2; ++n) acc[a][b][m][n] = (f32x4){0.f, 0.f, 0.f, 0.f};
    bf16x8 At[4][2], B0[2][2], B1[2][2]; v8i At8[4], B08[2], B18[2];
    unsigned voffA[2][2], voffAn[2][2];
    cfg.a_offs(cur, 0, Rr, Cc, voffA);
    const char* cA = cfg.a_base(cur); const char* cB = cfg.b_base(cur);
    PG8_STAGE(PG8_SB(0, 0), cB, voffB); PG8_STAGE(PG8_SB(0, 1), cB + hstepB, voffB); PG8_STAGE(PG8_SA(0, 0), cA, voffA[0]); PG8_STAGE(PG8_SA(0, 1), cA, voffA[1]);
    if (wr == 1) PG8_BAR;
    PG8_WAIT_V(2); PG8_BAR;
    PG8_STAGE(PG8_SB(1, 0), cB + kstep, voffB); PG8_STAGE(PG8_SA(1, 0), cA + kstep, voffA[0]); PG8_STAGE(PG8_SB(1, 1), cB + hstepB + kstep, voffB);
    PG8_WAIT_V(6); PG8_BAR;
    for (;;) {
        const bool has_next = cfg.next(ui + 1, nxt);
        const char* nA = has_next ? cfg.a_base(nxt) : cA; const char* nB = has_next ? cfg.b_base(nxt) : cB;
#pragma unroll 1
        for (int t = 0; t < nt; t += 2) {
            const bool last = (t == nt - 2);
            const char* a1 = cA + (size_t)(t + 1) * kstep;
            const char* a2 = last ? nA : cA + (size_t)(t + 2) * kstep; const char* b2 = last ? nB : cB + (size_t)(t + 2) * kstep;
            const char* a3 = a2 + kstep; const char* b3 = b2 + kstep;
            unsigned o2[2][2];
            if constexpr (Cfg::GATHER) {
                if (last) { if (has_next) { int R2[2], C2[2]; stage_rc(tid * 16, R2[0], C2[0]); stage_rc(tid * 16 + 8192, R2[1], C2[1]); cfg.a_offs(nxt, ui + 1, R2, C2, voffAn); } else {
#pragma unroll
                    for (int h = 0; h < 2; ++h) { voffAn[h][0] = voffA[h][0]; voffAn[h][1] = voffA[h][1]; } } }
#pragma unroll
                for (int h = 0; h < 2; ++h) { o2[h][0] = last ? voffAn[h][0] : voffA[h][0]; o2[h][1] = last ? voffAn[h][1] : voffA[h][1]; }
            } else {
#pragma unroll
                for (int h = 0; h < 2; ++h) { o2[h][0] = voffA[h][0]; o2[h][1] = voffA[h][1]; }
            }
            PG8_LDB(B0, 0, 0); PG8_LDB(B1, 0, 1); PG8_SCHED; PG8_LDA(At, 0, 0); PG8_STAGE(PG8_SA(1, 1), a1, voffA[1]);
            PG8_WAIT_V(8); PG8_WAIT_L(0); PG8_BAR; PG8_MMA(0, 0, At, B0); PG8_MMA(0, 1, At, B1); PG8_BAR; PG8_SCHED;
            PG8_LDA(At, 0, 1); PG8_STAGE(PG8_SB(0, 0), b2, voffB); PG8_STAGE(PG8_SB(0, 1), b2 + hstepB, voffB); PG8_STAGE(PG8_SA(0, 0), a2, o2[0]);
            PG8_WAIT_V(8); PG8_WAIT_L(0); PG8_BAR; PG8_MMA(1, 0, At, B0); PG8_MMA(1, 1, At, B1); PG8_BAR; PG8_SCHED;
            PG8_LDB(B0, 1, 0); PG8_LDB(B1, 1, 1); PG8_SCHED; PG8_LDA(At, 1, 0); PG8_STAGE(PG8_SA(0, 1), a2, o2[1]);
            PG8_WAIT_V(8); PG8_WAIT_L(0); PG8_BAR; PG8_MMA(0, 0, At, B0); PG8_MMA(0, 1, At, B1); PG8_BAR; PG8_SCHED;
            PG8_LDA(At, 1, 1); PG8_STAGE(PG8_SB(1, 0), b3, voffB); PG8_STAGE(PG8_SB(1, 1), b3 + hstepB, voffB); PG8_STAGE(PG8_SA(1, 0), a3, o2[0]);
            PG8_WAIT_V(8); PG8_WAIT_L(0); PG8_BAR; PG8_MMA(1, 0, At, B0); PG8_MMA(1, 1, At, B1); PG8_BAR; PG8_SCHED;
        }
        if (wr == 0) PG8_BAR;
        if constexpr (F8) asm volatile("s_nop 15\n\ts_nop 15" ::: "memory");
        cfg.epi(acc, cur, wr, wc, fr, fq);
        if (!has_next) break;
#pragma unroll
        for (int a = 0; a < 2; ++a)
#pragma unroll
            for (int b = 0; b < 2; ++b)
#pragma unroll
                for (int m = 0; m < 4; ++m)
#pragma unroll
                    for (int n = 0; n < 2; ++n) acc[a][b][m][n] = (f32x4){0.f, 0.f, 0.f, 0.f};
        cur = nxt; cA = nA; cB = nB; ++ui;
        if constexpr (Cfg::GATHER) {
#pragma unroll
            for (int h = 0; h < 2; ++h) { voffA[h][0] = voffAn[h][0]; voffA[h][1] = voffAn[h][1]; } }
        if (wr == 1) PG8_BAR;
    }
    PG8_WAIT_V(0);
    PG8_BAR;
#undef PG8_SA
#undef PG8_SB
#undef PG8_STAGE
#undef PG8_LDA
#undef PG8_LDB
#undef PG8_MMA
#undef PG8_LD32
#undef PG8_WAIT_V
#undef PG8_WAIT_L
#undef PG8_BAR
#undef PG8_SCHED
}
template <int LDA> __device__ __forceinline__ void lin_offs(const int (&R)[2], const int (&C)[2], unsigned (&off)[2][2]) {
#pragma unroll
    for (int h = 0; h < 2; ++h)
#pragma unroll
        for (int i = 0; i < 2; ++i) off[h][i] = (unsigned)(h * HALF + R[i]) * (unsigned)LDA + (unsigned)C[i] * 2u;
}
struct CfgPool {
    static constexpr bool PERMX = false; static constexpr bool GATHER = false; static constexpr bool FP8 = false; static constexpr int KB = 256 * 2; static constexpr bool PERM = true; static constexpr int K = 256, ldb = 512;
    SchedStd S; const bf16* P; const bf16* W; bf16* H; const float* scale;
    __device__ __forceinline__ bool next(int i, Unit& u) const { return S.next(i, u); }
    __device__ __forceinline__ const char* a_base(const Unit& u) const { return (const char*)(P + (size_t)u.pm * 256 * D + u.pn * 256); }
    __device__ __forceinline__ void a_offs(const Unit&, int, const int (&R)[2], const int (&C)[2], unsigned (&off)[2][2]) const { lin_offs<2048>(R, C, off); }
    __device__ __forceinline__ const char* b_base(const Unit& u) const { return (const char*)(W + (size_t)u.pn * 65536); }
    __device__ __forceinline__ void epi(const f32x4 (&acc)[2][2][4][2], const Unit& u, int wr, int wc, int fr, int fq) const {
        const int row0 = u.pm * 256 + wr * 64 + fr, col0 = u.pn * 256 + wc * 32 + 8 * fq;
        f32x4 sc[2][2];
#pragma unroll
        for (int bj = 0; bj < 2; ++bj)
#pragma unroll
            for (int n = 0; n < 2; ++n) sc[bj][n] = *(const f32x4*)(scale + col0 + bj * 128 + n * 4);
#pragma unroll
        for (int ai = 0; ai < 2; ++ai) {
            u32x4 hw[4][2];
#pragma unroll
            for (int m = 0; m < 4; ++m)
#pragma unroll
                for (int bj = 0; bj < 2; ++bj) hw[m][bj] = *(const u32x4*)(H + (size_t)(row0 + ai * 128 + m * 16) * D + col0 + bj * 128);
            asm volatile("" ::: "memory");
#pragma unroll
            for (int m = 0; m < 4; ++m) { bf16* rowp = H + (size_t)(row0 + ai * 128 + m * 16) * D + col0;
#pragma unroll
                for (int bj = 0; bj < 2; ++bj) { const u32x4 w = hw[m][bj];
                    const f32x4 o0 = (f32x4){bflo(w.x), bfhi(w.x), bflo(w.y), bfhi(w.y)} + acc[ai][bj][m][0] * sc[bj][0], o1 = (f32x4){bflo(w.z), bfhi(w.z), bflo(w.w), bfhi(w.w)} + acc[ai][bj][m][1] * sc[bj][1];
                    u32x4 ow; ow.x = cvt_pk_bf16(o0.x, o0.y); ow.y = cvt_pk_bf16(o0.z, o0.w); ow.z = cvt_pk_bf16(o1.x, o1.y); ow.w = cvt_pk_bf16(o1.z, o1.w);
                    *(u32x4*)(rowp + bj * 128) = ow; } }
            asm volatile("" ::: "memory");
        }
    }
};
struct CfgOut {
    static constexpr bool PERMX = false; static constexpr bool GATHER = false; static constexpr bool FP8 = false; static constexpr int KB = 1024 * 2; static constexpr bool PERM = true; static constexpr int K = 1024, ldb = 2048;
    SchedStd S; const bf16* A; const bf16* W; bf16* H;
    __device__ __forceinline__ bool next(int i, Unit& u) const { return S.next(i, u); }
    __device__ __forceinline__ const char* a_base(const Unit& u) const { return (const char*)(A + (size_t)u.pm * 256 * D); }
    __device__ __forceinline__ void a_offs(const Unit&, int, const int (&R)[2], const int (&C)[2], unsigned (&off)[2][2]) const { lin_offs<2048>(R, C, off); }
    __device__ __forceinline__ const char* b_base(const Unit& u) const { return (const char*)(W + (size_t)u.pn * 256 * 1024); }
    __device__ __forceinline__ void epi(const f32x4 (&acc)[2][2][4][2], const Unit& u, int wr, int wc, int fr, int fq) const {
        const int row0 = u.pm * 256 + wr * 64 + fr, col0 = u.pn * 256 + wc * 32 + 8 * fq;
#pragma unroll
        for (int ai = 0; ai < 2; ++ai) {
            u32x4 hw[4][2];
#pragma unroll
            for (int m = 0; m < 4; ++m)
#pragma unroll
                for (int bj = 0; bj < 2; ++bj) hw[m][bj] = *(const u32x4*)(H + (size_t)(row0 + ai * 128 + m * 16) * D + col0 + bj * 128);
            asm volatile("" ::: "memory");
#pragma unroll
            for (int m = 0; m < 4; ++m) { bf16* rowp = H + (size_t)(row0 + ai * 128 + m * 16) * D + col0;
#pragma unroll
                for (int bj = 0; bj < 2; ++bj) { const u32x4 w = hw[m][bj];
                    const f32x4 o0 = (f32x4){bflo(w.x), bfhi(w.x), bflo(w.y), bfhi(w.y)} + acc[ai][bj][m][0], o1 = (f32x4){bflo(w.z), bfhi(w.z), bflo(w.w), bfhi(w.w)} + acc[ai][bj][m][1];
                    u32x4 ow; ow.x = cvt_pk_bf16(o0.x, o0.y); ow.y = cvt_pk_bf16(o0.z, o0.w); ow.z = cvt_pk_bf16(o1.x, o1.y); ow.w = cvt_pk_bf16(o1.z, o1.w);
                    *(u32x4*)(rowp + bj * 128) = ow; } }
            asm volatile("" ::: "memory");
        }
    }
};
struct CfgIn {
    static constexpr bool PERMX = false; static constexpr bool GATHER = false; static constexpr bool FP8 = false; static constexpr int KB = 1024 * 2; static constexpr bool PERM = true; static constexpr int K = 1024, ldb = 2048;
    SchedStd S; const bf16* U; const bf16* W; bf16* XB; bf16* GY; const float* RS;
    __device__ __forceinline__ bool next(int i, Unit& u) const { return S.next(i, u); }
    __device__ __forceinline__ const char* a_base(const Unit& u) const { return (const char*)(U + (size_t)u.pm * 256 * D); }
    __device__ __forceinline__ void a_offs(const Unit&, int, const int (&R)[2], const int (&C)[2], unsigned (&off)[2][2]) const { lin_offs<2048>(R, C, off); }
    __device__ __forceinline__ const char* b_base(const Unit& u) const { return (const char*)(W + (size_t)u.pn * 256 * 1024); }
    __device__ __forceinline__ void epi(const f32x4 (&acc)[2][2][4][2], const Unit& u, int wr, int wc, int fr, int fq) const {
        const int row0 = u.pm * 256 + wr * 64 + fr, col0 = (u.pn & 3) * 256 + wc * 32 + 8 * fq; const bool act = u.pn >= 4; bf16* base = act ? GY : XB;
        float rs[2][4];
#pragma unroll
        for (int ai = 0; ai < 2; ++ai)
#pragma unroll
            for (int m = 0; m < 4; ++m) rs[ai][m] = RS[row0 + ai * 128 + m * 16];
#pragma unroll
        for (int ai = 0; ai < 2; ++ai)
#pragma unroll
            for (int m = 0; m < 4; ++m) { bf16* rowp = base + (size_t)(row0 + ai * 128 + m * 16) * D + col0;
#pragma unroll
                for (int bj = 0; bj < 2; ++bj) { f32x4 v0 = acc[ai][bj][m][0] * rs[ai][m], v1 = acc[ai][bj][m][1] * rs[ai][m];
                    if (act) { v0.x = gelu_tanh(v0.x); v0.y = gelu_tanh(v0.y); v0.z = gelu_tanh(v0.z); v0.w = gelu_tanh(v0.w); v1.x = gelu_tanh(v1.x); v1.y = gelu_tanh(v1.y); v1.z = gelu_tanh(v1.z); v1.w = gelu_tanh(v1.w); }
                    u32x4 w; w.x = cvt_pk_bf16(v0.x, v0.y); w.y = cvt_pk_bf16(v0.z, v0.w); w.z = cvt_pk_bf16(v1.x, v1.y); w.w = cvt_pk_bf16(v1.z, v1.w);
                    *(u32x4*)(rowp + bj * 128) = w; } }
    }
};
struct CfgGates {
    static constexpr bool PERMX = false; static constexpr bool GATHER = false; static constexpr bool FP8 = false; static constexpr int KB = 256 * 2; static constexpr bool PERM = true; static constexpr int K = 256, ldb = 512;
    SchedStd S; const bf16* XC; const bf16* W; bf16* LA; bf16* BV; const float* bg; const float* lam;
    __device__ __forceinline__ bool next(int i, Unit& u) const { return S.next(i, u); }
    __device__ __forceinline__ const char* a_base(const Unit& u) const { return (const char*)(XC + (size_t)u.pm * 256 * D + ((u.pn & 7) >> 1) * 256); }
    __device__ __forceinline__ void a_offs(const Unit&, int, const int (&R)[2], const int (&C)[2], unsigned (&off)[2][2]) const { lin_offs<2048>(R, C, off); }
    __device__ __forceinline__ const char* b_base(const Unit& u) const { return (const char*)(W + (size_t)u.pn * 65536); }
    __device__ __forceinline__ void epi(const f32x4 (&acc)[2][2][4][2], const Unit& u, int wr, int wc, int fr, int fq) const {
        const int d = u.pn >> 3, ch0 = (u.pn & 7) * 128 + wc * 32 + 8 * fq, row0 = u.pm * 256 + wr * 64 + fr;
        float br[8], bi[8], sp[8];
#pragma unroll
        for (int q = 0; q < 2; ++q) { const f32x4 a = *(const f32x4*)(bg + (d * 2 + 0) * D + ch0 + 4 * q), b = *(const f32x4*)(bg + (d * 2 + 1) * D + ch0 + 4 * q), l = *(const f32x4*)(lam + d * D + ch0 + 4 * q);
#pragma unroll
            for (int x = 0; x < 4; ++x) { br[4 * q + x] = a[x]; bi[4 * q + x] = b[x]; sp[4 * q + x] = l[x]; } }
        bool sl = false;
#pragma unroll
        for (int q = 0; q < 8; ++q) sl |= sp[q] < -0.25f;
        const bool slow = __any(sl);
        u32x4 xin[2][4];
#pragma unroll
        for (int ai = 0; ai < 2; ++ai)
#pragma unroll
            for (int m = 0; m < 4; ++m) xin[ai][m] = *(const u32x4*)(XC + (size_t)(row0 + ai * 128 + m * 16) * D + ch0);
        asm volatile("" ::: "memory");
#pragma unroll
        for (int ai = 0; ai < 2; ++ai)
#pragma unroll
            for (int m = 0; m < 4; ++m) { const size_t ro = (size_t)(row0 + ai * 128 + m * 16) * D + ch0;
                const u32x4 xw = xin[ai][m];
                const float xv[8] = {bflo(xw.x), bfhi(xw.x), bflo(xw.y), bfhi(xw.y), bflo(xw.z), bfhi(xw.z), bflo(xw.w), bfhi(xw.w)};
                float la[8], bv[8];
#pragma unroll
                for (int q = 0; q < 8; q += 2) { f32x2 l2, b2;
                    lru_gate2((f32x2){acc[ai][0][m][q >> 2][q & 3] + br[q], acc[ai][0][m][q >> 2][(q & 3) + 1] + br[q + 1]}, (f32x2){acc[ai][1][m][q >> 2][q & 3] + bi[q], acc[ai][1][m][q >> 2][(q & 3) + 1] + bi[q + 1]},
                              (f32x2){sp[q], sp[q + 1]}, (f32x2){xv[q], xv[q + 1]}, slow, l2, b2);
                    la[q] = l2.x; la[q + 1] = l2.y; bv[q] = b2.x; bv[q + 1] = b2.y; }
                u32x4 w; w.x = cvt_pk_bf16(la[0], la[1]); w.y = cvt_pk_bf16(la[2], la[3]); w.z = cvt_pk_bf16(la[4], la[5]); w.w = cvt_pk_bf16(la[6], la[7]);
                *(u32x4*)(LA + (size_t)d * MPAD * D + ro) = w;
                w.x = cvt_pk_bf16(bv[0], bv[1]); w.y = cvt_pk_bf16(bv[2], bv[3]); w.z = cvt_pk_bf16(bv[4], bv[5]); w.w = cvt_pk_bf16(bv[6], bv[7]);
                *(u32x4*)(BV + (size_t)d * MPAD * D + ro) = w; }
    }
};
struct CfgM1 {
    static constexpr bool PERMX = false; static constexpr bool GATHER = true; static constexpr bool FP8 = true; static constexpr int KB = 1024; static constexpr bool PERM = true; static constexpr int K = 1024, ldb = 1024;
    SchedMoe S; const unsigned char* U; const unsigned char* W; unsigned char* HID; const LAS unsigned short* idx;
    __device__ __forceinline__ bool next(int i, Unit& u) const { return S.next(i, u); }
    __device__ __forceinline__ const char* a_base(const Unit&) const { return (const char*)U; }
    __device__ __forceinline__ void a_offs(const Unit&, int ui, const int (&R)[2], const int (&C)[2], unsigned (&off)[2][2]) const {
#pragma unroll
        for (int h = 0; h < 2; ++h)
#pragma unroll
            for (int i = 0; i < 2; ++i) off[h][i] = (unsigned)idx[ui * 256 + h * HALF + R[i]] * 1024u + (unsigned)C[i] * 2u;
    }
    __device__ __forceinline__ const char* b_base(const Unit& u) const { return (const char*)(W + ((size_t)u.e * 4096 + u.pn * 256) * 1024); }
    __device__ __forceinline__ void epi(const f32x4 (&acc)[2][2][4][2], const Unit& u, int wr, int wc, int fr, int fq) const {
        const int row0 = u.e * EPAD + u.pm * 256 + wr * 64 + fr, col0 = u.pn * 128 + wc * 32 + 8 * fq;
#pragma unroll
        for (int ai = 0; ai < 2; ++ai)
#pragma unroll
            for (int m = 0; m < 4; ++m) { const f32x4 g0 = acc[ai][0][m][0], g1 = acc[ai][0][m][1], u0 = acc[ai][1][m][0], u1 = acc[ai][1][m][1];
                u32x2 w; w.x = pk4_fp8(silu_mul_s(g0.x, u0.x), silu_mul_s(g0.y, u0.y), silu_mul_s(g0.z, u0.z), silu_mul_s(g0.w, u0.w));
                w.y = pk4_fp8(silu_mul_s(g1.x, u1.x), silu_mul_s(g1.y, u1.y), silu_mul_s(g1.z, u1.z), silu_mul_s(g1.w, u1.w));
                *(u32x2*)(HID + (size_t)(row0 + ai * 128 + m * 16) * HIDP8 + col0) = w; }
    }
};
struct CfgM2 {
    static constexpr bool PERMX = true; static constexpr bool GATHER = false; static constexpr bool FP8 = true; static constexpr int KB = 2048; static constexpr bool PERM = true; static constexpr int K = 2048, ldb = WDP8;
    SchedMoe S; const unsigned char* HID; const unsigned char* W; bf16* Y;
    __device__ __forceinline__ bool next(int i, Unit& u) const { return S.next(i, u); }
    __device__ __forceinline__ const char* a_base(const Unit& u) const { return (const char*)(HID + ((size_t)u.e * EPAD + u.pm * 256) * HIDP8); }
    __device__ __forceinline__ void a_offs(const Unit&, int, const int (&R)[2], const int (&C)[2], unsigned (&off)[2][2]) const { lin_offs<HIDP8>(R, C, off); }
    __device__ __forceinline__ const char* b_base(const Unit& u) const { return (const char*)(W + ((size_t)u.e * 1024 + u.pn * 256) * WDP8); }
    __device__ __forceinline__ void epi(const f32x4 (&acc)[2][2][4][2], const Unit& u, int wr, int wc, int fr, int fq) const {
        const int row0 = u.e * EPAD + u.pm * 256 + wr * 64 + fr, col0 = u.pn * 256 + wc * 64 + 16 * fq;
#pragma unroll
        for (int ai = 0; ai < 2; ++ai)
#pragma unroll
            for (int m = 0; m < 4; ++m) { const f32x4 v0 = acc[ai][0][m][0] * WINV, v1 = acc[ai][0][m][1] * WINV, v2 = acc[ai][1][m][0] * WINV, v3 = acc[ai][1][m][1] * WINV;
                u32x4 w; w.x = pk4_fp8(v0.x, v0.y, v0.z, v0.w); w.y = pk4_fp8(v1.x, v1.y, v1.z, v1.w); w.z = pk4_fp8(v2.x, v2.y, v2.z, v2.w); w.w = pk4_fp8(v3.x, v3.y, v3.z, v3.w);
                *(u32x4*)((unsigned char*)Y + (size_t)(row0 + ai * 128 + m * 16) * D + col0) = w; }
    }
};
}

#ifndef FAST_PG
#define FAST_PG 1
#endif
#ifndef FAST_LIN
#define FAST_LIN 1
#endif
#ifndef FAST_LGT
#define FAST_LGT 1
#endif
#ifndef FAST_LOUT
#define FAST_LOUT 1
#endif
#ifndef FAST_M1
#define FAST_M1 1
#endif
#ifndef FAST_M2
#define FAST_M2 1
#endif
constexpr int IDX_OFF = RING_BYTES + 1024;

#ifndef REP_PRO
#define REP_PRO 1
#endif
#ifndef REP_PP
#define REP_PP 1
#endif
#ifndef REP_LIN
#define REP_LIN 1
#endif
#ifndef REP_LCV
#define REP_LCV 1
#endif
#ifndef REP_LGT
#define REP_LGT 1
#endif
#ifndef REP_LS1
#define REP_LS1 1
#endif
#ifndef REP_LS3
#define REP_LS3 1
#endif
#ifndef REP_RB
#define REP_RB 1
#endif
#ifndef REP_TK
#define REP_TK 1
#endif
#ifndef REP_M1
#define REP_M1 1
#endif
#ifndef REP_M2
#define REP_M2 1
#endif
#ifndef REP_RA
#define REP_RA 1
#endif
#ifndef REP_LOUT
#define REP_LOUT 1
#endif
#ifndef REP_PG
#define REP_PG 1
#endif
#define REPEAT(n) _Pragma("unroll") for (int rep_ = 0; rep_ < (n); ++rep_)
#define IN(k) (lo <= (k) && (k) < hi)
#define SEAM(k) do { if ((k) + 1 < hi) xcd_barrier(bar); } while (0)
template <int layer>
__device__ __forceinline__ void run_layer(const Frame& F, const int lo, const int hi, const XcdBarrier& bar) {
    const int gw = F.vcu * 8 + F.wave, NGW = F.G * 8;
    const bool fast = (F.G == 256);
    {
        const int pb = layer * 16, j = layer >> 1;
        if (IN(pb + 0)) { if constexpr (layer == 0) REPEAT(REP_PRO) phase_prologue(F); if (REP_RA > 1) phase_rowA<false, layer == 0, true>(F, layer); phase_rowA<false, layer == 0>(F, layer); SEAM(pb + 0); }
        if constexpr ((layer & 1) == 0) {
            if (IN(pb + 1)) { REPEAT(REP_PP) phase_poolwin(F, layer); SEAM(pb + 1); }
            if (IN(pb + 2)) { FnPool fn{F.P, F.WPOOL + (size_t)j * 4 * 65536, F.H, F.pool_scale + (size_t)j * D};
                if (FAST_PG && fast) { pg8::CfgPool cfg; cfg.S.init(128, 4, F.G, (int)blockIdx.x); cfg.P = F.P; cfg.W = fn.W; cfg.scale = fn.scale; if (REP_PG > 1) { cfg.H = (bf16*)F.HF; pg8::gemm_phase(F.lds, cfg); } cfg.H = F.H; pg8::gemm_phase(F.lds, cfg);
                    wg_gemm_ksplit<2>(fn, TaskMap{4 * 16, 16, 1024, 1}, F.lds, F.vcu, F.G, F.tid); }
                else wave_gemm(fn, TaskMap{FnPool::nrb * 16, 16, 0, 1}, gw, NGW, F.lane);
                SEAM(pb + 2); }
        } else {
            if (IN(pb + 3)) { REPEAT(REP_LIN) { FnIn fn{F.H, F.WIN + (size_t)j * 2048 * 1024, F.XB, F.GY, F.RSTD};
                if (FAST_LIN && fast) { pg8::CfgIn cfg; cfg.S.init(128, 8, F.G, (int)blockIdx.x); cfg.U = F.H; cfg.W = fn.W; cfg.XB = F.XB; cfg.GY = F.GY; cfg.RS = F.RSTD; pg8::gemm_phase(F.lds, cfg);
                    wg_gemm_ksplit<2>(fn, TaskMap{4 * 32, 32, 1024, 1}, F.lds, F.vcu, F.G, F.tid); }
                else wave_gemm(fn, TaskMap{FnIn::nrb * 32, 32, 0, 1}, gw, NGW, F.lane);
                } SEAM(pb + 3); }
            if (IN(pb + 4)) { REPEAT(REP_LCV) phase_conv(F, j); SEAM(pb + 4); }
            if (IN(pb + 5)) { REPEAT(REP_LGT) { FnGates fn{F.P, F.WGT + (size_t)j * 16 * 65536, F.LA, F.BV, F.b_gates + (size_t)j * 4 * D, F.SPT + (size_t)j * 2 * D};
                if (FAST_LGT && fast) { pg8::CfgGates cfg; cfg.S.init(128, 16, F.G, (int)blockIdx.x); cfg.XC = F.P; cfg.W = fn.W; cfg.LA = F.LA; cfg.BV = F.BV; cfg.bg = fn.bg; cfg.lam = fn.lam; pg8::gemm_phase(F.lds, cfg);
                    wg_gemm_ksplit<2>(fn, TaskMap{4 * 64, 64, 1024, 1}, F.lds, F.vcu, F.G, F.tid); }
                else wave_gemm(fn, TaskMap{FnGates::nrb * 64, 64, 0, 1}, gw, NGW, F.lane);
                } SEAM(pb + 5); }
            if (IN(pb + 6)) { REPEAT(REP_LS1) phase_scan1(F); SEAM(pb + 6); }
            if (IN(pb + 7)) { REPEAT(REP_LS3) phase_scan3(F); SEAM(pb + 7); }
            if (IN(pb + 8)) { FnOut fn{F.HG, F.WOUT + (size_t)j * 1024 * 1024, F.H};
                if (FAST_LOUT && fast) { pg8::CfgOut cfg; cfg.S.init(128, 4, F.G, (int)blockIdx.x); cfg.A = F.HG; cfg.W = fn.W; if (REP_LOUT > 1) { cfg.H = (bf16*)F.HF; pg8::gemm_phase(F.lds, cfg); } cfg.H = F.H; pg8::gemm_phase(F.lds, cfg);
                    wg_gemm_ksplit<2>(fn, TaskMap{4 * 16, 16, 1024, 1}, F.lds, F.vcu, F.G, F.tid); }
                else wave_gemm(fn, TaskMap{FnOut::nrb * 16, 16, 0, 1}, gw, NGW, F.lane);
                SEAM(pb + 8); }
        }
        if (IN(pb + 9)) { REPEAT(REP_RB) phase_rowB(F, layer); SEAM(pb + 9); }
        if (IN(pb + 10)) { REPEAT(REP_TK) phase_topk(F); SEAM(pb + 10); }
        if (IN(pb + 11)) { REPEAT(REP_M1) { FnM1f8 fn{(const unsigned char*)F.U, (const unsigned char*)F.WG1 + (size_t)layer * NE * 4096 * 1024, F.ROWL, (unsigned char*)F.HID};
            if (FAST_M1 && fast) { pg8::CfgM1 cfg; cfg.S.init(16, F.G, (int)blockIdx.x, 0, 4); cfg.U = fn.U; cfg.W = fn.W; cfg.HID = fn.HID;
                LAS unsigned short* idx = (LAS unsigned short*)(F.lds + IDX_OFF); cfg.idx = idx;
                {
                    int rl[16];
#pragma unroll
                    for (int ui = 0; ui < 16; ++ui) { pg8::Unit u; const bool ok = cfg.S.next(ui, u); rl[ui] = F.ROWL[(ok ? u.e * EPAD + u.pm * 256 : 0) + (F.tid & 255)]; }
#pragma unroll
                    for (int ui = 0; ui < 16; ++ui) if (F.tid < 256) idx[ui * 256 + F.tid] = (unsigned short)rl[ui];
                }
                __syncthreads();
                pg8::gemm_phase(F.lds, cfg);
                wg_gemm_ksplit8(fn, TaskMap{16 * 64, 64, ERB16 - 1, ERB16}, F.lds, F.vcu, F.G, F.tid); }
            else wg_gemm_ksplit8(fn, TaskMap{NE * ERB16 * 64, 64, 0, 1}, F.lds, F.vcu, F.G, F.tid);
            } SEAM(pb + 11); }
        if (IN(pb + 12)) { REPEAT(REP_M2) { FnM2f8 fn{(const unsigned char*)F.HID, (const unsigned char*)F.WD + (size_t)layer * NE * 1024 * WDP8, F.Y};
            if (FAST_M2 && fast) { pg8::CfgM2 cfg; cfg.S.init(4, F.G, (int)blockIdx.x); cfg.HID = fn.HID; cfg.W = fn.W; cfg.Y = F.Y; pg8::gemm_phase(F.lds, cfg);
                wg_gemm_ksplit8(fn, TaskMap{16 * 16, 16, ERB16 - 1, ERB16}, F.lds, F.vcu, F.G, F.tid); }
            else wg_gemm_ksplit8(fn, TaskMap{NE * ERB16 * 16, 16, 0, 1}, F.lds, F.vcu, F.G, F.tid);
            } SEAM(pb + 12); }
    }
}
#undef IN
#undef SEAM

__global__ void __launch_bounds__(512, 2) mega(Args args) {
    extern __shared__ __attribute__((aligned(16))) unsigned char lds_raw[];
    Frame F;
    F.lds = (LAS unsigned char*)lds_raw;
    F.tid = threadIdx.x; F.lane = F.tid & 63; F.wave = __builtin_amdgcn_readfirstlane(F.tid >> 6);
    F.G = gridDim.x; { const int bx = blockIdx.x; F.vcu = (F.G % 8 == 0) ? (bx % 8) * (F.G / 8) + bx / 8 : bx; }
    F.x = args.in[0]; F.meta = args.in[1]; F.norm_mix = args.in[2]; F.norm_ffn = args.in[3]; F.norm_final = args.in[4]; F.pool_w = args.in[5]; F.pool_scale = args.in[6]; F.w_in = args.in[7]; F.conv_w = args.in[8];
    F.conv_b = args.in[9]; F.w_gates = args.in[10]; F.b_gates = args.in[11]; F.lam = args.in[12]; F.w_out = args.in[13]; F.router_w = args.in[14]; F.moe_g = args.in[15]; F.moe_u = args.in[16]; F.moe_d = args.in[17];
    F.out = args.out; F.ws = args.ws;
    unsigned char* ws = args.ws;
    F.WG1 = (bf16*)(ws + WS_WG1); F.WD = (bf16*)(ws + WS_WD); F.WIN = (bf16*)(ws + WS_WIN); F.WGT = (bf16*)(ws + WS_WGT); F.WOUT = (bf16*)(ws + WS_WOUT); F.WPOOL = (bf16*)(ws + WS_WPOOL);
    F.H = (bf16*)(ws + WS_H); F.U = (bf16*)(ws + WS_U); F.P = (bf16*)(ws + WS_P); F.XB = (bf16*)(ws + WS_XB); F.GY = (bf16*)(ws + WS_GY); F.HG = (bf16*)(ws + WS_HG); F.HF = (float*)(ws + WS_Y);
    F.LA = (bf16*)(ws + WS_BIG); F.BV = (bf16*)(ws + WS_BIG + 2 * LA_BYTES); F.HID = (bf16*)(ws + WS_BIG); F.Y = (bf16*)(ws + WS_Y);
    F.AFF = (float*)(ws + WS_AFF); F.SLOT = (int*)(ws + WS_SLOT); F.GMAP = (float*)(ws + WS_GMAP); F.ROWL = (int*)(ws + WS_ROWL); F.AGG = (float*)(ws + WS_AGG); F.SPT = (float*)(ws + WS_SPT); F.RSTD = (float*)(ws + WS_RSTD);
    volatile LAS unsigned* MISC = (volatile LAS unsigned*)(F.lds + MISC_OFF);
    if (F.tid < 32) MISC[F.tid] = 0u;
    __syncthreads();
    const int lo = args.lo, hi = args.hi;
    const bool multi = (hi - lo) > 1;
    XcdBarrier bar; bar.bar = (unsigned*)(ws + WS_CTL) + CW_BAR; bar.x = 0; bar.st = nullptr;
    if (multi) bar = xcd_barrier_post((unsigned*)(ws + WS_CTL) + CW_BAR, MISC + 8);
#define IN(k) (lo <= (k) && (k) < hi)
#define SEAM(k) do { if ((k) + 1 < hi) xcd_barrier(bar); } while (0)
    run_layer<0>(F, lo, hi, bar); run_layer<1>(F, lo, hi, bar); run_layer<2>(F, lo, hi, bar); run_layer<3>(F, lo, hi, bar);
    if (IN(64)) { if (REP_RA > 1) phase_rowA<true, false>(F, DEPTH); phase_rowA<true, false>(F, DEPTH); }
#undef IN
#undef SEAM
}

extern "C" void kernel_launch(void* const* d_in, const int* in_sizes, int n_in, void* d_out, int out_size, void* d_ws, size_t ws_size, hipStream_t stream) {
    static int grid = 0;
    if (grid == 0) {
        if (n_in != 18 || in_sizes[0] != NB * SEQ * D || out_size != NB * SEQ * D || ws_size < WS_END) {
            fprintf(stderr, "kernel_launch: unexpected shapes (n_in %d, in0 %d, out %d, ws %zu < %zu)\n", n_in, n_in > 0 ? in_sizes[0] : -1, out_size, ws_size, (size_t)WS_END); grid = -1; return; }
        int dev = 0, cus = 0;
        if (hipGetDevice(&dev) != hipSuccess || hipDeviceGetAttribute(&cus, hipDeviceAttributeMultiprocessorCount, dev) != hipSuccess) { grid = -1; return; }
        if (hipFuncSetAttribute((const void*)mega, hipFuncAttributeMaxDynamicSharedMemorySize, LDS_BYTES) != hipSuccess) { fprintf(stderr, "kernel_launch: hipFuncSetAttribute failed\n"); grid = -1; return; }
        int per_cu = 0;
        if (hipOccupancyMaxActiveBlocksPerMultiprocessor(&per_cu, (const void*)mega, 512, LDS_BYTES) != hipSuccess || per_cu < 1) fprintf(stderr, "kernel_launch: occupancy query reports %d\n", per_cu);
        (void)hipGetLastError();
        grid = cus;
    }
    if (grid < 0) return;
    if (hipMemsetAsync((char*)d_ws + WS_CTL, 0, CTL_ZERO_BYTES, stream) != hipSuccess) return;
    Args a{};
    for (int i = 0; i < 18; ++i) a.in[i] = (const float*)d_in[i];
    a.out = (float*)d_out; a.ws = (unsigned char*)d_ws;
#if SINGLE_LAUNCH
    a.lo = 0; a.hi = 65;
    hipLaunchKernelGGL(mega, dim3(grid), dim3(512), LDS_BYTES, stream, a);
#else
    for (int layer = 0; layer < DEPTH; ++layer) {
        static const int pool_ph[] = {0, 1, 2, 9, 10, 11, 12}, lru_ph[] = {0, 3, 4, 5, 6, 7, 8, 9, 10, 11, 12};
        const int* ph = (layer & 1) ? lru_ph : pool_ph; const int n = (layer & 1) ? 11 : 7;
        for (int q = 0; q < n; ++q) { a.lo = layer * 16 + ph[q]; a.hi = a.lo + 1; hipLaunchKernelGGL(mega, dim3(grid), dim3(512), LDS_BYTES, stream, a); }
    }
    a.lo = 64; a.hi = 65; hipLaunchKernelGGL(mega, dim3(grid), dim3(512), LDS_BYTES, stream, a);
#endif
}
```

```cpp
#include <hip/hip_runtime.h>
#include <cstdio>
#include <cstdint>

#ifndef SINGLE_LAUNCH
#define SINGLE_LAUNCH 1
#endif

constexpr int NB = 8, SEQ = 4096, NMETA = 16, T = SEQ + NMETA, D = 1024, NE = 16, CAP = 2 * T / NE, DF = 2048, DEPTH = 4;
constexpr int MMAIN = NB * SEQ;
constexpr int MROWS = NB * T;
constexpr int MPAD = 33024;
constexpr int EROWS = NB * CAP;
constexpr int EPAD = 4352;
constexpr int HIDP8 = 2112, WDP8 = 2112;
constexpr float WSCALE = 32.0f, WINV = 1.0f / 32.0f;
constexpr int NCHUNK = 33, CHL = 128;
static_assert(CAP == 514 && T == 4112 && EROWS == 4112, "shapes");
constexpr float RMS_EPS = 1e-6f;

constexpr size_t MiB = 1u << 20;
constexpr size_t WS_CTL = 0, CTL_ZERO_BYTES = 1 * MiB;
constexpr size_t WS_WG1 = 1 * MiB;
constexpr size_t WS_WD = WS_WG1 + 512 * MiB;
constexpr size_t WS_WIN = WS_WD + 264 * MiB;
constexpr size_t WS_WGT = WS_WIN + 8 * MiB;
constexpr size_t WS_WOUT = WS_WGT + 4 * MiB;
constexpr size_t WS_WPOOL = WS_WOUT + 4 * MiB;
constexpr size_t WS_H = WS_WPOOL + 1 * MiB;
constexpr size_t WS_U = WS_H + 129 * MiB;
constexpr size_t WS_P = WS_U + 65 * MiB;
constexpr size_t WS_XB = WS_P + 65 * MiB;
constexpr size_t WS_GY = WS_XB + 65 * MiB;
constexpr size_t WS_HG = WS_GY + 65 * MiB;
constexpr size_t WS_BIG = WS_HG + 65 * MiB;
constexpr size_t WS_Y = WS_BIG + 282 * MiB;
constexpr size_t WS_AFF = WS_Y + 136 * MiB;
constexpr size_t WS_SLOT = WS_AFF + 3 * MiB;
constexpr size_t WS_GMAP = WS_SLOT + 3 * MiB;
constexpr size_t WS_ROWL = WS_GMAP + 3 * MiB;
constexpr size_t WS_AGG = WS_ROWL + 1 * MiB;
constexpr size_t WS_SPT = WS_AGG + 9 * MiB / 2;
constexpr size_t WS_RSTD = WS_SPT + 64 * 1024;
constexpr size_t WS_END = WS_AGG + 5 * MiB;
constexpr size_t LA_BYTES = (size_t)MPAD * 1024 * 2;

constexpr int CW_BAR = 4096;

constexpr int RING_BYTES = 131072;
constexpr int MISC_OFF = RING_BYTES + 320;
constexpr int LDS_BYTES = 147456;

#define LAS __attribute__((address_space(3)))
typedef unsigned short bf16;
typedef short bf16x8 __attribute__((ext_vector_type(8)));
typedef float f32x4 __attribute__((ext_vector_type(4)));
typedef float f32x2 __attribute__((ext_vector_type(2)));
typedef unsigned u32x4 __attribute__((ext_vector_type(4)));
typedef unsigned u32x2 __attribute__((ext_vector_type(2)));

__device__ __forceinline__ unsigned cvt_pk_bf16(float lo, float hi) { unsigned r; asm volatile("v_cvt_pk_bf16_f32 %0, %1, %2" : "=v"(r) : "v"(lo), "v"(hi)); return r; }
__device__ __forceinline__ float bflo(unsigned w) { return __uint_as_float(w << 16); }
__device__ __forceinline__ float bfhi(unsigned w) { return __uint_as_float(w & 0xffff0000u); }
__device__ __forceinline__ float fast_exp(float x) { return __builtin_amdgcn_exp2f(x * 1.44269504089f); }
__device__ __forceinline__ float fast_rcp(float x) { return __builtin_amdgcn_rcpf(x); }
__device__ __forceinline__ float sigmoidf_(float x) { return fast_rcp(1.0f + fast_exp(-x)); }
__device__ __forceinline__ float siluf_(float x) { return x * sigmoidf_(x); }
typedef int v4i __attribute__((ext_vector_type(4)));
typedef int v8i __attribute__((ext_vector_type(8)));
__device__ __forceinline__ unsigned pk4_fp8(float a, float b, float c, float d) {
    a = __builtin_amdgcn_fmed3f(a, -448.f, 448.f); b = __builtin_amdgcn_fmed3f(b, -448.f, 448.f); c = __builtin_amdgcn_fmed3f(c, -448.f, 448.f); d = __builtin_amdgcn_fmed3f(d, -448.f, 448.f);
    unsigned r = 0; r = (unsigned)__builtin_amdgcn_cvt_pk_fp8_f32(a, b, (int)r, false); r = (unsigned)__builtin_amdgcn_cvt_pk_fp8_f32(c, d, (int)r, true); return r; }
__device__ __forceinline__ f32x4 fp8x4_to_f32(unsigned w) { const f32x2 lo = __builtin_amdgcn_cvt_pk_f32_fp8((int)w, false), hi = __builtin_amdgcn_cvt_pk_f32_fp8((int)w, true); return (f32x4){lo.x, lo.y, hi.x, hi.y}; }
__device__ __forceinline__ float silu_mul_s(float G, float U) { const float e = __builtin_amdgcn_exp2f(G * (-1.44269504089f * WINV)); return (G * U) * fast_rcp(__builtin_fmaf(e, 1024.0f, 1024.0f)); }
__device__ __forceinline__ unsigned pk4_u8(float a, float b, float c, float d) { return (unsigned)(a * 255.0f + 0.5f) | ((unsigned)(b * 255.0f + 0.5f) << 8) | ((unsigned)(c * 255.0f + 0.5f) << 16) | ((unsigned)(d * 255.0f + 0.5f) << 24); }
__device__ __forceinline__ float gelu_tanh(float x) { const float z = 0.7978845608f * (x + 0.044715f * x * x * x); return x * sigmoidf_(2.0f * z); }
__device__ __forceinline__ float wave_sum(float v) {
#pragma unroll
    for (int o = 1; o < 64; o <<= 1) v += __shfl_xor(v, o);
    return v;
}
__device__ __forceinline__ int opaque(int v) { asm volatile("" : "+v"(v)); return v; }
__device__ __forceinline__ int row_of(int b, int t) { return t >= NMETA ? b * SEQ + (t - NMETA) : MMAIN + b * NMETA + t; }

#define XB_TMO      128
#define XB_XCNT(j)  (256  + 64 * (j))
#define XB_XSUB(j)  (1280 + 64 * (j))
#define XB_XGEN(j)  (2304 + 64 * (j))
#define XB_TOP      3328
#define XB_TOPGEN   3392
#define XCD_BAR_WORDS 3456
#define XB_SPIN_CAP (1u << 18)
__device__ __forceinline__ unsigned xb_ld(unsigned* p)              { return __hip_atomic_load(p, __ATOMIC_RELAXED, __HIP_MEMORY_SCOPE_AGENT); }
__device__ __forceinline__ unsigned xb_add(unsigned* p, unsigned v) { return __hip_atomic_fetch_add(p, v, __ATOMIC_RELAXED, __HIP_MEMORY_SCOPE_AGENT); }
__device__ __forceinline__ unsigned xb_xcc_id() { return (unsigned)__builtin_amdgcn_s_getreg((3 << 11) | 20) & 0xFu; }
#define XB_SPIN(cond, bar) do { unsigned _sp = 0; while (cond) { __builtin_amdgcn_s_sleep(1); \
    if ((++_sp & 255u) == 0u) { if (xb_ld(&(bar)[XB_TMO])) break; if (_sp > XB_SPIN_CAP) { atomicAdd(&(bar)[XB_TMO], 1u); break; } } } } while (0)
struct XcdBarrier { unsigned* bar; unsigned x; volatile LAS unsigned* st; };
__device__ __forceinline__ XcdBarrier xcd_barrier_post(unsigned* bar, volatile LAS unsigned* st) {
    XcdBarrier b; b.bar = bar; b.x = xb_xcc_id(); b.st = st;
    if (threadIdx.x == 0) (void)xb_add(&bar[XB_XCNT(b.x)], 1u);
    return b;
}
__device__ __forceinline__ void xcd_barrier_complete(unsigned* bar, unsigned x, unsigned& nloc, unsigned& nx) {
    const unsigned G = gridDim.x * gridDim.y * gridDim.z;
    unsigned sum, cnt, mine, sp = 0u;
    for (;;) {
        sum = 0u; cnt = 0u; mine = 0u;
#pragma unroll
        for (unsigned j = 0; j < 16; ++j) { const unsigned c = xb_ld(&bar[XB_XCNT(j)]); sum += c; cnt += (c > 0u) ? 1u : 0u; mine = (j == x) ? c : mine; }
        if (sum == G) break;
        __builtin_amdgcn_s_sleep(1);
        if ((++sp & 255u) == 0u) { if (xb_ld(&bar[XB_TMO])) break; if (sp > XB_SPIN_CAP) { atomicAdd(&bar[XB_TMO], 1u); break; } }
    }
    nloc = mine > 0u ? mine : 1u; nx = cnt > 0u ? cnt : 1u;
}
__device__ __forceinline__ void xcd_barrier(const XcdBarrier& b) {
    asm volatile("s_waitcnt vmcnt(0)" ::: "memory");
    __syncthreads();
    if (threadIdx.x == 0) {
        unsigned* bar = b.bar;
        __builtin_amdgcn_s_waitcnt(0);
        unsigned nloc = b.st[0], nx = b.st[1];
        if (nloc == 0u) { xcd_barrier_complete(bar, b.x, nloc, nx); b.st[0] = nloc; b.st[1] = nx; }
        const unsigned old = xb_add(&bar[XB_XSUB(b.x)], 1u);
        const unsigned gen = old / nloc;
        if (old + 1u == (gen + 1u) * nloc) {
            __builtin_amdgcn_fence(__ATOMIC_RELEASE, "agent");
            asm volatile("s_waitcnt vmcnt(0)" ::: "memory");
            const unsigned og = xb_add(&bar[XB_TOP], 1u);
            const unsigned tg = og / nx;
            if (og + 1u == (tg + 1u) * nx) xb_add(&bar[XB_TOPGEN], 1u);
            else XB_SPIN(xb_ld(&bar[XB_TOPGEN]) == tg, bar);
            __builtin_amdgcn_fence(__ATOMIC_ACQUIRE, "agent");
            xb_add(&bar[XB_XGEN(b.x)], 1u);
            asm volatile("s_waitcnt vmcnt(0)" ::: "memory");
        } else {
            XB_SPIN(xb_ld(&bar[XB_XGEN(b.x)]) == gen, bar);
            __builtin_amdgcn_fence(__ATOMIC_ACQUIRE, "agent");
            asm volatile("s_waitcnt vmcnt(0)" ::: "memory");
        }
    }
    __syncthreads();
}

struct Args { const float* in[18]; float* out; unsigned char* ws; int lo, hi; };
struct Frame {
    LAS unsigned char* lds;
    int tid, lane, wave, vcu, G;
    const float *x, *meta, *norm_mix, *norm_ffn, *norm_final, *pool_w, *pool_scale, *w_in, *conv_w, *conv_b, *w_gates, *b_gates, *lam, *w_out, *router_w, *moe_g, *moe_u, *moe_d;
    float* out; unsigned char* ws;
    bf16 *WG1, *WD, *WIN, *WGT, *WOUT, *WPOOL;
    bf16* H; float* HF; bf16 *U, *P, *XB, *GY, *HG, *LA, *BV, *HID, *Y;
    float* AFF; int* SLOT; float* GMAP; int* ROWL; float* AGG; float* SPT; float* RSTD;
};

struct ProItem { const float* src; unsigned char* dst; const float* ks; int ldw, ldt, f8; };
__device__ __forceinline__ ProItem pro_decode(const Frame& F, int it) {
    constexpr int I_MOE = 64 * 512, I_IN = 2 * 512, I_OUT = 2 * 256, I_GT = 32 * 16;
    ProItem p; p.ks = nullptr; int r = it;
    if (r < 2 * I_MOE) {
        const int up = r >= I_MOE; if (up) r -= I_MOE;
        const int le = r >> 9, q = r & 511, k0 = (q >> 6) * 128, n0 = (q & 63) * 32;
        p.src = (up ? F.moe_u : F.moe_g) + (size_t)le * 1024 * 2048 + (size_t)k0 * 2048 + n0; p.ldw = 2048;
        p.dst = (unsigned char*)F.WG1 + ((size_t)le * 4096 + (n0 >> 7) * 256 + up * 128 + (n0 & 127)) * 1024 + k0; p.ldt = 1024; p.f8 = 1; return p; }
    r -= 2 * I_MOE;
    if (r < I_MOE) {
        const int le = r >> 9, q = r & 511, k0 = (q >> 5) * 128, n0 = (q & 31) * 32;
        p.src = F.moe_d + (size_t)le * 2048 * 1024 + (size_t)k0 * 1024 + n0; p.ldw = 1024;
        p.dst = (unsigned char*)F.WD + ((size_t)le * 1024 + n0) * WDP8 + k0; p.ldt = WDP8; p.f8 = 1; return p; }
    r -= I_MOE; p.f8 = 0;
    if (r < I_IN) {
        const int j = r >> 9, q = r & 511, k0 = (q >> 6) * 128, n0 = (q & 63) * 32;
        p.src = F.w_in + (size_t)j * 1024 * 2048 + (size_t)k0 * 2048 + n0; p.ldw = 2048; p.dst = (unsigned char*)(F.WIN + ((size_t)j * 2048 + n0) * 1024 + k0); p.ldt = 2048; p.ks = F.norm_mix + (size_t)(2 * j + 1) * D + k0; return p; }
    r -= I_IN;
    if (r < I_OUT) {
        const int j = r >> 8, q = r & 255, k0 = (q >> 5) * 128, n0 = (q & 31) * 32;
        p.src = F.w_out + (size_t)j * 1024 * 1024 + (size_t)k0 * 1024 + n0; p.ldw = 1024; p.dst = (unsigned char*)(F.WOUT + ((size_t)j * 1024 + n0) * 1024 + k0); p.ldt = 2048; return p; }
    r -= I_OUT;
    if (r < I_GT) {
        const int mat = r >> 4, q = r & 15, k0 = (q >> 3) * 128, n0 = (q & 7) * 32;
        const int j = mat >> 4, d = (mat >> 3) & 1, g = (mat >> 2) & 1, h = mat & 3, nt = d * 8 + h * 2 + (n0 >> 7);
        p.src = F.w_gates + (size_t)mat * 65536 + (size_t)k0 * 256 + n0; p.ldw = 256; p.dst = (unsigned char*)(F.WGT + (((size_t)j * 16 + nt) * 256 + g * 128 + (n0 & 127)) * 256 + k0); p.ldt = 512; return p; }
    r -= I_GT;
    {
        const int mat = r >> 4, q = r & 15, k0 = (q >> 3) * 128, n0 = (q & 7) * 32;
        p.src = F.pool_w + (size_t)mat * 65536 + (size_t)k0 * 256 + n0; p.ldw = 256; p.dst = (unsigned char*)(F.WPOOL + ((size_t)mat * 256 + n0) * 256 + k0); p.ldt = 512; return p; }
}
__device__ __forceinline__ void pro_load(const ProItem& p, f32x4 (&v)[16], int lane) {
    const int rr = lane >> 3, sg = lane & 7;
#pragma unroll
    for (int i = 0; i < 16; ++i) v[i] = __builtin_nontemporal_load((const f32x4*)(p.src + (size_t)(8 * i + rr) * p.ldw + 4 * sg));
}
__device__ __forceinline__ void pro_finish(const ProItem& p, const f32x4 (&v)[16], LAS float* scr, int lane) {
    { const int rr = lane >> 3, sg = lane & 7;
#pragma unroll
        for (int i = 0; i < 16; ++i) *(LAS f32x4*)(scr + (8 * i + rr) * 32 + ((4 * sg) ^ (((i >> 1) & 3) << 3))) = v[i]; }
    asm volatile("s_waitcnt lgkmcnt(0)" ::: "memory");
    const int c = lane & 7;
#pragma unroll
    for (int j = 0; j < 4; ++j) { const int n = (lane >> 3) + 8 * j; const LAS float* s = scr + (16 * c) * 32 + (n ^ ((c & 3) << 3));
        float t[16];
#pragma unroll
        for (int q = 0; q < 16; ++q) t[q] = s[q * 32];
        if (p.f8) { u32x4 o; o.x = pk4_fp8(t[0] * WSCALE, t[1] * WSCALE, t[2] * WSCALE, t[3] * WSCALE); o.y = pk4_fp8(t[4] * WSCALE, t[5] * WSCALE, t[6] * WSCALE, t[7] * WSCALE);
            o.z = pk4_fp8(t[8] * WSCALE, t[9] * WSCALE, t[10] * WSCALE, t[11] * WSCALE); o.w = pk4_fp8(t[12] * WSCALE, t[13] * WSCALE, t[14] * WSCALE, t[15] * WSCALE);
            __builtin_nontemporal_store(o, (u32x4*)(p.dst + (size_t)n * p.ldt + 16 * c)); }
        else { if (p.ks) { const float* ks = p.ks + 16 * c;
#pragma unroll
                for (int q4 = 0; q4 < 4; ++q4) { const f32x4 g4 = *(const f32x4*)(ks + 4 * q4); t[4 * q4] *= g4.x; t[4 * q4 + 1] *= g4.y; t[4 * q4 + 2] *= g4.z; t[4 * q4 + 3] *= g4.w; } }
            u32x4 o0, o1; o0.x = cvt_pk_bf16(t[0], t[1]); o0.y = cvt_pk_bf16(t[2], t[3]); o0.z = cvt_pk_bf16(t[4], t[5]); o0.w = cvt_pk_bf16(t[6], t[7]);
            o1.x = cvt_pk_bf16(t[8], t[9]); o1.y = cvt_pk_bf16(t[10], t[11]); o1.z = cvt_pk_bf16(t[12], t[13]); o1.w = cvt_pk_bf16(t[14], t[15]);
            unsigned char* d = p.dst + (size_t)n * p.ldt + 32 * c; __builtin_nontemporal_store(o0, (u32x4*)d); __builtin_nontemporal_store(o1, (u32x4*)(d + 16)); } }
    asm volatile("s_waitcnt lgkmcnt(0)" ::: "memory");
}
__device__ __forceinline__ void phase_prologue(const Frame& F) {
    LAS float* scr = (LAS float*)(F.lds + F.wave * 16384);
    const int gw = F.vcu * 8 + F.wave, NGW = F.G * 8, lane = F.lane;
    for (int i = gw * 64 + lane; i < 4 * D; i += NGW * 64) F.SPT[i] = -8.0f * log1pf(expf(-F.lam[i]));
    constexpr int NITEMS = 3 * 64 * 512 + 2 * 512 + 2 * 256 + 32 * 16 + 8 * 16;
    int it = gw; if (it >= NITEMS) return;
    ProItem cur = pro_decode(F, it); f32x4 v[16], w[16]; pro_load(cur, v, lane);
    for (;;) {
        const int nit = it + NGW; const bool more = nit < NITEMS; ProItem nxt = cur;
        if (more) nxt = pro_decode(F, nit);
        pro_load(nxt, w, lane);
        pro_finish(cur, v, scr, lane);
        if (!more) break;
        cur = nxt; it = nit;
#pragma unroll
        for (int i = 0; i < 16; ++i) v[i] = w[i];
    }
}

template <bool FINAL, bool FIRST, bool DRY = false>
__device__ __forceinline__ void phase_rowA(const Frame& F, int layer) {
    const int gw = F.vcu * 8 + F.wave, NGW = F.G * 8, lane = F.lane;
    const float* gain = FINAL ? F.norm_final : F.norm_mix + layer * D;
    f32x4 gn[4];
#pragma unroll
    for (int j = 0; j < 4; ++j) gn[j] = *(const f32x4*)(gain + 4 * lane + 256 * j);
    const int rend = FINAL ? MMAIN : MROWS;
    int sl_n = -1; float gg_n = 0.f;
    if (!FIRST) { if (lane < 16 && gw < rend) { sl_n = F.SLOT[(size_t)gw * 16 + lane]; gg_n = F.GMAP[(size_t)gw * 16 + lane]; } }
    for (int r = gw; r < rend; r += NGW) {
        f32x4 v[4];
        if (FIRST) {
            const float* src = r < MMAIN ? F.x + (size_t)r * D : F.meta + (size_t)((r - MMAIN) & 15) * D;
#pragma unroll
            for (int j = 0; j < 4; ++j) v[j] = *(const f32x4*)(src + 4 * lane + 256 * j);
        } else {
            const int sl = sl_n; const float gg = gg_n;
            const bf16* src = F.H + (size_t)r * D;
#pragma unroll
            for (int j = 0; j < 4; ++j) { const u32x2 w = *(const u32x2*)(src + 4 * lane + 256 * j); v[j] = (f32x4){bflo(w.x), bfhi(w.x), bflo(w.y), bfhi(w.y)}; }
            { const int rn = r + NGW; sl_n = -1; if (lane < 16 && rn < rend) { sl_n = F.SLOT[(size_t)rn * 16 + lane]; gg_n = F.GMAP[(size_t)rn * 16 + lane]; } }
            unsigned mask = (unsigned)__ballot(sl >= 0) & 0xffffu;
            while (mask) {
                int ee[4]; float gq[4]; const unsigned char* yr[4];
#pragma unroll
                for (int q = 0; q < 4; ++q) { const bool on = mask != 0u; const int e = on ? (__builtin_ffs((int)mask) - 1) : 0; mask &= mask - 1u;
                    const int s = __builtin_amdgcn_readlane(sl, e); const float g = __uint_as_float(__builtin_amdgcn_readlane(__float_as_uint(gg), e));
                    ee[q] = e; gq[q] = on ? g : 0.f; yr[q] = (const unsigned char*)F.Y + ((size_t)e * EPAD + (on ? s : 0)) * D; }
                unsigned w[4][4];
#pragma unroll
                for (int q = 0; q < 4; ++q)
#pragma unroll
                    for (int j = 0; j < 4; ++j) w[q][j] = *(const unsigned*)(yr[q] + 4 * lane + 256 * j);
#pragma unroll
                for (int q = 0; q < 4; ++q)
#pragma unroll
                    for (int j = 0; j < 4; ++j) v[j] += fp8x4_to_f32(w[q][j]) * gq[q];
                (void)ee;
            }
        }
        if (!FINAL && !DRY) {
            bf16* dst = F.H + (size_t)r * D;
#pragma unroll
            for (int j = 0; j < 4; ++j) { u32x2 w; w.x = cvt_pk_bf16(v[j].x, v[j].y); w.y = cvt_pk_bf16(v[j].z, v[j].w); *(u32x2*)(dst + 4 * lane + 256 * j) = w; }
        }
        float ss = 0.f;
#pragma unroll
        for (int j = 0; j < 4; ++j) ss += (v[j].x * v[j].x + v[j].y * v[j].y) + (v[j].z * v[j].z + v[j].w * v[j].w);
        const float rstd = 1.0f / sqrtf(wave_sum(ss) * (1.0f / D) + RMS_EPS);
        if (FINAL) {
            float* dst = F.out + (size_t)r * D;
#pragma unroll
            for (int j = 0; j < 4; ++j) *(f32x4*)(dst + 4 * lane + 256 * j) = v[j] * rstd * gn[j];
        } else {
            if (lane == 0) F.RSTD[r] = rstd;
        }
    }
}
__device__ __forceinline__ void phase_rowB(const Frame& F, int layer) {
    const int gw = F.vcu * 8 + F.wave, NGW = F.G * 8, lane = F.lane;
    LAS float* wT = (LAS float*)F.lds;
    const float* rw = F.router_w + (size_t)layer * D * NE;
    const float* gain = F.norm_ffn + layer * D;
    f32x4 gn[4];
#pragma unroll
    for (int j = 0; j < 4; ++j) gn[j] = *(const f32x4*)(gain + 4 * lane + 256 * j);
    f32x4 nx[2][4];
#pragma unroll
    for (int q = 0; q < 2; ++q) { const int r = gw + q * NGW; const bf16* src = F.H + (size_t)(r < MROWS ? r : gw) * D;
#pragma unroll
        for (int j = 0; j < 4; ++j) { const u32x2 w = *(const u32x2*)(src + 4 * lane + 256 * j); nx[q][j] = (f32x4){bflo(w.x), bfhi(w.x), bflo(w.y), bfhi(w.y)}; } }
    {
        f32x4 rv[8];
#pragma unroll
        for (int i = 0; i < 8; ++i) rv[i] = *(const f32x4*)(rw + 4 * (F.tid + 512 * i));
#pragma unroll
        for (int i = 0; i < 8; ++i) { const int i4 = F.tid + 512 * i, c = i4 >> 2, e = (i4 & 3) * 4; wT[e * 1024 + c] = rv[i].x; wT[(e + 1) * 1024 + c] = rv[i].y; wT[(e + 2) * 1024 + c] = rv[i].z; wT[(e + 3) * 1024 + c] = rv[i].w; }
    }
    __syncthreads();
    for (int r0 = gw; r0 < MROWS; r0 += 2 * NGW) {
        f32x4 v[2][4];
#pragma unroll
        for (int q = 0; q < 2; ++q)
#pragma unroll
            for (int j = 0; j < 4; ++j) v[q][j] = nx[q][j];
#pragma unroll
        for (int q = 0; q < 2; ++q) { const int r = r0 + (2 + q) * NGW; const bf16* src = F.H + (size_t)(r < MROWS ? r : gw) * D;
#pragma unroll
            for (int j = 0; j < 4; ++j) { const u32x2 w = *(const u32x2*)(src + 4 * lane + 256 * j); nx[q][j] = (f32x4){bflo(w.x), bfhi(w.x), bflo(w.y), bfhi(w.y)}; } }
        const bool has1 = (r0 + NGW) < MROWS;
#pragma unroll
        for (int q = 0; q < 2; ++q) {
            float ss = 0.f;
#pragma unroll
            for (int j = 0; j < 4; ++j) ss += (v[q][j].x * v[q][j].x + v[q][j].y * v[q][j].y) + (v[q][j].z * v[q][j].z + v[q][j].w * v[q][j].w);
            const float rstd = 1.0f / sqrtf(wave_sum(ss) * (1.0f / D) + RMS_EPS);
            const int r = r0 + q * NGW;
#pragma unroll
            for (int j = 0; j < 4; ++j) v[q][j] = v[q][j] * rstd * gn[j];
            if (q == 0 || has1) { unsigned char* dst = (unsigned char*)F.U + (size_t)r * D;
#pragma unroll
                for (int j = 0; j < 4; ++j) *(unsigned*)(dst + 4 * lane + 256 * j) = pk4_fp8(v[q][j].x, v[q][j].y, v[q][j].z, v[q][j].w); }
        }
        float val[32];
        const int woff = opaque(4 * lane);
#pragma unroll
        for (int e = 0; e < 16; ++e) { f32x2 p0 = (f32x2){0.f, 0.f}, p1 = p0;
#pragma unroll
            for (int j = 0; j < 4; ++j) { const f32x4 w = *(const LAS f32x4*)(wT + e * 1024 + woff + 256 * j); const f32x2 wl = (f32x2){w.x, w.y}, wh = (f32x2){w.z, w.w};
                p0 += (f32x2){v[0][j].x, v[0][j].y} * wl; p0 += (f32x2){v[0][j].z, v[0][j].w} * wh; p1 += (f32x2){v[1][j].x, v[1][j].y} * wl; p1 += (f32x2){v[1][j].z, v[1][j].w} * wh; }
            val[e] = p0.x + p0.y; val[16 + e] = p1.x + p1.y; }
#define BFLY(S, HH) { const bool up = (lane >> (S)) & 1; _Pragma("unroll") for (int i = 0; i < (HH); ++i) { const float keep = up ? val[(HH) + i] : val[i], send = up ? val[i] : val[(HH) + i]; val[i] = keep + __shfl_xor(send, 1 << (S)); } }
        BFLY(0, 16) BFLY(1, 8) BFLY(2, 4) BFLY(3, 2) BFLY(4, 1)
#undef BFLY
        float lg = val[0] + __shfl_xor(val[0], 32);
        const int vi = ((lane & 1) << 4) | ((lane & 2) << 2) | (lane & 4) | ((lane & 8) >> 2) | ((lane & 16) >> 4);
        float mx = lg;
#pragma unroll
        for (int o = 2; o <= 16; o <<= 1) mx = fmaxf(mx, __shfl_xor(mx, o));
        const float p = expf(lg - mx); float sum = p;
#pragma unroll
        for (int o = 2; o <= 16; o <<= 1) sum += __shfl_xor(sum, o);
        const int q = vi >> 4, e = vi & 15, r = r0 + q * NGW;
        if (lane < 32 && (q == 0 || has1)) {
            int b, t; if (r < MMAIN) { b = r >> 12; t = (r & 4095) + NMETA; } else { b = (r - MMAIN) >> 4; t = (r - MMAIN) & 15; }
            F.AFF[((size_t)b * NE + e) * T + t] = p / sum;
        }
    }
    __syncthreads();
}

__device__ __forceinline__ int block_excl_scan(int v, LAS int* wsum, int tid, int lane, int wave, int& total) {
    int s = v;
#pragma unroll
    for (int o = 1; o < 64; o <<= 1) { const int t = __shfl_up(s, o); if (lane >= o) s += t; }
    __syncthreads();
    if (lane == 63) wsum[wave] = s;
    __syncthreads();
    int base = 0, tot = 0;
#pragma unroll
    for (int w = 0; w < 8; ++w) { const int x = wsum[w]; if (w < wave) base += x; tot += x; }
    total = tot;
    return base + s - v;
}
__device__ __forceinline__ void phase_topk(const Frame& F) {
    LAS unsigned* keys = (LAS unsigned*)F.lds;
    LAS int* hist = (LAS int*)(F.lds + 20480);
    LAS int* misc = (LAS int*)(F.lds + 20480 + 1024);
    const int tid = F.tid, lane = F.lane, wave = F.wave;
    for (int task = blockIdx.x; task < NB * NE; task += F.G) {
        const int b = task >> 4, e = task & 15;
        const float* aff = F.AFF + ((size_t)b * NE + e) * T;
        __syncthreads();
        {   unsigned kv[9];
#pragma unroll
            for (int i = 0; i < 9; ++i) { const int t = tid + 512 * i; kv[i] = __float_as_uint(aff[t < T ? t : T - 1]); }
#pragma unroll
            for (int i = 0; i < 9; ++i) { const int t = tid + 512 * i; if (t < T) keys[t] = kv[i]; } }
        unsigned prefix = 0u, pmask = 0u; int need = CAP;
        for (int p = 3; p >= 0; --p) {
            if (tid < 256) hist[tid] = 0;
            __syncthreads();
            for (int t = tid; t < T; t += 512) { const unsigned k = keys[t]; if ((k & pmask) == prefix) __hip_atomic_fetch_add(&hist[(k >> (8 * p)) & 255u], 1, __ATOMIC_RELAXED, __HIP_MEMORY_SCOPE_WORKGROUP); }
            __syncthreads();
            if (wave == 0) {
                int c[4]; int tot = 0;
#pragma unroll
                for (int q = 0; q < 4; ++q) { c[q] = hist[4 * lane + q]; tot += c[q]; }
                int s = tot;
#pragma unroll
                for (int o = 1; o < 64; o <<= 1) { const int x = __shfl_down(s, o); if (lane + o < 64) s += x; }
                int above = s - tot;
                if (above < need && need <= s) {
                    int a = above;
#pragma unroll
                    for (int q = 3; q >= 0; --q) { if (need <= a + c[q] && need > a) { misc[0] = 4 * lane + q; misc[1] = need - a; } a += c[q]; }
                }
            }
            __syncthreads();
            prefix |= (unsigned)misc[0] << (8 * p); pmask |= 0xFFu << (8 * p); need = misc[1];
            __syncthreads();
        }
        const unsigned vstar = prefix;
        const int t0 = tid * 9, t1 = (t0 + 9 < T) ? t0 + 9 : T;
        int neq = 0;
        for (int t = t0; t < t1; ++t) neq += (keys[t] == vstar) ? 1 : 0;
        int toteq; int eqbase = block_excl_scan(neq, misc + 8, tid, lane, wave, toteq);
        int nsel = 0; unsigned selmask = 0u; { int er = eqbase;
            for (int t = t0; t < t1; ++t) { const unsigned k = keys[t]; bool s = k > vstar; if (k == vstar) { s = er < need; ++er; } if (s) { selmask |= 1u << (t - t0); ++nsel; } } }
        int totsel; int sbase = block_excl_scan(nsel, misc + 8, tid, lane, wave, totsel);
        for (int t = t0; t < t1; ++t) {
            const int row = row_of(b, t);
            if ((selmask >> (t - t0)) & 1u) { const int pos = b * CAP + sbase; ++sbase;
                F.ROWL[e * EPAD + pos] = row; F.SLOT[(size_t)row * 16 + e] = pos; F.GMAP[(size_t)row * 16 + e] = __uint_as_float(keys[t]); }
            else F.SLOT[(size_t)row * 16 + e] = -1;
        }
        if (b == 0 && tid < EPAD - EROWS) F.ROWL[e * EPAD + EROWS + tid] = 0;
    }
    __syncthreads();
}

__device__ __forceinline__ void phase_poolwin(const Frame& F, int layer) {
    const int gw = F.vcu * 8 + F.wave, NGW = F.G * 8, lane = F.lane;
    constexpr int CHS = 33, NTC = (T + CHS - 1) / CHS;
    for (int it = gw; it < NB * NTC * 2; it += NGW) {
        const int half = it & 1, tc = (it >> 1) % NTC, b = (it >> 1) / NTC;
        const int col = half * 512 + lane * 8, g = col >> 8, hw = 1 << g;
        const int t0 = tc * CHS, t1 = (t0 + CHS < T) ? t0 + CHS : T;
        float sum[8];
#pragma unroll
        for (int q = 0; q < 8; ++q) sum[q] = 0.f;
        const u32x4 zero4 = (u32x4){0u, 0u, 0u, 0u};
        const bf16* ucol = F.H + col;
        float gnv[8];
        { const float* gp = F.norm_mix + (size_t)layer * D + col; const f32x4 g0 = *(const f32x4*)gp, g1 = *(const f32x4*)(gp + 4); gnv[0] = g0.x; gnv[1] = g0.y; gnv[2] = g0.z; gnv[3] = g0.w; gnv[4] = g1.x; gnv[5] = g1.y; gnv[6] = g1.z; gnv[7] = g1.w; }
#define PW_FMA(V_, S_) do { sum[0] += bflo(V_.x) * (S_); sum[1] += bfhi(V_.x) * (S_); sum[2] += bflo(V_.y) * (S_); sum[3] += bfhi(V_.y) * (S_); sum[4] += bflo(V_.z) * (S_); sum[5] += bfhi(V_.z) * (S_); sum[6] += bflo(V_.w) * (S_); sum[7] += bfhi(V_.w) * (S_); } while (0)
        {
            u32x4 iw[16]; float ir[16];
#pragma unroll
            for (int q = 0; q < 16; ++q) { const int dt = q - 8, tt = t0 + dt; const bool v = dt >= -hw && dt < hw && tt >= 0 && tt < T; const int row = row_of(b, v ? tt : t0); iw[q] = *(const u32x4*)(ucol + (size_t)row * D); ir[q] = F.RSTD[row]; }
#pragma unroll
            for (int q = 0; q < 16; ++q) { const int dt = q - 8, tt = t0 + dt; const bool v = dt >= -hw && dt < hw && tt >= 0 && tt < T; const float sc = v ? ir[q] : 0.f; PW_FMA(iw[q], sc); }
        }
        for (int tb = t0; tb < t1; tb += 11) {
            u32x4 c[11], wp[11], wm[11]; float rc[11], rp[11], rm[11];
#pragma unroll
            for (int q = 0; q < 11; ++q) { const int t = (tb + q < t1) ? tb + q : t1 - 1; const bool vp = t + hw < T, vm = t - hw >= 0;
                const int r0_ = row_of(b, t), r1_ = row_of(b, vp ? t + hw : t), r2_ = row_of(b, vm ? t - hw : t);
                c[q] = *(const u32x4*)(ucol + (size_t)r0_ * D); wp[q] = *(const u32x4*)(ucol + (size_t)r1_ * D); wm[q] = *(const u32x4*)(ucol + (size_t)r2_ * D);
                rc[q] = F.RSTD[r0_]; rp[q] = F.RSTD[r1_]; rm[q] = F.RSTD[r2_]; }
#pragma unroll
            for (int q = 0; q < 11; ++q) { const int t = tb + q;
                if (t < t1) {
                    const int lo = (t - hw > 0) ? t - hw : 0, hi = (t + hw < T) ? t + hw : T;
                    const float inv = 1.0f / (float)(hi - lo), cs = rc[q];
                    u32x4 o;
                    o.x = cvt_pk_bf16((sum[0] * inv - bflo(c[q].x) * cs) * gnv[0], (sum[1] * inv - bfhi(c[q].x) * cs) * gnv[1]); o.y = cvt_pk_bf16((sum[2] * inv - bflo(c[q].y) * cs) * gnv[2], (sum[3] * inv - bfhi(c[q].y) * cs) * gnv[3]);
                    o.z = cvt_pk_bf16((sum[4] * inv - bflo(c[q].z) * cs) * gnv[4], (sum[5] * inv - bfhi(c[q].z) * cs) * gnv[5]); o.w = cvt_pk_bf16((sum[6] * inv - bflo(c[q].w) * cs) * gnv[6], (sum[7] * inv - bfhi(c[q].w) * cs) * gnv[7]);
                    *(u32x4*)(F.P + (size_t)row_of(b, t) * D + col) = o;
                    const float sa = (t + hw < T) ? rp[q] : 0.f, sm = (t - hw >= 0) ? -rm[q] : 0.f;
                    PW_FMA(wp[q], sa); PW_FMA(wm[q], sm);
                }
            }
        }
#undef PW_FMA
    }
}
__device__ __forceinline__ void phase_conv(const Frame& F, int j) {
    const int gw = F.vcu * 8 + F.wave, NGW = F.G * 8, lane = F.lane;
    constexpr int CHS = 33, NTC = (T + CHS - 1) / CHS;
    const float* cw = F.conv_w + (size_t)j * 4 * D; const float* cb = F.conv_b + (size_t)j * D;
    for (int it = gw; it < NB * NTC * 2; it += NGW) {
        const int half = it & 1, tc = (it >> 1) % NTC, b = (it >> 1) / NTC;
        const int col = half * 512 + lane * 8;
        const int t0 = tc * CHS, t1 = (t0 + CHS < T) ? t0 + CHS : T;
        float w[4][8], bias[8];
#pragma unroll
        for (int k = 0; k < 4; ++k) { const f32x4 a = *(const f32x4*)(cw + k * D + col), c = *(const f32x4*)(cw + k * D + col + 4);
            w[k][0] = a.x; w[k][1] = a.y; w[k][2] = a.z; w[k][3] = a.w; w[k][4] = c.x; w[k][5] = c.y; w[k][6] = c.z; w[k][7] = c.w; }
        { const f32x4 a = *(const f32x4*)(cb + col), c = *(const f32x4*)(cb + col + 4); bias[0] = a.x; bias[1] = a.y; bias[2] = a.z; bias[3] = a.w; bias[4] = c.x; bias[5] = c.y; bias[6] = c.z; bias[7] = c.w; }
        u32x4 xm1 = (u32x4){0u, 0u, 0u, 0u}, x0 = xm1, xp1 = xm1, xp2 = xm1;
        if (t0 - 1 >= 0) xm1 = *(const u32x4*)(F.XB + (size_t)row_of(b, t0 - 1) * D + col);
        x0 = *(const u32x4*)(F.XB + (size_t)row_of(b, t0) * D + col);
        if (t0 + 1 < T) xp1 = *(const u32x4*)(F.XB + (size_t)row_of(b, t0 + 1) * D + col);
        for (int tb = t0; tb < t1; tb += 11) {
            u32x4 xn[11];
#pragma unroll
            for (int q = 0; q < 11; ++q) { const int tt = tb + q + 2; xn[q] = *(const u32x4*)(F.XB + (size_t)row_of(b, tt < T ? tt : T - 1) * D + col); }
#pragma unroll
            for (int q = 0; q < 11; ++q) { const int t = tb + q;
                if (t < t1) {
                    xp2 = (t + 2 < T) ? xn[q] : (u32x4){0u, 0u, 0u, 0u};
                    float o[8];
#define CONV2(q_, m) o[2 * q_] = bias[2 * q_] + w[0][2 * q_] * bflo(xm1.m) + w[1][2 * q_] * bflo(x0.m) + w[2][2 * q_] * bflo(xp1.m) + w[3][2 * q_] * bflo(xp2.m); \
                     o[2 * q_ + 1] = bias[2 * q_ + 1] + w[0][2 * q_ + 1] * bfhi(xm1.m) + w[1][2 * q_ + 1] * bfhi(x0.m) + w[2][2 * q_ + 1] * bfhi(xp1.m) + w[3][2 * q_ + 1] * bfhi(xp2.m);
                    CONV2(0, x) CONV2(1, y) CONV2(2, z) CONV2(3, w)
#undef CONV2
                    u32x4 ov; ov.x = cvt_pk_bf16(o[0], o[1]); ov.y = cvt_pk_bf16(o[2], o[3]); ov.z = cvt_pk_bf16(o[4], o[5]); ov.w = cvt_pk_bf16(o[6], o[7]);
                    *(u32x4*)(F.P + (size_t)row_of(b, t) * D + col) = ov;
                    xm1 = x0; x0 = xp1; xp1 = xp2;
                }
            }
        }
    }
}
__device__ __forceinline__ void chunk_rows(int b, int k, int& r0, int& n) { if (k == 0) { r0 = MMAIN + b * NMETA; n = NMETA; } else { r0 = b * SEQ + (k - 1) * CHL; n = CHL; } }
__device__ __forceinline__ void phase_scan1(const Frame& F, int j) {
    const int lane = F.lane;
    for (int it = F.wave * F.G + F.vcu; it < 2 * NB * NCHUNK * 8; it += 8 * F.G) {
        int cq, k, b, d;
        if (it < 4096) { cq = it & 7; k = 1 + ((it >> 3) & 31); b = (it >> 8) & 7; d = it >> 11; } else { const int u = it - 4096; cq = u & 7; k = 0; b = (u >> 3) & 7; d = u >> 6; }
        const int c0 = cq * 128 + lane * 2;
        int r0, n; chunk_rows(b, k, r0, n);
        const unsigned char* la = (const unsigned char*)F.LA + (size_t)d * MPAD * D + c0; const bf16* bv = F.BV + (size_t)d * MPAD * D + c0;
        const f32x2 spq = *(const f32x2*)(F.SPT + (size_t)(j * 2 + d) * D + c0) * (1.0f / 255.0f);
        float h0 = 0.f, h1 = 0.f, s0 = 0.f, s1 = 0.f;
        for (int s = 0; s < n; s += 32) {
            unsigned lw[32], bw[32];
#pragma unroll
            for (int q = 0; q < 32; ++q) { const int sq = (s + q < n) ? s + q : n - 1; const int r = d ? (r0 + n - 1 - sq) : (r0 + sq); lw[q] = *(const unsigned short*)(la + (size_t)r * D); bw[q] = *(const unsigned*)(bv + (size_t)r * D); }
#pragma unroll
            for (int q = 0; q < 32; ++q) { const bool ok = s + q < n; const unsigned lq = ok ? lw[q] : 0u, bq = ok ? bw[q] : 0u;
                const float l0 = (float)(lq & 255u) * spq.x, l1 = (float)(lq >> 8) * spq.y; s0 += l0; s1 += l1; h0 = fast_exp(l0) * h0 + bflo(bq); h1 = fast_exp(l1) * h1 + bfhi(bq); }
        }
        float* agg = F.AGG + ((size_t)(d * NB + b) * NCHUNK + k) * D + c0;
        *(f32x2*)agg = (f32x2){s0, s1};
        *(f32x2*)(agg + (size_t)2 * NB * NCHUNK * D) = (f32x2){h0, h1};
    }
}
template <int N>
__device__ __forceinline__ void scan3_rows(const Frame& F, int j, int r0, int c0, float hf0, float hf1, float hb0, float hb1) {
    constexpr int HALF = N / 2;
    const unsigned char* laf = (const unsigned char*)F.LA + c0; const bf16* bvf = F.BV + c0; const unsigned char* lab = laf + (size_t)MPAD * D; const bf16* bvb = bvf + (size_t)MPAD * D;
    const f32x2 sqf = *(const f32x2*)(F.SPT + (size_t)(j * 2 + 0) * D + c0) * (1.0f / 255.0f), sqb = *(const f32x2*)(F.SPT + (size_t)(j * 2 + 1) * D + c0) * (1.0f / 255.0f);
#define L8LO(W_, S_) ((float)((W_) & 255u) * (S_).x)
#define L8HI(W_, S_) ((float)((W_) >> 8) * (S_).y)
    unsigned sf[HALF], sb[HALF];
#pragma unroll
    for (int s = 0; s < HALF; s += 8) {
        unsigned lf[8], bf_[8], lb[8], bb[8];
#pragma unroll
        for (int q = 0; q < 8; ++q) { const size_t rf = (size_t)(r0 + s + q) * D, rb = (size_t)(r0 + N - 1 - s - q) * D;
            lf[q] = *(const unsigned short*)(laf + rf); bf_[q] = *(const unsigned*)(bvf + rf); lb[q] = *(const unsigned short*)(lab + rb); bb[q] = *(const unsigned*)(bvb + rb); }
#pragma unroll
        for (int q = 0; q < 8; ++q) {
            hf0 = fast_exp(L8LO(lf[q], sqf)) * hf0 + bflo(bf_[q]); hf1 = fast_exp(L8HI(lf[q], sqf)) * hf1 + bfhi(bf_[q]); sf[s + q] = cvt_pk_bf16(hf0, hf1);
            hb0 = fast_exp(L8LO(lb[q], sqb)) * hb0 + bflo(bb[q]); hb1 = fast_exp(L8HI(lb[q], sqb)) * hb1 + bfhi(bb[q]); sb[s + q] = cvt_pk_bf16(hb0, hb1); }
    }
#pragma unroll
    for (int s = HALF; s < N; s += 8) {
        unsigned lf[8], bf_[8], lb[8], bb[8], gf[8], gb[8];
#pragma unroll
        for (int q = 0; q < 8; ++q) { const size_t rf = (size_t)(r0 + s + q) * D, rb = (size_t)(r0 + N - 1 - s - q) * D;
            lf[q] = *(const unsigned short*)(laf + rf); bf_[q] = *(const unsigned*)(bvf + rf); lb[q] = *(const unsigned short*)(lab + rb); bb[q] = *(const unsigned*)(bvb + rb);
            gf[q] = *(const unsigned*)(F.GY + rf + c0); gb[q] = *(const unsigned*)(F.GY + rb + c0); }
#pragma unroll
        for (int q = 0; q < 8; ++q) { const size_t rf = (size_t)(r0 + s + q) * D, rb = (size_t)(r0 + N - 1 - s - q) * D;
            const unsigned xf = sb[N - 1 - s - q], xb = sf[N - 1 - s - q];
            hf0 = fast_exp(L8LO(lf[q], sqf)) * hf0 + bflo(bf_[q]); hf1 = fast_exp(L8HI(lf[q], sqf)) * hf1 + bfhi(bf_[q]);
            *(unsigned*)(F.HG + rf + c0) = cvt_pk_bf16((hf0 + bflo(xf)) * bflo(gf[q]), (hf1 + bfhi(xf)) * bfhi(gf[q]));
            hb0 = fast_exp(L8LO(lb[q], sqb)) * hb0 + bflo(bb[q]); hb1 = fast_exp(L8HI(lb[q], sqb)) * hb1 + bfhi(bb[q]);
            *(unsigned*)(F.HG + rb + c0) = cvt_pk_bf16((bflo(xb) + hb0) * bflo(gb[q]), (bfhi(xb) + hb1) * bfhi(gb[q])); }
    }
#undef L8LO
#undef L8HI
}
__device__ __forceinline__ void phase_scan3(const Frame& F, int j) {
    const int lane = F.lane;
    constexpr size_t HOFF = (size_t)2 * NB * NCHUNK * D;
    for (int it = F.wave * F.G + F.vcu; it < NB * NCHUNK * 8; it += 8 * F.G) {
        int cq, k, b;
        if (it < 2048) { cq = it & 7; k = 1 + ((it >> 3) & 31); b = it >> 8; } else { const int u = it - 2048; cq = u & 7; k = 0; b = u >> 3; }
        const int c0 = cq * 128 + lane * 2;
        int r0, n; chunk_rows(b, k, r0, n);
        float hf0 = 0.f, hf1 = 0.f, hb0 = 0.f, hb1 = 0.f;
        for (int j0 = 0; j0 < k; j0 += 8) {
            f32x2 al[8], he[8];
#pragma unroll
            for (int q = 0; q < 8; ++q) { const int jx = (j0 + q < k) ? j0 + q : 0; const float* agg = F.AGG + ((size_t)(0 * NB + b) * NCHUNK + jx) * D + c0; al[q] = *(const f32x2*)agg; he[q] = *(const f32x2*)(agg + HOFF); }
#pragma unroll
            for (int q = 0; q < 8; ++q) if (j0 + q < k) { hf0 = fast_exp(al[q].x) * hf0 + he[q].x; hf1 = fast_exp(al[q].y) * hf1 + he[q].y; }
        }
        for (int j0 = NCHUNK - 1; j0 > k; j0 -= 8) {
            f32x2 al[8], he[8];
#pragma unroll
            for (int q = 0; q < 8; ++q) { const int jx = (j0 - q > k) ? j0 - q : NCHUNK - 1; const float* agg = F.AGG + ((size_t)(1 * NB + b) * NCHUNK + jx) * D + c0; al[q] = *(const f32x2*)agg; he[q] = *(const f32x2*)(agg + HOFF); }
#pragma unroll
            for (int q = 0; q < 8; ++q) if (j0 - q > k) { hb0 = fast_exp(al[q].x) * hb0 + he[q].x; hb1 = fast_exp(al[q].y) * hb1 + he[q].y; }
        }
        if (k == 0) scan3_rows<NMETA>(F, j, r0, c0, hf0, hf1, hb0, hb1); else scan3_rows<CHL>(F, j, r0, c0, hf0, hf1, hb0, hb1);
    }
}

struct TaskMap { int ntask, ncb, rb0, rbstride; };
template <class Fn>
__device__ __forceinline__ void wave_gemm(const Fn& fn, const TaskMap tm, int gw, int ngw, int lane_) {
    const int lane = opaque(lane_), fr = lane & 15, fq = lane >> 4;
    for (int task = gw; task < tm.ntask; task += ngw) {
        const int cb = task % tm.ncb, rb = tm.rb0 + (task / tm.ncb) * tm.rbstride;
        const bf16* ap[2]; const bf16* bp[4];
#pragma unroll
        for (int mi = 0; mi < 2; ++mi) ap[mi] = fn.arow(rb, cb, mi * 16 + fr) + 8 * fq;
#pragma unroll
        for (int nb = 0; nb < 4; ++nb) bp[nb] = fn.brow(rb, cb, nb * 16 + fr) + 8 * fq;
        f32x4 acc[2][4];
#pragma unroll
        for (int mi = 0; mi < 2; ++mi)
#pragma unroll
            for (int nb = 0; nb < 4; ++nb) acc[mi][nb] = (f32x4){0.f, 0.f, 0.f, 0.f};
#pragma unroll 2
        for (int k0 = 0; k0 < fn.K; k0 += 32) {
            bf16x8 a[2], bb[4];
#pragma unroll
            for (int mi = 0; mi < 2; ++mi) a[mi] = *(const bf16x8*)(ap[mi] + k0);
#pragma unroll
            for (int nb = 0; nb < 4; ++nb) bb[nb] = *(const bf16x8*)(bp[nb] + k0);
#pragma unroll
            for (int mi = 0; mi < 2; ++mi)
#pragma unroll
                for (int nb = 0; nb < 4; ++nb) acc[mi][nb] = __builtin_amdgcn_mfma_f32_16x16x32_bf16(bb[nb], a[mi], acc[mi][nb], 0, 0, 0);
        }
#pragma unroll
        for (int mi = 0; mi < 2; ++mi)
#pragma unroll
            for (int nb = 0; nb < (Fn::PAIRED ? 2 : 4); ++nb) fn.epi_blk(rb, cb, mi, nb, acc[mi][nb], acc[mi][Fn::PAIRED ? nb + 2 : nb], fr, fq);
    }
}
struct FnPool {
    static constexpr int nrb = MROWS / 32, ncb = 16, K = 256; static constexpr bool PAIRED = false;
    const bf16* P; const bf16* W; bf16* H; const float* scale;
    __device__ __forceinline__ const bf16* arow(int rb, int cb, int r) const { return P + (size_t)(rb * 32 + r) * D + (cb >> 2) * 256; }
    __device__ __forceinline__ const bf16* brow(int rb, int cb, int n) const { return W + (size_t)(cb * 64 + n) * 256; }
    __device__ __forceinline__ void epi_blk(int rb, int cb, int mi, int nb, const f32x4& v, const f32x4&, int fr, int fq) const {
        const int c = cb * 64 + nb * 16 + 4 * fq; bf16* p = H + (size_t)(rb * 32 + mi * 16 + fr) * D + c; const u32x2 w = *(const u32x2*)p; const f32x4 o = (f32x4){bflo(w.x), bfhi(w.x), bflo(w.y), bfhi(w.y)} + v * *(const f32x4*)(scale + c);
        u32x2 ow; ow.x = cvt_pk_bf16(o.x, o.y); ow.y = cvt_pk_bf16(o.z, o.w); *(u32x2*)p = ow; }
};
struct FnIn {
    static constexpr int nrb = MROWS / 32, ncb = 32, K = 1024; static constexpr bool PAIRED = false;
    const bf16* U; const bf16* W; bf16* XB; bf16* GY; const float* RS;
    __device__ __forceinline__ const bf16* arow(int rb, int cb, int r) const { return U + (size_t)(rb * 32 + r) * D; }
    __device__ __forceinline__ const bf16* brow(int rb, int cb, int n) const { return W + (size_t)(cb * 64 + n) * 1024; }
    __device__ __forceinline__ void epi_blk(int rb, int cb, int mi, int nb, const f32x4& v_, const f32x4&, int fr, int fq) const {
        const int c = cb * 64 + nb * 16 + 4 * fq; const size_t ro = (size_t)(rb * 32 + mi * 16 + fr) * D; u32x2 w; const f32x4 v = v_ * RS[rb * 32 + mi * 16 + fr];
        if (cb < 16) { w.x = cvt_pk_bf16(v.x, v.y); w.y = cvt_pk_bf16(v.z, v.w); *(u32x2*)(XB + ro + c) = w; }
        else { w.x = cvt_pk_bf16(gelu_tanh(v.x), gelu_tanh(v.y)); w.y = cvt_pk_bf16(gelu_tanh(v.z), gelu_tanh(v.w)); *(u32x2*)(GY + ro + c - 1024) = w; } }
};
__device__ __forceinline__ void lru_gate2(f32x2 zr, f32x2 zi, f32x2 sp, f32x2 x, bool slow, f32x2& rg, f32x2& bv) {
    const f32x2 tr = zr * (-1.44269504089f), ti = zi * (-1.44269504089f);
    f32x2 e1, e2; e1.x = __builtin_amdgcn_exp2f(tr.x); e1.y = __builtin_amdgcn_exp2f(tr.y); e2.x = __builtin_amdgcn_exp2f(ti.x); e2.y = __builtin_amdgcn_exp2f(ti.y);
    const f32x2 d1 = e1 + 1.0f, d2 = e2 + 1.0f, dd = d1 * d2;
    f32x2 inv; inv.x = fast_rcp(dd.x); inv.y = fast_rcp(dd.y);
    const f32x2 rgate = inv * d2, l = rgate * sp, x2 = l * 2.0f;
    f32x2 q = x2 * 0.0001984127f + 0.0013888889f; q = q * x2 + 0.0083333333f; q = q * x2 + 0.041666667f; q = q * x2 + 0.16666667f; q = q * x2 + 0.5f; q = q * x2 + 1.0f;
    f32x2 em = -x2 * q;
    if (__builtin_expect(slow, 0)) { asm volatile("" ::: "memory"); em.x = 1.0f - fast_exp(x2.x); em.y = 1.0f - fast_exp(x2.y); }
    f32x2 sq; sq.x = __builtin_amdgcn_sqrtf(em.x); sq.y = __builtin_amdgcn_sqrtf(em.y);
    rg = rgate; bv = sq * (inv * d1) * x;
}
struct FnGates {
    static constexpr int nrb = MROWS / 32, ncb = 64, K = 256; static constexpr bool PAIRED = true;
    const bf16* XC; const bf16* W; bf16* LA; bf16* BV; const float* bg; const float* lam;
    __device__ __forceinline__ const bf16* arow(int rb, int cb, int r) const { return XC + (size_t)(rb * 32 + r) * D + (((cb & 31) * 32) >> 8) * 256; }
    __device__ __forceinline__ const bf16* brow(int rb, int cb, int n) const {
        const int d = cb >> 5, nb = n >> 4, frn = n & 15, ch = (cb & 31) * 32 + (nb & 1) * 16 + frn, g = nb >> 1, h = ch >> 8, jl = ch & 255;
        return W + (((size_t)(d * 8 + h * 2 + (jl >> 7)) * 256) + g * 128 + (jl & 127)) * 256; }
    __device__ __forceinline__ void epi_blk(int rb, int cb, int mi, int nb, const f32x4& vr, const f32x4& vi, int fr, int fq) const {
        const int d = cb >> 5, ch = (cb & 31) * 32 + nb * 16 + 4 * fq;
        const f32x4 br = *(const f32x4*)(bg + (d * 2 + 0) * D + ch), bi = *(const f32x4*)(bg + (d * 2 + 1) * D + ch), lm = *(const f32x4*)(lam + d * D + ch);
        const size_t ro = (size_t)(rb * 32 + mi * 16 + fr) * D + ch;
        const u32x2 xw = *(const u32x2*)(XC + ro); const float xv[4] = {bflo(xw.x), bfhi(xw.x), bflo(xw.y), bfhi(xw.y)};
        float la[4], bvv[4];
        const bool slow = __any((lm.x < -0.25f) | (lm.y < -0.25f) | (lm.z < -0.25f) | (lm.w < -0.25f));
#pragma unroll
        for (int q = 0; q < 4; q += 2) { f32x2 l2, b2; lru_gate2((f32x2){vr[q] + br[q], vr[q + 1] + br[q + 1]}, (f32x2){vi[q] + bi[q], vi[q + 1] + bi[q + 1]}, (f32x2){lm[q], lm[q + 1]}, (f32x2){xv[q], xv[q + 1]}, slow, l2, b2);
            la[q] = l2.x; la[q + 1] = l2.y; bvv[q] = b2.x; bvv[q + 1] = b2.y; }
        *(unsigned*)((unsigned char*)LA + (size_t)d * MPAD * D + ro) = pk4_u8(la[0], la[1], la[2], la[3]);
        u32x2 w; w.x = cvt_pk_bf16(bvv[0], bvv[1]); w.y = cvt_pk_bf16(bvv[2], bvv[3]); *(u32x2*)(BV + (size_t)d * MPAD * D + ro) = w; }
};
struct FnOut {
    static constexpr int nrb = MROWS / 32, ncb = 16, K = 1024; static constexpr bool PAIRED = false;
    const bf16* A; const bf16* W; bf16* H;
    __device__ __forceinline__ const bf16* arow(int rb, int cb, int r) const { return A + (size_t)(rb * 32 + r) * D; }
    __device__ __forceinline__ const bf16* brow(int rb, int cb, int n) const { return W + (size_t)(cb * 64 + n) * 1024; }
    __device__ __forceinline__ void epi_blk(int rb, int cb, int mi, int nb, const f32x4& v, const f32x4&, int fr, int fq) const {
        bf16* p = H + (size_t)(rb * 32 + mi * 16 + fr) * D + cb * 64 + nb * 16 + 4 * fq; const u32x2 w = *(const u32x2*)p; const f32x4 o = (f32x4){bflo(w.x), bfhi(w.x), bflo(w.y), bfhi(w.y)} + v;
        u32x2 ow; ow.x = cvt_pk_bf16(o.x, o.y); ow.y = cvt_pk_bf16(o.z, o.w); *(u32x2*)p = ow; }
};
constexpr int ERB = (EROWS + 31) / 32;
constexpr int ERB16 = (EROWS + 15) / 16;
struct FnM1f8 {
    static constexpr int KB = 1024; static constexpr bool PAIRED = true;
    const unsigned char* U; const unsigned char* W; const int* ROWL; unsigned char* HID;
    __device__ __forceinline__ const unsigned char* arow(int rb, int cb, int r) const { const int e = rb / ERB16, pos = (rb % ERB16) * 16 + r; return U + (size_t)ROWL[e * EPAD + pos] * 1024; }
    __device__ __forceinline__ const unsigned char* brow(int rb, int cb, int n) const { const int e = rb / ERB16, nb = n >> 4, f = cb * 32 + (nb & 1) * 16 + (n & 15);
        return W + ((size_t)e * 4096 + (f >> 7) * 256 + (nb >> 1) * 128 + (f & 127)) * 1024; }
    __device__ __forceinline__ void epi_blk(int rb, int cb, int nb, const f32x4& gs, const f32x4& us, int fr, int fq) const {
        const int e = rb / ERB16, pos = (rb % ERB16) * 16 + fr, f = cb * 32 + nb * 16 + 4 * fq; const f32x4 g = gs * WINV, u = us * WINV;
        *(unsigned*)(HID + ((size_t)e * EPAD + pos) * HIDP8 + f) = pk4_fp8(siluf_(g.x) * u.x, siluf_(g.y) * u.y, siluf_(g.z) * u.z, siluf_(g.w) * u.w); }
};
struct FnM2f8 {
    static constexpr int KB = 2048; static constexpr bool PAIRED = false;
    const unsigned char* HID; const unsigned char* W; bf16* Y;
    __device__ __forceinline__ const unsigned char* arow(int rb, int cb, int r) const { const int e = rb / ERB16, pos = (rb % ERB16) * 16 + r; return HID + ((size_t)e * EPAD + pos) * HIDP8; }
    __device__ __forceinline__ const unsigned char* brow(int rb, int cb, int n) const { const int e = rb / ERB16; return W + ((size_t)e * 1024 + cb * 64 + n) * WDP8; }
    __device__ __forceinline__ void epi_blk(int rb, int cb, int nb, const f32x4& vs, const f32x4&, int fr, int fq) const {
        const int e = rb / ERB16, pos = (rb % ERB16) * 16 + fr; const f32x4 v = vs * WINV;
        *(unsigned*)((unsigned char*)Y + ((size_t)e * EPAD + pos) * D + cb * 64 + nb * 16 + 4 * fq) = pk4_fp8(v.x, v.y, v.z, v.w); }
};
template <class Fn>
__device__ __forceinline__ void wg_gemm_ksplit8(const Fn& fn, const TaskMap tm, LAS unsigned char* lds, int vcu, int G, int tid_) {
    const int tid = opaque(tid_), lane = tid & 63, wave = __builtin_amdgcn_readfirstlane(tid >> 6), fr = lane & 15, fq = lane >> 4;
    constexpr int KW = Fn::KB / 8, NS = KW / 128;
    LAS f32x4* part = (LAS f32x4*)lds;
    for (int task = vcu; task < tm.ntask; task += G) {
        const int cb = task % tm.ncb, rb = tm.rb0 + (task / tm.ncb) * tm.rbstride;
        const unsigned char* ap = fn.arow(rb, cb, fr) + wave * KW + 32 * fq; const unsigned char* bp[4];
#pragma unroll
        for (int nb = 0; nb < 4; ++nb) bp[nb] = fn.brow(rb, cb, nb * 16 + fr) + wave * KW + 32 * fq;
        v4i a[NS][2], bb[NS][4][2];
#pragma unroll
        for (int s = 0; s < NS; ++s) { a[s][0] = *(const v4i*)(ap + s * 128); a[s][1] = *(const v4i*)(ap + s * 128 + 16);
#pragma unroll
            for (int nb = 0; nb < 4; ++nb) { bb[s][nb][0] = *(const v4i*)(bp[nb] + s * 128); bb[s][nb][1] = *(const v4i*)(bp[nb] + s * 128 + 16); } }
        f32x4 acc[4];
#pragma unroll
        for (int nb = 0; nb < 4; ++nb) acc[nb] = (f32x4){0.f, 0.f, 0.f, 0.f};
#pragma unroll
        for (int s = 0; s < NS; ++s)
#pragma unroll
            for (int nb = 0; nb < 4; ++nb) acc[nb] = __builtin_amdgcn_mfma_scale_f32_16x16x128_f8f6f4(__builtin_shufflevector(bb[s][nb][0], bb[s][nb][1], 0, 1, 2, 3, 4, 5, 6, 7),
                                                                                                     __builtin_shufflevector(a[s][0], a[s][1], 0, 1, 2, 3, 4, 5, 6, 7), acc[nb], 0, 0, 0, 0, 0, 0);
#pragma unroll
        for (int nb = 0; nb < 4; ++nb) part[(wave * 4 + nb) * 64 + lane] = acc[nb];
        __syncthreads();
        if (wave < 4 && (!Fn::PAIRED || wave < 2)) {
            const int nb = wave;
            f32x4 v = (f32x4){0.f, 0.f, 0.f, 0.f}, v2 = v;
#pragma unroll
            for (int w = 0; w < 8; ++w) { v += part[(w * 4 + nb) * 64 + lane]; if (Fn::PAIRED) v2 += part[(w * 4 + nb + 2) * 64 + lane]; }
            fn.epi_blk(rb, cb, nb, v, v2, fr, fq);
        }
        __syncthreads();
    }
}

template <int MI, class Fn>
__device__ __forceinline__ void wg_gemm_ksplit(const Fn& fn, const TaskMap tm, LAS unsigned char* lds, int vcu, int G, int tid_) {
    const int tid = opaque(tid_), lane = tid & 63, wave = __builtin_amdgcn_readfirstlane(tid >> 6), fr = lane & 15, fq = lane >> 4;
    constexpr int KW = Fn::K / 8, NS = KW / 32;
    LAS f32x4* part = (LAS f32x4*)lds;
    for (int task = vcu; task < tm.ntask; task += G) {
        const int cb = task % tm.ncb, rb = tm.rb0 + (task / tm.ncb) * tm.rbstride;
        const bf16* ap[MI]; const bf16* bp[4];
#pragma unroll
        for (int mi = 0; mi < MI; ++mi) ap[mi] = fn.arow(rb, cb, mi * 16 + fr) + wave * KW + 8 * fq;
#pragma unroll
        for (int nb = 0; nb < 4; ++nb) bp[nb] = fn.brow(rb, cb, nb * 16 + fr) + wave * KW + 8 * fq;
        f32x4 acc[MI][4];
#pragma unroll
        for (int mi = 0; mi < MI; ++mi)
#pragma unroll
            for (int nb = 0; nb < 4; ++nb) acc[mi][nb] = (f32x4){0.f, 0.f, 0.f, 0.f};
#pragma unroll
        for (int s0 = 0; s0 < NS; s0 += 4) {
            bf16x8 a[4][MI], bb[4][4];
#pragma unroll
            for (int s = 0; s < 4; ++s) if (s0 + s < NS) {
#pragma unroll
                for (int mi = 0; mi < MI; ++mi) a[s][mi] = *(const bf16x8*)(ap[mi] + (s0 + s) * 32);
#pragma unroll
                for (int nb = 0; nb < 4; ++nb) bb[s][nb] = *(const bf16x8*)(bp[nb] + (s0 + s) * 32); }
#pragma unroll
            for (int s = 0; s < 4; ++s) if (s0 + s < NS) {
#pragma unroll
                for (int mi = 0; mi < MI; ++mi)
#pragma unroll
                    for (int nb = 0; nb < 4; ++nb) acc[mi][nb] = __builtin_amdgcn_mfma_f32_16x16x32_bf16(bb[s][nb], a[s][mi], acc[mi][nb], 0, 0, 0); }
        }
#pragma unroll
        for (int mi = 0; mi < MI; ++mi)
#pragma unroll
            for (int nb = 0; nb < 4; ++nb) part[((wave * MI + mi) * 4 + nb) * 64 + lane] = acc[mi][nb];
        __syncthreads();
        if (wave < MI * 4) {
            const int mi = wave >> 2, nb = wave & 3;
            if (!Fn::PAIRED || nb < 2) {
                f32x4 v = (f32x4){0.f, 0.f, 0.f, 0.f}, v2 = v;
#pragma unroll
                for (int w = 0; w < 8; ++w) { v += part[((w * MI + mi) * 4 + nb) * 64 + lane]; if (Fn::PAIRED) v2 += part[((w * MI + mi) * 4 + nb + 2) * 64 + lane]; }
                fn.epi_blk(rb, cb, mi, nb, v, v2, fr, fq);
            }
        }
        __syncthreads();
    }
}

namespace pg8 {
constexpr int BM = 256, BK = 64, HALF = 128, HTB = HALF * BK * 2, STAGE_BYTES = 8 * HTB;
__device__ __forceinline__ int lds_byte(int r, int c) { const int st = (r >> 4) * 2 + (c >> 5), rr = r & 15, cc = c & 31, ob = rr * 64 + cc * 2; return st * 1024 + (ob ^ (((ob >> 9) & 1) << 5)); }
__device__ __forceinline__ void stage_rc(int b, int& R, int& C) { const int st = b / 1024, sb = b % 1024, swz = sb ^ (((sb >> 9) & 1) << 5); R = (st >> 1) * 16 + swz / 64; C = (st & 1) * 32 + (swz % 64) / 2; }
__device__ __forceinline__ int perm32(int rho) { const int n = rho >> 4, i = rho & 15; return 8 * (i >> 2) + 4 * n + (i & 3); }
struct Unit { int pm, pn, e; };
struct SchedStd {
    int nM, nN, nwg, G, c;
    __device__ __forceinline__ void init(int nM_, int nN_, int G_, int c_) { nM = nM_; nN = nN_; nwg = nM * nN; G = G_; c = c_; }
    __device__ __forceinline__ bool next(int i, Unit& u) const {
        const int L = i * G + c; if (L >= nwg) return false;
        int wgid = L; { const int q = nwg / 8, r = nwg % 8, xcd = wgid % 8, off = wgid / 8; wgid = (xcd < r ? xcd * (q + 1) : r * (q + 1) + (xcd - r) * q) + off; }
        const int nig = 8 * nN, gid = wgid / nig, fm = gid * 8, gsz = (nM - fm) < 8 ? (nM - fm) : 8;
        u.pm = fm + ((wgid % nig) % gsz); u.pn = (wgid % nig) / gsz; u.e = 0; return true;
    }
};
struct SchedMoe {
    int nN, total, G, c, rev, gm;
    __device__ __forceinline__ void init(int nN_, int G_, int c_, int rev_ = 0, int gm_ = 8) { nN = nN_; total = 16 * 16 * nN_; G = G_; c = c_; rev = rev_; gm = gm_; }
    __device__ __forceinline__ bool next(int i, Unit& u) const {
        const int L = i * G + c; if (L >= total) return false;
        const int off = rev ? (total / 8 - 1 - L / 8) : L / 8;
        const int wgid = (L % 8) * (total / 8) + off, per = 16 * nN, w = wgid % per, nig = gm * nN;
        u.e = wgid / per; u.pm = (w / nig) * gm + (w % nig) % gm; u.pn = (w % nig) / gm; return true;
    }
};
template <class Cfg>
__device__ __forceinline__ void gemm_phase(LAS unsigned char* lds, const Cfg& cfg) {
    const int tid = opaque((int)threadIdx.x), wid = __builtin_amdgcn_readfirstlane(tid >> 6), lane = tid & 63, wr = wid >> 2, wc = wid & 3, fr = lane & 15, fq = lane >> 4;
    constexpr bool F8 = Cfg::FP8;
    constexpr int nt = Cfg::KB / 128;
    int Rr[2], Cc[2]; unsigned voffB[2];
#pragma unroll
    for (int i = 0; i < 2; ++i) { stage_rc(tid * 16 + i * 8192, Rr[i], Cc[i]); const int R = Rr[i];
        const int Rb = Cfg::PERMX ? (((R >> 5) & 3) * 64 + 16 * ((R & 15) >> 2) + 4 * ((R >> 4) & 1) + (R & 3)) : (Cfg::PERM ? ((R & ~31) + perm32(R & 31)) : R);
        voffB[i] = (unsigned)Rb * (unsigned)Cfg::ldb + (unsigned)Cc[i] * 2u; }
    const size_t kstep = (size_t)(BK * 2);
    const size_t hstepB = (size_t)(Cfg::PERMX ? 8 : HALF) * Cfg::ldb;
    const unsigned ldsw = (unsigned)wid * 1024u;
    const int aoff = lds_byte(wr * 64 + fr, F8 ? fq * 16 : fq * 8), boff = lds_byte(wc * 32 + fr, F8 ? fq * 16 : fq * 8);

#define PG8_SA(b, h) (((b) * 2 + (h)) * HTB)
#define PG8_SB(b, h) ((4 + (b) * 2 + (h)) * HTB)
#define PG8_STAGE(bufoff, gbase, voff) do { _Pragma("unroll") for (int _i = 0; _i < 2; ++_i) \
        __builtin_amdgcn_global_load_lds((const unsigned*)((const char*)(gbase) + (voff)[_i]), (LAS unsigned*)(lds + (bufoff) + ldsw + _i * 8192), 16, 0, 0); } while (0)
typedef v8i v8i_a16 __attribute__((aligned(16)));
#define PG8_LD32(p) (*(const LAS v8i_a16*)(p))
#define PG8_LDA(dst, b, h) do { if constexpr (F8) { _Pragma("unroll") for (int m = 0; m < 4; ++m) dst##8[m] = PG8_LD32(lds + PG8_SA(b, h) + aoff + m * 2048); } \
        else { _Pragma("unroll") for (int m = 0; m < 4; ++m) _Pragma("unroll") for (int k = 0; k < 2; ++k) dst[m][k] = *(const LAS bf16x8*)(lds + PG8_SA(b, h) + aoff + m * 2048 + k * 1024); } } while (0)
#define PG8_LDB(dst, b, h) do { if constexpr (F8) { _Pragma("unroll") for (int n = 0; n < 2; ++n) dst##8[n] = PG8_LD32(lds + PG8_SB(b, h) + boff + n * 2048); } \
        else { _Pragma("unroll") for (int n = 0; n < 2; ++n) _Pragma("unroll") for (int k = 0; k < 2; ++k) dst[n][k] = *(const LAS bf16x8*)(lds + PG8_SB(b, h) + boff + n * 2048 + k * 1024); } } while (0)
#define PG8_MMA(ai, bj, At, Bt) do { __builtin_amdgcn_s_setprio(1); _Pragma("unroll") for (int m = 0; m < 4; ++m) _Pragma("unroll") for (int n = 0; n < 2; ++n) { \
        if constexpr (F8) asm volatile("v_mfma_f32_16x16x128_f8f6f4 %0, %1, %2, %0" : "+v"(acc[ai][bj][m][n]) : "v"(Bt##8[n]), "v"(At##8[m]));   \
        else { _Pragma("unroll") for (int k = 0; k < 2; ++k) acc[ai][bj][m][n] = __builtin_amdgcn_mfma_f32_16x16x32_bf16(Bt[n][k], At[m][k], acc[ai][bj][m][n], 0, 0, 0); } } __builtin_amdgcn_s_setprio(0); } while (0)
#define PG8_WAIT_V(n) asm volatile("s_waitcnt vmcnt(" #n ")" ::: "memory")
#define PG8_WAIT_L(n) asm volatile("s_waitcnt lgkmcnt(" #n ")" ::: "memory")
#define PG8_BAR __builtin_amdgcn_s_barrier()
#define PG8_SCHED __builtin_amdgcn_sched_barrier(0)
    Unit cur, nxt; int ui = 0;
    if (!cfg.next(0, cur)) return;
    f32x4 acc[2][2][4][2];
#pragma unroll
    for (int a = 0; a < 2; ++a)
#pragma unroll
        for (int b = 0; b < 2; ++b)
#pragma unroll
            for (int m = 0; m < 4; ++m)
#pragma unroll
                for (int n = 0; n < 2; ++n) acc[a][b][m][n] = (f32x4){0.f, 0.f, 0.f, 0.f};
    bf16x8 At[4][2], B0[2][2], B1[2][2]; v8i At8[4], B08[2], B18[2];
    unsigned voffA[2][2], voffAn[2][2];
    cfg.a_offs(cur, 0, Rr, Cc, voffA);
    const char* cA = cfg.a_base(cur); const char* cB = cfg.b_base(cur);
    PG8_STAGE(PG8_SB(0, 0), cB, voffB); PG8_STAGE(PG8_SB(0, 1), cB + hstepB, voffB); PG8_STAGE(PG8_SA(0, 0), cA, voffA[0]); PG8_STAGE(PG8_SA(0, 1), cA, voffA[1]);
    if (wr == 1) PG8_BAR;
    PG8_WAIT_V(2); PG8_BAR;
    PG8_STAGE(PG8_SB(1, 0), cB + kstep, voffB); PG8_STAGE(PG8_SA(1, 0), cA + kstep, voffA[0]); PG8_STAGE(PG8_SB(1, 1), cB + hstepB + kstep, voffB);
    PG8_WAIT_V(6); PG8_BAR;
    for (;;) {
        const bool has_next = cfg.next(ui + 1, nxt);
        const char* nA = has_next ? cfg.a_base(nxt) : cA; const char* nB = has_next ? cfg.b_base(nxt) : cB;
#pragma unroll 1
        for (int t = 0; t < nt; t += 2) {
            const bool last = (t == nt - 2);
            const char* a1 = cA + (size_t)(t + 1) * kstep;
            const char* a2 = last ? nA : cA + (size_t)(t + 2) * kstep; const char* b2 = last ? nB : cB + (size_t)(t + 2) * kstep;
            const char* a3 = a2 + kstep; const char* b3 = b2 + kstep;
            unsigned o2[2][2];
            if constexpr (Cfg::GATHER) {
                if (last) { if (has_next) { int R2[2], C2[2]; stage_rc(tid * 16, R2[0], C2[0]); stage_rc(tid * 16 + 8192, R2[1], C2[1]); cfg.a_offs(nxt, ui + 1, R2, C2, voffAn); } else {
#pragma unroll
                    for (int h = 0; h < 2; ++h) { voffAn[h][0] = voffA[h][0]; voffAn[h][1] = voffA[h][1]; } } }
#pragma unroll
                for (int h = 0; h < 2; ++h) { o2[h][0] = last ? voffAn[h][0] : voffA[h][0]; o2[h][1] = last ? voffAn[h][1] : voffA[h][1]; }
            } else {
#pragma unroll
                for (int h = 0; h < 2; ++h) { o2[h][0] = voffA[h][0]; o2[h][1] = voffA[h][1]; }
            }
            PG8_LDB(B0, 0, 0); PG8_LDB(B1, 0, 1); PG8_SCHED; PG8_LDA(At, 0, 0); PG8_STAGE(PG8_SA(1, 1), a1, voffA[1]);
            PG8_WAIT_V(8); PG8_WAIT_L(0); PG8_BAR; PG8_MMA(0, 0, At, B0); PG8_MMA(0, 1, At, B1); PG8_BAR; PG8_SCHED;
            PG8_LDA(At, 0, 1); PG8_STAGE(PG8_SB(0, 0), b2, voffB); PG8_STAGE(PG8_SB(0, 1), b2 + hstepB, voffB); PG8_STAGE(PG8_SA(0, 0), a2, o2[0]);
            PG8_WAIT_V(8); PG8_WAIT_L(0); PG8_BAR; PG8_MMA(1, 0, At, B0); PG8_MMA(1, 1, At, B1); PG8_BAR; PG8_SCHED;
            PG8_LDB(B0, 1, 0); PG8_LDB(B1, 1, 1); PG8_SCHED; PG8_LDA(At, 1, 0); PG8_STAGE(PG8_SA(0, 1), a2, o2[1]);
            PG8_WAIT_V(8); PG8_WAIT_L(0); PG8_BAR; PG8_MMA(0, 0, At, B0); PG8_MMA(0, 1, At, B1); PG8_BAR; PG8_SCHED;
            PG8_LDA(At, 1, 1); PG8_STAGE(PG8_SB(1, 0), b3, voffB); PG8_STAGE(PG8_SB(1, 1), b3 + hstepB, voffB); PG8_STAGE(PG8_SA(1, 0), a3, o2[0]);
            PG8_WAIT_V(8); PG8_WAIT_L(0); PG8_BAR; PG8_MMA(1, 0, At, B0); PG8_MMA(1, 1, At, B1); PG8_BAR; PG8_SCHED;
        }
        if (wr == 0) PG8_BAR;
        if constexpr (F8) asm volatile("s_nop 15\n\ts_nop 15" ::: "memory");
        cfg.epi(acc, cur, wr, wc, fr, fq);
        if (!has_next) break;
#pragma unroll
        for (int a = 0; a < 2; ++a)
#pragma unroll
            for (int b = 0; b < 2; ++b)
#pragma unroll
                for (int m = 0; m < 4; ++m)
#pragma unroll
                    for (int n = 0; n < 2; ++n) acc[a][b][m][n] = (f32x4){0.f, 0.f, 0.f, 0.f};
        cur = nxt; cA = nA; cB = nB; ++ui;
        if constexpr (Cfg::GATHER) {
#pragma unroll
            for (int h = 0; h < 2; ++h) { voffA[h][0] = voffAn[h][0]; voffA[h][1] = voffAn[h][1]; } }
        if (wr == 1) PG8_BAR;
    }
    PG8_WAIT_V(0);
    PG8_BAR;
#undef PG8_SA
#undef PG8_SB
#undef PG8_STAGE
#undef PG8_LDA
#undef PG8_LDB
#undef PG8_MMA
#undef PG8_LD32
#undef PG8_WAIT_V
#undef PG8_WAIT_L
#undef PG8_BAR
#undef PG8_SCHED
}
template <int LDA> __device__ __forceinline__ void lin_offs(const int (&R)[2], const int (&C)[2], unsigned (&off)[2][2]) {
#pragma unroll
    for (int h = 0; h < 2; ++h)
#pragma unroll
        for (int i = 0; i < 2; ++i) off[h][i] = (unsigned)(h * HALF + R[i]) * (unsigned)LDA + (unsigned)C[i] * 2u;
}
struct CfgPool {
    static constexpr bool PERMX = false; static constexpr bool GATHER = false; static constexpr bool FP8 = false; static constexpr int KB = 256 * 2; static constexpr bool PERM = true; static constexpr int K = 256, ldb = 512;
    SchedStd S; const bf16* P; const bf16* W; bf16* H; const float* scale;
    __device__ __forceinline__ bool next(int i, Unit& u) const { return S.next(i, u); }
    __device__ __forceinline__ const char* a_base(const Unit& u) const { return (const char*)(P + (size_t)u.pm * 256 * D + u.pn * 256); }
    __device__ __forceinline__ void a_offs(const Unit&, int, const int (&R)[2], const int (&C)[2], unsigned (&off)[2][2]) const { lin_offs<2048>(R, C, off); }
    __device__ __forceinline__ const char* b_base(const Unit& u) const { return (const char*)(W + (size_t)u.pn * 65536); }
    __device__ __forceinline__ void epi(const f32x4 (&acc)[2][2][4][2], const Unit& u, int wr, int wc, int fr, int fq) const {
        const int row0 = u.pm * 256 + wr * 64 + fr, col0 = u.pn * 256 + wc * 32 + 8 * fq;
        f32x4 sc[2][2];
#pragma unroll
        for (int bj = 0; bj < 2; ++bj)
#pragma unroll
            for (int n = 0; n < 2; ++n) sc[bj][n] = *(const f32x4*)(scale + col0 + bj * 128 + n * 4);
#pragma unroll
        for (int ai = 0; ai < 2; ++ai) {
            u32x4 hw[4][2];
#pragma unroll
            for (int m = 0; m < 4; ++m)
#pragma unroll
                for (int bj = 0; bj < 2; ++bj) hw[m][bj] = *(const u32x4*)(H + (size_t)(row0 + ai * 128 + m * 16) * D + col0 + bj * 128);
            asm volatile("" ::: "memory");
#pragma unroll
            for (int m = 0; m < 4; ++m) { bf16* rowp = H + (size_t)(row0 + ai * 128 + m * 16) * D + col0;
#pragma unroll
                for (int bj = 0; bj < 2; ++bj) { const u32x4 w = hw[m][bj];
                    const f32x4 o0 = (f32x4){bflo(w.x), bfhi(w.x), bflo(w.y), bfhi(w.y)} + acc[ai][bj][m][0] * sc[bj][0], o1 = (f32x4){bflo(w.z), bfhi(w.z), bflo(w.w), bfhi(w.w)} + acc[ai][bj][m][1] * sc[bj][1];
                    u32x4 ow; ow.x = cvt_pk_bf16(o0.x, o0.y); ow.y = cvt_pk_bf16(o0.z, o0.w); ow.z = cvt_pk_bf16(o1.x, o1.y); ow.w = cvt_pk_bf16(o1.z, o1.w);
                    *(u32x4*)(rowp + bj * 128) = ow; } }
            asm volatile("" ::: "memory");
        }
    }
};
struct CfgOut {
    static constexpr bool PERMX = false; static constexpr bool GATHER = false; static constexpr bool FP8 = false; static constexpr int KB = 1024 * 2; static constexpr bool PERM = true; static constexpr int K = 1024, ldb = 2048;
    SchedStd S; const bf16* A; const bf16* W; bf16* H;
    __device__ __forceinline__ bool next(int i, Unit& u) const { return S.next(i, u); }
    __device__ __forceinline__ const char* a_base(const Unit& u) const { return (const char*)(A + (size_t)u.pm * 256 * D); }
    __device__ __forceinline__ void a_offs(const Unit&, int, const int (&R)[2], const int (&C)[2], unsigned (&off)[2][2]) const { lin_offs<2048>(R, C, off); }
    __device__ __forceinline__ const char* b_base(const Unit& u) const { return (const char*)(W + (size_t)u.pn * 256 * 1024); }
    __device__ __forceinline__ void epi(const f32x4 (&acc)[2][2][4][2], const Unit& u, int wr, int wc, int fr, int fq) const {
        const int row0 = u.pm * 256 + wr * 64 + fr, col0 = u.pn * 256 + wc * 32 + 8 * fq;
#pragma unroll
        for (int ai = 0; ai < 2; ++ai) {
            u32x4 hw[4][2];
#pragma unroll
            for (int m = 0; m < 4; ++m)
#pragma unroll
                for (int bj = 0; bj < 2; ++bj) hw[m][bj] = *(const u32x4*)(H + (size_t)(row0 + ai * 128 + m * 16) * D + col0 + bj * 128);
            asm volatile("" ::: "memory");
#pragma unroll
            for (int m = 0; m < 4; ++m) { bf16* rowp = H + (size_t)(row0 + ai * 128 + m * 16) * D + col0;
#pragma unroll
                for (int bj = 0; bj < 2; ++bj) { const u32x4 w = hw[m][bj];
                    const f32x4 o0 = (f32x4){bflo(w.x), bfhi(w.x), bflo(w.y), bfhi(w.y)} + acc[ai][bj][m][0], o1 = (f32x4){bflo(w.z), bfhi(w.z), bflo(w.w), bfhi(w.w)} + acc[ai][bj][m][1];
                    u32x4 ow; ow.x = cvt_pk_bf16(o0.x, o0.y); ow.y = cvt_pk_bf16(o0.z, o0.w); ow.z = cvt_pk_bf16(o1.x, o1.y); ow.w = cvt_pk_bf16(o1.z, o1.w);
                    *(u32x4*)(rowp + bj * 128) = ow; } }
            asm volatile("" ::: "memory");
        }
    }
};
struct CfgIn {
    static constexpr bool PERMX = false; static constexpr bool GATHER = false; static constexpr bool FP8 = false; static constexpr int KB = 1024 * 2; static constexpr bool PERM = true; static constexpr int K = 1024, ldb = 2048;
    SchedStd S; const bf16* U; const bf16* W; bf16* XB; bf16* GY; const float* RS;
    __device__ __forceinline__ bool next(int i, Unit& u) const { return S.next(i, u); }
    __device__ __forceinline__ const char* a_base(const Unit& u) const { return (const char*)(U + (size_t)u.pm * 256 * D); }
    __device__ __forceinline__ void a_offs(const Unit&, int, const int (&R)[2], const int (&C)[2], unsigned (&off)[2][2]) const { lin_offs<2048>(R, C, off); }
    __device__ __forceinline__ const char* b_base(const Unit& u) const { return (const char*)(W + (size_t)u.pn * 256 * 1024); }
    __device__ __forceinline__ void epi(const f32x4 (&acc)[2][2][4][2], const Unit& u, int wr, int wc, int fr, int fq) const {
        const int row0 = u.pm * 256 + wr * 64 + fr, col0 = (u.pn & 3) * 256 + wc * 32 + 8 * fq; const bool act = u.pn >= 4; bf16* base = act ? GY : XB;
        float rs[2][4];
#pragma unroll
        for (int ai = 0; ai < 2; ++ai)
#pragma unroll
            for (int m = 0; m < 4; ++m) rs[ai][m] = RS[row0 + ai * 128 + m * 16];
#pragma unroll
        for (int ai = 0; ai < 2; ++ai)
#pragma unroll
            for (int m = 0; m < 4; ++m) { bf16* rowp = base + (size_t)(row0 + ai * 128 + m * 16) * D + col0;
#pragma unroll
                for (int bj = 0; bj < 2; ++bj) { f32x4 v0 = acc[ai][bj][m][0] * rs[ai][m], v1 = acc[ai][bj][m][1] * rs[ai][m];
                    if (act) { v0.x = gelu_tanh(v0.x); v0.y = gelu_tanh(v0.y); v0.z = gelu_tanh(v0.z); v0.w = gelu_tanh(v0.w); v1.x = gelu_tanh(v1.x); v1.y = gelu_tanh(v1.y); v1.z = gelu_tanh(v1.z); v1.w = gelu_tanh(v1.w); }
                    u32x4 w; w.x = cvt_pk_bf16(v0.x, v0.y); w.y = cvt_pk_bf16(v0.z, v0.w); w.z = cvt_pk_bf16(v1.x, v1.y); w.w = cvt_pk_bf16(v1.z, v1.w);
                    *(u32x4*)(rowp + bj * 128) = w; } }
    }
};
struct CfgGates {
    static constexpr bool PERMX = false; static constexpr bool GATHER = false; static constexpr bool FP8 = false; static constexpr int KB = 256 * 2; static constexpr bool PERM = true; static constexpr int K = 256, ldb = 512;
    SchedStd S; const bf16* XC; const bf16* W; bf16* LA; bf16* BV; const float* bg; const float* lam;
    __device__ __forceinline__ bool next(int i, Unit& u) const { return S.next(i, u); }
    __device__ __forceinline__ const char* a_base(const Unit& u) const { return (const char*)(XC + (size_t)u.pm * 256 * D + ((u.pn & 7) >> 1) * 256); }
    __device__ __forceinline__ void a_offs(const Unit&, int, const int (&R)[2], const int (&C)[2], unsigned (&off)[2][2]) const { lin_offs<2048>(R, C, off); }
    __device__ __forceinline__ const char* b_base(const Unit& u) const { return (const char*)(W + (size_t)u.pn * 65536); }
    __device__ __forceinline__ void epi(const f32x4 (&acc)[2][2][4][2], const Unit& u, int wr, int wc, int fr, int fq) const {
        const int d = u.pn >> 3, ch0 = (u.pn & 7) * 128 + wc * 32 + 8 * fq, row0 = u.pm * 256 + wr * 64 + fr;
        float br[8], bi[8], sp[8];
#pragma unroll
        for (int q = 0; q < 2; ++q) { const f32x4 a = *(const f32x4*)(bg + (d * 2 + 0) * D + ch0 + 4 * q), b = *(const f32x4*)(bg + (d * 2 + 1) * D + ch0 + 4 * q), l = *(const f32x4*)(lam + d * D + ch0 + 4 * q);
#pragma unroll
            for (int x = 0; x < 4; ++x) { br[4 * q + x] = a[x]; bi[4 * q + x] = b[x]; sp[4 * q + x] = l[x]; } }
        bool sl = false;
#pragma unroll
        for (int q = 0; q < 8; ++q) sl |= sp[q] < -0.25f;
        const bool slow = __any(sl);
        u32x4 xin[2][4];
#pragma unroll
        for (int ai = 0; ai < 2; ++ai)
#pragma unroll
            for (int m = 0; m < 4; ++m) xin[ai][m] = *(const u32x4*)(XC + (size_t)(row0 + ai * 128 + m * 16) * D + ch0);
        asm volatile("" ::: "memory");
#pragma unroll
        for (int ai = 0; ai < 2; ++ai)
#pragma unroll
            for (int m = 0; m < 4; ++m) { const size_t ro = (size_t)(row0 + ai * 128 + m * 16) * D + ch0;
                const u32x4 xw = xin[ai][m];
                const float xv[8] = {bflo(xw.x), bfhi(xw.x), bflo(xw.y), bfhi(xw.y), bflo(xw.z), bfhi(xw.z), bflo(xw.w), bfhi(xw.w)};
                float la[8], bv[8];
#pragma unroll
                for (int q = 0; q < 8; q += 2) { f32x2 l2, b2;
                    lru_gate2((f32x2){acc[ai][0][m][q >> 2][q & 3] + br[q], acc[ai][0][m][q >> 2][(q & 3) + 1] + br[q + 1]}, (f32x2){acc[ai][1][m][q >> 2][q & 3] + bi[q], acc[ai][1][m][q >> 2][(q & 3) + 1] + bi[q + 1]},
                              (f32x2){sp[q], sp[q + 1]}, (f32x2){xv[q], xv[q + 1]}, slow, l2, b2);
                    la[q] = l2.x; la[q + 1] = l2.y; bv[q] = b2.x; bv[q + 1] = b2.y; }
                { u32x2 w8; w8.x = pk4_u8(la[0], la[1], la[2], la[3]); w8.y = pk4_u8(la[4], la[5], la[6], la[7]); *(u32x2*)((unsigned char*)LA + (size_t)d * MPAD * D + ro) = w8; }
                u32x4 w; w.x = cvt_pk_bf16(bv[0], bv[1]); w.y = cvt_pk_bf16(bv[2], bv[3]); w.z = cvt_pk_bf16(bv[4], bv[5]); w.w = cvt_pk_bf16(bv[6], bv[7]);
                *(u32x4*)(BV + (size_t)d * MPAD * D + ro) = w; }
    }
};
struct CfgM1 {
    static constexpr bool PERMX = false; static constexpr bool GATHER = true; static constexpr bool FP8 = true; static constexpr int KB = 1024; static constexpr bool PERM = true; static constexpr int K = 1024, ldb = 1024;
    SchedMoe S; const unsigned char* U; const unsigned char* W; unsigned char* HID; const LAS unsigned short* idx;
    __device__ __forceinline__ bool next(int i, Unit& u) const { return S.next(i, u); }
    __device__ __forceinline__ const char* a_base(const Unit&) const { return (const char*)U; }
    __device__ __forceinline__ void a_offs(const Unit&, int ui, const int (&R)[2], const int (&C)[2], unsigned (&off)[2][2]) const {
#pragma unroll
        for (int h = 0; h < 2; ++h)
#pragma unroll
            for (int i = 0; i < 2; ++i) off[h][i] = (unsigned)idx[ui * 256 + h * HALF + R[i]] * 1024u + (unsigned)C[i] * 2u;
    }
    __device__ __forceinline__ const char* b_base(const Unit& u) const { return (const char*)(W + ((size_t)u.e * 4096 + u.pn * 256) * 1024); }
    __device__ __forceinline__ void epi(const f32x4 (&acc)[2][2][4][2], const Unit& u, int wr, int wc, int fr, int fq) const {
        const int row0 = u.e * EPAD + u.pm * 256 + wr * 64 + fr, col0 = u.pn * 128 + wc * 32 + 8 * fq;
#pragma unroll
        for (int ai = 0; ai < 2; ++ai)
#pragma unroll
            for (int m = 0; m < 4; ++m) { const f32x4 g0 = acc[ai][0][m][0], g1 = acc[ai][0][m][1], u0 = acc[ai][1][m][0], u1 = acc[ai][1][m][1];
                u32x2 w; w.x = pk4_fp8(silu_mul_s(g0.x, u0.x), silu_mul_s(g0.y, u0.y), silu_mul_s(g0.z, u0.z), silu_mul_s(g0.w, u0.w));
                w.y = pk4_fp8(silu_mul_s(g1.x, u1.x), silu_mul_s(g1.y, u1.y), silu_mul_s(g1.z, u1.z), silu_mul_s(g1.w, u1.w));
                *(u32x2*)(HID + (size_t)(row0 + ai * 128 + m * 16) * HIDP8 + col0) = w; }
    }
};
struct CfgM2 {
    static constexpr bool PERMX = true; static constexpr bool GATHER = false; static constexpr bool FP8 = true; static constexpr int KB = 2048; static constexpr bool PERM = true; static constexpr int K = 2048, ldb = WDP8;
    SchedMoe S; const unsigned char* HID; const unsigned char* W; bf16* Y;
    __device__ __forceinline__ bool next(int i, Unit& u) const { return S.next(i, u); }
    __device__ __forceinline__ const char* a_base(const Unit& u) const { return (const char*)(HID + ((size_t)u.e * EPAD + u.pm * 256) * HIDP8); }
    __device__ __forceinline__ void a_offs(const Unit&, int, const int (&R)[2], const int (&C)[2], unsigned (&off)[2][2]) const { lin_offs<HIDP8>(R, C, off); }
    __device__ __forceinline__ const char* b_base(const Unit& u) const { return (const char*)(W + ((size_t)u.e * 1024 + u.pn * 256) * WDP8); }
    __device__ __forceinline__ void epi(const f32x4 (&acc)[2][2][4][2], const Unit& u, int wr, int wc, int fr, int fq) const {
        const int row0 = u.e * EPAD + u.pm * 256 + wr * 64 + fr, col0 = u.pn * 256 + wc * 64 + 16 * fq;
#pragma unroll
        for (int ai = 0; ai < 2; ++ai)
#pragma unroll
            for (int m = 0; m < 4; ++m) { const f32x4 v0 = acc[ai][0][m][0] * WINV, v1 = acc[ai][0][m][1] * WINV, v2 = acc[ai][1][m][0] * WINV, v3 = acc[ai][1][m][1] * WINV;
                u32x4 w; w.x = pk4_fp8(v0.x, v0.y, v0.z, v0.w); w.y = pk4_fp8(v1.x, v1.y, v1.z, v1.w); w.z = pk4_fp8(v2.x, v2.y, v2.z, v2.w); w.w = pk4_fp8(v3.x, v3.y, v3.z, v3.w);
                *(u32x4*)((unsigned char*)Y + (size_t)(row0 + ai * 128 + m * 16) * D + col0) = w; }
    }
};
}

#ifndef FAST_PG
#define FAST_PG 1
#endif
#ifndef FAST_LIN
#define FAST_LIN 1
#endif
#ifndef FAST_LGT
#define FAST_LGT 1
#endif
#ifndef FAST_LOUT
#define FAST_LOUT 1
#endif
#ifndef FAST_M1
#define FAST_M1 1
#endif
#ifndef FAST_M2
#define FAST_M2 1
#endif
constexpr int IDX_OFF = RING_BYTES + 1024;

#ifndef REP_PRO
#define REP_PRO 1
#endif
#ifndef REP_PP
#define REP_PP 1
#endif
#ifndef REP_LIN
#define REP_LIN 1
#endif
#ifndef REP_LCV
#define REP_LCV 1
#endif
#ifndef REP_LGT
#define REP_LGT 1
#endif
#ifndef REP_LS1
#define REP_LS1 1
#endif
#ifndef REP_LS3
#define REP_LS3 1
#endif
#ifndef REP_RB
#define REP_RB 1
#endif
#ifndef REP_TK
#define REP_TK 1
#endif
#ifndef REP_M1
#define REP_M1 1
#endif
#ifndef REP_M2
#define REP_M2 1
#endif
#ifndef REP_RA
#define REP_RA 1
#endif
#ifndef REP_LOUT
#define REP_LOUT 1
#endif
#ifndef REP_PG
#define REP_PG 1
#endif
#define REPEAT(n) _Pragma("unroll") for (int rep_ = 0; rep_ < (n); ++rep_)
#define IN(k) (lo <= (k) && (k) < hi)
#define SEAM(k) do { if ((k) + 1 < hi) xcd_barrier(bar); } while (0)
template <int layer>
__device__ __forceinline__ void run_layer(const Frame& F, const int lo, const int hi, const XcdBarrier& bar) {
    const int gw = F.vcu * 8 + F.wave, NGW = F.G * 8;
    const bool fast = (F.G == 256);
    {
        const int pb = layer * 16, j = layer >> 1;
        if (IN(pb + 0)) { if constexpr (layer == 0) REPEAT(REP_PRO) phase_prologue(F); if (REP_RA > 1) phase_rowA<false, layer == 0, true>(F, layer); phase_rowA<false, layer == 0>(F, layer); SEAM(pb + 0); }
        if constexpr ((layer & 1) == 0) {
            if (IN(pb + 1)) { REPEAT(REP_PP) phase_poolwin(F, layer); SEAM(pb + 1); }
            if (IN(pb + 2)) { FnPool fn{F.P, F.WPOOL + (size_t)j * 4 * 65536, F.H, F.pool_scale + (size_t)j * D};
                if (FAST_PG && fast) { pg8::CfgPool cfg; cfg.S.init(128, 4, F.G, (int)blockIdx.x); cfg.P = F.P; cfg.W = fn.W; cfg.scale = fn.scale; if (REP_PG > 1) { cfg.H = (bf16*)F.HF; pg8::gemm_phase(F.lds, cfg); } cfg.H = F.H; pg8::gemm_phase(F.lds, cfg);
                    wg_gemm_ksplit<2>(fn, TaskMap{4 * 16, 16, 1024, 1}, F.lds, F.vcu, F.G, F.tid); }
                else wave_gemm(fn, TaskMap{FnPool::nrb * 16, 16, 0, 1}, gw, NGW, F.lane);
                SEAM(pb + 2); }
        } else {
            if (IN(pb + 3)) { REPEAT(REP_LIN) { FnIn fn{F.H, F.WIN + (size_t)j * 2048 * 1024, F.XB, F.GY, F.RSTD};
                if (FAST_LIN && fast) { pg8::CfgIn cfg; cfg.S.init(128, 8, F.G, (int)blockIdx.x); cfg.U = F.H; cfg.W = fn.W; cfg.XB = F.XB; cfg.GY = F.GY; cfg.RS = F.RSTD; pg8::gemm_phase(F.lds, cfg);
                    wg_gemm_ksplit<2>(fn, TaskMap{4 * 32, 32, 1024, 1}, F.lds, F.vcu, F.G, F.tid); }
                else wave_gemm(fn, TaskMap{FnIn::nrb * 32, 32, 0, 1}, gw, NGW, F.lane);
                } SEAM(pb + 3); }
            if (IN(pb + 4)) { REPEAT(REP_LCV) phase_conv(F, j); SEAM(pb + 4); }
            if (IN(pb + 5)) { REPEAT(REP_LGT) { FnGates fn{F.P, F.WGT + (size_t)j * 16 * 65536, F.LA, F.BV, F.b_gates + (size_t)j * 4 * D, F.SPT + (size_t)j * 2 * D};
                if (FAST_LGT && fast) { pg8::CfgGates cfg; cfg.S.init(128, 16, F.G, (int)blockIdx.x); cfg.XC = F.P; cfg.W = fn.W; cfg.LA = F.LA; cfg.BV = F.BV; cfg.bg = fn.bg; cfg.lam = fn.lam; pg8::gemm_phase(F.lds, cfg);
                    wg_gemm_ksplit<2>(fn, TaskMap{4 * 64, 64, 1024, 1}, F.lds, F.vcu, F.G, F.tid); }
                else wave_gemm(fn, TaskMap{FnGates::nrb * 64, 64, 0, 1}, gw, NGW, F.lane);
                } SEAM(pb + 5); }
            if (IN(pb + 6)) { REPEAT(REP_LS1) phase_scan1(F, j); SEAM(pb + 6); }
            if (IN(pb + 7)) { REPEAT(REP_LS3) phase_scan3(F, j); SEAM(pb + 7); }
            if (IN(pb + 8)) { FnOut fn{F.HG, F.WOUT + (size_t)j * 1024 * 1024, F.H};
                if (FAST_LOUT && fast) { pg8::CfgOut cfg; cfg.S.init(128, 4, F.G, (int)blockIdx.x); cfg.A = F.HG; cfg.W = fn.W; if (REP_LOUT > 1) { cfg.H = (bf16*)F.HF; pg8::gemm_phase(F.lds, cfg); } cfg.H = F.H; pg8::gemm_phase(F.lds, cfg);
                    wg_gemm_ksplit<2>(fn, TaskMap{4 * 16, 16, 1024, 1}, F.lds, F.vcu, F.G, F.tid); }
                else wave_gemm(fn, TaskMap{FnOut::nrb * 16, 16, 0, 1}, gw, NGW, F.lane);
                SEAM(pb + 8); }
        }
        if (IN(pb + 9)) { REPEAT(REP_RB) phase_rowB(F, layer); SEAM(pb + 9); }
        if (IN(pb + 10)) { REPEAT(REP_TK) phase_topk(F); SEAM(pb + 10); }
        if (IN(pb + 11)) { REPEAT(REP_M1) { FnM1f8 fn{(const unsigned char*)F.U, (const unsigned char*)F.WG1 + (size_t)layer * NE * 4096 * 1024, F.ROWL, (unsigned char*)F.HID};
            if (FAST_M1 && fast) { pg8::CfgM1 cfg; cfg.S.init(16, F.G, (int)blockIdx.x, 0, 4); cfg.U = fn.U; cfg.W = fn.W; cfg.HID = fn.HID;
                LAS unsigned short* idx = (LAS unsigned short*)(F.lds + IDX_OFF); cfg.idx = idx;
                {
                    int rl[16];
#pragma unroll
                    for (int ui = 0; ui < 16; ++ui) { pg8::Unit u; const bool ok = cfg.S.next(ui, u); rl[ui] = F.ROWL[(ok ? u.e * EPAD + u.pm * 256 : 0) + (F.tid & 255)]; }
#pragma unroll
                    for (int ui = 0; ui < 16; ++ui) if (F.tid < 256) idx[ui * 256 + F.tid] = (unsigned short)rl[ui];
                }
                __syncthreads();
                pg8::gemm_phase(F.lds, cfg);
                wg_gemm_ksplit8(fn, TaskMap{16 * 64, 64, ERB16 - 1, ERB16}, F.lds, F.vcu, F.G, F.tid); }
            else wg_gemm_ksplit8(fn, TaskMap{NE * ERB16 * 64, 64, 0, 1}, F.lds, F.vcu, F.G, F.tid);
            } SEAM(pb + 11); }
        if (IN(pb + 12)) { REPEAT(REP_M2) { FnM2f8 fn{(const unsigned char*)F.HID, (const unsigned char*)F.WD + (size_t)layer * NE * 1024 * WDP8, F.Y};
            if (FAST_M2 && fast) { pg8::CfgM2 cfg; cfg.S.init(4, F.G, (int)blockIdx.x); cfg.HID = fn.HID; cfg.W = fn.W; cfg.Y = F.Y; pg8::gemm_phase(F.lds, cfg);
                wg_gemm_ksplit8(fn, TaskMap{16 * 16, 16, ERB16 - 1, ERB16}, F.lds, F.vcu, F.G, F.tid); }
            else wg_gemm_ksplit8(fn, TaskMap{NE * ERB16 * 16, 16, 0, 1}, F.lds, F.vcu, F.G, F.tid);
            } SEAM(pb + 12); }
    }
}
#undef IN
#undef SEAM

__global__ void __launch_bounds__(512, 2) mega(Args args) {
    extern __shared__ __attribute__((aligned(16))) unsigned char lds_raw[];
    Frame F;
    F.lds = (LAS unsigned char*)lds_raw;
    F.tid = threadIdx.x; F.lane = F.tid & 63; F.wave = __builtin_amdgcn_readfirstlane(F.tid >> 6);
    F.G = gridDim.x; { const int bx = blockIdx.x; F.vcu = (F.G % 8 == 0) ? (bx % 8) * (F.G / 8) + bx / 8 : bx; }
    F.x = args.in[0]; F.meta = args.in[1]; F.norm_mix = args.in[2]; F.norm_ffn = args.in[3]; F.norm_final = args.in[4]; F.pool_w = args.in[5]; F.pool_scale = args.in[6]; F.w_in = args.in[7]; F.conv_w = args.in[8];
    F.conv_b = args.in[9]; F.w_gates = args.in[10]; F.b_gates = args.in[11]; F.lam = args.in[12]; F.w_out = args.in[13]; F.router_w = args.in[14]; F.moe_g = args.in[15]; F.moe_u = args.in[16]; F.moe_d = args.in[17];
    F.out = args.out; F.ws = args.ws;
    unsigned char* ws = args.ws;
    F.WG1 = (bf16*)(ws + WS_WG1); F.WD = (bf16*)(ws + WS_WD); F.WIN = (bf16*)(ws + WS_WIN); F.WGT = (bf16*)(ws + WS_WGT); F.WOUT = (bf16*)(ws + WS_WOUT); F.WPOOL = (bf16*)(ws + WS_WPOOL);
    F.H = (bf16*)(ws + WS_H); F.U = (bf16*)(ws + WS_U); F.P = (bf16*)(ws + WS_P); F.XB = (bf16*)(ws + WS_XB); F.GY = (bf16*)(ws + WS_GY); F.HG = (bf16*)(ws + WS_HG); F.HF = (float*)(ws + WS_Y);
    F.LA = (bf16*)(ws + WS_BIG); F.BV = (bf16*)(ws + WS_BIG + 2 * LA_BYTES); F.HID = (bf16*)(ws + WS_BIG); F.Y = (bf16*)(ws + WS_Y);
    F.AFF = (float*)(ws + WS_AFF); F.SLOT = (int*)(ws + WS_SLOT); F.GMAP = (float*)(ws + WS_GMAP); F.ROWL = (int*)(ws + WS_ROWL); F.AGG = (float*)(ws + WS_AGG); F.SPT = (float*)(ws + WS_SPT); F.RSTD = (float*)(ws + WS_RSTD);
    volatile LAS unsigned* MISC = (volatile LAS unsigned*)(F.lds + MISC_OFF);
    if (F.tid < 32) MISC[F.tid] = 0u;
    __syncthreads();
    const int lo = args.lo, hi = args.hi;
    const bool multi = (hi - lo) > 1;
    XcdBarrier bar; bar.bar = (unsigned*)(ws + WS_CTL) + CW_BAR; bar.x = 0; bar.st = nullptr;
    if (multi) bar = xcd_barrier_post((unsigned*)(ws + WS_CTL) + CW_BAR, MISC + 8);
#define IN(k) (lo <= (k) && (k) < hi)
#define SEAM(k) do { if ((k) + 1 < hi) xcd_barrier(bar); } while (0)
    run_layer<0>(F, lo, hi, bar); run_layer<1>(F, lo, hi, bar); run_layer<2>(F, lo, hi, bar); run_layer<3>(F, lo, hi, bar);
    if (IN(64)) { if (REP_RA > 1) phase_rowA<true, false>(F, DEPTH); phase_rowA<true, false>(F, DEPTH); }
#undef IN
#undef SEAM
}

extern "C" void kernel_launch(void* const* d_in, const int* in_sizes, int n_in, void* d_out, int out_size, void* d_ws, size_t ws_size, hipStream_t stream) {
    static int grid = 0;
    if (grid == 0) {
        if (n_in != 18 || in_sizes[0] != NB * SEQ * D || out_size != NB * SEQ * D || ws_size < WS_END) {
            fprintf(stderr, "kernel_launch: unexpected shapes (n_in %d, in0 %d, out %d, ws %zu < %zu)\n", n_in, n_in > 0 ? in_sizes[0] : -1, out_size, ws_size, (size_t)WS_END); grid = -1; return; }
        int dev = 0, cus = 0;
        if (hipGetDevice(&dev) != hipSuccess || hipDeviceGetAttribute(&cus, hipDeviceAttributeMultiprocessorCount, dev) != hipSuccess) { grid = -1; return; }
        if (hipFuncSetAttribute((const void*)mega, hipFuncAttributeMaxDynamicSharedMemorySize, LDS_BYTES) != hipSuccess) { fprintf(stderr, "kernel_launch: hipFuncSetAttribute failed\n"); grid = -1; return; }
        int per_cu = 0;
        if (hipOccupancyMaxActiveBlocksPerMultiprocessor(&per_cu, (const void*)mega, 512, LDS_BYTES) != hipSuccess || per_cu < 1) fprintf(stderr, "kernel_launch: occupancy query reports %d\n", per_cu);
        (void)hipGetLastError();
        grid = cus;
    }
    if (grid < 0) return;
    if (hipMemsetAsync((char*)d_ws + WS_CTL, 0, CTL_ZERO_BYTES, stream) != hipSuccess) return;
    Args a{};
    for (int i = 0; i < 18; ++i) a.in[i] = (const float*)d_in[i];
    a.out = (float*)d_out; a.ws = (unsigned char*)d_ws;
#if SINGLE_LAUNCH
    a.lo = 0; a.hi = 65;
    hipLaunchKernelGGL(mega, dim3(grid), dim3(512), LDS_BYTES, stream, a);
#else
    for (int layer = 0; layer < DEPTH; ++layer) {
        static const int pool_ph[] = {0, 1, 2, 9, 10, 11, 12}, lru_ph[] = {0, 3, 4, 5, 6, 7, 8, 9, 10, 11, 12};
        const int* ph = (layer & 1) ? lru_ph : pool_ph; const int n = (layer & 1) ? 11 : 7;
        for (int q = 0; q < n; ++q) { a.lo = layer * 16 + ph[q]; a.hi = a.lo + 1; hipLaunchKernelGGL(mega, dim3(grid), dim3(512), LDS_BYTES, stream, a); }
    }
    a.lo = 64; a.hi = 65; hipLaunchKernelGGL(mega, dim3(grid), dim3(512), LDS_BYTES, stream, a);
#endif
}
```

```cpp
#include <hip/hip_runtime.h>
#include <cstdio>
#include <cstdint>

#ifndef SINGLE_LAUNCH
#define SINGLE_LAUNCH 1
#endif

constexpr int NB = 8, SEQ = 4096, NMETA = 16, T = SEQ + NMETA, D = 1024, NE = 16, CAP = 2 * T / NE, DF = 2048, DEPTH = 4;
constexpr int MMAIN = NB * SEQ;
constexpr int MROWS = NB * T;
constexpr int MPAD = 33024;
constexpr int EROWS = NB * CAP;
constexpr int EPAD = 4352;
constexpr int HIDP8 = 2112, WDP8 = 2112;
constexpr float WSCALE = 32.0f, WINV = 1.0f / 32.0f;
constexpr int NCHUNK = 33, CHL = 128;
static_assert(CAP == 514 && T == 4112 && EROWS == 4112, "shapes");
constexpr float RMS_EPS = 1e-6f;

constexpr size_t MiB = 1u << 20;
constexpr size_t WS_CTL = 0, CTL_ZERO_BYTES = 1 * MiB;
constexpr size_t WS_WG1 = 1 * MiB;
constexpr size_t WS_WD = WS_WG1 + 512 * MiB;
constexpr size_t WS_WIN = WS_WD + 264 * MiB;
constexpr size_t WS_WGT = WS_WIN + 8 * MiB;
constexpr size_t WS_WOUT = WS_WGT + 4 * MiB;
constexpr size_t WS_WPOOL = WS_WOUT + 4 * MiB;
constexpr size_t WS_H = WS_WPOOL + 1 * MiB;
constexpr size_t WS_U = WS_H + 129 * MiB;
constexpr size_t WS_P = WS_U + 65 * MiB;
constexpr size_t WS_XB = WS_P + 65 * MiB;
constexpr size_t WS_GY = WS_XB + 65 * MiB;
constexpr size_t WS_HG = WS_GY + 65 * MiB;
constexpr size_t WS_BIG = WS_HG + 65 * MiB;
constexpr size_t WS_Y = WS_BIG + 282 * MiB;
constexpr size_t WS_AFF = WS_Y + 136 * MiB;
constexpr size_t WS_SLOT = WS_AFF + 3 * MiB;
constexpr size_t WS_GMAP = WS_SLOT + 3 * MiB;
constexpr size_t WS_ROWL = WS_GMAP + 3 * MiB;
constexpr size_t WS_AGG = WS_ROWL + 1 * MiB;
constexpr size_t WS_SPT = WS_AGG + 9 * MiB / 2;
constexpr size_t WS_RSTD = WS_SPT + 64 * 1024;
constexpr size_t WS_END = WS_AGG + 5 * MiB;
constexpr size_t LA_BYTES = (size_t)MPAD * 1024 * 2;

constexpr int CW_BAR = 4096;

constexpr int RING_BYTES = 131072;
constexpr int MISC_OFF = RING_BYTES + 320;
constexpr int LDS_BYTES = 147456;

#define LAS __attribute__((address_space(3)))
typedef unsigned short bf16;
typedef short bf16x8 __attribute__((ext_vector_type(8)));
typedef float f32x4 __attribute__((ext_vector_type(4)));
typedef float f32x2 __attribute__((ext_vector_type(2)));
typedef unsigned u32x4 __attribute__((ext_vector_type(4)));
typedef unsigned u32x2 __attribute__((ext_vector_type(2)));

__device__ __forceinline__ unsigned cvt_pk_bf16(float lo, float hi) { unsigned r; asm volatile("v_cvt_pk_bf16_f32 %0, %1, %2" : "=v"(r) : "v"(lo), "v"(hi)); return r; }
__device__ __forceinline__ float bflo(unsigned w) { return __uint_as_float(w << 16); }
__device__ __forceinline__ float bfhi(unsigned w) { return __uint_as_float(w & 0xffff0000u); }
__device__ __forceinline__ float fast_exp(float x) { return __builtin_amdgcn_exp2f(x * 1.44269504089f); }
__device__ __forceinline__ float fast_rcp(float x) { return __builtin_amdgcn_rcpf(x); }
__device__ __forceinline__ float sigmoidf_(float x) { return fast_rcp(1.0f + fast_exp(-x)); }
__device__ __forceinline__ float siluf_(float x) { return x * sigmoidf_(x); }
typedef int v4i __attribute__((ext_vector_type(4)));
typedef int v8i __attribute__((ext_vector_type(8)));
__device__ __forceinline__ unsigned pk4_fp8(float a, float b, float c, float d) {
    a = __builtin_amdgcn_fmed3f(a, -448.f, 448.f); b = __builtin_amdgcn_fmed3f(b, -448.f, 448.f); c = __builtin_amdgcn_fmed3f(c, -448.f, 448.f); d = __builtin_amdgcn_fmed3f(d, -448.f, 448.f);
    unsigned r = 0; r = (unsigned)__builtin_amdgcn_cvt_pk_fp8_f32(a, b, (int)r, false); r = (unsigned)__builtin_amdgcn_cvt_pk_fp8_f32(c, d, (int)r, true); return r; }
__device__ __forceinline__ f32x4 fp8x4_to_f32(unsigned w) { const f32x2 lo = __builtin_amdgcn_cvt_pk_f32_fp8((int)w, false), hi = __builtin_amdgcn_cvt_pk_f32_fp8((int)w, true); return (f32x4){lo.x, lo.y, hi.x, hi.y}; }
__device__ __forceinline__ float silu_mul_s(float G, float U) { const float e = __builtin_amdgcn_exp2f(G * (-1.44269504089f * WINV)); return (G * U) * fast_rcp(__builtin_fmaf(e, 1024.0f, 1024.0f)); }
__device__ __forceinline__ unsigned pk4_u8(float a, float b, float c, float d) { return (unsigned)(a * 255.0f + 0.5f) | ((unsigned)(b * 255.0f + 0.5f) << 8) | ((unsigned)(c * 255.0f + 0.5f) << 16) | ((unsigned)(d * 255.0f + 0.5f) << 24); }
__device__ __forceinline__ float gelu_tanh(float x) { const float z = 0.7978845608f * (x + 0.044715f * x * x * x); return x * sigmoidf_(2.0f * z); }
__device__ __forceinline__ float wave_sum(float v) {
#pragma unroll
    for (int o = 1; o < 64; o <<= 1) v += __shfl_xor(v, o);
    return v;
}
__device__ __forceinline__ int opaque(int v) { asm volatile("" : "+v"(v)); return v; }
__device__ __forceinline__ int row_of(int b, int t) { return t >= NMETA ? b * SEQ + (t - NMETA) : MMAIN + b * NMETA + t; }

#define XB_TMO      128
#define XB_XCNT(j)  (256  + 64 * (j))
#define XB_XSUB(j)  (1280 + 64 * (j))
#define XB_XGEN(j)  (2304 + 64 * (j))
#define XB_TOP      3328
#define XB_TOPGEN   3392
#define XCD_BAR_WORDS 3456
#define XB_SPIN_CAP (1u << 18)
__device__ __forceinline__ unsigned xb_ld(unsigned* p)              { return __hip_atomic_load(p, __ATOMIC_RELAXED, __HIP_MEMORY_SCOPE_AGENT); }
__device__ __forceinline__ unsigned xb_add(unsigned* p, unsigned v) { return __hip_atomic_fetch_add(p, v, __ATOMIC_RELAXED, __HIP_MEMORY_SCOPE_AGENT); }
__device__ __forceinline__ unsigned xb_xcc_id() { return (unsigned)__builtin_amdgcn_s_getreg((3 << 11) | 20) & 0xFu; }
#define XB_SPIN(cond, bar) do { unsigned _sp = 0; while (cond) { __builtin_amdgcn_s_sleep(1); \
    if ((++_sp & 255u) == 0u) { if (xb_ld(&(bar)[XB_TMO])) break; if (_sp > XB_SPIN_CAP) { atomicAdd(&(bar)[XB_TMO], 1u); break; } } } } while (0)
struct XcdBarrier { unsigned* bar; unsigned x; volatile LAS unsigned* st; };
__device__ __forceinline__ XcdBarrier xcd_barrier_post(unsigned* bar, volatile LAS unsigned* st) {
    XcdBarrier b; b.bar = bar; b.x = xb_xcc_id(); b.st = st;
    if (threadIdx.x == 0) (void)xb_add(&bar[XB_XCNT(b.x)], 1u);
    return b;
}
__device__ __forceinline__ void xcd_barrier_complete(unsigned* bar, unsigned x, unsigned& nloc, unsigned& nx) {
    const unsigned G = gridDim.x * gridDim.y * gridDim.z;
    unsigned sum, cnt, mine, sp = 0u;
    for (;;) {
        sum = 0u; cnt = 0u; mine = 0u;
#pragma unroll
        for (unsigned j = 0; j < 16; ++j) { const unsigned c = xb_ld(&bar[XB_XCNT(j)]); sum += c; cnt += (c > 0u) ? 1u : 0u; mine = (j == x) ? c : mine; }
        if (sum == G) break;
        __builtin_amdgcn_s_sleep(1);
        if ((++sp & 255u) == 0u) { if (xb_ld(&bar[XB_TMO])) break; if (sp > XB_SPIN_CAP) { atomicAdd(&bar[XB_TMO], 1u); break; } }
    }
    nloc = mine > 0u ? mine : 1u; nx = cnt > 0u ? cnt : 1u;
}
__device__ __forceinline__ void xcd_barrier(const XcdBarrier& b) {
    asm volatile("s_waitcnt vmcnt(0)" ::: "memory");
    __syncthreads();
    if (threadIdx.x == 0) {
        unsigned* bar = b.bar;
        __builtin_amdgcn_s_waitcnt(0);
        unsigned nloc = b.st[0], nx = b.st[1];
        if (nloc == 0u) { xcd_barrier_complete(bar, b.x, nloc, nx); b.st[0] = nloc; b.st[1] = nx; }
        const unsigned old = xb_add(&bar[XB_XSUB(b.x)], 1u);
        const unsigned gen = old / nloc;
        if (old + 1u == (gen + 1u) * nloc) {
            __builtin_amdgcn_fence(__ATOMIC_RELEASE, "agent");
            asm volatile("s_waitcnt vmcnt(0)" ::: "memory");
            const unsigned og = xb_add(&bar[XB_TOP], 1u);
            const unsigned tg = og / nx;
            if (og + 1u == (tg + 1u) * nx) xb_add(&bar[XB_TOPGEN], 1u);
            else XB_SPIN(xb_ld(&bar[XB_TOPGEN]) == tg, bar);
            __builtin_amdgcn_fence(__ATOMIC_ACQUIRE, "agent");
            xb_add(&bar[XB_XGEN(b.x)], 1u);
            asm volatile("s_waitcnt vmcnt(0)" ::: "memory");
        } else {
            XB_SPIN(xb_ld(&bar[XB_XGEN(b.x)]) == gen, bar);
            __builtin_amdgcn_fence(__ATOMIC_ACQUIRE, "agent");
            asm volatile("s_waitcnt vmcnt(0)" ::: "memory");
        }
    }
    __syncthreads();
}

struct Args { const float* in[18]; float* out; unsigned char* ws; int lo, hi; };
struct Frame {
    LAS unsigned char* lds;
    int tid, lane, wave, vcu, G;
    const float *x, *meta, *norm_mix, *norm_ffn, *norm_final, *pool_w, *pool_scale, *w_in, *conv_w, *conv_b, *w_gates, *b_gates, *lam, *w_out, *router_w, *moe_g, *moe_u, *moe_d;
    float* out; unsigned char* ws;
    bf16 *WG1, *WD, *WIN, *WGT, *WOUT, *WPOOL;
    bf16* H; float* HF; bf16 *U, *P, *XB, *GY, *HG, *LA, *BV, *HID, *Y;
    float* AFF; int* SLOT; float* GMAP; int* ROWL; float* AGG; float* SPT; float* RSTD;
};

struct ProItem { const float* src; unsigned char* dst; const float* ks; int ldw, ldt, f8; };
__device__ __forceinline__ ProItem pro_decode(const Frame& F, int it) {
    constexpr int I_MOE = 64 * 512, I_IN = 2 * 512, I_OUT = 2 * 256, I_GT = 32 * 16;
    ProItem p; p.ks = nullptr; int r = it;
    if (r < 2 * I_MOE) {
        const int up = r >= I_MOE; if (up) r -= I_MOE;
        const int le = r >> 9, q = r & 511, k0 = (q >> 6) * 128, n0 = (q & 63) * 32;
        p.src = (up ? F.moe_u : F.moe_g) + (size_t)le * 1024 * 2048 + (size_t)k0 * 2048 + n0; p.ldw = 2048;
        p.dst = (unsigned char*)F.WG1 + ((size_t)le * 4096 + (n0 >> 7) * 256 + up * 128 + (n0 & 127)) * 1024 + k0; p.ldt = 1024; p.f8 = 1; return p; }
    r -= 2 * I_MOE;
    if (r < I_MOE) {
        const int le = r >> 9, q = r & 511, k0 = (q >> 5) * 128, n0 = (q & 31) * 32;
        p.src = F.moe_d + (size_t)le * 2048 * 1024 + (size_t)k0 * 1024 + n0; p.ldw = 1024;
        p.dst = (unsigned char*)F.WD + ((size_t)le * 1024 + n0) * WDP8 + k0; p.ldt = WDP8; p.f8 = 1; return p; }
    r -= I_MOE; p.f8 = 0;
    if (r < I_IN) {
        const int j = r >> 9, q = r & 511, k0 = (q >> 6) * 128, n0 = (q & 63) * 32;
        p.src = F.w_in + (size_t)j * 1024 * 2048 + (size_t)k0 * 2048 + n0; p.ldw = 2048; p.dst = (unsigned char*)(F.WIN + ((size_t)j * 2048 + n0) * 1024 + k0); p.ldt = 2048; p.ks = F.norm_mix + (size_t)(2 * j + 1) * D + k0; return p; }
    r -= I_IN;
    if (r < I_OUT) {
        const int j = r >> 8, q = r & 255, k0 = (q >> 5) * 128, n0 = (q & 31) * 32;
        p.src = F.w_out + (size_t)j * 1024 * 1024 + (size_t)k0 * 1024 + n0; p.ldw = 1024; p.dst = (unsigned char*)(F.WOUT + ((size_t)j * 1024 + n0) * 1024 + k0); p.ldt = 2048; return p; }
    r -= I_OUT;
    if (r < I_GT) {
        const int mat = r >> 4, q = r & 15, k0 = (q >> 3) * 128, n0 = (q & 7) * 32;
        const int j = mat >> 4, d = (mat >> 3) & 1, g = (mat >> 2) & 1, h = mat & 3, nt = d * 8 + h * 2 + (n0 >> 7);
        p.src = F.w_gates + (size_t)mat * 65536 + (size_t)k0 * 256 + n0; p.ldw = 256; p.dst = (unsigned char*)(F.WGT + (((size_t)j * 16 + nt) * 256 + g * 128 + (n0 & 127)) * 256 + k0); p.ldt = 512; return p; }
    r -= I_GT;
    {
        const int mat = r >> 4, q = r & 15, k0 = (q >> 3) * 128, n0 = (q & 7) * 32;
        p.src = F.pool_w + (size_t)mat * 65536 + (size_t)k0 * 256 + n0; p.ldw = 256; p.dst = (unsigned char*)(F.WPOOL + ((size_t)mat * 256 + n0) * 256 + k0); p.ldt = 512; return p; }
}
__device__ __forceinline__ void pro_load(const ProItem& p, f32x4 (&v)[16], int lane) {
    const int rr = lane >> 3, sg = lane & 7;
#pragma unroll
    for (int i = 0; i < 16; ++i) v[i] = __builtin_nontemporal_load((const f32x4*)(p.src + (size_t)(8 * i + rr) * p.ldw + 4 * sg));
}
__device__ __forceinline__ void pro_finish(const ProItem& p, const f32x4 (&v)[16], LAS float* scr, int lane) {
    { const int rr = lane >> 3, sg = lane & 7;
#pragma unroll
        for (int i = 0; i < 16; ++i) *(LAS f32x4*)(scr + (8 * i + rr) * 32 + ((4 * sg) ^ (((i >> 1) & 3) << 3))) = v[i]; }
    asm volatile("s_waitcnt lgkmcnt(0)" ::: "memory");
    const int c = lane & 7;
#pragma unroll
    for (int j = 0; j < 4; ++j) { const int n = (lane >> 3) + 8 * j; const LAS float* s = scr + (16 * c) * 32 + (n ^ ((c & 3) << 3));
        float t[16];
#pragma unroll
        for (int q = 0; q < 16; ++q) t[q] = s[q * 32];
        if (p.f8) { u32x4 o; o.x = pk4_fp8(t[0] * WSCALE, t[1] * WSCALE, t[2] * WSCALE, t[3] * WSCALE); o.y = pk4_fp8(t[4] * WSCALE, t[5] * WSCALE, t[6] * WSCALE, t[7] * WSCALE);
            o.z = pk4_fp8(t[8] * WSCALE, t[9] * WSCALE, t[10] * WSCALE, t[11] * WSCALE); o.w = pk4_fp8(t[12] * WSCALE, t[13] * WSCALE, t[14] * WSCALE, t[15] * WSCALE);
            __builtin_nontemporal_store(o, (u32x4*)(p.dst + (size_t)n * p.ldt + 16 * c)); }
        else { if (p.ks) { const float* ks = p.ks + 16 * c;
#pragma unroll
                for (int q4 = 0; q4 < 4; ++q4) { const f32x4 g4 = *(const f32x4*)(ks + 4 * q4); t[4 * q4] *= g4.x; t[4 * q4 + 1] *= g4.y; t[4 * q4 + 2] *= g4.z; t[4 * q4 + 3] *= g4.w; } }
            u32x4 o0, o1; o0.x = cvt_pk_bf16(t[0], t[1]); o0.y = cvt_pk_bf16(t[2], t[3]); o0.z = cvt_pk_bf16(t[4], t[5]); o0.w = cvt_pk_bf16(t[6], t[7]);
            o1.x = cvt_pk_bf16(t[8], t[9]); o1.y = cvt_pk_bf16(t[10], t[11]); o1.z = cvt_pk_bf16(t[12], t[13]); o1.w = cvt_pk_bf16(t[14], t[15]);
            unsigned char* d = p.dst + (size_t)n * p.ldt + 32 * c; __builtin_nontemporal_store(o0, (u32x4*)d); __builtin_nontemporal_store(o1, (u32x4*)(d + 16)); } }
    asm volatile("s_waitcnt lgkmcnt(0)" ::: "memory");
}
__device__ __forceinline__ void phase_prologue(const Frame& F) {
    LAS float* scr = (LAS float*)(F.lds + F.wave * 16384);
    const int gw = F.vcu * 8 + F.wave, NGW = F.G * 8, lane = F.lane;
    for (int i = gw * 64 + lane; i < 4 * D; i += NGW * 64) F.SPT[i] = -8.0f * log1pf(expf(-F.lam[i]));
    constexpr int NITEMS = 3 * 64 * 512 + 2 * 512 + 2 * 256 + 32 * 16 + 8 * 16;
    int it = gw; if (it >= NITEMS) return;
    ProItem cur = pro_decode(F, it); f32x4 v[16], w[16]; pro_load(cur, v, lane);
    for (;;) {
        const int nit = it + NGW; const bool more = nit < NITEMS; ProItem nxt = cur;
        if (more) nxt = pro_decode(F, nit);
        pro_load(nxt, w, lane);
        pro_finish(cur, v, scr, lane);
        if (!more) break;
        cur = nxt; it = nit;
#pragma unroll
        for (int i = 0; i < 16; ++i) v[i] = w[i];
    }
}

template <bool FINAL, bool FIRST, bool DRY = false>
__device__ __forceinline__ void phase_rowA(const Frame& F, int layer) {
    const int gw = F.vcu * 8 + F.wave, NGW = F.G * 8, lane = F.lane;
    const float* gain = FINAL ? F.norm_final : F.norm_mix + layer * D;
    f32x4 gn[4];
#pragma unroll
    for (int j = 0; j < 4; ++j) gn[j] = *(const f32x4*)(gain + 4 * lane + 256 * j);
    const int rend = FINAL ? MMAIN : MROWS;
    int sl_n = -1; float gg_n = 0.f;
    if (!FIRST) { if (lane < 16 && gw < rend) { sl_n = F.SLOT[(size_t)gw * 16 + lane]; gg_n = F.GMAP[(size_t)gw * 16 + lane]; } }
    for (int r = gw; r < rend; r += NGW) {
        f32x4 v[4];
        if (FIRST) {
            const float* src = r < MMAIN ? F.x + (size_t)r * D : F.meta + (size_t)((r - MMAIN) & 15) * D;
#pragma unroll
            for (int j = 0; j < 4; ++j) v[j] = *(const f32x4*)(src + 4 * lane + 256 * j);
        } else {
            const int sl = sl_n; const float gg = gg_n;
            const bf16* src = F.H + (size_t)r * D;
#pragma unroll
            for (int j = 0; j < 4; ++j) { const u32x2 w = *(const u32x2*)(src + 4 * lane + 256 * j); v[j] = (f32x4){bflo(w.x), bfhi(w.x), bflo(w.y), bfhi(w.y)}; }
            { const int rn = r + NGW; sl_n = -1; if (lane < 16 && rn < rend) { sl_n = F.SLOT[(size_t)rn * 16 + lane]; gg_n = F.GMAP[(size_t)rn * 16 + lane]; } }
            unsigned mask = (unsigned)__ballot(sl >= 0) & 0xffffu;
            while (mask) {
                int ee[4]; float gq[4]; const unsigned char* yr[4];
#pragma unroll
                for (int q = 0; q < 4; ++q) { const bool on = mask != 0u; const int e = on ? (__builtin_ffs((int)mask) - 1) : 0; mask &= mask - 1u;
                    const int s = __builtin_amdgcn_readlane(sl, e); const float g = __uint_as_float(__builtin_amdgcn_readlane(__float_as_uint(gg), e));
                    ee[q] = e; gq[q] = on ? g : 0.f; yr[q] = (const unsigned char*)F.Y + ((size_t)e * EPAD + (on ? s : 0)) * D; }
                unsigned w[4][4];
#pragma unroll
                for (int q = 0; q < 4; ++q)
#pragma unroll
                    for (int j = 0; j < 4; ++j) w[q][j] = *(const unsigned*)(yr[q] + 4 * lane + 256 * j);
#pragma unroll
                for (int q = 0; q < 4; ++q)
#pragma unroll
                    for (int j = 0; j < 4; ++j) v[j] += fp8x4_to_f32(w[q][j]) * gq[q];
                (void)ee;
            }
        }
        if (!FINAL && !DRY) {
            bf16* dst = F.H + (size_t)r * D;
#pragma unroll
            for (int j = 0; j < 4; ++j) { u32x2 w; w.x = cvt_pk_bf16(v[j].x, v[j].y); w.y = cvt_pk_bf16(v[j].z, v[j].w); *(u32x2*)(dst + 4 * lane + 256 * j) = w; }
        }
        float ss = 0.f;
#pragma unroll
        for (int j = 0; j < 4; ++j) ss += (v[j].x * v[j].x + v[j].y * v[j].y) + (v[j].z * v[j].z + v[j].w * v[j].w);
        const float rstd = 1.0f / sqrtf(wave_sum(ss) * (1.0f / D) + RMS_EPS);
        if (FINAL) {
            float* dst = F.out + (size_t)r * D;
#pragma unroll
            for (int j = 0; j < 4; ++j) *(f32x4*)(dst + 4 * lane + 256 * j) = v[j] * rstd * gn[j];
        } else {
            if (lane == 0) F.RSTD[r] = rstd;
        }
    }
}
constexpr int RB_PITCH = 2064;
__device__ __forceinline__ unsigned short bf16_rne(float x) { return (unsigned short)(cvt_pk_bf16(x, 0.f) & 0xffffu); }
__device__ __forceinline__ void phase_rowB(const Frame& F, int layer) {
    const int gw = F.vcu * 8 + F.wave, NGW = F.G * 8, lane = F.lane, fr = lane & 15, fq = lane >> 4;
    LAS unsigned char* wl = F.lds;
    LAS float* gl = (LAS float*)(F.lds + 3 * 16 * RB_PITCH);
    const float* rw = F.router_w + (size_t)layer * D * NE;
    const float* gain = F.norm_ffn + layer * D;
    {   f32x4 rv[8]; float gk[8];
#pragma unroll
        for (int i = 0; i < 8; ++i) { const int i4 = F.tid + 512 * i; rv[i] = *(const f32x4*)(rw + 4 * i4); gk[i] = gain[i4 >> 2]; }
#pragma unroll
        for (int i = 0; i < 8; ++i) { const int i4 = F.tid + 512 * i, k = i4 >> 2, e0 = (i4 & 3) * 4;
#pragma unroll
            for (int x = 0; x < 4; ++x) { const float w = rv[i][x] * gk[i];
                const unsigned short hi = bf16_rne(w); const float r1 = w - __uint_as_float((unsigned)hi << 16);
                const unsigned short mid = bf16_rne(r1); const float r2 = r1 - __uint_as_float((unsigned)mid << 16);
                const unsigned short lo = bf16_rne(r2);
                LAS unsigned char* p = wl + (e0 + x) * RB_PITCH + 2 * k;
                *(LAS unsigned short*)p = hi; *(LAS unsigned short*)(p + 16 * RB_PITCH) = mid; *(LAS unsigned short*)(p + 32 * RB_PITCH) = lo; } }
        for (int k = F.tid; k < D; k += 512) gl[k] = gain[k];
    }
    __syncthreads();
    constexpr int NBLK = MROWS / 16;
    for (int blk = gw; blk < NBLK; blk += NGW) {
        const int row = blk * 16 + fr;
        const bf16* src = F.H + (size_t)row * D + 8 * fq;
        u32x4 hv[32];
#pragma unroll
        for (int kk = 0; kk < 32; ++kk) hv[kk] = *(const u32x4*)(src + 32 * kk);
        f32x4 acc3[3], acch; acc3[0] = (f32x4){0.f, 0.f, 0.f, 0.f}; acc3[1] = acc3[0]; acc3[2] = acc3[0]; acch = acc3[0];
        const int woff = opaque(fr * RB_PITCH + 16 * fq);
#pragma unroll
        for (int k2 = 0; k2 < 32; k2 += 2) {
            bf16x8 wv[2][3];
#pragma unroll
            for (int u = 0; u < 2; ++u)
#pragma unroll
                for (int p = 0; p < 3; ++p) wv[u][p] = *(const LAS bf16x8*)(wl + woff + p * 16 * RB_PITCH + 64 * (k2 + u));
#pragma unroll
            for (int u = 0; u < 2; ++u) { const bf16x8 a = __builtin_bit_cast(bf16x8, hv[k2 + u]);
#pragma unroll
                for (int p = 0; p < 3; ++p) acc3[p] = __builtin_amdgcn_mfma_f32_16x16x32_bf16(wv[u][p], a, acc3[p], 0, 0, 0);
                acch = __builtin_amdgcn_mfma_f32_16x16x32_bf16(a, a, acch, 0, 0, 0); }
            asm volatile("" ::: "memory");
        }
        const f32x4 acc = (acc3[2] + acc3[1]) + acc3[0];
        const int jd = fr & 3; const float dg = jd == 0 ? acch.x : jd == 1 ? acch.y : jd == 2 ? acch.z : acch.w;
        const float ss = __shfl(dg, fr + 16 * (fr >> 2));
        const float rstd = 1.0f / sqrtf(ss * (1.0f / D) + RMS_EPS);
        unsigned char* dst = (unsigned char*)F.U + (size_t)row * D + 8 * fq;
        const int goff = opaque(8 * fq);
#pragma unroll
        for (int kk = 0; kk < 32; ++kk) {
            const u32x4 h4 = hv[kk]; const f32x4 g0 = *(const LAS f32x4*)(gl + goff + 32 * kk), g1 = *(const LAS f32x4*)(gl + goff + 32 * kk + 4);
            u32x2 o; o.x = pk4_fp8(bflo(h4.x) * rstd * g0.x, bfhi(h4.x) * rstd * g0.y, bflo(h4.y) * rstd * g0.z, bfhi(h4.y) * rstd * g0.w);
            o.y = pk4_fp8(bflo(h4.z) * rstd * g1.x, bfhi(h4.z) * rstd * g1.y, bflo(h4.w) * rstd * g1.z, bfhi(h4.w) * rstd * g1.w);
            *(u32x2*)(dst + 32 * kk) = o;
            asm volatile("" ::: "memory");
        }
        const f32x4 lg = acc * rstd;
        float mx = fmaxf(fmaxf(lg.x, lg.y), fmaxf(lg.z, lg.w)); mx = fmaxf(mx, __shfl_xor(mx, 16)); mx = fmaxf(mx, __shfl_xor(mx, 32));
        const f32x4 p = (f32x4){expf(lg.x - mx), expf(lg.y - mx), expf(lg.z - mx), expf(lg.w - mx)};
        float sum = (p.x + p.y) + (p.z + p.w); sum += __shfl_xor(sum, 16); sum += __shfl_xor(sum, 32);
        int b, t; if (row < MMAIN) { b = row >> 12; t = (row & 4095) + NMETA; } else { b = (row - MMAIN) >> 4; t = (row - MMAIN) & 15; }
        float* ap = F.AFF + ((size_t)b * NE + 4 * fq) * T + t;
        ap[0] = p.x / sum; ap[T] = p.y / sum; ap[2 * T] = p.z / sum; ap[3 * T] = p.w / sum;
    }
    __syncthreads();
}

__device__ __forceinline__ int block_excl_scan(int v, LAS int* wsum, int tid, int lane, int wave, int& total) {
    int s = v;
#pragma unroll
    for (int o = 1; o < 64; o <<= 1) { const int t = __shfl_up(s, o); if (lane >= o) s += t; }
    __syncthreads();
    if (lane == 63) wsum[wave] = s;
    __syncthreads();
    int base = 0, tot = 0;
#pragma unroll
    for (int w = 0; w < 8; ++w) { const int x = wsum[w]; if (w < wave) base += x; tot += x; }
    total = tot;
    return base + s - v;
}
__device__ __forceinline__ void phase_topk(const Frame& F) {
    LAS unsigned* keys = (LAS unsigned*)F.lds;
    LAS int* hist = (LAS int*)(F.lds + 20480);
    LAS int* misc = (LAS int*)(F.lds + 20480 + 1024);
    const int tid = F.tid, lane = F.lane, wave = F.wave;
    for (int task = blockIdx.x; task < NB * NE; task += F.G) {
        const int b = task >> 4, e = task & 15;
        const float* aff = F.AFF + ((size_t)b * NE + e) * T;
        __syncthreads();
        {   unsigned kv[9];
#pragma unroll
            for (int i = 0; i < 9; ++i) { const int t = tid + 512 * i; kv[i] = __float_as_uint(aff[t < T ? t : T - 1]); }
#pragma unroll
            for (int i = 0; i < 9; ++i) { const int t = tid + 512 * i; if (t < T) keys[t] = kv[i]; } }
        unsigned prefix = 0u, pmask = 0u; int need = CAP;
        for (int p = 3; p >= 0; --p) {
            if (tid < 256) hist[tid] = 0;
            __syncthreads();
            for (int t = tid; t < T; t += 512) { const unsigned k = keys[t]; if ((k & pmask) == prefix) __hip_atomic_fetch_add(&hist[(k >> (8 * p)) & 255u], 1, __ATOMIC_RELAXED, __HIP_MEMORY_SCOPE_WORKGROUP); }
            __syncthreads();
            if (wave == 0) {
                int c[4]; int tot = 0;
#pragma unroll
                for (int q = 0; q < 4; ++q) { c[q] = hist[4 * lane + q]; tot += c[q]; }
                int s = tot;
#pragma unroll
                for (int o = 1; o < 64; o <<= 1) { const int x = __shfl_down(s, o); if (lane + o < 64) s += x; }
                int above = s - tot;
                if (above < need && need <= s) {
                    int a = above;
#pragma unroll
                    for (int q = 3; q >= 0; --q) { if (need <= a + c[q] && need > a) { misc[0] = 4 * lane + q; misc[1] = need - a; } a += c[q]; }
                }
            }
            __syncthreads();
            prefix |= (unsigned)misc[0] << (8 * p); pmask |= 0xFFu << (8 * p); need = misc[1];
            __syncthreads();
        }
        const unsigned vstar = prefix;
        const int t0 = tid * 9, t1 = (t0 + 9 < T) ? t0 + 9 : T;
        int neq = 0;
        for (int t = t0; t < t1; ++t) neq += (keys[t] == vstar) ? 1 : 0;
        int toteq; int eqbase = block_excl_scan(neq, misc + 8, tid, lane, wave, toteq);
        int nsel = 0; unsigned selmask = 0u; { int er = eqbase;
            for (int t = t0; t < t1; ++t) { const unsigned k = keys[t]; bool s = k > vstar; if (k == vstar) { s = er < need; ++er; } if (s) { selmask |= 1u << (t - t0); ++nsel; } } }
        int totsel; int sbase = block_excl_scan(nsel, misc + 8, tid, lane, wave, totsel);
        for (int t = t0; t < t1; ++t) {
            const int row = row_of(b, t);
            if ((selmask >> (t - t0)) & 1u) { const int pos = b * CAP + sbase; ++sbase;
                F.ROWL[e * EPAD + pos] = row; F.SLOT[(size_t)row * 16 + e] = pos; F.GMAP[(size_t)row * 16 + e] = __uint_as_float(keys[t]); }
            else F.SLOT[(size_t)row * 16 + e] = -1;
        }
        if (b == 0 && tid < EPAD - EROWS) F.ROWL[e * EPAD + EROWS + tid] = 0;
    }
    __syncthreads();
}

__device__ __forceinline__ void phase_poolwin(const Frame& F, int layer) {
    const int gw = F.vcu * 8 + F.wave, NGW = F.G * 8, lane = F.lane;
    constexpr int CHS = 33, NTC = (T + CHS - 1) / CHS;
    for (int it = gw; it < NB * NTC * 2; it += NGW) {
        const int half = it & 1, tc = (it >> 1) % NTC, b = (it >> 1) / NTC;
        const int col = half * 512 + lane * 8, g = col >> 8, hw = 1 << g;
        const int t0 = tc * CHS, t1 = (t0 + CHS < T) ? t0 + CHS : T;
        float sum[8];
#pragma unroll
        for (int q = 0; q < 8; ++q) sum[q] = 0.f;
        const u32x4 zero4 = (u32x4){0u, 0u, 0u, 0u};
        const bf16* ucol = F.H + col;
        float gnv[8];
        { const float* gp = F.norm_mix + (size_t)layer * D + col; const f32x4 g0 = *(const f32x4*)gp, g1 = *(const f32x4*)(gp + 4); gnv[0] = g0.x; gnv[1] = g0.y; gnv[2] = g0.z; gnv[3] = g0.w; gnv[4] = g1.x; gnv[5] = g1.y; gnv[6] = g1.z; gnv[7] = g1.w; }
#define PW_FMA(V_, S_) do { sum[0] += bflo(V_.x) * (S_); sum[1] += bfhi(V_.x) * (S_); sum[2] += bflo(V_.y) * (S_); sum[3] += bfhi(V_.y) * (S_); sum[4] += bflo(V_.z) * (S_); sum[5] += bfhi(V_.z) * (S_); sum[6] += bflo(V_.w) * (S_); sum[7] += bfhi(V_.w) * (S_); } while (0)
        {
            u32x4 iw[16]; float ir[16];
#pragma unroll
            for (int q = 0; q < 16; ++q) { const int dt = q - 8, tt = t0 + dt; const bool v = dt >= -hw && dt < hw && tt >= 0 && tt < T; const int row = row_of(b, v ? tt : t0); iw[q] = *(const u32x4*)(ucol + (size_t)row * D); ir[q] = F.RSTD[row]; }
#pragma unroll
            for (int q = 0; q < 16; ++q) { const int dt = q - 8, tt = t0 + dt; const bool v = dt >= -hw && dt < hw && tt >= 0 && tt < T; const float sc = v ? ir[q] : 0.f; PW_FMA(iw[q], sc); }
        }
        for (int tb = t0; tb < t1; tb += 11) {
            u32x4 c[11], wp[11], wm[11]; float rc[11], rp[11], rm[11];
#pragma unroll
            for (int q = 0; q < 11; ++q) { const int t = (tb + q < t1) ? tb + q : t1 - 1; const bool vp = t + hw < T, vm = t - hw >= 0;
                const int r0_ = row_of(b, t), r1_ = row_of(b, vp ? t + hw : t), r2_ = row_of(b, vm ? t - hw : t);
                c[q] = *(const u32x4*)(ucol + (size_t)r0_ * D); wp[q] = *(const u32x4*)(ucol + (size_t)r1_ * D); wm[q] = *(const u32x4*)(ucol + (size_t)r2_ * D);
                rc[q] = F.RSTD[r0_]; rp[q] = F.RSTD[r1_]; rm[q] = F.RSTD[r2_]; }
#pragma unroll
            for (int q = 0; q < 11; ++q) { const int t = tb + q;
                if (t < t1) {
                    const int lo = (t - hw > 0) ? t - hw : 0, hi = (t + hw < T) ? t + hw : T;
                    const float inv = 1.0f / (float)(hi - lo), cs = rc[q];
                    u32x4 o;
                    o.x = cvt_pk_bf16((sum[0] * inv - bflo(c[q].x) * cs) * gnv[0], (sum[1] * inv - bfhi(c[q].x) * cs) * gnv[1]); o.y = cvt_pk_bf16((sum[2] * inv - bflo(c[q].y) * cs) * gnv[2], (sum[3] * inv - bfhi(c[q].y) * cs) * gnv[3]);
                    o.z = cvt_pk_bf16((sum[4] * inv - bflo(c[q].z) * cs) * gnv[4], (sum[5] * inv - bfhi(c[q].z) * cs) * gnv[5]); o.w = cvt_pk_bf16((sum[6] * inv - bflo(c[q].w) * cs) * gnv[6], (sum[7] * inv - bfhi(c[q].w) * cs) * gnv[7]);
                    *(u32x4*)(F.P + (size_t)row_of(b, t) * D + col) = o;
                    const float sa = (t + hw < T) ? rp[q] : 0.f, sm = (t - hw >= 0) ? -rm[q] : 0.f;
                    PW_FMA(wp[q], sa); PW_FMA(wm[q], sm);
                }
            }
        }
#undef PW_FMA
    }
}
__device__ __forceinline__ void phase_conv(const Frame& F, int j) {
    const int gw = F.vcu * 8 + F.wave, NGW = F.G * 8, lane = F.lane;
    constexpr int CHS = 33, NTC = (T + CHS - 1) / CHS;
    const float* cw = F.conv_w + (size_t)j * 4 * D; const float* cb = F.conv_b + (size_t)j * D;
    for (int it = gw; it < NB * NTC * 2; it += NGW) {
        const int half = it & 1, tc = (it >> 1) % NTC, b = (it >> 1) / NTC;
        const int col = half * 512 + lane * 8;
        const int t0 = tc * CHS, t1 = (t0 + CHS < T) ? t0 + CHS : T;
        float w[4][8], bias[8];
#pragma unroll
        for (int k = 0; k < 4; ++k) { const f32x4 a = *(const f32x4*)(cw + k * D + col), c = *(const f32x4*)(cw + k * D + col + 4);
            w[k][0] = a.x; w[k][1] = a.y; w[k][2] = a.z; w[k][3] = a.w; w[k][4] = c.x; w[k][5] = c.y; w[k][6] = c.z; w[k][7] = c.w; }
        { const f32x4 a = *(const f32x4*)(cb + col), c = *(const f32x4*)(cb + col + 4); bias[0] = a.x; bias[1] = a.y; bias[2] = a.z; bias[3] = a.w; bias[4] = c.x; bias[5] = c.y; bias[6] = c.z; bias[7] = c.w; }
        u32x4 xm1 = (u32x4){0u, 0u, 0u, 0u}, x0 = xm1, xp1 = xm1, xp2 = xm1;
        if (t0 - 1 >= 0) xm1 = *(const u32x4*)(F.XB + (size_t)row_of(b, t0 - 1) * D + col);
        x0 = *(const u32x4*)(F.XB + (size_t)row_of(b, t0) * D + col);
        if (t0 + 1 < T) xp1 = *(const u32x4*)(F.XB + (size_t)row_of(b, t0 + 1) * D + col);
        for (int tb = t0; tb < t1; tb += 11) {
            u32x4 xn[11];
#pragma unroll
            for (int q = 0; q < 11; ++q) { const int tt = tb + q + 2; xn[q] = *(const u32x4*)(F.XB + (size_t)row_of(b, tt < T ? tt : T - 1) * D + col); }
#pragma unroll
            for (int q = 0; q < 11; ++q) { const int t = tb + q;
                if (t < t1) {
                    xp2 = (t + 2 < T) ? xn[q] : (u32x4){0u, 0u, 0u, 0u};
                    float o[8];
#define CONV2(q_, m) o[2 * q_] = bias[2 * q_] + w[0][2 * q_] * bflo(xm1.m) + w[1][2 * q_] * bflo(x0.m) + w[2][2 * q_] * bflo(xp1.m) + w[3][2 * q_] * bflo(xp2.m); \
                     o[2 * q_ + 1] = bias[2 * q_ + 1] + w[0][2 * q_ + 1] * bfhi(xm1.m) + w[1][2 * q_ + 1] * bfhi(x0.m) + w[2][2 * q_ + 1] * bfhi(xp1.m) + w[3][2 * q_ + 1] * bfhi(xp2.m);
                    CONV2(0, x) CONV2(1, y) CONV2(2, z) CONV2(3, w)
#undef CONV2
                    u32x4 ov; ov.x = cvt_pk_bf16(o[0], o[1]); ov.y = cvt_pk_bf16(o[2], o[3]); ov.z = cvt_pk_bf16(o[4], o[5]); ov.w = cvt_pk_bf16(o[6], o[7]);
                    *(u32x4*)(F.P + (size_t)row_of(b, t) * D + col) = ov;
                    xm1 = x0; x0 = xp1; xp1 = xp2;
                }
            }
        }
    }
}
__device__ __forceinline__ void chunk_rows(int b, int k, int& r0, int& n) { if (k == 0) { r0 = MMAIN + b * NMETA; n = NMETA; } else { r0 = b * SEQ + (k - 1) * CHL; n = CHL; } }
__device__ __forceinline__ void phase_scan1(const Frame& F, int j) {
    const int lane = F.lane;
    for (int it = F.wave * F.G + F.vcu; it < 2 * NB * NCHUNK * 8; it += 8 * F.G) {
        int cq, k, b, d;
        if (it < 4096) { cq = it & 7; k = 1 + ((it >> 3) & 31); b = (it >> 8) & 7; d = it >> 11; } else { const int u = it - 4096; cq = u & 7; k = 0; b = (u >> 3) & 7; d = u >> 6; }
        const int c0 = cq * 128 + lane * 2;
        int r0, n; chunk_rows(b, k, r0, n);
        const unsigned char* la = (const unsigned char*)F.LA + (size_t)d * MPAD * D + c0; const bf16* bv = F.BV + (size_t)d * MPAD * D + c0;
        const f32x2 spq = *(const f32x2*)(F.SPT + (size_t)(j * 2 + d) * D + c0) * (1.0f / 255.0f);
        float h0 = 0.f, h1 = 0.f, s0 = 0.f, s1 = 0.f;
        for (int s = 0; s < n; s += 32) {
            unsigned lw[32], bw[32];
#pragma unroll
            for (int q = 0; q < 32; ++q) { const int sq = (s + q < n) ? s + q : n - 1; const int r = d ? (r0 + n - 1 - sq) : (r0 + sq); lw[q] = *(const unsigned short*)(la + (size_t)r * D); bw[q] = *(const unsigned*)(bv + (size_t)r * D); }
#pragma unroll
            for (int q = 0; q < 32; ++q) { const bool ok = s + q < n; const unsigned lq = ok ? lw[q] : 0u, bq = ok ? bw[q] : 0u;
                const float l0 = (float)(lq & 255u) * spq.x, l1 = (float)(lq >> 8) * spq.y; s0 += l0; s1 += l1; h0 = fast_exp(l0) * h0 + bflo(bq); h1 = fast_exp(l1) * h1 + bfhi(bq); }
        }
        float* agg = F.AGG + ((size_t)(d * NB + b) * NCHUNK + k) * D + c0;
        *(f32x2*)agg = (f32x2){s0, s1};
        *(f32x2*)(agg + (size_t)2 * NB * NCHUNK * D) = (f32x2){h0, h1};
    }
}
template <int N>
__device__ __forceinline__ void scan3_rows(const Frame& F, int j, int r0, int c0, float hf0, float hf1, float hb0, float hb1) {
    constexpr int HALF = N / 2;
    const unsigned char* laf = (const unsigned char*)F.LA + c0; const bf16* bvf = F.BV + c0; const unsigned char* lab = laf + (size_t)MPAD * D; const bf16* bvb = bvf + (size_t)MPAD * D;
    const f32x2 sqf = *(const f32x2*)(F.SPT + (size_t)(j * 2 + 0) * D + c0) * (1.0f / 255.0f), sqb = *(const f32x2*)(F.SPT + (size_t)(j * 2 + 1) * D + c0) * (1.0f / 255.0f);
#define L8LO(W_, S_) ((float)((W_) & 255u) * (S_).x)
#define L8HI(W_, S_) ((float)((W_) >> 8) * (S_).y)
    unsigned sf[HALF], sb[HALF];
#pragma unroll
    for (int s = 0; s < HALF; s += 8) {
        unsigned lf[8], bf_[8], lb[8], bb[8];
#pragma unroll
        for (int q = 0; q < 8; ++q) { const size_t rf = (size_t)(r0 + s + q) * D, rb = (size_t)(r0 + N - 1 - s - q) * D;
            lf[q] = *(const unsigned short*)(laf + rf); bf_[q] = *(const unsigned*)(bvf + rf); lb[q] = *(const unsigned short*)(lab + rb); bb[q] = *(const unsigned*)(bvb + rb); }
#pragma unroll
        for (int q = 0; q < 8; ++q) {
            hf0 = fast_exp(L8LO(lf[q], sqf)) * hf0 + bflo(bf_[q]); hf1 = fast_exp(L8HI(lf[q], sqf)) * hf1 + bfhi(bf_[q]); sf[s + q] = cvt_pk_bf16(hf0, hf1);
            hb0 = fast_exp(L8LO(lb[q], sqb)) * hb0 + bflo(bb[q]); hb1 = fast_exp(L8HI(lb[q], sqb)) * hb1 + bfhi(bb[q]); sb[s + q] = cvt_pk_bf16(hb0, hb1); }
    }
#pragma unroll
    for (int s = HALF; s < N; s += 8) {
        unsigned lf[8], bf_[8], lb[8], bb[8], gf[8], gb[8];
#pragma unroll
        for (int q = 0; q < 8; ++q) { const size_t rf = (size_t)(r0 + s + q) * D, rb = (size_t)(r0 + N - 1 - s - q) * D;
            lf[q] = *(const unsigned short*)(laf + rf); bf_[q] = *(const unsigned*)(bvf + rf); lb[q] = *(const unsigned short*)(lab + rb); bb[q] = *(const unsigned*)(bvb + rb);
            gf[q] = *(const unsigned*)(F.GY + rf + c0); gb[q] = *(const unsigned*)(F.GY + rb + c0); }
#pragma unroll
        for (int q = 0; q < 8; ++q) { const size_t rf = (size_t)(r0 + s + q) * D, rb = (size_t)(r0 + N - 1 - s - q) * D;
            const unsigned xf = sb[N - 1 - s - q], xb = sf[N - 1 - s - q];
            hf0 = fast_exp(L8LO(lf[q], sqf)) * hf0 + bflo(bf_[q]); hf1 = fast_exp(L8HI(lf[q], sqf)) * hf1 + bfhi(bf_[q]);
            *(unsigned*)(F.HG + rf + c0) = cvt_pk_bf16((hf0 + bflo(xf)) * bflo(gf[q]), (hf1 + bfhi(xf)) * bfhi(gf[q]));
            hb0 = fast_exp(L8LO(lb[q], sqb)) * hb0 + bflo(bb[q]); hb1 = fast_exp(L8HI(lb[q], sqb)) * hb1 + bfhi(bb[q]);
            *(unsigned*)(F.HG + rb + c0) = cvt_pk_bf16((bflo(xb) + hb0) * bflo(gb[q]), (bfhi(xb) + hb1) * bfhi(gb[q])); }
    }
#undef L8LO
#undef L8HI
}
__device__ __forceinline__ void phase_scan3(const Frame& F, int j) {
    const int lane = F.lane;
    constexpr size_t HOFF = (size_t)2 * NB * NCHUNK * D;
    for (int it = F.wave * F.G + F.vcu; it < NB * NCHUNK * 8; it += 8 * F.G) {
        int cq, k, b;
        if (it < 2048) { cq = it & 7; k = 1 + ((it >> 3) & 31); b = it >> 8; } else { const int u = it - 2048; cq = u & 7; k = 0; b = u >> 3; }
        const int c0 = cq * 128 + lane * 2;
        int r0, n; chunk_rows(b, k, r0, n);
        float hf0 = 0.f, hf1 = 0.f, hb0 = 0.f, hb1 = 0.f;
        for (int j0 = 0; j0 < k; j0 += 8) {
            f32x2 al[8], he[8];
#pragma unroll
            for (int q = 0; q < 8; ++q) { const int jx = (j0 + q < k) ? j0 + q : 0; const float* agg = F.AGG + ((size_t)(0 * NB + b) * NCHUNK + jx) * D + c0; al[q] = *(const f32x2*)agg; he[q] = *(const f32x2*)(agg + HOFF); }
#pragma unroll
            for (int q = 0; q < 8; ++q) if (j0 + q < k) { hf0 = fast_exp(al[q].x) * hf0 + he[q].x; hf1 = fast_exp(al[q].y) * hf1 + he[q].y; }
        }
        for (int j0 = NCHUNK - 1; j0 > k; j0 -= 8) {
            f32x2 al[8], he[8];
#pragma unroll
            for (int q = 0; q < 8; ++q) { const int jx = (j0 - q > k) ? j0 - q : NCHUNK - 1; const float* agg = F.AGG + ((size_t)(1 * NB + b) * NCHUNK + jx) * D + c0; al[q] = *(const f32x2*)agg; he[q] = *(const f32x2*)(agg + HOFF); }
#pragma unroll
            for (int q = 0; q < 8; ++q) if (j0 - q > k) { hb0 = fast_exp(al[q].x) * hb0 + he[q].x; hb1 = fast_exp(al[q].y) * hb1 + he[q].y; }
        }
        if (k == 0) scan3_rows<NMETA>(F, j, r0, c0, hf0, hf1, hb0, hb1); else scan3_rows<CHL>(F, j, r0, c0, hf0, hf1, hb0, hb1);
    }
}

struct TaskMap { int ntask, ncb, rb0, rbstride; };
template <class Fn>
__device__ __forceinline__ void wave_gemm(const Fn& fn, const TaskMap tm, int gw, int ngw, int lane_) {
    const int lane = opaque(lane_), fr = lane & 15, fq = lane >> 4;
    for (int task = gw; task < tm.ntask; task += ngw) {
        const int cb = task % tm.ncb, rb = tm.rb0 + (task / tm.ncb) * tm.rbstride;
        const bf16* ap[2]; const bf16* bp[4];
#pragma unroll
        for (int mi = 0; mi < 2; ++mi) ap[mi] = fn.arow(rb, cb, mi * 16 + fr) + 8 * fq;
#pragma unroll
        for (int nb = 0; nb < 4; ++nb) bp[nb] = fn.brow(rb, cb, nb * 16 + fr) + 8 * fq;
        f32x4 acc[2][4];
#pragma unroll
        for (int mi = 0; mi < 2; ++mi)
#pragma unroll
            for (int nb = 0; nb < 4; ++nb) acc[mi][nb] = (f32x4){0.f, 0.f, 0.f, 0.f};
#pragma unroll 2
        for (int k0 = 0; k0 < fn.K; k0 += 32) {
            bf16x8 a[2], bb[4];
#pragma unroll
            for (int mi = 0; mi < 2; ++mi) a[mi] = *(const bf16x8*)(ap[mi] + k0);
#pragma unroll
            for (int nb = 0; nb < 4; ++nb) bb[nb] = *(const bf16x8*)(bp[nb] + k0);
#pragma unroll
            for (int mi = 0; mi < 2; ++mi)
#pragma unroll
                for (int nb = 0; nb < 4; ++nb) acc[mi][nb] = __builtin_amdgcn_mfma_f32_16x16x32_bf16(bb[nb], a[mi], acc[mi][nb], 0, 0, 0);
        }
#pragma unroll
        for (int mi = 0; mi < 2; ++mi)
#pragma unroll
            for (int nb = 0; nb < (Fn::PAIRED ? 2 : 4); ++nb) fn.epi_blk(rb, cb, mi, nb, acc[mi][nb], acc[mi][Fn::PAIRED ? nb + 2 : nb], fr, fq);
    }
}
struct FnPool {
    static constexpr int nrb = MROWS / 32, ncb = 16, K = 256; static constexpr bool PAIRED = false;
    const bf16* P; const bf16* W; bf16* H; const float* scale;
    __device__ __forceinline__ const bf16* arow(int rb, int cb, int r) const { return P + (size_t)(rb * 32 + r) * D + (cb >> 2) * 256; }
    __device__ __forceinline__ const bf16* brow(int rb, int cb, int n) const { return W + (size_t)(cb * 64 + n) * 256; }
    __device__ __forceinline__ void epi_blk(int rb, int cb, int mi, int nb, const f32x4& v, const f32x4&, int fr, int fq) const {
        const int c = cb * 64 + nb * 16 + 4 * fq; bf16* p = H + (size_t)(rb * 32 + mi * 16 + fr) * D + c; const u32x2 w = *(const u32x2*)p; const f32x4 o = (f32x4){bflo(w.x), bfhi(w.x), bflo(w.y), bfhi(w.y)} + v * *(const f32x4*)(scale + c);
        u32x2 ow; ow.x = cvt_pk_bf16(o.x, o.y); ow.y = cvt_pk_bf16(o.z, o.w); *(u32x2*)p = ow; }
};
struct FnIn {
    static constexpr int nrb = MROWS / 32, ncb = 32, K = 1024; static constexpr bool PAIRED = false;
    const bf16* U; const bf16* W; bf16* XB; bf16* GY; const float* RS;
    __device__ __forceinline__ const bf16* arow(int rb, int cb, int r) const { return U + (size_t)(rb * 32 + r) * D; }
    __device__ __forceinline__ const bf16* brow(int rb, int cb, int n) const { return W + (size_t)(cb * 64 + n) * 1024; }
    __device__ __forceinline__ void epi_blk(int rb, int cb, int mi, int nb, const f32x4& v_, const f32x4&, int fr, int fq) const {
        const int c = cb * 64 + nb * 16 + 4 * fq; const size_t ro = (size_t)(rb * 32 + mi * 16 + fr) * D; u32x2 w; const f32x4 v = v_ * RS[rb * 32 + mi * 16 + fr];
        if (cb < 16) { w.x = cvt_pk_bf16(v.x, v.y); w.y = cvt_pk_bf16(v.z, v.w); *(u32x2*)(XB + ro + c) = w; }
        else { w.x = cvt_pk_bf16(gelu_tanh(v.x), gelu_tanh(v.y)); w.y = cvt_pk_bf16(gelu_tanh(v.z), gelu_tanh(v.w)); *(u32x2*)(GY + ro + c - 1024) = w; } }
};
__device__ __forceinline__ void lru_gate2(f32x2 zr, f32x2 zi, f32x2 sp, f32x2 x, bool slow, f32x2& rg, f32x2& bv) {
    const f32x2 tr = zr * (-1.44269504089f), ti = zi * (-1.44269504089f);
    f32x2 e1, e2; e1.x = __builtin_amdgcn_exp2f(tr.x); e1.y = __builtin_amdgcn_exp2f(tr.y); e2.x = __builtin_amdgcn_exp2f(ti.x); e2.y = __builtin_amdgcn_exp2f(ti.y);
    const f32x2 d1 = e1 + 1.0f, d2 = e2 + 1.0f, dd = d1 * d2;
    f32x2 inv; inv.x = fast_rcp(dd.x); inv.y = fast_rcp(dd.y);
    const f32x2 rgate = inv * d2, l = rgate * sp, x2 = l * 2.0f;
    f32x2 q = x2 * 0.0001984127f + 0.0013888889f; q = q * x2 + 0.0083333333f; q = q * x2 + 0.041666667f; q = q * x2 + 0.16666667f; q = q * x2 + 0.5f; q = q * x2 + 1.0f;
    f32x2 em = -x2 * q;
    if (__builtin_expect(slow, 0)) { asm volatile("" ::: "memory"); em.x = 1.0f - fast_exp(x2.x); em.y = 1.0f - fast_exp(x2.y); }
    f32x2 sq; sq.x = __builtin_amdgcn_sqrtf(em.x); sq.y = __builtin_amdgcn_sqrtf(em.y);
    rg = rgate; bv = sq * (inv * d1) * x;
}
struct FnGates {
    static constexpr int nrb = MROWS / 32, ncb = 64, K = 256; static constexpr bool PAIRED = true;
    const bf16* XC; const bf16* W; bf16* LA; bf16* BV; const float* bg; const float* lam;
    __device__ __forceinline__ const bf16* arow(int rb, int cb, int r) const { return XC + (size_t)(rb * 32 + r) * D + (((cb & 31) * 32) >> 8) * 256; }
    __device__ __forceinline__ const bf16* brow(int rb, int cb, int n) const {
        const int d = cb >> 5, nb = n >> 4, frn = n & 15, ch = (cb & 31) * 32 + (nb & 1) * 16 + frn, g = nb >> 1, h = ch >> 8, jl = ch & 255;
        return W + (((size_t)(d * 8 + h * 2 + (jl >> 7)) * 256) + g * 128 + (jl & 127)) * 256; }
    __device__ __forceinline__ void epi_blk(int rb, int cb, int mi, int nb, const f32x4& vr, const f32x4& vi, int fr, int fq) const {
        const int d = cb >> 5, ch = (cb & 31) * 32 + nb * 16 + 4 * fq;
        const f32x4 br = *(const f32x4*)(bg + (d * 2 + 0) * D + ch), bi = *(const f32x4*)(bg + (d * 2 + 1) * D + ch), lm = *(const f32x4*)(lam + d * D + ch);
        const size_t ro = (size_t)(rb * 32 + mi * 16 + fr) * D + ch;
        const u32x2 xw = *(const u32x2*)(XC + ro); const float xv[4] = {bflo(xw.x), bfhi(xw.x), bflo(xw.y), bfhi(xw.y)};
        float la[4], bvv[4];
        const bool slow = __any((lm.x < -0.25f) | (lm.y < -0.25f) | (lm.z < -0.25f) | (lm.w < -0.25f));
#pragma unroll
        for (int q = 0; q < 4; q += 2) { f32x2 l2, b2; lru_gate2((f32x2){vr[q] + br[q], vr[q + 1] + br[q + 1]}, (f32x2){vi[q] + bi[q], vi[q + 1] + bi[q + 1]}, (f32x2){lm[q], lm[q + 1]}, (f32x2){xv[q], xv[q + 1]}, slow, l2, b2);
            la[q] = l2.x; la[q + 1] = l2.y; bvv[q] = b2.x; bvv[q + 1] = b2.y; }
        *(unsigned*)((unsigned char*)LA + (size_t)d * MPAD * D + ro) = pk4_u8(la[0], la[1], la[2], la[3]);
        u32x2 w; w.x = cvt_pk_bf16(bvv[0], bvv[1]); w.y = cvt_pk_bf16(bvv[2], bvv[3]); *(u32x2*)(BV + (size_t)d * MPAD * D + ro) = w; }
};
struct FnOut {
    static constexpr int nrb = MROWS / 32, ncb = 16, K = 1024; static constexpr bool PAIRED = false;
    const bf16* A; const bf16* W; bf16* H;
    __device__ __forceinline__ const bf16* arow(int rb, int cb, int r) const { return A + (size_t)(rb * 32 + r) * D; }
    __device__ __forceinline__ const bf16* brow(int rb, int cb, int n) const { return W + (size_t)(cb * 64 + n) * 1024; }
    __device__ __forceinline__ void epi_blk(int rb, int cb, int mi, int nb, const f32x4& v, const f32x4&, int fr, int fq) const {
        bf16* p = H + (size_t)(rb * 32 + mi * 16 + fr) * D + cb * 64 + nb * 16 + 4 * fq; const u32x2 w = *(const u32x2*)p; const f32x4 o = (f32x4){bflo(w.x), bfhi(w.x), bflo(w.y), bfhi(w.y)} + v;
        u32x2 ow; ow.x = cvt_pk_bf16(o.x, o.y); ow.y = cvt_pk_bf16(o.z, o.w); *(u32x2*)p = ow; }
};
constexpr int ERB = (EROWS + 31) / 32;
constexpr int ERB16 = (EROWS + 15) / 16;
struct FnM1f8 {
    static constexpr int KB = 1024; static constexpr bool PAIRED = true;
    const unsigned char* U; const unsigned char* W; const int* ROWL; unsigned char* HID;
    __device__ __forceinline__ const unsigned char* arow(int rb, int cb, int r) const { const int e = rb / ERB16, pos = (rb % ERB16) * 16 + r; return U + (size_t)ROWL[e * EPAD + pos] * 1024; }
    __device__ __forceinline__ const unsigned char* brow(int rb, int cb, int n) const { const int e = rb / ERB16, nb = n >> 4, f = cb * 32 + (nb & 1) * 16 + (n & 15);
        return W + ((size_t)e * 4096 + (f >> 7) * 256 + (nb >> 1) * 128 + (f & 127)) * 1024; }
    __device__ __forceinline__ void epi_blk(int rb, int cb, int nb, const f32x4& gs, const f32x4& us, int fr, int fq) const {
        const int e = rb / ERB16, pos = (rb % ERB16) * 16 + fr, f = cb * 32 + nb * 16 + 4 * fq; const f32x4 g = gs * WINV, u = us * WINV;
        *(unsigned*)(HID + ((size_t)e * EPAD + pos) * HIDP8 + f) = pk4_fp8(siluf_(g.x) * u.x, siluf_(g.y) * u.y, siluf_(g.z) * u.z, siluf_(g.w) * u.w); }
};
struct FnM2f8 {
    static constexpr int KB = 2048; static constexpr bool PAIRED = false;
    const unsigned char* HID; const unsigned char* W; bf16* Y;
    __device__ __forceinline__ const unsigned char* arow(int rb, int cb, int r) const { const int e = rb / ERB16, pos = (rb % ERB16) * 16 + r; return HID + ((size_t)e * EPAD + pos) * HIDP8; }
    __device__ __forceinline__ const unsigned char* brow(int rb, int cb, int n) const { const int e = rb / ERB16; return W + ((size_t)e * 1024 + cb * 64 + n) * WDP8; }
    __device__ __forceinline__ void epi_blk(int rb, int cb, int nb, const f32x4& vs, const f32x4&, int fr, int fq) const {
        const int e = rb / ERB16, pos = (rb % ERB16) * 16 + fr; const f32x4 v = vs * WINV;
        *(unsigned*)((unsigned char*)Y + ((size_t)e * EPAD + pos) * D + cb * 64 + nb * 16 + 4 * fq) = pk4_fp8(v.x, v.y, v.z, v.w); }
};
template <class Fn>
__device__ __forceinline__ void wg_gemm_ksplit8(const Fn& fn, const TaskMap tm, LAS unsigned char* lds, int vcu, int G, int tid_) {
    const int tid = opaque(tid_), lane = tid & 63, wave = __builtin_amdgcn_readfirstlane(tid >> 6), fr = lane & 15, fq = lane >> 4;
    constexpr int KW = Fn::KB / 8, NS = KW / 128;
    LAS f32x4* part = (LAS f32x4*)lds;
    for (int task = vcu; task < tm.ntask; task += G) {
        const int cb = task % tm.ncb, rb = tm.rb0 + (task / tm.ncb) * tm.rbstride;
        const unsigned char* ap = fn.arow(rb, cb, fr) + wave * KW + 32 * fq; const unsigned char* bp[4];
#pragma unroll
        for (int nb = 0; nb < 4; ++nb) bp[nb] = fn.brow(rb, cb, nb * 16 + fr) + wave * KW + 32 * fq;
        v4i a[NS][2], bb[NS][4][2];
#pragma unroll
        for (int s = 0; s < NS; ++s) { a[s][0] = *(const v4i*)(ap + s * 128); a[s][1] = *(const v4i*)(ap + s * 128 + 16);
#pragma unroll
            for (int nb = 0; nb < 4; ++nb) { bb[s][nb][0] = *(const v4i*)(bp[nb] + s * 128); bb[s][nb][1] = *(const v4i*)(bp[nb] + s * 128 + 16); } }
        f32x4 acc[4];
#pragma unroll
        for (int nb = 0; nb < 4; ++nb) acc[nb] = (f32x4){0.f, 0.f, 0.f, 0.f};
#pragma unroll
        for (int s = 0; s < NS; ++s)
#pragma unroll
            for (int nb = 0; nb < 4; ++nb) acc[nb] = __builtin_amdgcn_mfma_scale_f32_16x16x128_f8f6f4(__builtin_shufflevector(bb[s][nb][0], bb[s][nb][1], 0, 1, 2, 3, 4, 5, 6, 7),
                                                                                                     __builtin_shufflevector(a[s][0], a[s][1], 0, 1, 2, 3, 4, 5, 6, 7), acc[nb], 0, 0, 0, 0, 0, 0);
#pragma unroll
        for (int nb = 0; nb < 4; ++nb) part[(wave * 4 + nb) * 64 + lane] = acc[nb];
        __syncthreads();
        if (wave < 4 && (!Fn::PAIRED || wave < 2)) {
            const int nb = wave;
            f32x4 v = (f32x4){0.f, 0.f, 0.f, 0.f}, v2 = v;
#pragma unroll
            for (int w = 0; w < 8; ++w) { v += part[(w * 4 + nb) * 64 + lane]; if (Fn::PAIRED) v2 += part[(w * 4 + nb + 2) * 64 + lane]; }
            fn.epi_blk(rb, cb, nb, v, v2, fr, fq);
        }
        __syncthreads();
    }
}

template <int MI, class Fn>
__device__ __forceinline__ void wg_gemm_ksplit(const Fn& fn, const TaskMap tm, LAS unsigned char* lds, int vcu, int G, int tid_) {
    const int tid = opaque(tid_), lane = tid & 63, wave = __builtin_amdgcn_readfirstlane(tid >> 6), fr = lane & 15, fq = lane >> 4;
    constexpr int KW = Fn::K / 8, NS = KW / 32;
    LAS f32x4* part = (LAS f32x4*)lds;
    for (int task = vcu; task < tm.ntask; task += G) {
        const int cb = task % tm.ncb, rb = tm.rb0 + (task / tm.ncb) * tm.rbstride;
        const bf16* ap[MI]; const bf16* bp[4];
#pragma unroll
        for (int mi = 0; mi < MI; ++mi) ap[mi] = fn.arow(rb, cb, mi * 16 + fr) + wave * KW + 8 * fq;
#pragma unroll
        for (int nb = 0; nb < 4; ++nb) bp[nb] = fn.brow(rb, cb, nb * 16 + fr) + wave * KW + 8 * fq;
        f32x4 acc[MI][4];
#pragma unroll
        for (int mi = 0; mi < MI; ++mi)
#pragma unroll
            for (int nb = 0; nb < 4; ++nb) acc[mi][nb] = (f32x4){0.f, 0.f, 0.f, 0.f};
#pragma unroll
        for (int s0 = 0; s0 < NS; s0 += 4) {
            bf16x8 a[4][MI], bb[4][4];
#pragma unroll
            for (int s = 0; s < 4; ++s) if (s0 + s < NS) {
#pragma unroll
                for (int mi = 0; mi < MI; ++mi) a[s][mi] = *(const bf16x8*)(ap[mi] + (s0 + s) * 32);
#pragma unroll
                for (int nb = 0; nb < 4; ++nb) bb[s][nb] = *(const bf16x8*)(bp[nb] + (s0 + s) * 32); }
#pragma unroll
            for (int s = 0; s < 4; ++s) if (s0 + s < NS) {
#pragma unroll
                for (int mi = 0; mi < MI; ++mi)
#pragma unroll
                    for (int nb = 0; nb < 4; ++nb) acc[mi][nb] = __builtin_amdgcn_mfma_f32_16x16x32_bf16(bb[s][nb], a[s][mi], acc[mi][nb], 0, 0, 0); }
        }
#pragma unroll
        for (int mi = 0; mi < MI; ++mi)
#pragma unroll
            for (int nb = 0; nb < 4; ++nb) part[((wave * MI + mi) * 4 + nb) * 64 + lane] = acc[mi][nb];
        __syncthreads();
        if (wave < MI * 4) {
            const int mi = wave >> 2, nb = wave & 3;
            if (!Fn::PAIRED || nb < 2) {
                f32x4 v = (f32x4){0.f, 0.f, 0.f, 0.f}, v2 = v;
#pragma unroll
                for (int w = 0; w < 8; ++w) { v += part[((w * MI + mi) * 4 + nb) * 64 + lane]; if (Fn::PAIRED) v2 += part[((w * MI + mi) * 4 + nb + 2) * 64 + lane]; }
                fn.epi_blk(rb, cb, mi, nb, v, v2, fr, fq);
            }
        }
        __syncthreads();
    }
}

namespace pg8 {
constexpr int BM = 256, BK = 64, HALF = 128, HTB = HALF * BK * 2, STAGE_BYTES = 8 * HTB;
__device__ __forceinline__ int lds_byte(int r, int c) { const int st = (r >> 4) * 2 + (c >> 5), rr = r & 15, cc = c & 31, ob = rr * 64 + cc * 2; return st * 1024 + (ob ^ (((ob >> 9) & 1) << 5)); }
__device__ __forceinline__ void stage_rc(int b, int& R, int& C) { const int st = b / 1024, sb = b % 1024, swz = sb ^ (((sb >> 9) & 1) << 5); R = (st >> 1) * 16 + swz / 64; C = (st & 1) * 32 + (swz % 64) / 2; }
__device__ __forceinline__ int perm32(int rho) { const int n = rho >> 4, i = rho & 15; return 8 * (i >> 2) + 4 * n + (i & 3); }
struct Unit { int pm, pn, e; };
struct SchedStd {
    int nM, nN, nwg, G, c;
    __device__ __forceinline__ void init(int nM_, int nN_, int G_, int c_) { nM = nM_; nN = nN_; nwg = nM * nN; G = G_; c = c_; }
    __device__ __forceinline__ bool next(int i, Unit& u) const {
        const int L = i * G + c; if (L >= nwg) return false;
        int wgid = L; { const int q = nwg / 8, r = nwg % 8, xcd = wgid % 8, off = wgid / 8; wgid = (xcd < r ? xcd * (q + 1) : r * (q + 1) + (xcd - r) * q) + off; }
        const int nig = 8 * nN, gid = wgid / nig, fm = gid * 8, gsz = (nM - fm) < 8 ? (nM - fm) : 8;
        u.pm = fm + ((wgid % nig) % gsz); u.pn = (wgid % nig) / gsz; u.e = 0; return true;
    }
};
struct SchedMoe {
    int nN, total, G, c, rev, gm;
    __device__ __forceinline__ void init(int nN_, int G_, int c_, int rev_ = 0, int gm_ = 8) { nN = nN_; total = 16 * 16 * nN_; G = G_; c = c_; rev = rev_; gm = gm_; }
    __device__ __forceinline__ bool next(int i, Unit& u) const {
        const int L = i * G + c; if (L >= total) return false;
        const int off = rev ? (total / 8 - 1 - L / 8) : L / 8;
        const int wgid = (L % 8) * (total / 8) + off, per = 16 * nN, w = wgid % per, nig = gm * nN;
        u.e = wgid / per; u.pm = (w / nig) * gm + (w % nig) % gm; u.pn = (w % nig) / gm; return true;
    }
};
template <class Cfg>
__device__ __forceinline__ void gemm_phase(LAS unsigned char* lds, const Cfg& cfg) {
    const int tid = opaque((int)threadIdx.x), wid = __builtin_amdgcn_readfirstlane(tid >> 6), lane = tid & 63, wr = wid >> 2, wc = wid & 3, fr = lane & 15, fq = lane >> 4;
    constexpr bool F8 = Cfg::FP8;
    constexpr int nt = Cfg::KB / 128;
    int Rr[2], Cc[2]; unsigned voffB[2];
#pragma unroll
    for (int i = 0; i < 2; ++i) { stage_rc(tid * 16 + i * 8192, Rr[i], Cc[i]); const int R = Rr[i];
        const int Rb = Cfg::PERMX ? (((R >> 5) & 3) * 64 + 16 * ((R & 15) >> 2) + 4 * ((R >> 4) & 1) + (R & 3)) : (Cfg::PERM ? ((R & ~31) + perm32(R & 31)) : R);
        voffB[i] = (unsigned)Rb * (unsigned)Cfg::ldb + (unsigned)Cc[i] * 2u; }
    const size_t kstep = (size_t)(BK * 2);
    const size_t hstepB = (size_t)(Cfg::PERMX ? 8 : HALF) * Cfg::ldb;
    const unsigned ldsw = (unsigned)wid * 1024u;
    const int aoff = lds_byte(wr * 64 + fr, F8 ? fq * 16 : fq * 8), boff = lds_byte(wc * 32 + fr, F8 ? fq * 16 : fq * 8);

#define PG8_SA(b, h) (((b) * 2 + (h)) * HTB)
#define PG8_SB(b, h) ((4 + (b) * 2 + (h)) * HTB)
#define PG8_STAGE(bufoff, gbase, voff) do { _Pragma("unroll") for (int _i = 0; _i < 2; ++_i) \
        __builtin_amdgcn_global_load_lds((const unsigned*)((const char*)(gbase) + (voff)[_i]), (LAS unsigned*)(lds + (bufoff) + ldsw + _i * 8192), 16, 0, 0); } while (0)
typedef v8i v8i_a16 __attribute__((aligned(16)));
#define PG8_LD32(p) (*(const LAS v8i_a16*)(p))
#define PG8_LDA(dst, b, h) do { if constexpr (F8) { _Pragma("unroll") for (int m = 0; m < 4; ++m) dst##8[m] = PG8_LD32(lds + PG8_SA(b, h) + aoff + m * 2048); } \
        else { _Pragma("unroll") for (int m = 0; m < 4; ++m) _Pragma("unroll") for (int k = 0; k < 2; ++k) dst[m][k] = *(const LAS bf16x8*)(lds + PG8_SA(b, h) + aoff + m * 2048 + k * 1024); } } while (0)
#define PG8_LDB(dst, b, h) do { if constexpr (F8) { _Pragma("unroll") for (int n = 0; n < 2; ++n) dst##8[n] = PG8_LD32(lds + PG8_SB(b, h) + boff + n * 2048); } \
        else { _Pragma("unroll") for (int n = 0; n < 2; ++n) _Pragma("unroll") for (int k = 0; k < 2; ++k) dst[n][k] = *(const LAS bf16x8*)(lds + PG8_SB(b, h) + boff + n * 2048 + k * 1024); } } while (0)
#define PG8_MMA(ai, bj, At, Bt) do { __builtin_amdgcn_s_setprio(1); _Pragma("unroll") for (int m = 0; m < 4; ++m) _Pragma("unroll") for (int n = 0; n < 2; ++n) { \
        if constexpr (F8) asm volatile("v_mfma_f32_16x16x128_f8f6f4 %0, %1, %2, %0" : "+v"(acc[ai][bj][m][n]) : "v"(Bt##8[n]), "v"(At##8[m]));   \
        else { _Pragma("unroll") for (int k = 0; k < 2; ++k) acc[ai][bj][m][n] = __builtin_amdgcn_mfma_f32_16x16x32_bf16(Bt[n][k], At[m][k], acc[ai][bj][m][n], 0, 0, 0); } } __builtin_amdgcn_s_setprio(0); } while (0)
#define PG8_WAIT_V(n) asm volatile("s_waitcnt vmcnt(" #n ")" ::: "memory")
#define PG8_WAIT_L(n) asm volatile("s_waitcnt lgkmcnt(" #n ")" ::: "memory")
#define PG8_BAR __builtin_amdgcn_s_barrier()
#define PG8_SCHED __builtin_amdgcn_sched_barrier(0)
    Unit cur, nxt; int ui = 0;
    if (!cfg.next(0, cur)) return;
    f32x4 acc[2][2][4][2];
#pragma unroll
    for (int a = 0; a < 2; ++a)
#pragma unroll
        for (int b = 0; b < 2; ++b)
#pragma unroll
            for (int m = 0; m < 4; ++m)
#pragma unroll
                for (int n = 0; n < 2; ++n) acc[a][b][m][n] = (f32x4){0.f, 0.f, 0.f, 0.f};
    bf16x8 At[4][2], B0[2][2], B1[2][2]; v8i At8[4], B08[2], B18[2];
    unsigned voffA[2][2], voffAn[2][2];
    cfg.a_offs(cur, 0, Rr, Cc, voffA);
    const char* cA = cfg.a_base(cur); const char* cB = cfg.b_base(cur);
    PG8_STAGE(PG8_SB(0, 0), cB, voffB); PG8_STAGE(PG8_SB(0, 1), cB + hstepB, voffB); PG8_STAGE(PG8_SA(0, 0), cA, voffA[0]); PG8_STAGE(PG8_SA(0, 1), cA, voffA[1]);
    if (wr == 1) PG8_BAR;
    PG8_WAIT_V(2); PG8_BAR;
    PG8_STAGE(PG8_SB(1, 0), cB + kstep, voffB); PG8_STAGE(PG8_SA(1, 0), cA + kstep, voffA[0]); PG8_STAGE(PG8_SB(1, 1), cB + hstepB + kstep, voffB);
    PG8_WAIT_V(6); PG8_BAR;
    for (;;) {
        const bool has_next = cfg.next(ui + 1, nxt);
        const char* nA = has_next ? cfg.a_base(nxt) : cA; const char* nB = has_next ? cfg.b_base(nxt) : cB;
#pragma unroll 1
        for (int t = 0; t < nt; t += 2) {
            const bool last = (t == nt - 2);
            const char* a1 = cA + (size_t)(t + 1) * kstep;
            const char* a2 = last ? nA : cA + (size_t)(t + 2) * kstep; const char* b2 = last ? nB : cB + (size_t)(t + 2) * kstep;
            const char* a3 = a2 + kstep; const char* b3 = b2 + kstep;
            unsigned o2[2][2];
            if constexpr (Cfg::GATHER) {
                if (last) { if (has_next) { int R2[2], C2[2]; stage_rc(tid * 16, R2[0], C2[0]); stage_rc(tid * 16 + 8192, R2[1], C2[1]); cfg.a_offs(nxt, ui + 1, R2, C2, voffAn); } else {
#pragma unroll
                    for (int h = 0; h < 2; ++h) { voffAn[h][0] = voffA[h][0]; voffAn[h][1] = voffA[h][1]; } } }
#pragma unroll
                for (int h = 0; h < 2; ++h) { o2[h][0] = last ? voffAn[h][0] : voffA[h][0]; o2[h][1] = last ? voffAn[h][1] : voffA[h][1]; }
            } else {
#pragma unroll
                for (int h = 0; h < 2; ++h) { o2[h][0] = voffA[h][0]; o2[h][1] = voffA[h][1]; }
            }
            PG8_LDB(B0, 0, 0); PG8_LDB(B1, 0, 1); PG8_SCHED; PG8_LDA(At, 0, 0); PG8_STAGE(PG8_SA(1, 1), a1, voffA[1]);
            PG8_WAIT_V(8); PG8_WAIT_L(0); PG8_BAR; PG8_MMA(0, 0, At, B0); PG8_MMA(0, 1, At, B1); PG8_BAR; PG8_SCHED;
            PG8_LDA(At, 0, 1); PG8_STAGE(PG8_SB(0, 0), b2, voffB); PG8_STAGE(PG8_SB(0, 1), b2 + hstepB, voffB); PG8_STAGE(PG8_SA(0, 0), a2, o2[0]);
            PG8_WAIT_V(8); PG8_WAIT_L(0); PG8_BAR; PG8_MMA(1, 0, At, B0); PG8_MMA(1, 1, At, B1); PG8_BAR; PG8_SCHED;
            PG8_LDB(B0, 1, 0); PG8_LDB(B1, 1, 1); PG8_SCHED; PG8_LDA(At, 1, 0); PG8_STAGE(PG8_SA(0, 1), a2, o2[1]);
            PG8_WAIT_V(8); PG8_WAIT_L(0); PG8_BAR; PG8_MMA(0, 0, At, B0); PG8_MMA(0, 1, At, B1); PG8_BAR; PG8_SCHED;
            PG8_LDA(At, 1, 1); PG8_STAGE(PG8_SB(1, 0), b3, voffB); PG8_STAGE(PG8_SB(1, 1), b3 + hstepB, voffB); PG8_STAGE(PG8_SA(1, 0), a3, o2[0]);
            PG8_WAIT_V(8); PG8_WAIT_L(0); PG8_BAR; PG8_MMA(1, 0, At, B0); PG8_MMA(1, 1, At, B1); PG8_BAR; PG8_SCHED;
        }
        if (wr == 0) PG8_BAR;
        if constexpr (F8) asm volatile("s_nop 15\n\ts_nop 15" ::: "memory");
        cfg.epi(acc, cur, wr, wc, fr, fq);
        if (!has_next) break;
#pragma unroll
        for (int a = 0; a < 2; ++a)
#pragma unroll
            for (int b = 0; b < 2; ++b)
#pragma unroll
                for (int m = 0; m < 4; ++m)
#pragma unroll
                    for (int n = 0; n < 2; ++n) acc[a][b][m][n] = (f32x4){0.f, 0.f, 0.f, 0.f};
        cur = nxt; cA = nA; cB = nB; ++ui;
        if constexpr (Cfg::GATHER) {
#pragma unroll
            for (int h = 0; h < 2; ++h) { voffA[h][0] = voffAn[h][0]; voffA[h][1] = voffAn[h][1]; } }
        if (wr == 1) PG8_BAR;
    }
    PG8_WAIT_V(0);
    PG8_BAR;
#undef PG8_SA
#undef PG8_SB
#undef PG8_STAGE
#undef PG8_LDA
#undef PG8_LDB
#undef PG8_MMA
#undef PG8_LD32
#undef PG8_WAIT_V
#undef PG8_WAIT_L
#undef PG8_BAR
#undef PG8_SCHED
}
template <int LDA> __device__ __forceinline__ void lin_offs(const int (&R)[2], const int (&C)[2], unsigned (&off)[2][2]) {
#pragma unroll
    for (int h = 0; h < 2; ++h)
#pragma unroll
        for (int i = 0; i < 2; ++i) off[h][i] = (unsigned)(h * HALF + R[i]) * (unsigned)LDA + (unsigned)C[i] * 2u;
}
struct CfgPool {
    static constexpr bool PERMX = false; static constexpr bool GATHER = false; static constexpr bool FP8 = false; static constexpr int KB = 256 * 2; static constexpr bool PERM = true; static constexpr int K = 256, ldb = 512;
    SchedStd S; const bf16* P; const bf16* W; bf16* H; const float* scale;
    __device__ __forceinline__ bool next(int i, Unit& u) const { return S.next(i, u); }
    __device__ __forceinline__ const char* a_base(const Unit& u) const { return (const char*)(P + (size_t)u.pm * 256 * D + u.pn * 256); }
    __device__ __forceinline__ void a_offs(const Unit&, int, const int (&R)[2], const int (&C)[2], unsigned (&off)[2][2]) const { lin_offs<2048>(R, C, off); }
    __device__ __forceinline__ const char* b_base(const Unit& u) const { return (const char*)(W + (size_t)u.pn * 65536); }
    __device__ __forceinline__ void epi(const f32x4 (&acc)[2][2][4][2], const Unit& u, int wr, int wc, int fr, int fq) const {
        const int row0 = u.pm * 256 + wr * 64 + fr, col0 = u.pn * 256 + wc * 32 + 8 * fq;
        f32x4 sc[2][2];
#pragma unroll
        for (int bj = 0; bj < 2; ++bj)
#pragma unroll
            for (int n = 0; n < 2; ++n) sc[bj][n] = *(const f32x4*)(scale + col0 + bj * 128 + n * 4);
#pragma unroll
        for (int ai = 0; ai < 2; ++ai) {
            u32x4 hw[4][2];
#pragma unroll
            for (int m = 0; m < 4; ++m)
#pragma unroll
                for (int bj = 0; bj < 2; ++bj) hw[m][bj] = *(const u32x4*)(H + (size_t)(row0 + ai * 128 + m * 16) * D + col0 + bj * 128);
            asm volatile("" ::: "memory");
#pragma unroll
            for (int m = 0; m < 4; ++m) { bf16* rowp = H + (size_t)(row0 + ai * 128 + m * 16) * D + col0;
#pragma unroll
                for (int bj = 0; bj < 2; ++bj) { const u32x4 w = hw[m][bj];
                    const f32x4 o0 = (f32x4){bflo(w.x), bfhi(w.x), bflo(w.y), bfhi(w.y)} + acc[ai][bj][m][0] * sc[bj][0], o1 = (f32x4){bflo(w.z), bfhi(w.z), bflo(w.w), bfhi(w.w)} + acc[ai][bj][m][1] * sc[bj][1];
                    u32x4 ow; ow.x = cvt_pk_bf16(o0.x, o0.y); ow.y = cvt_pk_bf16(o0.z, o0.w); ow.z = cvt_pk_bf16(o1.x, o1.y); ow.w = cvt_pk_bf16(o1.z, o1.w);
                    *(u32x4*)(rowp + bj * 128) = ow; } }
            asm volatile("" ::: "memory");
        }
    }
};
struct CfgOut {
    static constexpr bool PERMX = false; static constexpr bool GATHER = false; static constexpr bool FP8 = false; static constexpr int KB = 1024 * 2; static constexpr bool PERM = true; static constexpr int K = 1024, ldb = 2048;
    SchedStd S; const bf16* A; const bf16* W; bf16* H;
    __device__ __forceinline__ bool next(int i, Unit& u) const { return S.next(i, u); }
    __device__ __forceinline__ const char* a_base(const Unit& u) const { return (const char*)(A + (size_t)u.pm * 256 * D); }
    __device__ __forceinline__ void a_offs(const Unit&, int, const int (&R)[2], const int (&C)[2], unsigned (&off)[2][2]) const { lin_offs<2048>(R, C, off); }
    __device__ __forceinline__ const char* b_base(const Unit& u) const { return (const char*)(W + (size_t)u.pn * 256 * 1024); }
    __device__ __forceinline__ void epi(const f32x4 (&acc)[2][2][4][2], const Unit& u, int wr, int wc, int fr, int fq) const {
        const int row0 = u.pm * 256 + wr * 64 + fr, col0 = u.pn * 256 + wc * 32 + 8 * fq;
#pragma unroll
        for (int ai = 0; ai < 2; ++ai) {
            u32x4 hw[4][2];
#pragma unroll
            for (int m = 0; m < 4; ++m)
#pragma unroll
                for (int bj = 0; bj < 2; ++bj) hw[m][bj] = *(const u32x4*)(H + (size_t)(row0 + ai * 128 + m * 16) * D + col0 + bj * 128);
            asm volatile("" ::: "memory");
#pragma unroll
            for (int m = 0; m < 4; ++m) { bf16* rowp = H + (size_t)(row0 + ai * 128 + m * 16) * D + col0;
#pragma unroll
                for (int bj = 0; bj < 2; ++bj) { const u32x4 w = hw[m][bj];
                    const f32x4 o0 = (f32x4){bflo(w.x), bfhi(w.x), bflo(w.y), bfhi(w.y)} + acc[ai][bj][m][0], o1 = (f32x4){bflo(w.z), bfhi(w.z), bflo(w.w), bfhi(w.w)} + acc[ai][bj][m][1];
                    u32x4 ow; ow.x = cvt_pk_bf16(o0.x, o0.y); ow.y = cvt_pk_bf16(o0.z, o0.w); ow.z = cvt_pk_bf16(o1.x, o1.y); ow.w = cvt_pk_bf16(o1.z, o1.w);
                    *(u32x4*)(rowp + bj * 128) = ow; } }
            asm volatile("" ::: "memory");
        }
    }
};
struct CfgIn {
    static constexpr bool PERMX = false; static constexpr bool GATHER = false; static constexpr bool FP8 = false; static constexpr int KB = 1024 * 2; static constexpr bool PERM = true; static constexpr int K = 1024, ldb = 2048;
    SchedStd S; const bf16* U; const bf16* W; bf16* XB; bf16* GY; const float* RS;
    __device__ __forceinline__ bool next(int i, Unit& u) const { return S.next(i, u); }
    __device__ __forceinline__ const char* a_base(const Unit& u) const { return (const char*)(U + (size_t)u.pm * 256 * D); }
    __device__ __forceinline__ void a_offs(const Unit&, int, const int (&R)[2], const int (&C)[2], unsigned (&off)[2][2]) const { lin_offs<2048>(R, C, off); }
    __device__ __forceinline__ const char* b_base(const Unit& u) const { return (const char*)(W + (size_t)u.pn * 256 * 1024); }
    __device__ __forceinline__ void epi(const f32x4 (&acc)[2][2][4][2], const Unit& u, int wr, int wc, int fr, int fq) const {
        const int row0 = u.pm * 256 + wr * 64 + fr, col0 = (u.pn & 3) * 256 + wc * 32 + 8 * fq; const bool act = u.pn >= 4; bf16* base = act ? GY : XB;
        float rs[2][4];
#pragma unroll
        for (int ai = 0; ai < 2; ++ai)
#pragma unroll
            for (int m = 0; m < 4; ++m) rs[ai][m] = RS[row0 + ai * 128 + m * 16];
#pragma unroll
        for (int ai = 0; ai < 2; ++ai)
#pragma unroll
            for (int m = 0; m < 4; ++m) { bf16* rowp = base + (size_t)(row0 + ai * 128 + m * 16) * D + col0;
#pragma unroll
                for (int bj = 0; bj < 2; ++bj) { f32x4 v0 = acc[ai][bj][m][0] * rs[ai][m], v1 = acc[ai][bj][m][1] * rs[ai][m];
                    if (act) { v0.x = gelu_tanh(v0.x); v0.y = gelu_tanh(v0.y); v0.z = gelu_tanh(v0.z); v0.w = gelu_tanh(v0.w); v1.x = gelu_tanh(v1.x); v1.y = gelu_tanh(v1.y); v1.z = gelu_tanh(v1.z); v1.w = gelu_tanh(v1.w); }
                    u32x4 w; w.x = cvt_pk_bf16(v0.x, v0.y); w.y = cvt_pk_bf16(v0.z, v0.w); w.z = cvt_pk_bf16(v1.x, v1.y); w.w = cvt_pk_bf16(v1.z, v1.w);
                    *(u32x4*)(rowp + bj * 128) = w; } }
    }
};
struct CfgGates {
    static constexpr bool PERMX = false; static constexpr bool GATHER = false; static constexpr bool FP8 = false; static constexpr int KB = 256 * 2; static constexpr bool PERM = true; static constexpr int K = 256, ldb = 512;
    SchedStd S; const bf16* XC; const bf16* W; bf16* LA; bf16* BV; const float* bg; const float* lam;
    __device__ __forceinline__ bool next(int i, Unit& u) const { return S.next(i, u); }
    __device__ __forceinline__ const char* a_base(const Unit& u) const { return (const char*)(XC + (size_t)u.pm * 256 * D + ((u.pn & 7) >> 1) * 256); }
    __device__ __forceinline__ void a_offs(const Unit&, int, const int (&R)[2], const int (&C)[2], unsigned (&off)[2][2]) const { lin_offs<2048>(R, C, off); }
    __device__ __forceinline__ const char* b_base(const Unit& u) const { return (const char*)(W + (size_t)u.pn * 65536); }
    __device__ __forceinline__ void epi(const f32x4 (&acc)[2][2][4][2], const Unit& u, int wr, int wc, int fr, int fq) const {
        const int d = u.pn >> 3, ch0 = (u.pn & 7) * 128 + wc * 32 + 8 * fq, row0 = u.pm * 256 + wr * 64 + fr;
        float br[8], bi[8], sp[8];
#pragma unroll
        for (int q = 0; q < 2; ++q) { const f32x4 a = *(const f32x4*)(bg + (d * 2 + 0) * D + ch0 + 4 * q), b = *(const f32x4*)(bg + (d * 2 + 1) * D + ch0 + 4 * q), l = *(const f32x4*)(lam + d * D + ch0 + 4 * q);
#pragma unroll
            for (int x = 0; x < 4; ++x) { br[4 * q + x] = a[x]; bi[4 * q + x] = b[x]; sp[4 * q + x] = l[x]; } }
        bool sl = false;
#pragma unroll
        for (int q = 0; q < 8; ++q) sl |= sp[q] < -0.25f;
        const bool slow = __any(sl);
        u32x4 xin[2][4];
#pragma unroll
        for (int ai = 0; ai < 2; ++ai)
#pragma unroll
            for (int m = 0; m < 4; ++m) xin[ai][m] = *(const u32x4*)(XC + (size_t)(row0 + ai * 128 + m * 16) * D + ch0);
        asm volatile("" ::: "memory");
#pragma unroll
        for (int ai = 0; ai < 2; ++ai)
#pragma unroll
            for (int m = 0; m < 4; ++m) { const size_t ro = (size_t)(row0 + ai * 128 + m * 16) * D + ch0;
                const u32x4 xw = xin[ai][m];
                const float xv[8] = {bflo(xw.x), bfhi(xw.x), bflo(xw.y), bfhi(xw.y), bflo(xw.z), bfhi(xw.z), bflo(xw.w), bfhi(xw.w)};
                float la[8], bv[8];
#pragma unroll
                for (int q = 0; q < 8; q += 2) { f32x2 l2, b2;
                    lru_gate2((f32x2){acc[ai][0][m][q >> 2][q & 3] + br[q], acc[ai][0][m][q >> 2][(q & 3) + 1] + br[q + 1]}, (f32x2){acc[ai][1][m][q >> 2][q & 3] + bi[q], acc[ai][1][m][q >> 2][(q & 3) + 1] + bi[q + 1]},
                              (f32x2){sp[q], sp[q + 1]}, (f32x2){xv[q], xv[q + 1]}, slow, l2, b2);
                    la[q] = l2.x; la[q + 1] = l2.y; bv[q] = b2.x; bv[q + 1] = b2.y; }
                { u32x2 w8; w8.x = pk4_u8(la[0], la[1], la[2], la[3]); w8.y = pk4_u8(la[4], la[5], la[6], la[7]); *(u32x2*)((unsigned char*)LA + (size_t)d * MPAD * D + ro) = w8; }
                u32x4 w; w.x = cvt_pk_bf16(bv[0], bv[1]); w.y = cvt_pk_bf16(bv[2], bv[3]); w.z = cvt_pk_bf16(bv[4], bv[5]); w.w = cvt_pk_bf16(bv[6], bv[7]);
                *(u32x4*)(BV + (size_t)d * MPAD * D + ro) = w; }
    }
};
struct CfgM1 {
    static constexpr bool PERMX = false; static constexpr bool GATHER = true; static constexpr bool FP8 = true; static constexpr int KB = 1024; static constexpr bool PERM = true; static constexpr int K = 1024, ldb = 1024;
    SchedMoe S; const unsigned char* U; const unsigned char* W; unsigned char* HID; const LAS unsigned short* idx;
    __device__ __forceinline__ bool next(int i, Unit& u) const { return S.next(i, u); }
    __device__ __forceinline__ const char* a_base(const Unit&) const { return (const char*)U; }
    __device__ __forceinline__ void a_offs(const Unit&, int ui, const int (&R)[2], const int (&C)[2], unsigned (&off)[2][2]) const {
#pragma unroll
        for (int h = 0; h < 2; ++h)
#pragma unroll
            for (int i = 0; i < 2; ++i) off[h][i] = (unsigned)idx[ui * 256 + h * HALF + R[i]] * 1024u + (unsigned)C[i] * 2u;
    }
    __device__ __forceinline__ const char* b_base(const Unit& u) const { return (const char*)(W + ((size_t)u.e * 4096 + u.pn * 256) * 1024); }
    __device__ __forceinline__ void epi(const f32x4 (&acc)[2][2][4][2], const Unit& u, int wr, int wc, int fr, int fq) const {
        const int row0 = u.e * EPAD + u.pm * 256 + wr * 64 + fr, col0 = u.pn * 128 + wc * 32 + 8 * fq;
#pragma unroll
        for (int ai = 0; ai < 2; ++ai)
#pragma unroll
            for (int m = 0; m < 4; ++m) { const f32x4 g0 = acc[ai][0][m][0], g1 = acc[ai][0][m][1], u0 = acc[ai][1][m][0], u1 = acc[ai][1][m][1];
                u32x2 w; w.x = pk4_fp8(silu_mul_s(g0.x, u0.x), silu_mul_s(g0.y, u0.y), silu_mul_s(g0.z, u0.z), silu_mul_s(g0.w, u0.w));
                w.y = pk4_fp8(silu_mul_s(g1.x, u1.x), silu_mul_s(g1.y, u1.y), silu_mul_s(g1.z, u1.z), silu_mul_s(g1.w, u1.w));
                *(u32x2*)(HID + (size_t)(row0 + ai * 128 + m * 16) * HIDP8 + col0) = w; }
    }
};
struct CfgM2 {
    static constexpr bool PERMX = true; static constexpr bool GATHER = false; static constexpr bool FP8 = true; static constexpr int KB = 2048; static constexpr bool PERM = true; static constexpr int K = 2048, ldb = WDP8;
    SchedMoe S; const unsigned char* HID; const unsigned char* W; bf16* Y;
    __device__ __forceinline__ bool next(int i, Unit& u) const { return S.next(i, u); }
    __device__ __forceinline__ const char* a_base(const Unit& u) const { return (const char*)(HID + ((size_t)u.e * EPAD + u.pm * 256) * HIDP8); }
    __device__ __forceinline__ void a_offs(const Unit&, int, const int (&R)[2], const int (&C)[2], unsigned (&off)[2][2]) const { lin_offs<HIDP8>(R, C, off); }
    __device__ __forceinline__ const char* b_base(const Unit& u) const { return (const char*)(W + ((size_t)u.e * 1024 + u.pn * 256) * WDP8); }
    __device__ __forceinline__ void epi(const f32x4 (&acc)[2][2][4][2], const Unit& u, int wr, int wc, int fr, int fq) const {
        const int row0 = u.e * EPAD + u.pm * 256 + wr * 64 + fr, col0 = u.pn * 256 + wc * 64 + 16 * fq;
#pragma unroll
        for (int ai = 0; ai < 2; ++ai)
#pragma unroll
            for (int m = 0; m < 4; ++m) { const f32x4 v0 = acc[ai][0][m][0] * WINV, v1 = acc[ai][0][m][1] * WINV, v2 = acc[ai][1][m][0] * WINV, v3 = acc[ai][1][m][1] * WINV;
                u32x4 w; w.x = pk4_fp8(v0.x, v0.y, v0.z, v0.w); w.y = pk4_fp8(v1.x, v1.y, v1.z, v1.w); w.z = pk4_fp8(v2.x, v2.y, v2.z, v2.w); w.w = pk4_fp8(v3.x, v3.y, v3.z, v3.w);
                *(u32x4*)((unsigned char*)Y + (size_t)(row0 + ai * 128 + m * 16) * D + col0) = w; }
    }
};
}

#ifndef FAST_PG
#define FAST_PG 1
#endif
#ifndef FAST_LIN
#define FAST_LIN 1
#endif
#ifndef FAST_LGT
#define FAST_LGT 1
#endif
#ifndef FAST_LOUT
#define FAST_LOUT 1
#endif
#ifndef FAST_M1
#define FAST_M1 1
#endif
#ifndef FAST_M2
#define FAST_M2 1
#endif
constexpr int IDX_OFF = RING_BYTES + 1024;

#ifndef REP_PRO
#define REP_PRO 1
#endif
#ifndef REP_PP
#define REP_PP 1
#endif
#ifndef REP_LIN
#define REP_LIN 1
#endif
#ifndef REP_LCV
#define REP_LCV 1
#endif
#ifndef REP_LGT
#define REP_LGT 1
#endif
#ifndef REP_LS1
#define REP_LS1 1
#endif
#ifndef REP_LS3
#define REP_LS3 1
#endif
#ifndef REP_RB
#define REP_RB 1
#endif
#ifndef REP_TK
#define REP_TK 1
#endif
#ifndef REP_M1
#define REP_M1 1
#endif
#ifndef REP_M2
#define REP_M2 1
#endif
#ifndef REP_RA
#define REP_RA 1
#endif
#ifndef REP_LOUT
#define REP_LOUT 1
#endif
#ifndef REP_PG
#define REP_PG 1
#endif
#define REPEAT(n) _Pragma("unroll") for (int rep_ = 0; rep_ < (n); ++rep_)
#define IN(k) (lo <= (k) && (k) < hi)
#define SEAM(k) do { if ((k) + 1 < hi) xcd_barrier(bar); } while (0)
template <int layer>
__device__ __forceinline__ void run_layer(const Frame& F, const int lo, const int hi, const XcdBarrier& bar) {
    const int gw = F.vcu * 8 + F.wave, NGW = F.G * 8;
    const bool fast = (F.G == 256);
    {
        const int pb = layer * 16, j = layer >> 1;
        if (IN(pb + 0)) { if constexpr (layer == 0) REPEAT(REP_PRO) phase_prologue(F); if (REP_RA > 1) phase_rowA<false, layer == 0, true>(F, layer); phase_rowA<false, layer == 0>(F, layer); SEAM(pb + 0); }
        if constexpr ((layer & 1) == 0) {
            if (IN(pb + 1)) { REPEAT(REP_PP) phase_poolwin(F, layer); SEAM(pb + 1); }
            if (IN(pb + 2)) { FnPool fn{F.P, F.WPOOL + (size_t)j * 4 * 65536, F.H, F.pool_scale + (size_t)j * D};
                if (FAST_PG && fast) { pg8::CfgPool cfg; cfg.S.init(128, 4, F.G, (int)blockIdx.x); cfg.P = F.P; cfg.W = fn.W; cfg.scale = fn.scale; if (REP_PG > 1) { cfg.H = (bf16*)F.HF; pg8::gemm_phase(F.lds, cfg); } cfg.H = F.H; pg8::gemm_phase(F.lds, cfg);
                    wg_gemm_ksplit<2>(fn, TaskMap{4 * 16, 16, 1024, 1}, F.lds, F.vcu, F.G, F.tid); }
                else wave_gemm(fn, TaskMap{FnPool::nrb * 16, 16, 0, 1}, gw, NGW, F.lane);
                SEAM(pb + 2); }
        } else {
            if (IN(pb + 3)) { REPEAT(REP_LIN) { FnIn fn{F.H, F.WIN + (size_t)j * 2048 * 1024, F.XB, F.GY, F.RSTD};
                if (FAST_LIN && fast) { pg8::CfgIn cfg; cfg.S.init(128, 8, F.G, (int)blockIdx.x); cfg.U = F.H; cfg.W = fn.W; cfg.XB = F.XB; cfg.GY = F.GY; cfg.RS = F.RSTD; pg8::gemm_phase(F.lds, cfg);
                    wg_gemm_ksplit<2>(fn, TaskMap{4 * 32, 32, 1024, 1}, F.lds, F.vcu, F.G, F.tid); }
                else wave_gemm(fn, TaskMap{FnIn::nrb * 32, 32, 0, 1}, gw, NGW, F.lane);
                } SEAM(pb + 3); }
            if (IN(pb + 4)) { REPEAT(REP_LCV) phase_conv(F, j); SEAM(pb + 4); }
            if (IN(pb + 5)) { REPEAT(REP_LGT) { FnGates fn{F.P, F.WGT + (size_t)j * 16 * 65536, F.LA, F.BV, F.b_gates + (size_t)j * 4 * D, F.SPT + (size_t)j * 2 * D};
                if (FAST_LGT && fast) { pg8::CfgGates cfg; cfg.S.init(128, 16, F.G, (int)blockIdx.x); cfg.XC = F.P; cfg.W = fn.W; cfg.LA = F.LA; cfg.BV = F.BV; cfg.bg = fn.bg; cfg.lam = fn.lam; pg8::gemm_phase(F.lds, cfg);
                    wg_gemm_ksplit<2>(fn, TaskMap{4 * 64, 64, 1024, 1}, F.lds, F.vcu, F.G, F.tid); }
                else wave_gemm(fn, TaskMap{FnGates::nrb * 64, 64, 0, 1}, gw, NGW, F.lane);
                } SEAM(pb + 5); }
            if (IN(pb + 6)) { REPEAT(REP_LS1) phase_scan1(F, j); SEAM(pb + 6); }
            if (IN(pb + 7)) { REPEAT(REP_LS3) phase_scan3(F, j); SEAM(pb + 7); }
            if (IN(pb + 8)) { FnOut fn{F.HG, F.WOUT + (size_t)j * 1024 * 1024, F.H};
                if (FAST_LOUT && fast) { pg8::CfgOut cfg; cfg.S.init(128, 4, F.G, (int)blockIdx.x); cfg.A = F.HG; cfg.W = fn.W; if (REP_LOUT > 1) { cfg.H = (bf16*)F.HF; pg8::gemm_phase(F.lds, cfg); } cfg.H = F.H; pg8::gemm_phase(F.lds, cfg);
                    wg_gemm_ksplit<2>(fn, TaskMap{4 * 16, 16, 1024, 1}, F.lds, F.vcu, F.G, F.tid); }
                else wave_gemm(fn, TaskMap{FnOut::nrb * 16, 16, 0, 1}, gw, NGW, F.lane);
                SEAM(pb + 8); }
        }
        if (IN(pb + 9)) { REPEAT(REP_RB) phase_rowB(F, layer); SEAM(pb + 9); }
        if (IN(pb + 10)) { REPEAT(REP_TK) phase_topk(F); SEAM(pb + 10); }
        if (IN(pb + 11)) { REPEAT(REP_M1) { FnM1f8 fn{(const unsigned char*)F.U, (const unsigned char*)F.WG1 + (size_t)layer * NE * 4096 * 1024, F.ROWL, (unsigned char*)F.HID};
            if (FAST_M1 && fast) { pg8::CfgM1 cfg; cfg.S.init(16, F.G, (int)blockIdx.x, 0, 4); cfg.U = fn.U; cfg.W = fn.W; cfg.HID = fn.HID;
                LAS unsigned short* idx = (LAS unsigned short*)(F.lds + IDX_OFF); cfg.idx = idx;
                {
                    int rl[16];
#pragma unroll
                    for (int ui = 0; ui < 16; ++ui) { pg8::Unit u; const bool ok = cfg.S.next(ui, u); rl[ui] = F.ROWL[(ok ? u.e * EPAD + u.pm * 256 : 0) + (F.tid & 255)]; }
#pragma unroll
                    for (int ui = 0; ui < 16; ++ui) if (F.tid < 256) idx[ui * 256 + F.tid] = (unsigned short)rl[ui];
                }
                __syncthreads();
                pg8::gemm_phase(F.lds, cfg);
                wg_gemm_ksplit8(fn, TaskMap{16 * 64, 64, ERB16 - 1, ERB16}, F.lds, F.vcu, F.G, F.tid); }
            else wg_gemm_ksplit8(fn, TaskMap{NE * ERB16 * 64, 64, 0, 1}, F.lds, F.vcu, F.G, F.tid);
            } SEAM(pb + 11); }
        if (IN(pb + 12)) { REPEAT(REP_M2) { FnM2f8 fn{(const unsigned char*)F.HID, (const unsigned char*)F.WD + (size_t)layer * NE * 1024 * WDP8, F.Y};
            if (FAST_M2 && fast) { pg8::CfgM2 cfg; cfg.S.init(4, F.G, (int)blockIdx.x); cfg.HID = fn.HID; cfg.W = fn.W; cfg.Y = F.Y; pg8::gemm_phase(F.lds, cfg);
                wg_gemm_ksplit8(fn, TaskMap{16 * 16, 16, ERB16 - 1, ERB16}, F.lds, F.vcu, F.G, F.tid); }
            else wg_gemm_ksplit8(fn, TaskMap{NE * ERB16 * 16, 16, 0, 1}, F.lds, F.vcu, F.G, F.tid);
            } SEAM(pb + 12); }
    }
}
#undef IN
#undef SEAM

__global__ void __launch_bounds__(512, 2) mega(Args args) {
    extern __shared__ __attribute__((aligned(16))) unsigned char lds_raw[];
    Frame F;
    F.lds = (LAS unsigned char*)lds_raw;
    F.tid = threadIdx.x; F.lane = F.tid & 63; F.wave = __builtin_amdgcn_readfirstlane(F.tid >> 6);
    F.G = gridDim.x; { const int bx = blockIdx.x; F.vcu = (F.G % 8 == 0) ? (bx % 8) * (F.G / 8) + bx / 8 : bx; }
    F.x = args.in[0]; F.meta = args.in[1]; F.norm_mix = args.in[2]; F.norm_ffn = args.in[3]; F.norm_final = args.in[4]; F.pool_w = args.in[5]; F.pool_scale = args.in[6]; F.w_in = args.in[7]; F.conv_w = args.in[8];
    F.conv_b = args.in[9]; F.w_gates = args.in[10]; F.b_gates = args.in[11]; F.lam = args.in[12]; F.w_out = args.in[13]; F.router_w = args.in[14]; F.moe_g = args.in[15]; F.moe_u = args.in[16]; F.moe_d = args.in[17];
    F.out = args.out; F.ws = args.ws;
    unsigned char* ws = args.ws;
    F.WG1 = (bf16*)(ws + WS_WG1); F.WD = (bf16*)(ws + WS_WD); F.WIN = (bf16*)(ws + WS_WIN); F.WGT = (bf16*)(ws + WS_WGT); F.WOUT = (bf16*)(ws + WS_WOUT); F.WPOOL = (bf16*)(ws + WS_WPOOL);
    F.H = (bf16*)(ws + WS_H); F.U = (bf16*)(ws + WS_U); F.P = (bf16*)(ws + WS_P); F.XB = (bf16*)(ws + WS_XB); F.GY = (bf16*)(ws + WS_GY); F.HG = (bf16*)(ws + WS_HG); F.HF = (float*)(ws + WS_Y);
    F.LA = (bf16*)(ws + WS_BIG); F.BV = (bf16*)(ws + WS_BIG + 2 * LA_BYTES); F.HID = (bf16*)(ws + WS_BIG); F.Y = (bf16*)(ws + WS_Y);
    F.AFF = (float*)(ws + WS_AFF); F.SLOT = (int*)(ws + WS_SLOT); F.GMAP = (float*)(ws + WS_GMAP); F.ROWL = (int*)(ws + WS_ROWL); F.AGG = (float*)(ws + WS_AGG); F.SPT = (float*)(ws + WS_SPT); F.RSTD = (float*)(ws + WS_RSTD);
    volatile LAS unsigned* MISC = (volatile LAS unsigned*)(F.lds + MISC_OFF);
    if (F.tid < 32) MISC[F.tid] = 0u;
    __syncthreads();
    const int lo = args.lo, hi = args.hi;
    const bool multi = (hi - lo) > 1;
    XcdBarrier bar; bar.bar = (unsigned*)(ws + WS_CTL) + CW_BAR; bar.x = 0; bar.st = nullptr;
    if (multi) bar = xcd_barrier_post((unsigned*)(ws + WS_CTL) + CW_BAR, MISC + 8);
#define IN(k) (lo <= (k) && (k) < hi)
#define SEAM(k) do { if ((k) + 1 < hi) xcd_barrier(bar); } while (0)
    run_layer<0>(F, lo, hi, bar); run_layer<1>(F, lo, hi, bar); run_layer<2>(F, lo, hi, bar); run_layer<3>(F, lo, hi, bar);
    if (IN(64)) { if (REP_RA > 1) phase_rowA<true, false>(F, DEPTH); phase_rowA<true, false>(F, DEPTH); }
#undef IN
#undef SEAM
}

extern "C" void kernel_launch(void* const* d_in, const int* in_sizes, int n_in, void* d_out, int out_size, void* d_ws, size_t ws_size, hipStream_t stream) {
    static int grid = 0;
    if (grid == 0) {
        if (n_in != 18 || in_sizes[0] != NB * SEQ * D || out_size != NB * SEQ * D || ws_size < WS_END) {
            fprintf(stderr, "kernel_launch: unexpected shapes (n_in %d, in0 %d, out %d, ws %zu < %zu)\n", n_in, n_in > 0 ? in_sizes[0] : -1, out_size, ws_size, (size_t)WS_END); grid = -1; return; }
        int dev = 0, cus = 0;
        if (hipGetDevice(&dev) != hipSuccess || hipDeviceGetAttribute(&cus, hipDeviceAttributeMultiprocessorCount, dev) != hipSuccess) { grid = -1; return; }
        if (hipFuncSetAttribute((const void*)mega, hipFuncAttributeMaxDynamicSharedMemorySize, LDS_BYTES) != hipSuccess) { fprintf(stderr, "kernel_launch: hipFuncSetAttribute failed\n"); grid = -1; return; }
        int per_cu = 0;
        if (hipOccupancyMaxActiveBlocksPerMultiprocessor(&per_cu, (const void*)mega, 512, LDS_BYTES) != hipSuccess || per_cu < 1) fprintf(stderr, "kernel_launch: occupancy query reports %d\n", per_cu);
        (void)hipGetLastError();
        grid = cus;
    }
    if (grid < 0) return;
    if (hipMemsetAsync((char*)d_ws + WS_CTL, 0, CTL_ZERO_BYTES, stream) != hipSuccess) return;
    Args a{};
    for (int i = 0; i < 18; ++i) a.in[i] = (const float*)d_in[i];
    a.out = (float*)d_out; a.ws = (unsigned char*)d_ws;
#if SINGLE_LAUNCH
    a.lo = 0; a.hi = 65;
    hipLaunchKernelGGL(mega, dim3(grid), dim3(512), LDS_BYTES, stream, a);
#else
    for (int layer = 0; layer < DEPTH; ++layer) {
        static const int pool_ph[] = {0, 1, 2, 9, 10, 11, 12}, lru_ph[] = {0, 3, 4, 5, 6, 7, 8, 9, 10, 11, 12};
        const int* ph = (layer & 1) ? lru_ph : pool_ph; const int n = (layer & 1) ? 11 : 7;
        for (int q = 0; q < n; ++q) { a.lo = layer * 16 + ph[q]; a.hi = a.lo + 1; hipLaunchKernelGGL(mega, dim3(grid), dim3(512), LDS_BYTES, stream, a); }
    }
    a.lo = 64; a.hi = 65; hipLaunchKernelGGL(mega, dim3(grid), dim3(512), LDS_BYTES, stream, a);
#endif
}
```

```cpp
#include <hip/hip_runtime.h>
#include <cstdio>
#include <cstdint>

#ifndef SINGLE_LAUNCH
#define SINGLE_LAUNCH 1
#endif

constexpr int NB = 8, SEQ = 4096, NMETA = 16, T = SEQ + NMETA, D = 1024, NE = 16, CAP = 2 * T / NE, DF = 2048, DEPTH = 4;
constexpr int MMAIN = NB * SEQ;
constexpr int MROWS = NB * T;
constexpr int MPAD = 33024;
constexpr int EROWS = NB * CAP;
constexpr int EPAD = 4352;
constexpr int HIDP8 = 2112, WDP8 = 2112;
constexpr float WSCALE = 32.0f, WINV = 1.0f / 32.0f;
constexpr int NCHUNK = 33, CHL = 128;
static_assert(CAP == 514 && T == 4112 && EROWS == 4112, "shapes");
constexpr float RMS_EPS = 1e-6f;

constexpr size_t MiB = 1u << 20;
constexpr size_t WS_CTL = 0, CTL_ZERO_BYTES = 1 * MiB;
constexpr size_t WS_WG1 = 1 * MiB;
constexpr size_t WS_WD = WS_WG1 + 512 * MiB;
constexpr size_t WS_WIN = WS_WD + 264 * MiB;
constexpr size_t WS_WGT = WS_WIN + 8 * MiB;
constexpr size_t WS_WOUT = WS_WGT + 4 * MiB;
constexpr size_t WS_WPOOL = WS_WOUT + 4 * MiB;
constexpr size_t WS_H = WS_WPOOL + 1 * MiB;
constexpr size_t WS_U = WS_H + 129 * MiB;
constexpr size_t WS_P = WS_U + 65 * MiB;
constexpr size_t WS_XB = WS_P + 65 * MiB;
constexpr size_t WS_GY = WS_XB + 65 * MiB;
constexpr size_t WS_HG = WS_GY + 65 * MiB;
constexpr size_t WS_BIG = WS_HG + 65 * MiB;
constexpr size_t WS_Y = WS_BIG + 282 * MiB;
constexpr size_t WS_AFF = WS_Y + 136 * MiB;
constexpr size_t WS_SLOT = WS_AFF + 3 * MiB;
constexpr size_t WS_GMAP = WS_SLOT + 3 * MiB;
constexpr size_t WS_ROWL = WS_GMAP + 3 * MiB;
constexpr size_t WS_AGG = WS_ROWL + 1 * MiB;
constexpr size_t WS_SPT = WS_AGG + 9 * MiB / 2;
constexpr size_t WS_RSTD = WS_SPT + 64 * 1024;
constexpr size_t WS_END = WS_AGG + 5 * MiB;
constexpr size_t LA_BYTES = (size_t)MPAD * 1024 * 2;

constexpr int CW_BAR = 4096;

constexpr int RING_BYTES = 131072;
constexpr int MISC_OFF = RING_BYTES + 320;
constexpr int LDS_BYTES = 147456;

#define LAS __attribute__((address_space(3)))
typedef unsigned short bf16;
typedef short bf16x8 __attribute__((ext_vector_type(8)));
typedef float f32x4 __attribute__((ext_vector_type(4)));
typedef float f32x2 __attribute__((ext_vector_type(2)));
typedef unsigned u32x4 __attribute__((ext_vector_type(4)));
typedef unsigned u32x2 __attribute__((ext_vector_type(2)));

__device__ __forceinline__ unsigned cvt_pk_bf16(float lo, float hi) { unsigned r; asm volatile("v_cvt_pk_bf16_f32 %0, %1, %2" : "=v"(r) : "v"(lo), "v"(hi)); return r; }
__device__ __forceinline__ float bflo(unsigned w) { return __uint_as_float(w << 16); }
__device__ __forceinline__ float bfhi(unsigned w) { return __uint_as_float(w & 0xffff0000u); }
__device__ __forceinline__ float fast_exp(float x) { return __builtin_amdgcn_exp2f(x * 1.44269504089f); }
__device__ __forceinline__ float fast_rcp(float x) { return __builtin_amdgcn_rcpf(x); }
__device__ __forceinline__ float sigmoidf_(float x) { return fast_rcp(1.0f + fast_exp(-x)); }
__device__ __forceinline__ float siluf_(float x) { return x * sigmoidf_(x); }
typedef int v4i __attribute__((ext_vector_type(4)));
typedef int v8i __attribute__((ext_vector_type(8)));
__device__ __forceinline__ unsigned pk4_fp8(float a, float b, float c, float d) {
    a = __builtin_amdgcn_fmed3f(a, -448.f, 448.f); b = __builtin_amdgcn_fmed3f(b, -448.f, 448.f); c = __builtin_amdgcn_fmed3f(c, -448.f, 448.f); d = __builtin_amdgcn_fmed3f(d, -448.f, 448.f);
    unsigned r = 0; r = (unsigned)__builtin_amdgcn_cvt_pk_fp8_f32(a, b, (int)r, false); r = (unsigned)__builtin_amdgcn_cvt_pk_fp8_f32(c, d, (int)r, true); return r; }
__device__ __forceinline__ f32x4 fp8x4_to_f32(unsigned w) { const f32x2 lo = __builtin_amdgcn_cvt_pk_f32_fp8((int)w, false), hi = __builtin_amdgcn_cvt_pk_f32_fp8((int)w, true); return (f32x4){lo.x, lo.y, hi.x, hi.y}; }
__device__ __forceinline__ float silu_mul_s(float G, float U) { const float e = __builtin_amdgcn_exp2f(G * (-1.44269504089f * WINV)); return (G * U) * fast_rcp(__builtin_fmaf(e, 1024.0f, 1024.0f)); }
__device__ __forceinline__ unsigned pk4_u8(float a, float b, float c, float d) { return (unsigned)(a * 255.0f + 0.5f) | ((unsigned)(b * 255.0f + 0.5f) << 8) | ((unsigned)(c * 255.0f + 0.5f) << 16) | ((unsigned)(d * 255.0f + 0.5f) << 24); }
__device__ __forceinline__ unsigned silu_mul_fp8x4(const f32x4 G, const f32x4 U) {
    const f32x2 g0 = (f32x2){G.x, G.y}, g1 = (f32x2){G.z, G.w}, u0 = (f32x2){U.x, U.y}, u1 = (f32x2){U.z, U.w};
    const f32x2 t0 = g0 * (-1.44269504089f * WINV), t1 = g1 * (-1.44269504089f * WINV);
    f32x2 e0, e1; e0.x = __builtin_amdgcn_exp2f(t0.x); e0.y = __builtin_amdgcn_exp2f(t0.y); e1.x = __builtin_amdgcn_exp2f(t1.x); e1.y = __builtin_amdgcn_exp2f(t1.y);
    const f32x2 d0 = e0 * 1024.0f + 1024.0f, d1 = e1 * 1024.0f + 1024.0f;
    f32x2 r0, r1; r0.x = fast_rcp(d0.x); r0.y = fast_rcp(d0.y); r1.x = fast_rcp(d1.x); r1.y = fast_rcp(d1.y);
    const f32x2 o0 = (g0 * u0) * r0, o1 = (g1 * u1) * r1;
    return pk4_fp8(o0.x, o0.y, o1.x, o1.y);
}
__device__ __forceinline__ float gelu_tanh(float x) { const float z = 0.7978845608f * (x + 0.044715f * x * x * x); return x * sigmoidf_(2.0f * z); }
__device__ __forceinline__ float wave_sum(float v) {
#pragma unroll
    for (int o = 1; o < 64; o <<= 1) v += __shfl_xor(v, o);
    return v;
}
__device__ __forceinline__ int opaque(int v) { asm volatile("" : "+v"(v)); return v; }
__device__ __forceinline__ int row_of(int b, int t) { return t >= NMETA ? b * SEQ + (t - NMETA) : MMAIN + b * NMETA + t; }

#define XB_TMO      128
#define XB_XCNT(j)  (256  + 64 * (j))
#define XB_XSUB(j)  (1280 + 64 * (j))
#define XB_XGEN(j)  (2304 + 64 * (j))
#define XB_TOP      3328
#define XB_TOPGEN   3392
#define XCD_BAR_WORDS 3456
#define XB_SPIN_CAP (1u << 18)
__device__ __forceinline__ unsigned xb_ld(unsigned* p)              { return __hip_atomic_load(p, __ATOMIC_RELAXED, __HIP_MEMORY_SCOPE_AGENT); }
__device__ __forceinline__ unsigned xb_add(unsigned* p, unsigned v) { return __hip_atomic_fetch_add(p, v, __ATOMIC_RELAXED, __HIP_MEMORY_SCOPE_AGENT); }
__device__ __forceinline__ unsigned xb_xcc_id() { return (unsigned)__builtin_amdgcn_s_getreg((3 << 11) | 20) & 0xFu; }
#define XB_SPIN(cond, bar) do { unsigned _sp = 0; while (cond) { __builtin_amdgcn_s_sleep(1); \
    if ((++_sp & 255u) == 0u) { if (xb_ld(&(bar)[XB_TMO])) break; if (_sp > XB_SPIN_CAP) { atomicAdd(&(bar)[XB_TMO], 1u); break; } } } } while (0)
struct XcdBarrier { unsigned* bar; unsigned x; volatile LAS unsigned* st; };
__device__ __forceinline__ XcdBarrier xcd_barrier_post(unsigned* bar, volatile LAS unsigned* st) {
    XcdBarrier b; b.bar = bar; b.x = xb_xcc_id(); b.st = st;
    if (threadIdx.x == 0) (void)xb_add(&bar[XB_XCNT(b.x)], 1u);
    return b;
}
__device__ __forceinline__ void xcd_barrier_complete(unsigned* bar, unsigned x, unsigned& nloc, unsigned& nx) {
    const unsigned G = gridDim.x * gridDim.y * gridDim.z;
    unsigned sum, cnt, mine, sp = 0u;
    for (;;) {
        sum = 0u; cnt = 0u; mine = 0u;
#pragma unroll
        for (unsigned j = 0; j < 16; ++j) { const unsigned c = xb_ld(&bar[XB_XCNT(j)]); sum += c; cnt += (c > 0u) ? 1u : 0u; mine = (j == x) ? c : mine; }
        if (sum == G) break;
        __builtin_amdgcn_s_sleep(1);
        if ((++sp & 255u) == 0u) { if (xb_ld(&bar[XB_TMO])) break; if (sp > XB_SPIN_CAP) { atomicAdd(&bar[XB_TMO], 1u); break; } }
    }
    nloc = mine > 0u ? mine : 1u; nx = cnt > 0u ? cnt : 1u;
}
__device__ __forceinline__ void xcd_barrier(const XcdBarrier& b) {
    asm volatile("s_waitcnt vmcnt(0)" ::: "memory");
    __syncthreads();
    if (threadIdx.x == 0) {
        unsigned* bar = b.bar;
        __builtin_amdgcn_s_waitcnt(0);
        unsigned nloc = b.st[0], nx = b.st[1];
        if (nloc == 0u) { xcd_barrier_complete(bar, b.x, nloc, nx); b.st[0] = nloc; b.st[1] = nx; }
        const unsigned old = xb_add(&bar[XB_XSUB(b.x)], 1u);
        const unsigned gen = old / nloc;
        if (old + 1u == (gen + 1u) * nloc) {
            __builtin_amdgcn_fence(__ATOMIC_RELEASE, "agent");
            asm volatile("s_waitcnt vmcnt(0)" ::: "memory");
            const unsigned og = xb_add(&bar[XB_TOP], 1u);
            const unsigned tg = og / nx;
            if (og + 1u == (tg + 1u) * nx) xb_add(&bar[XB_TOPGEN], 1u);
            else XB_SPIN(xb_ld(&bar[XB_TOPGEN]) == tg, bar);
            __builtin_amdgcn_fence(__ATOMIC_ACQUIRE, "agent");
            xb_add(&bar[XB_XGEN(b.x)], 1u);
            asm volatile("s_waitcnt vmcnt(0)" ::: "memory");
        } else {
            XB_SPIN(xb_ld(&bar[XB_XGEN(b.x)]) == gen, bar);
            __builtin_amdgcn_fence(__ATOMIC_ACQUIRE, "agent");
            asm volatile("s_waitcnt vmcnt(0)" ::: "memory");
        }
    }
    __syncthreads();
}

struct Args { const float* in[18]; float* out; unsigned char* ws; int lo, hi; };
struct Frame {
    LAS unsigned char* lds;
    int tid, lane, wave, vcu, G;
    const float *x, *meta, *norm_mix, *norm_ffn, *norm_final, *pool_w, *pool_scale, *w_in, *conv_w, *conv_b, *w_gates, *b_gates, *lam, *w_out, *router_w, *moe_g, *moe_u, *moe_d;
    float* out; unsigned char* ws;
    bf16 *WG1, *WD, *WIN, *WGT, *WOUT, *WPOOL;
    bf16* H; float* HF; bf16 *U, *P, *XB, *GY, *HG, *LA, *BV, *HID, *Y;
    float* AFF; int* SLOT; float* GMAP; int* ROWL; float* AGG; float* SPT; float* RSTD;
};

struct ProItem { const float* src; unsigned char* dst; const float* ks; int ldw, ldt, f8; };
__device__ __forceinline__ ProItem pro_decode(const Frame& F, int it) {
    constexpr int I_MOE = 64 * 512, I_IN = 2 * 512, I_OUT = 2 * 256, I_GT = 32 * 16;
    ProItem p; p.ks = nullptr; int r = it;
    if (r < 2 * I_MOE) {
        const int up = r >= I_MOE; if (up) r -= I_MOE;
        const int le = r >> 9, q = r & 511, k0 = (q >> 6) * 128, n0 = (q & 63) * 32;
        p.src = (up ? F.moe_u : F.moe_g) + (size_t)le * 1024 * 2048 + (size_t)k0 * 2048 + n0; p.ldw = 2048;
        p.dst = (unsigned char*)F.WG1 + ((size_t)le * 4096 + (n0 >> 7) * 256 + up * 128 + (n0 & 127)) * 1024 + k0; p.ldt = 1024; p.f8 = 1; return p; }
    r -= 2 * I_MOE;
    if (r < I_MOE) {
        const int le = r >> 9, q = r & 511, k0 = (q >> 5) * 128, n0 = (q & 31) * 32;
        p.src = F.moe_d + (size_t)le * 2048 * 1024 + (size_t)k0 * 1024 + n0; p.ldw = 1024;
        p.dst = (unsigned char*)F.WD + ((size_t)le * 1024 + n0) * WDP8 + k0; p.ldt = WDP8; p.f8 = 1; return p; }
    r -= I_MOE; p.f8 = 0;
    if (r < I_IN) {
        const int j = r >> 9, q = r & 511, k0 = (q >> 6) * 128, n0 = (q & 63) * 32;
        p.src = F.w_in + (size_t)j * 1024 * 2048 + (size_t)k0 * 2048 + n0; p.ldw = 2048; p.dst = (unsigned char*)(F.WIN + ((size_t)j * 2048 + n0) * 1024 + k0); p.ldt = 2048; p.ks = F.norm_mix + (size_t)(2 * j + 1) * D + k0; return p; }
    r -= I_IN;
    if (r < I_OUT) {
        const int j = r >> 8, q = r & 255, k0 = (q >> 5) * 128, n0 = (q & 31) * 32;
        p.src = F.w_out + (size_t)j * 1024 * 1024 + (size_t)k0 * 1024 + n0; p.ldw = 1024; p.dst = (unsigned char*)(F.WOUT + ((size_t)j * 1024 + n0) * 1024 + k0); p.ldt = 2048; return p; }
    r -= I_OUT;
    if (r < I_GT) {
        const int mat = r >> 4, q = r & 15, k0 = (q >> 3) * 128, n0 = (q & 7) * 32;
        const int j = mat >> 4, d = (mat >> 3) & 1, g = (mat >> 2) & 1, h = mat & 3, nt = d * 8 + h * 2 + (n0 >> 7);
        p.src = F.w_gates + (size_t)mat * 65536 + (size_t)k0 * 256 + n0; p.ldw = 256; p.dst = (unsigned char*)(F.WGT + (((size_t)j * 16 + nt) * 256 + g * 128 + (n0 & 127)) * 256 + k0); p.ldt = 512; return p; }
    r -= I_GT;
    {
        const int mat = r >> 4, q = r & 15, k0 = (q >> 3) * 128, n0 = (q & 7) * 32;
        p.src = F.pool_w + (size_t)mat * 65536 + (size_t)k0 * 256 + n0; p.ldw = 256; p.dst = (unsigned char*)(F.WPOOL + ((size_t)mat * 256 + n0) * 256 + k0); p.ldt = 512; return p; }
}
__device__ __forceinline__ void pro_load(const ProItem& p, f32x4 (&v)[16], int lane) {
    const int rr = lane >> 3, sg = lane & 7;
#pragma unroll
    for (int i = 0; i < 16; ++i) v[i] = __builtin_nontemporal_load((const f32x4*)(p.src + (size_t)(8 * i + rr) * p.ldw + 4 * sg));
}
__device__ __forceinline__ void pro_finish(const ProItem& p, const f32x4 (&v)[16], LAS float* scr, int lane) {
    { const int rr = lane >> 3, sg = lane & 7;
#pragma unroll
        for (int i = 0; i < 16; ++i) *(LAS f32x4*)(scr + (8 * i + rr) * 32 + ((4 * sg) ^ (((i >> 1) & 3) << 3))) = v[i]; }
    asm volatile("s_waitcnt lgkmcnt(0)" ::: "memory");
    const int c = lane & 7;
#pragma unroll
    for (int j = 0; j < 4; ++j) { const int n = (lane >> 3) + 8 * j; const LAS float* s = scr + (16 * c) * 32 + (n ^ ((c & 3) << 3));
        float t[16];
#pragma unroll
        for (int q = 0; q < 16; ++q) t[q] = s[q * 32];
        if (p.f8) { u32x4 o; o.x = pk4_fp8(t[0] * WSCALE, t[1] * WSCALE, t[2] * WSCALE, t[3] * WSCALE); o.y = pk4_fp8(t[4] * WSCALE, t[5] * WSCALE, t[6] * WSCALE, t[7] * WSCALE);
            o.z = pk4_fp8(t[8] * WSCALE, t[9] * WSCALE, t[10] * WSCALE, t[11] * WSCALE); o.w = pk4_fp8(t[12] * WSCALE, t[13] * WSCALE, t[14] * WSCALE, t[15] * WSCALE);
            __builtin_nontemporal_store(o, (u32x4*)(p.dst + (size_t)n * p.ldt + 16 * c)); }
        else { if (p.ks) { const float* ks = p.ks + 16 * c;
#pragma unroll
                for (int q4 = 0; q4 < 4; ++q4) { const f32x4 g4 = *(const f32x4*)(ks + 4 * q4); t[4 * q4] *= g4.x; t[4 * q4 + 1] *= g4.y; t[4 * q4 + 2] *= g4.z; t[4 * q4 + 3] *= g4.w; } }
            u32x4 o0, o1; o0.x = cvt_pk_bf16(t[0], t[1]); o0.y = cvt_pk_bf16(t[2], t[3]); o0.z = cvt_pk_bf16(t[4], t[5]); o0.w = cvt_pk_bf16(t[6], t[7]);
            o1.x = cvt_pk_bf16(t[8], t[9]); o1.y = cvt_pk_bf16(t[10], t[11]); o1.z = cvt_pk_bf16(t[12], t[13]); o1.w = cvt_pk_bf16(t[14], t[15]);
            unsigned char* d = p.dst + (size_t)n * p.ldt + 32 * c; __builtin_nontemporal_store(o0, (u32x4*)d); __builtin_nontemporal_store(o1, (u32x4*)(d + 16)); } }
    asm volatile("s_waitcnt lgkmcnt(0)" ::: "memory");
}
__device__ __forceinline__ void phase_prologue(const Frame& F) {
    LAS float* scr = (LAS float*)(F.lds + F.wave * 16384);
    const int gw = F.vcu * 8 + F.wave, NGW = F.G * 8, lane = F.lane;
    for (int i = gw * 64 + lane; i < 4 * D; i += NGW * 64) F.SPT[i] = -8.0f * log1pf(expf(-F.lam[i]));
    constexpr int NITEMS = 3 * 64 * 512 + 2 * 512 + 2 * 256 + 32 * 16 + 8 * 16;
    int it = gw; if (it >= NITEMS) return;
    ProItem cur = pro_decode(F, it); f32x4 v[16], w[16]; pro_load(cur, v, lane);
    for (;;) {
        const int nit = it + NGW; const bool more = nit < NITEMS; ProItem nxt = cur;
        if (more) nxt = pro_decode(F, nit);
        pro_load(nxt, w, lane);
        pro_finish(cur, v, scr, lane);
        if (!more) break;
        cur = nxt; it = nit;
#pragma unroll
        for (int i = 0; i < 16; ++i) v[i] = w[i];
    }
}

template <bool FINAL, bool FIRST, bool DRY = false>
__device__ __forceinline__ void phase_rowA(const Frame& F, int layer) {
    const int gw = F.vcu * 8 + F.wave, NGW = F.G * 8, lane = F.lane;
    const float* gain = FINAL ? F.norm_final : F.norm_mix + layer * D;
    f32x4 gn[4];
#pragma unroll
    for (int j = 0; j < 4; ++j) gn[j] = *(const f32x4*)(gain + 4 * lane + 256 * j);
    const int rend = FINAL ? MMAIN : MROWS;
    int sl_n = -1; float gg_n = 0.f;
    if (!FIRST) { if (lane < 16 && gw < rend) { sl_n = F.SLOT[(size_t)gw * 16 + lane]; gg_n = F.GMAP[(size_t)gw * 16 + lane]; } }
    for (int r = gw; r < rend; r += NGW) {
        f32x4 v[4];
        if (FIRST) {
            const float* src = r < MMAIN ? F.x + (size_t)r * D : F.meta + (size_t)((r - MMAIN) & 15) * D;
#pragma unroll
            for (int j = 0; j < 4; ++j) v[j] = *(const f32x4*)(src + 4 * lane + 256 * j);
        } else {
            const int sl = sl_n; const float gg = gg_n;
            const bf16* src = F.H + (size_t)r * D;
#pragma unroll
            for (int j = 0; j < 4; ++j) { const u32x2 w = *(const u32x2*)(src + 4 * lane + 256 * j); v[j] = (f32x4){bflo(w.x), bfhi(w.x), bflo(w.y), bfhi(w.y)}; }
            { const int rn = r + NGW; sl_n = -1; if (lane < 16 && rn < rend) { sl_n = F.SLOT[(size_t)rn * 16 + lane]; gg_n = F.GMAP[(size_t)rn * 16 + lane]; } }
            unsigned mask = (unsigned)__ballot(sl >= 0) & 0xffffu;
            while (mask) {
                int ee[4]; float gq[4]; const unsigned char* yr[4];
#pragma unroll
                for (int q = 0; q < 4; ++q) { const bool on = mask != 0u; const int e = on ? (__builtin_ffs((int)mask) - 1) : 0; mask &= mask - 1u;
                    const int s = __builtin_amdgcn_readlane(sl, e); const float g = __uint_as_float(__builtin_amdgcn_readlane(__float_as_uint(gg), e));
                    ee[q] = e; gq[q] = on ? g : 0.f; yr[q] = (const unsigned char*)F.Y + ((size_t)e * EPAD + (on ? s : 0)) * D; }
                unsigned w[4][4];
#pragma unroll
                for (int q = 0; q < 4; ++q)
#pragma unroll
                    for (int j = 0; j < 4; ++j) w[q][j] = *(const unsigned*)(yr[q] + 4 * lane + 256 * j);
#pragma unroll
                for (int q = 0; q < 4; ++q)
#pragma unroll
                    for (int j = 0; j < 4; ++j) v[j] += fp8x4_to_f32(w[q][j]) * gq[q];
                (void)ee;
            }
        }
        if (!FINAL && !DRY) {
            bf16* dst = F.H + (size_t)r * D;
#pragma unroll
            for (int j = 0; j < 4; ++j) { u32x2 w; w.x = cvt_pk_bf16(v[j].x, v[j].y); w.y = cvt_pk_bf16(v[j].z, v[j].w); *(u32x2*)(dst + 4 * lane + 256 * j) = w; }
        }
        float ss = 0.f;
#pragma unroll
        for (int j = 0; j < 4; ++j) ss += (v[j].x * v[j].x + v[j].y * v[j].y) + (v[j].z * v[j].z + v[j].w * v[j].w);
        const float rstd = 1.0f / sqrtf(wave_sum(ss) * (1.0f / D) + RMS_EPS);
        if (FINAL) {
            float* dst = F.out + (size_t)r * D;
#pragma unroll
            for (int j = 0; j < 4; ++j) *(f32x4*)(dst + 4 * lane + 256 * j) = v[j] * rstd * gn[j];
        } else {
            if (lane == 0) F.RSTD[r] = rstd;
        }
    }
}
constexpr int RB_PITCH = 2064;
__device__ __forceinline__ unsigned short bf16_rne(float x) { return (unsigned short)(cvt_pk_bf16(x, 0.f) & 0xffffu); }
__device__ __forceinline__ void phase_rowB(const Frame& F, int layer) {
    const int gw = F.vcu * 8 + F.wave, NGW = F.G * 8, lane = F.lane, fr = lane & 15, fq = lane >> 4;
    LAS unsigned char* wl = F.lds;
    LAS float* gl = (LAS float*)(F.lds + 3 * 16 * RB_PITCH);
    const float* rw = F.router_w + (size_t)layer * D * NE;
    const float* gain = F.norm_ffn + layer * D;
    {   f32x4 rv[8]; float gk[8];
#pragma unroll
        for (int i = 0; i < 8; ++i) { const int i4 = F.tid + 512 * i; rv[i] = *(const f32x4*)(rw + 4 * i4); gk[i] = gain[i4 >> 2]; }
#pragma unroll
        for (int i = 0; i < 8; ++i) { const int i4 = F.tid + 512 * i, k = i4 >> 2, e0 = (i4 & 3) * 4;
#pragma unroll
            for (int x = 0; x < 4; ++x) { const float w = rv[i][x] * gk[i];
                const unsigned short hi = bf16_rne(w); const float r1 = w - __uint_as_float((unsigned)hi << 16);
                const unsigned short mid = bf16_rne(r1); const float r2 = r1 - __uint_as_float((unsigned)mid << 16);
                const unsigned short lo = bf16_rne(r2);
                LAS unsigned char* p = wl + (e0 + x) * RB_PITCH + 2 * k;
                *(LAS unsigned short*)p = hi; *(LAS unsigned short*)(p + 16 * RB_PITCH) = mid; *(LAS unsigned short*)(p + 32 * RB_PITCH) = lo; } }
        for (int k = F.tid; k < D; k += 512) gl[k] = gain[k];
    }
    __syncthreads();
    constexpr int NBLK = MROWS / 16;
    for (int blk = gw; blk < NBLK; blk += NGW) {
        const int row = blk * 16 + fr;
        const bf16* src = F.H + (size_t)row * D + 8 * fq;
        u32x4 hv[32];
#pragma unroll
        for (int kk = 0; kk < 32; ++kk) hv[kk] = *(const u32x4*)(src + 32 * kk);
        f32x4 acc3[3], acch; acc3[0] = (f32x4){0.f, 0.f, 0.f, 0.f}; acc3[1] = acc3[0]; acc3[2] = acc3[0]; acch = acc3[0];
        const int woff = opaque(fr * RB_PITCH + 16 * fq);
#pragma unroll
        for (int k2 = 0; k2 < 32; k2 += 2) {
            bf16x8 wv[2][3];
#pragma unroll
            for (int u = 0; u < 2; ++u)
#pragma unroll
                for (int p = 0; p < 3; ++p) wv[u][p] = *(const LAS bf16x8*)(wl + woff + p * 16 * RB_PITCH + 64 * (k2 + u));
#pragma unroll
            for (int u = 0; u < 2; ++u) { const bf16x8 a = __builtin_bit_cast(bf16x8, hv[k2 + u]);
#pragma unroll
                for (int p = 0; p < 3; ++p) acc3[p] = __builtin_amdgcn_mfma_f32_16x16x32_bf16(wv[u][p], a, acc3[p], 0, 0, 0);
                acch = __builtin_amdgcn_mfma_f32_16x16x32_bf16(a, a, acch, 0, 0, 0); }
            asm volatile("" ::: "memory");
        }
        const f32x4 acc = (acc3[2] + acc3[1]) + acc3[0];
        const int jd = fr & 3; const float dg = jd == 0 ? acch.x : jd == 1 ? acch.y : jd == 2 ? acch.z : acch.w;
        const float ss = __shfl(dg, fr + 16 * (fr >> 2));
        const float rstd = 1.0f / sqrtf(ss * (1.0f / D) + RMS_EPS);
        unsigned char* dst = (unsigned char*)F.U + (size_t)row * D + 8 * fq;
        const int goff = opaque(8 * fq);
#pragma unroll
        for (int kk = 0; kk < 32; ++kk) {
            const u32x4 h4 = hv[kk]; const f32x4 g0 = *(const LAS f32x4*)(gl + goff + 32 * kk), g1 = *(const LAS f32x4*)(gl + goff + 32 * kk + 4);
            u32x2 o; o.x = pk4_fp8(bflo(h4.x) * rstd * g0.x, bfhi(h4.x) * rstd * g0.y, bflo(h4.y) * rstd * g0.z, bfhi(h4.y) * rstd * g0.w);
            o.y = pk4_fp8(bflo(h4.z) * rstd * g1.x, bfhi(h4.z) * rstd * g1.y, bflo(h4.w) * rstd * g1.z, bfhi(h4.w) * rstd * g1.w);
            *(u32x2*)(dst + 32 * kk) = o;
            asm volatile("" ::: "memory");
        }
        const f32x4 lg = acc * rstd;
        float mx = fmaxf(fmaxf(lg.x, lg.y), fmaxf(lg.z, lg.w)); mx = fmaxf(mx, __shfl_xor(mx, 16)); mx = fmaxf(mx, __shfl_xor(mx, 32));
        const f32x4 p = (f32x4){expf(lg.x - mx), expf(lg.y - mx), expf(lg.z - mx), expf(lg.w - mx)};
        float sum = (p.x + p.y) + (p.z + p.w); sum += __shfl_xor(sum, 16); sum += __shfl_xor(sum, 32);
        int b, t; if (row < MMAIN) { b = row >> 12; t = (row & 4095) + NMETA; } else { b = (row - MMAIN) >> 4; t = (row - MMAIN) & 15; }
        float* ap = F.AFF + ((size_t)b * NE + 4 * fq) * T + t;
        ap[0] = p.x / sum; ap[T] = p.y / sum; ap[2 * T] = p.z / sum; ap[3 * T] = p.w / sum;
    }
    __syncthreads();
}

__device__ __forceinline__ int block_excl_scan(int v, LAS int* wsum, int tid, int lane, int wave, int& total) {
    int s = v;
#pragma unroll
    for (int o = 1; o < 64; o <<= 1) { const int t = __shfl_up(s, o); if (lane >= o) s += t; }
    __syncthreads();
    if (lane == 63) wsum[wave] = s;
    __syncthreads();
    int base = 0, tot = 0;
#pragma unroll
    for (int w = 0; w < 8; ++w) { const int x = wsum[w]; if (w < wave) base += x; tot += x; }
    total = tot;
    return base + s - v;
}
__device__ __forceinline__ void phase_topk(const Frame& F) {
    LAS unsigned* keys = (LAS unsigned*)F.lds;
    LAS int* hist = (LAS int*)(F.lds + 20480);
    LAS int* misc = (LAS int*)(F.lds + 20480 + 1024);
    const int tid = F.tid, lane = F.lane, wave = F.wave;
    for (int task = blockIdx.x; task < NB * NE; task += F.G) {
        const int b = task >> 4, e = task & 15;
        const float* aff = F.AFF + ((size_t)b * NE + e) * T;
        __syncthreads();
        {   unsigned kv[9];
#pragma unroll
            for (int i = 0; i < 9; ++i) { const int t = tid + 512 * i; kv[i] = __float_as_uint(aff[t < T ? t : T - 1]); }
#pragma unroll
            for (int i = 0; i < 9; ++i) { const int t = tid + 512 * i; if (t < T) keys[t] = kv[i]; } }
        unsigned prefix = 0u, pmask = 0u; int need = CAP;
        for (int p = 3; p >= 0; --p) {
            if (tid < 256) hist[tid] = 0;
            __syncthreads();
            for (int t = tid; t < T; t += 512) { const unsigned k = keys[t]; if ((k & pmask) == prefix) __hip_atomic_fetch_add(&hist[(k >> (8 * p)) & 255u], 1, __ATOMIC_RELAXED, __HIP_MEMORY_SCOPE_WORKGROUP); }
            __syncthreads();
            if (wave == 0) {
                int c[4]; int tot = 0;
#pragma unroll
                for (int q = 0; q < 4; ++q) { c[q] = hist[4 * lane + q]; tot += c[q]; }
                int s = tot;
#pragma unroll
                for (int o = 1; o < 64; o <<= 1) { const int x = __shfl_down(s, o); if (lane + o < 64) s += x; }
                int above = s - tot;
                if (above < need && need <= s) {
                    int a = above;
#pragma unroll
                    for (int q = 3; q >= 0; --q) { if (need <= a + c[q] && need > a) { misc[0] = 4 * lane + q; misc[1] = need - a; } a += c[q]; }
                }
            }
            __syncthreads();
            prefix |= (unsigned)misc[0] << (8 * p); pmask |= 0xFFu << (8 * p); need = misc[1];
            __syncthreads();
        }
        const unsigned vstar = prefix;
        const int t0 = tid * 9, t1 = (t0 + 9 < T) ? t0 + 9 : T;
        int neq = 0;
        for (int t = t0; t < t1; ++t) neq += (keys[t] == vstar) ? 1 : 0;
        int toteq; int eqbase = block_excl_scan(neq, misc + 8, tid, lane, wave, toteq);
        int nsel = 0; unsigned selmask = 0u; { int er = eqbase;
            for (int t = t0; t < t1; ++t) { const unsigned k = keys[t]; bool s = k > vstar; if (k == vstar) { s = er < need; ++er; } if (s) { selmask |= 1u << (t - t0); ++nsel; } } }
        int totsel; int sbase = block_excl_scan(nsel, misc + 8, tid, lane, wave, totsel);
        for (int t = t0; t < t1; ++t) {
            const int row = row_of(b, t);
            if ((selmask >> (t - t0)) & 1u) { const int pos = b * CAP + sbase; ++sbase;
                F.ROWL[e * EPAD + pos] = row; F.SLOT[(size_t)row * 16 + e] = pos; F.GMAP[(size_t)row * 16 + e] = __uint_as_float(keys[t]); }
            else F.SLOT[(size_t)row * 16 + e] = -1;
        }
        if (b == 0 && tid < EPAD - EROWS) F.ROWL[e * EPAD + EROWS + tid] = 0;
    }
    __syncthreads();
}

__device__ __forceinline__ void phase_poolwin(const Frame& F, int layer) {
    const int gw = F.vcu * 8 + F.wave, NGW = F.G * 8, lane = F.lane;
    constexpr int CHS = 33, NTC = (T + CHS - 1) / CHS;
    for (int it = gw; it < NB * NTC * 2; it += NGW) {
        const int half = it & 1, tc = (it >> 1) % NTC, b = (it >> 1) / NTC;
        const int col = half * 512 + lane * 8, g = col >> 8, hw = 1 << g;
        const int t0 = tc * CHS, t1 = (t0 + CHS < T) ? t0 + CHS : T;
        float sum[8];
#pragma unroll
        for (int q = 0; q < 8; ++q) sum[q] = 0.f;
        const u32x4 zero4 = (u32x4){0u, 0u, 0u, 0u};
        const bf16* ucol = F.H + col;
        float gnv[8];
        { const float* gp = F.norm_mix + (size_t)layer * D + col; const f32x4 g0 = *(const f32x4*)gp, g1 = *(const f32x4*)(gp + 4); gnv[0] = g0.x; gnv[1] = g0.y; gnv[2] = g0.z; gnv[3] = g0.w; gnv[4] = g1.x; gnv[5] = g1.y; gnv[6] = g1.z; gnv[7] = g1.w; }
#define PW_FMA(V_, S_) do { sum[0] += bflo(V_.x) * (S_); sum[1] += bfhi(V_.x) * (S_); sum[2] += bflo(V_.y) * (S_); sum[3] += bfhi(V_.y) * (S_); sum[4] += bflo(V_.z) * (S_); sum[5] += bfhi(V_.z) * (S_); sum[6] += bflo(V_.w) * (S_); sum[7] += bfhi(V_.w) * (S_); } while (0)
        {
            u32x4 iw[16]; float ir[16];
#pragma unroll
            for (int q = 0; q < 16; ++q) { const int dt = q - 8, tt = t0 + dt; const bool v = dt >= -hw && dt < hw && tt >= 0 && tt < T; const int row = row_of(b, v ? tt : t0); iw[q] = *(const u32x4*)(ucol + (size_t)row * D); ir[q] = F.RSTD[row]; }
#pragma unroll
            for (int q = 0; q < 16; ++q) { const int dt = q - 8, tt = t0 + dt; const bool v = dt >= -hw && dt < hw && tt >= 0 && tt < T; const float sc = v ? ir[q] : 0.f; PW_FMA(iw[q], sc); }
        }
        for (int tb = t0; tb < t1; tb += 11) {
            u32x4 c[11], wp[11], wm[11]; float rc[11], rp[11], rm[11];
#pragma unroll
            for (int q = 0; q < 11; ++q) { const int t = (tb + q < t1) ? tb + q : t1 - 1; const bool vp = t + hw < T, vm = t - hw >= 0;
                const int r0_ = row_of(b, t), r1_ = row_of(b, vp ? t + hw : t), r2_ = row_of(b, vm ? t - hw : t);
                c[q] = *(const u32x4*)(ucol + (size_t)r0_ * D); wp[q] = *(const u32x4*)(ucol + (size_t)r1_ * D); wm[q] = *(const u32x4*)(ucol + (size_t)r2_ * D);
                rc[q] = F.RSTD[r0_]; rp[q] = F.RSTD[r1_]; rm[q] = F.RSTD[r2_]; }
#pragma unroll
            for (int q = 0; q < 11; ++q) { const int t = tb + q;
                if (t < t1) {
                    const int lo = (t - hw > 0) ? t - hw : 0, hi = (t + hw < T) ? t + hw : T;
                    const float inv = 1.0f / (float)(hi - lo), cs = rc[q];
                    u32x4 o;
                    o.x = cvt_pk_bf16((sum[0] * inv - bflo(c[q].x) * cs) * gnv[0], (sum[1] * inv - bfhi(c[q].x) * cs) * gnv[1]); o.y = cvt_pk_bf16((sum[2] * inv - bflo(c[q].y) * cs) * gnv[2], (sum[3] * inv - bfhi(c[q].y) * cs) * gnv[3]);
                    o.z = cvt_pk_bf16((sum[4] * inv - bflo(c[q].z) * cs) * gnv[4], (sum[5] * inv - bfhi(c[q].z) * cs) * gnv[5]); o.w = cvt_pk_bf16((sum[6] * inv - bflo(c[q].w) * cs) * gnv[6], (sum[7] * inv - bfhi(c[q].w) * cs) * gnv[7]);
                    *(u32x4*)(F.P + (size_t)row_of(b, t) * D + col) = o;
                    const float sa = (t + hw < T) ? rp[q] : 0.f, sm = (t - hw >= 0) ? -rm[q] : 0.f;
                    PW_FMA(wp[q], sa); PW_FMA(wm[q], sm);
                }
            }
        }
#undef PW_FMA
    }
}
__device__ __forceinline__ void phase_conv(const Frame& F, int j) {
    const int gw = F.vcu * 8 + F.wave, NGW = F.G * 8, lane = F.lane;
    constexpr int CHS = 33, NTC = (T + CHS - 1) / CHS;
    const float* cw = F.conv_w + (size_t)j * 4 * D; const float* cb = F.conv_b + (size_t)j * D;
    for (int it = gw; it < NB * NTC * 2; it += NGW) {
        const int half = it & 1, tc = (it >> 1) % NTC, b = (it >> 1) / NTC;
        const int col = half * 512 + lane * 8;
        const int t0 = tc * CHS, t1 = (t0 + CHS < T) ? t0 + CHS : T;
        float w[4][8], bias[8];
#pragma unroll
        for (int k = 0; k < 4; ++k) { const f32x4 a = *(const f32x4*)(cw + k * D + col), c = *(const f32x4*)(cw + k * D + col + 4);
            w[k][0] = a.x; w[k][1] = a.y; w[k][2] = a.z; w[k][3] = a.w; w[k][4] = c.x; w[k][5] = c.y; w[k][6] = c.z; w[k][7] = c.w; }
        { const f32x4 a = *(const f32x4*)(cb + col), c = *(const f32x4*)(cb + col + 4); bias[0] = a.x; bias[1] = a.y; bias[2] = a.z; bias[3] = a.w; bias[4] = c.x; bias[5] = c.y; bias[6] = c.z; bias[7] = c.w; }
        u32x4 xm1 = (u32x4){0u, 0u, 0u, 0u}, x0 = xm1, xp1 = xm1, xp2 = xm1;
        if (t0 - 1 >= 0) xm1 = *(const u32x4*)(F.XB + (size_t)row_of(b, t0 - 1) * D + col);
        x0 = *(const u32x4*)(F.XB + (size_t)row_of(b, t0) * D + col);
        if (t0 + 1 < T) xp1 = *(const u32x4*)(F.XB + (size_t)row_of(b, t0 + 1) * D + col);
        for (int tb = t0; tb < t1; tb += 11) {
            u32x4 xn[11];
#pragma unroll
            for (int q = 0; q < 11; ++q) { const int tt = tb + q + 2; xn[q] = *(const u32x4*)(F.XB + (size_t)row_of(b, tt < T ? tt : T - 1) * D + col); }
#pragma unroll
            for (int q = 0; q < 11; ++q) { const int t = tb + q;
                if (t < t1) {
                    xp2 = (t + 2 < T) ? xn[q] : (u32x4){0u, 0u, 0u, 0u};
                    float o[8];
#define CONV2(q_, m) o[2 * q_] = bias[2 * q_] + w[0][2 * q_] * bflo(xm1.m) + w[1][2 * q_] * bflo(x0.m) + w[2][2 * q_] * bflo(xp1.m) + w[3][2 * q_] * bflo(xp2.m); \
                     o[2 * q_ + 1] = bias[2 * q_ + 1] + w[0][2 * q_ + 1] * bfhi(xm1.m) + w[1][2 * q_ + 1] * bfhi(x0.m) + w[2][2 * q_ + 1] * bfhi(xp1.m) + w[3][2 * q_ + 1] * bfhi(xp2.m);
                    CONV2(0, x) CONV2(1, y) CONV2(2, z) CONV2(3, w)
#undef CONV2
                    u32x4 ov; ov.x = cvt_pk_bf16(o[0], o[1]); ov.y = cvt_pk_bf16(o[2], o[3]); ov.z = cvt_pk_bf16(o[4], o[5]); ov.w = cvt_pk_bf16(o[6], o[7]);
                    *(u32x4*)(F.P + (size_t)row_of(b, t) * D + col) = ov;
                    xm1 = x0; x0 = xp1; xp1 = xp2;
                }
            }
        }
    }
}
__device__ __forceinline__ void chunk_rows(int b, int k, int& r0, int& n) { if (k == 0) { r0 = MMAIN + b * NMETA; n = NMETA; } else { r0 = b * SEQ + (k - 1) * CHL; n = CHL; } }
__device__ __forceinline__ void phase_scan1(const Frame& F, int j) {
    const int lane = F.lane;
    for (int it = F.wave * F.G + F.vcu; it < 2 * NB * NCHUNK * 8; it += 8 * F.G) {
        int cq, k, b, d;
        if (it < 4096) { cq = it & 7; k = 1 + ((it >> 3) & 31); b = (it >> 8) & 7; d = it >> 11; } else { const int u = it - 4096; cq = u & 7; k = 0; b = (u >> 3) & 7; d = u >> 6; }
        const int c0 = cq * 128 + lane * 2;
        int r0, n; chunk_rows(b, k, r0, n);
        const unsigned char* la = (const unsigned char*)F.LA + (size_t)d * MPAD * D + c0; const bf16* bv = F.BV + (size_t)d * MPAD * D + c0;
        const f32x2 spq = *(const f32x2*)(F.SPT + (size_t)(j * 2 + d) * D + c0) * (1.0f / 255.0f);
        float h0 = 0.f, h1 = 0.f, s0 = 0.f, s1 = 0.f;
        for (int s = 0; s < n; s += 32) {
            unsigned lw[32], bw[32];
#pragma unroll
            for (int q = 0; q < 32; ++q) { const int sq = (s + q < n) ? s + q : n - 1; const int r = d ? (r0 + n - 1 - sq) : (r0 + sq); lw[q] = *(const unsigned short*)(la + (size_t)r * D); bw[q] = *(const unsigned*)(bv + (size_t)r * D); }
#pragma unroll
            for (int q = 0; q < 32; ++q) { const bool ok = s + q < n; const unsigned lq = ok ? lw[q] : 0u, bq = ok ? bw[q] : 0u;
                const float l0 = (float)(lq & 255u) * spq.x, l1 = (float)(lq >> 8) * spq.y; s0 += l0; s1 += l1; h0 = fast_exp(l0) * h0 + bflo(bq); h1 = fast_exp(l1) * h1 + bfhi(bq); }
        }
        float* agg = F.AGG + ((size_t)(d * NB + b) * NCHUNK + k) * D + c0;
        *(f32x2*)agg = (f32x2){s0, s1};
        *(f32x2*)(agg + (size_t)2 * NB * NCHUNK * D) = (f32x2){h0, h1};
    }
}
template <int N>
__device__ __forceinline__ void scan3_rows(const Frame& F, int j, int r0, int c0, float hf0, float hf1, float hb0, float hb1) {
    constexpr int HALF = N / 2;
    const unsigned char* laf = (const unsigned char*)F.LA + c0; const bf16* bvf = F.BV + c0; const unsigned char* lab = laf + (size_t)MPAD * D; const bf16* bvb = bvf + (size_t)MPAD * D;
    const f32x2 sqf = *(const f32x2*)(F.SPT + (size_t)(j * 2 + 0) * D + c0) * (1.0f / 255.0f), sqb = *(const f32x2*)(F.SPT + (size_t)(j * 2 + 1) * D + c0) * (1.0f / 255.0f);
#define L8LO(W_, S_) ((float)((W_) & 255u) * (S_).x)
#define L8HI(W_, S_) ((float)((W_) >> 8) * (S_).y)
    unsigned sf[HALF], sb[HALF];
#pragma unroll
    for (int s = 0; s < HALF; s += 8) {
        unsigned lf[8], bf_[8], lb[8], bb[8];
#pragma unroll
        for (int q = 0; q < 8; ++q) { const size_t rf = (size_t)(r0 + s + q) * D, rb = (size_t)(r0 + N - 1 - s - q) * D;
            lf[q] = *(const unsigned short*)(laf + rf); bf_[q] = *(const unsigned*)(bvf + rf); lb[q] = *(const unsigned short*)(lab + rb); bb[q] = *(const unsigned*)(bvb + rb); }
#pragma unroll
        for (int q = 0; q < 8; ++q) {
            hf0 = fast_exp(L8LO(lf[q], sqf)) * hf0 + bflo(bf_[q]); hf1 = fast_exp(L8HI(lf[q], sqf)) * hf1 + bfhi(bf_[q]); sf[s + q] = cvt_pk_bf16(hf0, hf1);
            hb0 = fast_exp(L8LO(lb[q], sqb)) * hb0 + bflo(bb[q]); hb1 = fast_exp(L8HI(lb[q], sqb)) * hb1 + bfhi(bb[q]); sb[s + q] = cvt_pk_bf16(hb0, hb1); }
    }
#pragma unroll
    for (int s = HALF; s < N; s += 8) {
        unsigned lf[8], bf_[8], lb[8], bb[8], gf[8], gb[8];
#pragma unroll
        for (int q = 0; q < 8; ++q) { const size_t rf = (size_t)(r0 + s + q) * D, rb = (size_t)(r0 + N - 1 - s - q) * D;
            lf[q] = *(const unsigned short*)(laf + rf); bf_[q] = *(const unsigned*)(bvf + rf); lb[q] = *(const unsigned short*)(lab + rb); bb[q] = *(const unsigned*)(bvb + rb);
            gf[q] = *(const unsigned*)(F.GY + rf + c0); gb[q] = *(const unsigned*)(F.GY + rb + c0); }
#pragma unroll
        for (int q = 0; q < 8; ++q) { const size_t rf = (size_t)(r0 + s + q) * D, rb = (size_t)(r0 + N - 1 - s - q) * D;
            const unsigned xf = sb[N - 1 - s - q], xb = sf[N - 1 - s - q];
            hf0 = fast_exp(L8LO(lf[q], sqf)) * hf0 + bflo(bf_[q]); hf1 = fast_exp(L8HI(lf[q], sqf)) * hf1 + bfhi(bf_[q]);
            *(unsigned*)(F.HG + rf + c0) = cvt_pk_bf16((hf0 + bflo(xf)) * bflo(gf[q]), (hf1 + bfhi(xf)) * bfhi(gf[q]));
            hb0 = fast_exp(L8LO(lb[q], sqb)) * hb0 + bflo(bb[q]); hb1 = fast_exp(L8HI(lb[q], sqb)) * hb1 + bfhi(bb[q]);
            *(unsigned*)(F.HG + rb + c0) = cvt_pk_bf16((bflo(xb) + hb0) * bflo(gb[q]), (bfhi(xb) + hb1) * bfhi(gb[q])); }
    }
#undef L8LO
#undef L8HI
}
__device__ __forceinline__ void phase_scan3(const Frame& F, int j) {
    const int lane = F.lane;
    constexpr size_t HOFF = (size_t)2 * NB * NCHUNK * D;
    for (int it = F.wave * F.G + F.vcu; it < NB * NCHUNK * 8; it += 8 * F.G) {
        int cq, k, b;
        if (it < 2048) { cq = it & 7; k = 1 + ((it >> 3) & 31); b = it >> 8; } else { const int u = it - 2048; cq = u & 7; k = 0; b = u >> 3; }
        const int c0 = cq * 128 + lane * 2;
        int r0, n; chunk_rows(b, k, r0, n);
        float hf0 = 0.f, hf1 = 0.f, hb0 = 0.f, hb1 = 0.f;
        for (int j0 = 0; j0 < k; j0 += 8) {
            f32x2 al[8], he[8];
#pragma unroll
            for (int q = 0; q < 8; ++q) { const int jx = (j0 + q < k) ? j0 + q : 0; const float* agg = F.AGG + ((size_t)(0 * NB + b) * NCHUNK + jx) * D + c0; al[q] = *(const f32x2*)agg; he[q] = *(const f32x2*)(agg + HOFF); }
#pragma unroll
            for (int q = 0; q < 8; ++q) if (j0 + q < k) { hf0 = fast_exp(al[q].x) * hf0 + he[q].x; hf1 = fast_exp(al[q].y) * hf1 + he[q].y; }
        }
        for (int j0 = NCHUNK - 1; j0 > k; j0 -= 8) {
            f32x2 al[8], he[8];
#pragma unroll
            for (int q = 0; q < 8; ++q) { const int jx = (j0 - q > k) ? j0 - q : NCHUNK - 1; const float* agg = F.AGG + ((size_t)(1 * NB + b) * NCHUNK + jx) * D + c0; al[q] = *(const f32x2*)agg; he[q] = *(const f32x2*)(agg + HOFF); }
#pragma unroll
            for (int q = 0; q < 8; ++q) if (j0 - q > k) { hb0 = fast_exp(al[q].x) * hb0 + he[q].x; hb1 = fast_exp(al[q].y) * hb1 + he[q].y; }
        }
        if (k == 0) scan3_rows<NMETA>(F, j, r0, c0, hf0, hf1, hb0, hb1); else scan3_rows<CHL>(F, j, r0, c0, hf0, hf1, hb0, hb1);
    }
}

struct TaskMap { int ntask, ncb, rb0, rbstride; };
template <class Fn>
__device__ __forceinline__ void wave_gemm(const Fn& fn, const TaskMap tm, int gw, int ngw, int lane_) {
    const int lane = opaque(lane_), fr = lane & 15, fq = lane >> 4;
    for (int task = gw; task < tm.ntask; task += ngw) {
        const int cb = task % tm.ncb, rb = tm.rb0 + (task / tm.ncb) * tm.rbstride;
        const bf16* ap[2]; const bf16* bp[4];
#pragma unroll
        for (int mi = 0; mi < 2; ++mi) ap[mi] = fn.arow(rb, cb, mi * 16 + fr) + 8 * fq;
#pragma unroll
        for (int nb = 0; nb < 4; ++nb) bp[nb] = fn.brow(rb, cb, nb * 16 + fr) + 8 * fq;
        f32x4 acc[2][4];
#pragma unroll
        for (int mi = 0; mi < 2; ++mi)
#pragma unroll
            for (int nb = 0; nb < 4; ++nb) acc[mi][nb] = (f32x4){0.f, 0.f, 0.f, 0.f};
#pragma unroll 2
        for (int k0 = 0; k0 < fn.K; k0 += 32) {
            bf16x8 a[2], bb[4];
#pragma unroll
            for (int mi = 0; mi < 2; ++mi) a[mi] = *(const bf16x8*)(ap[mi] + k0);
#pragma unroll
            for (int nb = 0; nb < 4; ++nb) bb[nb] = *(const bf16x8*)(bp[nb] + k0);
#pragma unroll
            for (int mi = 0; mi < 2; ++mi)
#pragma unroll
                for (int nb = 0; nb < 4; ++nb) acc[mi][nb] = __builtin_amdgcn_mfma_f32_16x16x32_bf16(bb[nb], a[mi], acc[mi][nb], 0, 0, 0);
        }
#pragma unroll
        for (int mi = 0; mi < 2; ++mi)
#pragma unroll
            for (int nb = 0; nb < (Fn::PAIRED ? 2 : 4); ++nb) fn.epi_blk(rb, cb, mi, nb, acc[mi][nb], acc[mi][Fn::PAIRED ? nb + 2 : nb], fr, fq);
    }
}
struct FnPool {
    static constexpr int nrb = MROWS / 32, ncb = 16, K = 256; static constexpr bool PAIRED = false;
    const bf16* P; const bf16* W; bf16* H; const float* scale;
    __device__ __forceinline__ const bf16* arow(int rb, int cb, int r) const { return P + (size_t)(rb * 32 + r) * D + (cb >> 2) * 256; }
    __device__ __forceinline__ const bf16* brow(int rb, int cb, int n) const { return W + (size_t)(cb * 64 + n) * 256; }
    __device__ __forceinline__ void epi_blk(int rb, int cb, int mi, int nb, const f32x4& v, const f32x4&, int fr, int fq) const {
        const int c = cb * 64 + nb * 16 + 4 * fq; bf16* p = H + (size_t)(rb * 32 + mi * 16 + fr) * D + c; const u32x2 w = *(const u32x2*)p; const f32x4 o = (f32x4){bflo(w.x), bfhi(w.x), bflo(w.y), bfhi(w.y)} + v * *(const f32x4*)(scale + c);
        u32x2 ow; ow.x = cvt_pk_bf16(o.x, o.y); ow.y = cvt_pk_bf16(o.z, o.w); *(u32x2*)p = ow; }
};
struct FnIn {
    static constexpr int nrb = MROWS / 32, ncb = 32, K = 1024; static constexpr bool PAIRED = false;
    const bf16* U; const bf16* W; bf16* XB; bf16* GY; const float* RS;
    __device__ __forceinline__ const bf16* arow(int rb, int cb, int r) const { return U + (size_t)(rb * 32 + r) * D; }
    __device__ __forceinline__ const bf16* brow(int rb, int cb, int n) const { return W + (size_t)(cb * 64 + n) * 1024; }
    __device__ __forceinline__ void epi_blk(int rb, int cb, int mi, int nb, const f32x4& v_, const f32x4&, int fr, int fq) const {
        const int c = cb * 64 + nb * 16 + 4 * fq; const size_t ro = (size_t)(rb * 32 + mi * 16 + fr) * D; u32x2 w; const f32x4 v = v_ * RS[rb * 32 + mi * 16 + fr];
        if (cb < 16) { w.x = cvt_pk_bf16(v.x, v.y); w.y = cvt_pk_bf16(v.z, v.w); *(u32x2*)(XB + ro + c) = w; }
        else { w.x = cvt_pk_bf16(gelu_tanh(v.x), gelu_tanh(v.y)); w.y = cvt_pk_bf16(gelu_tanh(v.z), gelu_tanh(v.w)); *(u32x2*)(GY + ro + c - 1024) = w; } }
};
__device__ __forceinline__ void lru_gate2(f32x2 zr, f32x2 zi, f32x2 sp, f32x2 x, bool slow, f32x2& rg, f32x2& bv) {
    const f32x2 tr = zr * (-1.44269504089f), ti = zi * (-1.44269504089f);
    f32x2 e1, e2; e1.x = __builtin_amdgcn_exp2f(tr.x); e1.y = __builtin_amdgcn_exp2f(tr.y); e2.x = __builtin_amdgcn_exp2f(ti.x); e2.y = __builtin_amdgcn_exp2f(ti.y);
    const f32x2 d1 = e1 + 1.0f, d2 = e2 + 1.0f, dd = d1 * d2;
    f32x2 inv; inv.x = fast_rcp(dd.x); inv.y = fast_rcp(dd.y);
    const f32x2 rgate = inv * d2, l = rgate * sp, x2 = l * 2.0f;
    f32x2 q = x2 * 0.0001984127f + 0.0013888889f; q = q * x2 + 0.0083333333f; q = q * x2 + 0.041666667f; q = q * x2 + 0.16666667f; q = q * x2 + 0.5f; q = q * x2 + 1.0f;
    f32x2 em = -x2 * q;
    if (__builtin_expect(slow, 0)) { asm volatile("" ::: "memory"); em.x = 1.0f - fast_exp(x2.x); em.y = 1.0f - fast_exp(x2.y); }
    f32x2 sq; sq.x = __builtin_amdgcn_sqrtf(em.x); sq.y = __builtin_amdgcn_sqrtf(em.y);
    rg = rgate; bv = sq * (inv * d1) * x;
}
struct FnGates {
    static constexpr int nrb = MROWS / 32, ncb = 64, K = 256; static constexpr bool PAIRED = true;
    const bf16* XC; const bf16* W; bf16* LA; bf16* BV; const float* bg; const float* lam;
    __device__ __forceinline__ const bf16* arow(int rb, int cb, int r) const { return XC + (size_t)(rb * 32 + r) * D + (((cb & 31) * 32) >> 8) * 256; }
    __device__ __forceinline__ const bf16* brow(int rb, int cb, int n) const {
        const int d = cb >> 5, nb = n >> 4, frn = n & 15, ch = (cb & 31) * 32 + (nb & 1) * 16 + frn, g = nb >> 1, h = ch >> 8, jl = ch & 255;
        return W + (((size_t)(d * 8 + h * 2 + (jl >> 7)) * 256) + g * 128 + (jl & 127)) * 256; }
    __device__ __forceinline__ void epi_blk(int rb, int cb, int mi, int nb, const f32x4& vr, const f32x4& vi, int fr, int fq) const {
        const int d = cb >> 5, ch = (cb & 31) * 32 + nb * 16 + 4 * fq;
        const f32x4 br = *(const f32x4*)(bg + (d * 2 + 0) * D + ch), bi = *(const f32x4*)(bg + (d * 2 + 1) * D + ch), lm = *(const f32x4*)(lam + d * D + ch);
        const size_t ro = (size_t)(rb * 32 + mi * 16 + fr) * D + ch;
        const u32x2 xw = *(const u32x2*)(XC + ro); const float xv[4] = {bflo(xw.x), bfhi(xw.x), bflo(xw.y), bfhi(xw.y)};
        float la[4], bvv[4];
        const bool slow = __any((lm.x < -0.25f) | (lm.y < -0.25f) | (lm.z < -0.25f) | (lm.w < -0.25f));
#pragma unroll
        for (int q = 0; q < 4; q += 2) { f32x2 l2, b2; lru_gate2((f32x2){vr[q] + br[q], vr[q + 1] + br[q + 1]}, (f32x2){vi[q] + bi[q], vi[q + 1] + bi[q + 1]}, (f32x2){lm[q], lm[q + 1]}, (f32x2){xv[q], xv[q + 1]}, slow, l2, b2);
            la[q] = l2.x; la[q + 1] = l2.y; bvv[q] = b2.x; bvv[q + 1] = b2.y; }
        *(unsigned*)((unsigned char*)LA + (size_t)d * MPAD * D + ro) = pk4_u8(la[0], la[1], la[2], la[3]);
        u32x2 w; w.x = cvt_pk_bf16(bvv[0], bvv[1]); w.y = cvt_pk_bf16(bvv[2], bvv[3]); *(u32x2*)(BV + (size_t)d * MPAD * D + ro) = w; }
};
struct FnOut {
    static constexpr int nrb = MROWS / 32, ncb = 16, K = 1024; static constexpr bool PAIRED = false;
    const bf16* A; const bf16* W; bf16* H;
    __device__ __forceinline__ const bf16* arow(int rb, int cb, int r) const { return A + (size_t)(rb * 32 + r) * D; }
    __device__ __forceinline__ const bf16* brow(int rb, int cb, int n) const { return W + (size_t)(cb * 64 + n) * 1024; }
    __device__ __forceinline__ void epi_blk(int rb, int cb, int mi, int nb, const f32x4& v, const f32x4&, int fr, int fq) const {
        bf16* p = H + (size_t)(rb * 32 + mi * 16 + fr) * D + cb * 64 + nb * 16 + 4 * fq; const u32x2 w = *(const u32x2*)p; const f32x4 o = (f32x4){bflo(w.x), bfhi(w.x), bflo(w.y), bfhi(w.y)} + v;
        u32x2 ow; ow.x = cvt_pk_bf16(o.x, o.y); ow.y = cvt_pk_bf16(o.z, o.w); *(u32x2*)p = ow; }
};
constexpr int ERB = (EROWS + 31) / 32;
constexpr int ERB16 = (EROWS + 15) / 16;
struct FnM1f8 {
    static constexpr int KB = 1024; static constexpr bool PAIRED = true;
    const unsigned char* U; const unsigned char* W; const int* ROWL; unsigned char* HID;
    __device__ __forceinline__ const unsigned char* arow(int rb, int cb, int r) const { const int e = rb / ERB16, pos = (rb % ERB16) * 16 + r; return U + (size_t)ROWL[e * EPAD + pos] * 1024; }
    __device__ __forceinline__ const unsigned char* brow(int rb, int cb, int n) const { const int e = rb / ERB16, nb = n >> 4, f = cb * 32 + (nb & 1) * 16 + (n & 15);
        return W + ((size_t)e * 4096 + (f >> 7) * 256 + (nb >> 1) * 128 + (f & 127)) * 1024; }
    __device__ __forceinline__ void epi_blk(int rb, int cb, int nb, const f32x4& gs, const f32x4& us, int fr, int fq) const {
        const int e = rb / ERB16, pos = (rb % ERB16) * 16 + fr, f = cb * 32 + nb * 16 + 4 * fq; const f32x4 g = gs * WINV, u = us * WINV;
        *(unsigned*)(HID + ((size_t)e * EPAD + pos) * HIDP8 + f) = pk4_fp8(siluf_(g.x) * u.x, siluf_(g.y) * u.y, siluf_(g.z) * u.z, siluf_(g.w) * u.w); }
};
struct FnM2f8 {
    static constexpr int KB = 2048; static constexpr bool PAIRED = false;
    const unsigned char* HID; const unsigned char* W; bf16* Y;
    __device__ __forceinline__ const unsigned char* arow(int rb, int cb, int r) const { const int e = rb / ERB16, pos = (rb % ERB16) * 16 + r; return HID + ((size_t)e * EPAD + pos) * HIDP8; }
    __device__ __forceinline__ const unsigned char* brow(int rb, int cb, int n) const { const int e = rb / ERB16; return W + ((size_t)e * 1024 + cb * 64 + n) * WDP8; }
    __device__ __forceinline__ void epi_blk(int rb, int cb, int nb, const f32x4& vs, const f32x4&, int fr, int fq) const {
        const int e = rb / ERB16, pos = (rb % ERB16) * 16 + fr; const f32x4 v = vs * WINV;
        *(unsigned*)((unsigned char*)Y + ((size_t)e * EPAD + pos) * D + cb * 64 + nb * 16 + 4 * fq) = pk4_fp8(v.x, v.y, v.z, v.w); }
};
template <class Fn>
__device__ __forceinline__ void wg_gemm_ksplit8(const Fn& fn, const TaskMap tm, LAS unsigned char* lds, int vcu, int G, int tid_) {
    const int tid = opaque(tid_), lane = tid & 63, wave = __builtin_amdgcn_readfirstlane(tid >> 6), fr = lane & 15, fq = lane >> 4;
    constexpr int KW = Fn::KB / 8, NS = KW / 128;
    LAS f32x4* part = (LAS f32x4*)lds;
    for (int task = vcu; task < tm.ntask; task += G) {
        const int cb = task % tm.ncb, rb = tm.rb0 + (task / tm.ncb) * tm.rbstride;
        const unsigned char* ap = fn.arow(rb, cb, fr) + wave * KW + 32 * fq; const unsigned char* bp[4];
#pragma unroll
        for (int nb = 0; nb < 4; ++nb) bp[nb] = fn.brow(rb, cb, nb * 16 + fr) + wave * KW + 32 * fq;
        v4i a[NS][2], bb[NS][4][2];
#pragma unroll
        for (int s = 0; s < NS; ++s) { a[s][0] = *(const v4i*)(ap + s * 128); a[s][1] = *(const v4i*)(ap + s * 128 + 16);
#pragma unroll
            for (int nb = 0; nb < 4; ++nb) { bb[s][nb][0] = *(const v4i*)(bp[nb] + s * 128); bb[s][nb][1] = *(const v4i*)(bp[nb] + s * 128 + 16); } }
        f32x4 acc[4];
#pragma unroll
        for (int nb = 0; nb < 4; ++nb) acc[nb] = (f32x4){0.f, 0.f, 0.f, 0.f};
#pragma unroll
        for (int s = 0; s < NS; ++s)
#pragma unroll
            for (int nb = 0; nb < 4; ++nb) acc[nb] = __builtin_amdgcn_mfma_scale_f32_16x16x128_f8f6f4(__builtin_shufflevector(bb[s][nb][0], bb[s][nb][1], 0, 1, 2, 3, 4, 5, 6, 7),
                                                                                                     __builtin_shufflevector(a[s][0], a[s][1], 0, 1, 2, 3, 4, 5, 6, 7), acc[nb], 0, 0, 0, 0, 0, 0);
#pragma unroll
        for (int nb = 0; nb < 4; ++nb) part[(wave * 4 + nb) * 64 + lane] = acc[nb];
        __syncthreads();
        if (wave < 4 && (!Fn::PAIRED || wave < 2)) {
            const int nb = wave;
            f32x4 v = (f32x4){0.f, 0.f, 0.f, 0.f}, v2 = v;
#pragma unroll
            for (int w = 0; w < 8; ++w) { v += part[(w * 4 + nb) * 64 + lane]; if (Fn::PAIRED) v2 += part[(w * 4 + nb + 2) * 64 + lane]; }
            fn.epi_blk(rb, cb, nb, v, v2, fr, fq);
        }
        __syncthreads();
    }
}

template <int MI, class Fn>
__device__ __forceinline__ void wg_gemm_ksplit(const Fn& fn, const TaskMap tm, LAS unsigned char* lds, int vcu, int G, int tid_) {
    const int tid = opaque(tid_), lane = tid & 63, wave = __builtin_amdgcn_readfirstlane(tid >> 6), fr = lane & 15, fq = lane >> 4;
    constexpr int KW = Fn::K / 8, NS = KW / 32;
    LAS f32x4* part = (LAS f32x4*)lds;
    for (int task = vcu; task < tm.ntask; task += G) {
        const int cb = task % tm.ncb, rb = tm.rb0 + (task / tm.ncb) * tm.rbstride;
        const bf16* ap[MI]; const bf16* bp[4];
#pragma unroll
        for (int mi = 0; mi < MI; ++mi) ap[mi] = fn.arow(rb, cb, mi * 16 + fr) + wave * KW + 8 * fq;
#pragma unroll
        for (int nb = 0; nb < 4; ++nb) bp[nb] = fn.brow(rb, cb, nb * 16 + fr) + wave * KW + 8 * fq;
        f32x4 acc[MI][4];
#pragma unroll
        for (int mi = 0; mi < MI; ++mi)
#pragma unroll
            for (int nb = 0; nb < 4; ++nb) acc[mi][nb] = (f32x4){0.f, 0.f, 0.f, 0.f};
#pragma unroll
        for (int s0 = 0; s0 < NS; s0 += 4) {
            bf16x8 a[4][MI], bb[4][4];
#pragma unroll
            for (int s = 0; s < 4; ++s) if (s0 + s < NS) {
#pragma unroll
                for (int mi = 0; mi < MI; ++mi) a[s][mi] = *(const bf16x8*)(ap[mi] + (s0 + s) * 32);
#pragma unroll
                for (int nb = 0; nb < 4; ++nb) bb[s][nb] = *(const bf16x8*)(bp[nb] + (s0 + s) * 32); }
#pragma unroll
            for (int s = 0; s < 4; ++s) if (s0 + s < NS) {
#pragma unroll
                for (int mi = 0; mi < MI; ++mi)
#pragma unroll
                    for (int nb = 0; nb < 4; ++nb) acc[mi][nb] = __builtin_amdgcn_mfma_f32_16x16x32_bf16(bb[s][nb], a[s][mi], acc[mi][nb], 0, 0, 0); }
        }
#pragma unroll
        for (int mi = 0; mi < MI; ++mi)
#pragma unroll
            for (int nb = 0; nb < 4; ++nb) part[((wave * MI + mi) * 4 + nb) * 64 + lane] = acc[mi][nb];
        __syncthreads();
        if (wave < MI * 4) {
            const int mi = wave >> 2, nb = wave & 3;
            if (!Fn::PAIRED || nb < 2) {
                f32x4 v = (f32x4){0.f, 0.f, 0.f, 0.f}, v2 = v;
#pragma unroll
                for (int w = 0; w < 8; ++w) { v += part[((w * MI + mi) * 4 + nb) * 64 + lane]; if (Fn::PAIRED) v2 += part[((w * MI + mi) * 4 + nb + 2) * 64 + lane]; }
                fn.epi_blk(rb, cb, mi, nb, v, v2, fr, fq);
            }
        }
        __syncthreads();
    }
}

namespace pg8 {
constexpr int BM = 256, BK = 64, HALF = 128, HTB = HALF * BK * 2, STAGE_BYTES = 8 * HTB;
__device__ __forceinline__ int lds_byte(int r, int c) { const int st = (r >> 4) * 2 + (c >> 5), rr = r & 15, cc = c & 31, ob = rr * 64 + cc * 2; return st * 1024 + (ob ^ (((ob >> 9) & 1) << 5)); }
__device__ __forceinline__ void stage_rc(int b, int& R, int& C) { const int st = b / 1024, sb = b % 1024, swz = sb ^ (((sb >> 9) & 1) << 5); R = (st >> 1) * 16 + swz / 64; C = (st & 1) * 32 + (swz % 64) / 2; }
__device__ __forceinline__ int perm32(int rho) { const int n = rho >> 4, i = rho & 15; return 8 * (i >> 2) + 4 * n + (i & 3); }
struct Unit { int pm, pn, e; };
struct SchedStd {
    int nM, nN, nwg, G, c;
    __device__ __forceinline__ void init(int nM_, int nN_, int G_, int c_) { nM = nM_; nN = nN_; nwg = nM * nN; G = G_; c = c_; }
    __device__ __forceinline__ bool next(int i, Unit& u) const {
        const int L = i * G + c; if (L >= nwg) return false;
        int wgid = L; { const int q = nwg / 8, r = nwg % 8, xcd = wgid % 8, off = wgid / 8; wgid = (xcd < r ? xcd * (q + 1) : r * (q + 1) + (xcd - r) * q) + off; }
        const int nig = 8 * nN, gid = wgid / nig, fm = gid * 8, gsz = (nM - fm) < 8 ? (nM - fm) : 8;
        u.pm = fm + ((wgid % nig) % gsz); u.pn = (wgid % nig) / gsz; u.e = 0; return true;
    }
};
struct SchedMoe {
    int nN, total, G, c, rev, gm;
    __device__ __forceinline__ void init(int nN_, int G_, int c_, int rev_ = 0, int gm_ = 8) { nN = nN_; total = 16 * 16 * nN_; G = G_; c = c_; rev = rev_; gm = gm_; }
    __device__ __forceinline__ bool next(int i, Unit& u) const {
        const int L = i * G + c; if (L >= total) return false;
        const int off = rev ? (total / 8 - 1 - L / 8) : L / 8;
        const int wgid = (L % 8) * (total / 8) + off, per = 16 * nN, w = wgid % per, nig = gm * nN;
        u.e = wgid / per; u.pm = (w / nig) * gm + (w % nig) % gm; u.pn = (w % nig) / gm; return true;
    }
};
template <class Cfg>
__device__ __forceinline__ void gemm_phase(LAS unsigned char* lds, const Cfg& cfg) {
    const int tid = opaque((int)threadIdx.x), wid = __builtin_amdgcn_readfirstlane(tid >> 6), lane = tid & 63, wr = wid >> 2, wc = wid & 3, fr = lane & 15, fq = lane >> 4;
    constexpr bool F8 = Cfg::FP8;
    constexpr int nt = Cfg::KB / 128;
    int Rr[2], Cc[2]; unsigned voffB[2];
#pragma unroll
    for (int i = 0; i < 2; ++i) { stage_rc(tid * 16 + i * 8192, Rr[i], Cc[i]); const int R = Rr[i];
        const int Rb = Cfg::PERMX ? (((R >> 5) & 3) * 64 + 16 * ((R & 15) >> 2) + 4 * ((R >> 4) & 1) + (R & 3)) : (Cfg::PERM ? ((R & ~31) + perm32(R & 31)) : R);
        voffB[i] = (unsigned)Rb * (unsigned)Cfg::ldb + (unsigned)Cc[i] * 2u; }
    const size_t kstep = (size_t)(BK * 2);
    const size_t hstepB = (size_t)(Cfg::PERMX ? 8 : HALF) * Cfg::ldb;
    const unsigned ldsw = (unsigned)wid * 1024u;
    const int aoff = lds_byte(wr * 64 + fr, F8 ? fq * 16 : fq * 8), boff = lds_byte(wc * 32 + fr, F8 ? fq * 16 : fq * 8);

#define PG8_SA(b, h) (((b) * 2 + (h)) * HTB)
#define PG8_SB(b, h) ((4 + (b) * 2 + (h)) * HTB)
#define PG8_STAGE(bufoff, gbase, voff) do { _Pragma("unroll") for (int _i = 0; _i < 2; ++_i) \
        __builtin_amdgcn_global_load_lds((const unsigned*)((const char*)(gbase) + (voff)[_i]), (LAS unsigned*)(lds + (bufoff) + ldsw + _i * 8192), 16, 0, 0); } while (0)
typedef v8i v8i_a16 __attribute__((aligned(16)));
#define PG8_LD32(p) (*(const LAS v8i_a16*)(p))
#define PG8_LDA(dst, b, h) do { if constexpr (F8) { _Pragma("unroll") for (int m = 0; m < 4; ++m) dst##8[m] = PG8_LD32(lds + PG8_SA(b, h) + aoff + m * 2048); } \
        else { _Pragma("unroll") for (int m = 0; m < 4; ++m) _Pragma("unroll") for (int k = 0; k < 2; ++k) dst[m][k] = *(const LAS bf16x8*)(lds + PG8_SA(b, h) + aoff + m * 2048 + k * 1024); } } while (0)
#define PG8_LDB(dst, b, h) do { if constexpr (F8) { _Pragma("unroll") for (int n = 0; n < 2; ++n) dst##8[n] = PG8_LD32(lds + PG8_SB(b, h) + boff + n * 2048); } \
        else { _Pragma("unroll") for (int n = 0; n < 2; ++n) _Pragma("unroll") for (int k = 0; k < 2; ++k) dst[n][k] = *(const LAS bf16x8*)(lds + PG8_SB(b, h) + boff + n * 2048 + k * 1024); } } while (0)
#define PG8_MMA(ai, bj, At, Bt) do { __builtin_amdgcn_s_setprio(1); _Pragma("unroll") for (int m = 0; m < 4; ++m) _Pragma("unroll") for (int n = 0; n < 2; ++n) { \
        if constexpr (F8) asm volatile("v_mfma_f32_16x16x128_f8f6f4 %0, %1, %2, %0" : "+v"(acc[ai][bj][m][n]) : "v"(Bt##8[n]), "v"(At##8[m]));   \
        else { _Pragma("unroll") for (int k = 0; k < 2; ++k) acc[ai][bj][m][n] = __builtin_amdgcn_mfma_f32_16x16x32_bf16(Bt[n][k], At[m][k], acc[ai][bj][m][n], 0, 0, 0); } } __builtin_amdgcn_s_setprio(0); } while (0)
#define PG8_WAIT_V(n) asm volatile("s_waitcnt vmcnt(" #n ")" ::: "memory")
#define PG8_WAIT_L(n) asm volatile("s_waitcnt lgkmcnt(" #n ")" ::: "memory")
#define PG8_BAR __builtin_amdgcn_s_barrier()
#define PG8_SCHED __builtin_amdgcn_sched_barrier(0)
    Unit cur, nxt; int ui = 0;
    if (!cfg.next(0, cur)) return;
    f32x4 acc[2][2][4][2];
#pragma unroll
    for (int a = 0; a < 2; ++a)
#pragma unroll
        for (int b = 0; b < 2; ++b)
#pragma unroll
            for (int m = 0; m < 4; ++m)
#pragma unroll
                for (int n = 0; n < 2; ++n) acc[a][b][m][n] = (f32x4){0.f, 0.f, 0.f, 0.f};
    bf16x8 At[4][2], B0[2][2], B1[2][2]; v8i At8[4], B08[2], B18[2];
    unsigned voffA[2][2], voffAn[2][2];
    cfg.a_offs(cur, 0, Rr, Cc, voffA);
    const char* cA = cfg.a_base(cur); const char* cB = cfg.b_base(cur);
    PG8_STAGE(PG8_SB(0, 0), cB, voffB); PG8_STAGE(PG8_SB(0, 1), cB + hstepB, voffB); PG8_STAGE(PG8_SA(0, 0), cA, voffA[0]); PG8_STAGE(PG8_SA(0, 1), cA, voffA[1]);
    if (wr == 1) PG8_BAR;
    PG8_WAIT_V(2); PG8_BAR;
    PG8_STAGE(PG8_SB(1, 0), cB + kstep, voffB); PG8_STAGE(PG8_SA(1, 0), cA + kstep, voffA[0]); PG8_STAGE(PG8_SB(1, 1), cB + hstepB + kstep, voffB);
    PG8_WAIT_V(6); PG8_BAR;
    for (;;) {
        const bool has_next = cfg.next(ui + 1, nxt);
        const char* nA = has_next ? cfg.a_base(nxt) : cA; const char* nB = has_next ? cfg.b_base(nxt) : cB;
#pragma unroll 1
        for (int t = 0; t < nt; t += 2) {
            const bool last = (t == nt - 2);
            const char* a1 = cA + (size_t)(t + 1) * kstep;
            const char* a2 = last ? nA : cA + (size_t)(t + 2) * kstep; const char* b2 = last ? nB : cB + (size_t)(t + 2) * kstep;
            const char* a3 = a2 + kstep; const char* b3 = b2 + kstep;
            unsigned o2[2][2];
            if constexpr (Cfg::GATHER) {
                if (last) { if (has_next) { int R2[2], C2[2]; stage_rc(tid * 16, R2[0], C2[0]); stage_rc(tid * 16 + 8192, R2[1], C2[1]); cfg.a_offs(nxt, ui + 1, R2, C2, voffAn); } else {
#pragma unroll
                    for (int h = 0; h < 2; ++h) { voffAn[h][0] = voffA[h][0]; voffAn[h][1] = voffA[h][1]; } } }
#pragma unroll
                for (int h = 0; h < 2; ++h) { o2[h][0] = last ? voffAn[h][0] : voffA[h][0]; o2[h][1] = last ? voffAn[h][1] : voffA[h][1]; }
            } else {
#pragma unroll
                for (int h = 0; h < 2; ++h) { o2[h][0] = voffA[h][0]; o2[h][1] = voffA[h][1]; }
            }
            PG8_LDB(B0, 0, 0); PG8_LDB(B1, 0, 1); PG8_SCHED; PG8_LDA(At, 0, 0); PG8_STAGE(PG8_SA(1, 1), a1, voffA[1]);
            PG8_WAIT_V(8); PG8_WAIT_L(0); PG8_BAR; PG8_MMA(0, 0, At, B0); PG8_MMA(0, 1, At, B1); PG8_BAR; PG8_SCHED;
            PG8_LDA(At, 0, 1); PG8_STAGE(PG8_SB(0, 0), b2, voffB); PG8_STAGE(PG8_SB(0, 1), b2 + hstepB, voffB); PG8_STAGE(PG8_SA(0, 0), a2, o2[0]);
            PG8_WAIT_V(8); PG8_WAIT_L(0); PG8_BAR; PG8_MMA(1, 0, At, B0); PG8_MMA(1, 1, At, B1); PG8_BAR; PG8_SCHED;
            PG8_LDB(B0, 1, 0); PG8_LDB(B1, 1, 1); PG8_SCHED; PG8_LDA(At, 1, 0); PG8_STAGE(PG8_SA(0, 1), a2, o2[1]);
            PG8_WAIT_V(8); PG8_WAIT_L(0); PG8_BAR; PG8_MMA(0, 0, At, B0); PG8_MMA(0, 1, At, B1); PG8_BAR; PG8_SCHED;
            PG8_LDA(At, 1, 1); PG8_STAGE(PG8_SB(1, 0), b3, voffB); PG8_STAGE(PG8_SB(1, 1), b3 + hstepB, voffB); PG8_STAGE(PG8_SA(1, 0), a3, o2[0]);
            PG8_WAIT_V(8); PG8_WAIT_L(0); PG8_BAR; PG8_MMA(1, 0, At, B0); PG8_MMA(1, 1, At, B1); PG8_BAR; PG8_SCHED;
        }
        if (wr == 0) PG8_BAR;
        if constexpr (F8) asm volatile("s_nop 15\n\ts_nop 15" ::: "memory");
        cfg.epi(acc, cur, wr, wc, fr, fq);
        if (!has_next) break;
#pragma unroll
        for (int a = 0; a < 2; ++a)
#pragma unroll
            for (int b = 0; b < 2; ++b)
#pragma unroll
                for (int m = 0; m < 4; ++m)
#pragma unroll
                    for (int n = 0; n < 2; ++n) acc[a][b][m][n] = (f32x4){0.f, 0.f, 0.f, 0.f};
        cur = nxt; cA = nA; cB = nB; ++ui;
        if constexpr (Cfg::GATHER) {
#pragma unroll
            for (int h = 0; h < 2; ++h) { voffA[h][0] = voffAn[h][0]; voffA[h][1] = voffAn[h][1]; } }
        if (wr == 1) PG8_BAR;
    }
    PG8_WAIT_V(0);
    PG8_BAR;
#undef PG8_SA
#undef PG8_SB
#undef PG8_STAGE
#undef PG8_LDA
#undef PG8_LDB
#undef PG8_MMA
#undef PG8_LD32
#undef PG8_WAIT_V
#undef PG8_WAIT_L
#undef PG8_BAR
#undef PG8_SCHED
}
template <int LDA> __device__ __forceinline__ void lin_offs(const int (&R)[2], const int (&C)[2], unsigned (&off)[2][2]) {
#pragma unroll
    for (int h = 0; h < 2; ++h)
#pragma unroll
        for (int i = 0; i < 2; ++i) off[h][i] = (unsigned)(h * HALF + R[i]) * (unsigned)LDA + (unsigned)C[i] * 2u;
}
struct CfgPool {
    static constexpr bool PERMX = false; static constexpr bool GATHER = false; static constexpr bool FP8 = false; static constexpr int KB = 256 * 2; static constexpr bool PERM = true; static constexpr int K = 256, ldb = 512;
    SchedStd S; const bf16* P; const bf16* W; bf16* H; const float* scale;
    __device__ __forceinline__ bool next(int i, Unit& u) const { return S.next(i, u); }
    __device__ __forceinline__ const char* a_base(const Unit& u) const { return (const char*)(P + (size_t)u.pm * 256 * D + u.pn * 256); }
    __device__ __forceinline__ void a_offs(const Unit&, int, const int (&R)[2], const int (&C)[2], unsigned (&off)[2][2]) const { lin_offs<2048>(R, C, off); }
    __device__ __forceinline__ const char* b_base(const Unit& u) const { return (const char*)(W + (size_t)u.pn * 65536); }
    __device__ __forceinline__ void epi(const f32x4 (&acc)[2][2][4][2], const Unit& u, int wr, int wc, int fr, int fq) const {
        const int row0 = u.pm * 256 + wr * 64 + fr, col0 = u.pn * 256 + wc * 32 + 8 * fq;
        f32x4 sc[2][2];
#pragma unroll
        for (int bj = 0; bj < 2; ++bj)
#pragma unroll
            for (int n = 0; n < 2; ++n) sc[bj][n] = *(const f32x4*)(scale + col0 + bj * 128 + n * 4);
#pragma unroll
        for (int ai = 0; ai < 2; ++ai) {
            u32x4 hw[4][2];
#pragma unroll
            for (int m = 0; m < 4; ++m)
#pragma unroll
                for (int bj = 0; bj < 2; ++bj) hw[m][bj] = *(const u32x4*)(H + (size_t)(row0 + ai * 128 + m * 16) * D + col0 + bj * 128);
            asm volatile("" ::: "memory");
#pragma unroll
            for (int m = 0; m < 4; ++m) { bf16* rowp = H + (size_t)(row0 + ai * 128 + m * 16) * D + col0;
#pragma unroll
                for (int bj = 0; bj < 2; ++bj) { const u32x4 w = hw[m][bj];
                    const f32x4 o0 = (f32x4){bflo(w.x), bfhi(w.x), bflo(w.y), bfhi(w.y)} + acc[ai][bj][m][0] * sc[bj][0], o1 = (f32x4){bflo(w.z), bfhi(w.z), bflo(w.w), bfhi(w.w)} + acc[ai][bj][m][1] * sc[bj][1];
                    u32x4 ow; ow.x = cvt_pk_bf16(o0.x, o0.y); ow.y = cvt_pk_bf16(o0.z, o0.w); ow.z = cvt_pk_bf16(o1.x, o1.y); ow.w = cvt_pk_bf16(o1.z, o1.w);
                    *(u32x4*)(rowp + bj * 128) = ow; } }
            asm volatile("" ::: "memory");
        }
    }
};
struct CfgOut {
    static constexpr bool PERMX = false; static constexpr bool GATHER = false; static constexpr bool FP8 = false; static constexpr int KB = 1024 * 2; static constexpr bool PERM = true; static constexpr int K = 1024, ldb = 2048;
    SchedStd S; const bf16* A; const bf16* W; bf16* H;
    __device__ __forceinline__ bool next(int i, Unit& u) const { return S.next(i, u); }
    __device__ __forceinline__ const char* a_base(const Unit& u) const { return (const char*)(A + (size_t)u.pm * 256 * D); }
    __device__ __forceinline__ void a_offs(const Unit&, int, const int (&R)[2], const int (&C)[2], unsigned (&off)[2][2]) const { lin_offs<2048>(R, C, off); }
    __device__ __forceinline__ const char* b_base(const Unit& u) const { return (const char*)(W + (size_t)u.pn * 256 * 1024); }
    __device__ __forceinline__ void epi(const f32x4 (&acc)[2][2][4][2], const Unit& u, int wr, int wc, int fr, int fq) const {
        const int row0 = u.pm * 256 + wr * 64 + fr, col0 = u.pn * 256 + wc * 32 + 8 * fq;
#pragma unroll
        for (int ai = 0; ai < 2; ++ai) {
            u32x4 hw[4][2];
#pragma unroll
            for (int m = 0; m < 4; ++m)
#pragma unroll
                for (int bj = 0; bj < 2; ++bj) hw[m][bj] = *(const u32x4*)(H + (size_t)(row0 + ai * 128 + m * 16) * D + col0 + bj * 128);
            asm volatile("" ::: "memory");
#pragma unroll
            for (int m = 0; m < 4; ++m) { bf16* rowp = H + (size_t)(row0 + ai * 128 + m * 16) * D + col0;
#pragma unroll
                for (int bj = 0; bj < 2; ++bj) { const u32x4 w = hw[m][bj];
                    const f32x4 o0 = (f32x4){bflo(w.x), bfhi(w.x), bflo(w.y), bfhi(w.y)} + acc[ai][bj][m][0], o1 = (f32x4){bflo(w.z), bfhi(w.z), bflo(w.w), bfhi(w.w)} + acc[ai][bj][m][1];
                    u32x4 ow; ow.x = cvt_pk_bf16(o0.x, o0.y); ow.y = cvt_pk_bf16(o0.z, o0.w); ow.z = cvt_pk_bf16(o1.x, o1.y); ow.w = cvt_pk_bf16(o1.z, o1.w);
                    *(u32x4*)(rowp + bj * 128) = ow; } }
            asm volatile("" ::: "memory");
        }
    }
};
struct CfgIn {
    static constexpr bool PERMX = false; static constexpr bool GATHER = false; static constexpr bool FP8 = false; static constexpr int KB = 1024 * 2; static constexpr bool PERM = true; static constexpr int K = 1024, ldb = 2048;
    SchedStd S; const bf16* U; const bf16* W; bf16* XB; bf16* GY; const float* RS;
    __device__ __forceinline__ bool next(int i, Unit& u) const { return S.next(i, u); }
    __device__ __forceinline__ const char* a_base(const Unit& u) const { return (const char*)(U + (size_t)u.pm * 256 * D); }
    __device__ __forceinline__ void a_offs(const Unit&, int, const int (&R)[2], const int (&C)[2], unsigned (&off)[2][2]) const { lin_offs<2048>(R, C, off); }
    __device__ __forceinline__ const char* b_base(const Unit& u) const { return (const char*)(W + (size_t)u.pn * 256 * 1024); }
    __device__ __forceinline__ void epi(const f32x4 (&acc)[2][2][4][2], const Unit& u, int wr, int wc, int fr, int fq) const {
        const int row0 = u.pm * 256 + wr * 64 + fr, col0 = (u.pn & 3) * 256 + wc * 32 + 8 * fq; const bool act = u.pn >= 4; bf16* base = act ? GY : XB;
        float rs[2][4];
#pragma unroll
        for (int ai = 0; ai < 2; ++ai)
#pragma unroll
            for (int m = 0; m < 4; ++m) rs[ai][m] = RS[row0 + ai * 128 + m * 16];
#pragma unroll
        for (int ai = 0; ai < 2; ++ai)
#pragma unroll
            for (int m = 0; m < 4; ++m) { bf16* rowp = base + (size_t)(row0 + ai * 128 + m * 16) * D + col0;
#pragma unroll
                for (int bj = 0; bj < 2; ++bj) { f32x4 v0 = acc[ai][bj][m][0] * rs[ai][m], v1 = acc[ai][bj][m][1] * rs[ai][m];
                    if (act) { v0.x = gelu_tanh(v0.x); v0.y = gelu_tanh(v0.y); v0.z = gelu_tanh(v0.z); v0.w = gelu_tanh(v0.w); v1.x = gelu_tanh(v1.x); v1.y = gelu_tanh(v1.y); v1.z = gelu_tanh(v1.z); v1.w = gelu_tanh(v1.w); }
                    u32x4 w; w.x = cvt_pk_bf16(v0.x, v0.y); w.y = cvt_pk_bf16(v0.z, v0.w); w.z = cvt_pk_bf16(v1.x, v1.y); w.w = cvt_pk_bf16(v1.z, v1.w);
                    *(u32x4*)(rowp + bj * 128) = w; } }
    }
};
struct CfgGates {
    static constexpr bool PERMX = false; static constexpr bool GATHER = false; static constexpr bool FP8 = false; static constexpr int KB = 256 * 2; static constexpr bool PERM = true; static constexpr int K = 256, ldb = 512;
    SchedStd S; const bf16* XC; const bf16* W; bf16* LA; bf16* BV; const float* bg; const float* lam;
    __device__ __forceinline__ bool next(int i, Unit& u) const { return S.next(i, u); }
    __device__ __forceinline__ const char* a_base(const Unit& u) const { return (const char*)(XC + (size_t)u.pm * 256 * D + ((u.pn & 7) >> 1) * 256); }
    __device__ __forceinline__ void a_offs(const Unit&, int, const int (&R)[2], const int (&C)[2], unsigned (&off)[2][2]) const { lin_offs<2048>(R, C, off); }
    __device__ __forceinline__ const char* b_base(const Unit& u) const { return (const char*)(W + (size_t)u.pn * 65536); }
    __device__ __forceinline__ void epi(const f32x4 (&acc)[2][2][4][2], const Unit& u, int wr, int wc, int fr, int fq) const {
        const int d = u.pn >> 3, ch0 = (u.pn & 7) * 128 + wc * 32 + 8 * fq, row0 = u.pm * 256 + wr * 64 + fr;
        float br[8], bi[8], sp[8];
#pragma unroll
        for (int q = 0; q < 2; ++q) { const f32x4 a = *(const f32x4*)(bg + (d * 2 + 0) * D + ch0 + 4 * q), b = *(const f32x4*)(bg + (d * 2 + 1) * D + ch0 + 4 * q), l = *(const f32x4*)(lam + d * D + ch0 + 4 * q);
#pragma unroll
            for (int x = 0; x < 4; ++x) { br[4 * q + x] = a[x]; bi[4 * q + x] = b[x]; sp[4 * q + x] = l[x]; } }
        bool sl = false;
#pragma unroll
        for (int q = 0; q < 8; ++q) sl |= sp[q] < -0.25f;
        const bool slow = __any(sl);
        u32x4 xin[2][4];
#pragma unroll
        for (int ai = 0; ai < 2; ++ai)
#pragma unroll
            for (int m = 0; m < 4; ++m) xin[ai][m] = *(const u32x4*)(XC + (size_t)(row0 + ai * 128 + m * 16) * D + ch0);
        asm volatile("" ::: "memory");
#pragma unroll
        for (int ai = 0; ai < 2; ++ai)
#pragma unroll
            for (int m = 0; m < 4; ++m) { const size_t ro = (size_t)(row0 + ai * 128 + m * 16) * D + ch0;
                const u32x4 xw = xin[ai][m];
                const float xv[8] = {bflo(xw.x), bfhi(xw.x), bflo(xw.y), bfhi(xw.y), bflo(xw.z), bfhi(xw.z), bflo(xw.w), bfhi(xw.w)};
                float la[8], bv[8];
#pragma unroll
                for (int q = 0; q < 8; q += 2) { f32x2 l2, b2;
                    lru_gate2((f32x2){acc[ai][0][m][q >> 2][q & 3] + br[q], acc[ai][0][m][q >> 2][(q & 3) + 1] + br[q + 1]}, (f32x2){acc[ai][1][m][q >> 2][q & 3] + bi[q], acc[ai][1][m][q >> 2][(q & 3) + 1] + bi[q + 1]},
                              (f32x2){sp[q], sp[q + 1]}, (f32x2){xv[q], xv[q + 1]}, slow, l2, b2);
                    la[q] = l2.x; la[q + 1] = l2.y; bv[q] = b2.x; bv[q + 1] = b2.y; }
                { u32x2 w8; w8.x = pk4_u8(la[0], la[1], la[2], la[3]); w8.y = pk4_u8(la[4], la[5], la[6], la[7]); *(u32x2*)((unsigned char*)LA + (size_t)d * MPAD * D + ro) = w8; }
                u32x4 w; w.x = cvt_pk_bf16(bv[0], bv[1]); w.y = cvt_pk_bf16(bv[2], bv[3]); w.z = cvt_pk_bf16(bv[4], bv[5]); w.w = cvt_pk_bf16(bv[6], bv[7]);
                *(u32x4*)(BV + (size_t)d * MPAD * D + ro) = w; }
    }
};
struct CfgM1 {
    static constexpr bool PERMX = false; static constexpr bool GATHER = true; static constexpr bool FP8 = true; static constexpr int KB = 1024; static constexpr bool PERM = true; static constexpr int K = 1024, ldb = 1024;
    SchedMoe S; const unsigned char* U; const unsigned char* W; unsigned char* HID; const LAS unsigned short* idx;
    __device__ __forceinline__ bool next(int i, Unit& u) const { return S.next(i, u); }
    __device__ __forceinline__ const char* a_base(const Unit&) const { return (const char*)U; }
    __device__ __forceinline__ void a_offs(const Unit&, int ui, const int (&R)[2], const int (&C)[2], unsigned (&off)[2][2]) const {
#pragma unroll
        for (int h = 0; h < 2; ++h)
#pragma unroll
            for (int i = 0; i < 2; ++i) off[h][i] = (unsigned)idx[ui * 256 + h * HALF + R[i]] * 1024u + (unsigned)C[i] * 2u;
    }
    __device__ __forceinline__ const char* b_base(const Unit& u) const { return (const char*)(W + ((size_t)u.e * 4096 + u.pn * 256) * 1024); }
    __device__ __forceinline__ void epi(const f32x4 (&acc)[2][2][4][2], const Unit& u, int wr, int wc, int fr, int fq) const {
        const int row0 = u.e * EPAD + u.pm * 256 + wr * 64 + fr, col0 = u.pn * 128 + wc * 32 + 8 * fq;
#pragma unroll
        for (int ai = 0; ai < 2; ++ai)
#pragma unroll
            for (int m = 0; m < 4; ++m) { const f32x4 g0 = acc[ai][0][m][0], g1 = acc[ai][0][m][1], u0 = acc[ai][1][m][0], u1 = acc[ai][1][m][1];
                u32x2 w; w.x = silu_mul_fp8x4(g0, u0); w.y = silu_mul_fp8x4(g1, u1);
                *(u32x2*)(HID + (size_t)(row0 + ai * 128 + m * 16) * HIDP8 + col0) = w; }
    }
};
struct CfgM2 {
    static constexpr bool PERMX = true; static constexpr bool GATHER = false; static constexpr bool FP8 = true; static constexpr int KB = 2048; static constexpr bool PERM = true; static constexpr int K = 2048, ldb = WDP8;
    SchedMoe S; const unsigned char* HID; const unsigned char* W; bf16* Y;
    __device__ __forceinline__ bool next(int i, Unit& u) const { return S.next(i, u); }
    __device__ __forceinline__ const char* a_base(const Unit& u) const { return (const char*)(HID + ((size_t)u.e * EPAD + u.pm * 256) * HIDP8); }
    __device__ __forceinline__ void a_offs(const Unit&, int, const int (&R)[2], const int (&C)[2], unsigned (&off)[2][2]) const { lin_offs<HIDP8>(R, C, off); }
    __device__ __forceinline__ const char* b_base(const Unit& u) const { return (const char*)(W + ((size_t)u.e * 1024 + u.pn * 256) * WDP8); }
    __device__ __forceinline__ void epi(const f32x4 (&acc)[2][2][4][2], const Unit& u, int wr, int wc, int fr, int fq) const {
        const int row0 = u.e * EPAD + u.pm * 256 + wr * 64 + fr, col0 = u.pn * 256 + wc * 64 + 16 * fq;
#pragma unroll
        for (int ai = 0; ai < 2; ++ai)
#pragma unroll
            for (int m = 0; m < 4; ++m) { const f32x4 v0 = acc[ai][0][m][0] * WINV, v1 = acc[ai][0][m][1] * WINV, v2 = acc[ai][1][m][0] * WINV, v3 = acc[ai][1][m][1] * WINV;
                u32x4 w; w.x = pk4_fp8(v0.x, v0.y, v0.z, v0.w); w.y = pk4_fp8(v1.x, v1.y, v1.z, v1.w); w.z = pk4_fp8(v2.x, v2.y, v2.z, v2.w); w.w = pk4_fp8(v3.x, v3.y, v3.z, v3.w);
                *(u32x4*)((unsigned char*)Y + (size_t)(row0 + ai * 128 + m * 16) * D + col0) = w; }
    }
};
}

#ifndef FAST_PG
#define FAST_PG 1
#endif
#ifndef FAST_LIN
#define FAST_LIN 1
#endif
#ifndef FAST_LGT
#define FAST_LGT 1
#endif
#ifndef FAST_LOUT
#define FAST_LOUT 1
#endif
#ifndef FAST_M1
#define FAST_M1 1
#endif
#ifndef FAST_M2
#define FAST_M2 1
#endif
constexpr int IDX_OFF = RING_BYTES + 1024;

#ifndef REP_PRO
#define REP_PRO 1
#endif
#ifndef REP_PP
#define REP_PP 1
#endif
#ifndef REP_LIN
#define REP_LIN 1
#endif
#ifndef REP_LCV
#define REP_LCV 1
#endif
#ifndef REP_LGT
#define REP_LGT 1
#endif
#ifndef REP_LS1
#define REP_LS1 1
#endif
#ifndef REP_LS3
#define REP_LS3 1
#endif
#ifndef REP_RB
#define REP_RB 1
#endif
#ifndef REP_TK
#define REP_TK 1
#endif
#ifndef REP_M1
#define REP_M1 1
#endif
#ifndef REP_M2
#define REP_M2 1
#endif
#ifndef REP_RA
#define REP_RA 1
#endif
#ifndef REP_LOUT
#define REP_LOUT 1
#endif
#ifndef REP_PG
#define REP_PG 1
#endif
#define REPEAT(n) _Pragma("unroll") for (int rep_ = 0; rep_ < (n); ++rep_)
#define IN(k) (lo <= (k) && (k) < hi)
#define SEAM(k) do { if ((k) + 1 < hi) xcd_barrier(bar); } while (0)
template <int layer>
__device__ __forceinline__ void run_layer(const Frame& F, const int lo, const int hi, const XcdBarrier& bar) {
    const int gw = F.vcu * 8 + F.wave, NGW = F.G * 8;
    const bool fast = (F.G == 256);
    {
        const int pb = layer * 16, j = layer >> 1;
        if (IN(pb + 0)) { if constexpr (layer == 0) REPEAT(REP_PRO) phase_prologue(F); if (REP_RA > 1) phase_rowA<false, layer == 0, true>(F, layer); phase_rowA<false, layer == 0>(F, layer); SEAM(pb + 0); }
        if constexpr ((layer & 1) == 0) {
            if (IN(pb + 1)) { REPEAT(REP_PP) phase_poolwin(F, layer); SEAM(pb + 1); }
            if (IN(pb + 2)) { FnPool fn{F.P, F.WPOOL + (size_t)j * 4 * 65536, F.H, F.pool_scale + (size_t)j * D};
                if (FAST_PG && fast) { pg8::CfgPool cfg; cfg.S.init(128, 4, F.G, (int)blockIdx.x); cfg.P = F.P; cfg.W = fn.W; cfg.scale = fn.scale; if (REP_PG > 1) { cfg.H = (bf16*)F.HF; pg8::gemm_phase(F.lds, cfg); } cfg.H = F.H; pg8::gemm_phase(F.lds, cfg);
                    wg_gemm_ksplit<2>(fn, TaskMap{4 * 16, 16, 1024, 1}, F.lds, F.vcu, F.G, F.tid); }
                else wave_gemm(fn, TaskMap{FnPool::nrb * 16, 16, 0, 1}, gw, NGW, F.lane);
                SEAM(pb + 2); }
        } else {
            if (IN(pb + 3)) { REPEAT(REP_LIN) { FnIn fn{F.H, F.WIN + (size_t)j * 2048 * 1024, F.XB, F.GY, F.RSTD};
                if (FAST_LIN && fast) { pg8::CfgIn cfg; cfg.S.init(128, 8, F.G, (int)blockIdx.x); cfg.U = F.H; cfg.W = fn.W; cfg.XB = F.XB; cfg.GY = F.GY; cfg.RS = F.RSTD; pg8::gemm_phase(F.lds, cfg);
                    wg_gemm_ksplit<2>(fn, TaskMap{4 * 32, 32, 1024, 1}, F.lds, F.vcu, F.G, F.tid); }
                else wave_gemm(fn, TaskMap{FnIn::nrb * 32, 32, 0, 1}, gw, NGW, F.lane);
                } SEAM(pb + 3); }
            if (IN(pb + 4)) { REPEAT(REP_LCV) phase_conv(F, j); SEAM(pb + 4); }
            if (IN(pb + 5)) { REPEAT(REP_LGT) { FnGates fn{F.P, F.WGT + (size_t)j * 16 * 65536, F.LA, F.BV, F.b_gates + (size_t)j * 4 * D, F.SPT + (size_t)j * 2 * D};
                if (FAST_LGT && fast) { pg8::CfgGates cfg; cfg.S.init(128, 16, F.G, (int)blockIdx.x); cfg.XC = F.P; cfg.W = fn.W; cfg.LA = F.LA; cfg.BV = F.BV; cfg.bg = fn.bg; cfg.lam = fn.lam; pg8::gemm_phase(F.lds, cfg);
                    wg_gemm_ksplit<2>(fn, TaskMap{4 * 64, 64, 1024, 1}, F.lds, F.vcu, F.G, F.tid); }
                else wave_gemm(fn, TaskMap{FnGates::nrb * 64, 64, 0, 1}, gw, NGW, F.lane);
                } SEAM(pb + 5); }
            if (IN(pb + 6)) { REPEAT(REP_LS1) phase_scan1(F, j); SEAM(pb + 6); }
            if (IN(pb + 7)) { REPEAT(REP_LS3) phase_scan3(F, j); SEAM(pb + 7); }
            if (IN(pb + 8)) { FnOut fn{F.HG, F.WOUT + (size_t)j * 1024 * 1024, F.H};
                if (FAST_LOUT && fast) { pg8::CfgOut cfg; cfg.S.init(128, 4, F.G, (int)blockIdx.x); cfg.A = F.HG; cfg.W = fn.W; if (REP_LOUT > 1) { cfg.H = (bf16*)F.HF; pg8::gemm_phase(F.lds, cfg); } cfg.H = F.H; pg8::gemm_phase(F.lds, cfg);
                    wg_gemm_ksplit<2>(fn, TaskMap{4 * 16, 16, 1024, 1}, F.lds, F.vcu, F.G, F.tid); }
                else wave_gemm(fn, TaskMap{FnOut::nrb * 16, 16, 0, 1}, gw, NGW, F.lane);
                SEAM(pb + 8); }
        }
        if (IN(pb + 9)) { REPEAT(REP_RB) phase_rowB(F, layer); SEAM(pb + 9); }
        if (IN(pb + 10)) { REPEAT(REP_TK) phase_topk(F); SEAM(pb + 10); }
        if (IN(pb + 11)) { REPEAT(REP_M1) { FnM1f8 fn{(const unsigned char*)F.U, (const unsigned char*)F.WG1 + (size_t)layer * NE * 4096 * 1024, F.ROWL, (unsigned char*)F.HID};
            if (FAST_M1 && fast) { pg8::CfgM1 cfg; cfg.S.init(16, F.G, (int)blockIdx.x, 0, 4); cfg.U = fn.U; cfg.W = fn.W; cfg.HID = fn.HID;
                LAS unsigned short* idx = (LAS unsigned short*)(F.lds + IDX_OFF); cfg.idx = idx;
                {
                    int rl[16];
#pragma unroll
                    for (int ui = 0; ui < 16; ++ui) { pg8::Unit u; const bool ok = cfg.S.next(ui, u); rl[ui] = F.ROWL[(ok ? u.e * EPAD + u.pm * 256 : 0) + (F.tid & 255)]; }
#pragma unroll
                    for (int ui = 0; ui < 16; ++ui) if (F.tid < 256) idx[ui * 256 + F.tid] = (unsigned short)rl[ui];
                }
                __syncthreads();
                pg8::gemm_phase(F.lds, cfg);
                wg_gemm_ksplit8(fn, TaskMap{16 * 64, 64, ERB16 - 1, ERB16}, F.lds, F.vcu, F.G, F.tid); }
            else wg_gemm_ksplit8(fn, TaskMap{NE * ERB16 * 64, 64, 0, 1}, F.lds, F.vcu, F.G, F.tid);
            } SEAM(pb + 11); }
        if (IN(pb + 12)) { REPEAT(REP_M2) { FnM2f8 fn{(const unsigned char*)F.HID, (const unsigned char*)F.WD + (size_t)layer * NE * 1024 * WDP8, F.Y};
            if (FAST_M2 && fast) { pg8::CfgM2 cfg; cfg.S.init(4, F.G, (int)blockIdx.x); cfg.HID = fn.HID; cfg.W = fn.W; cfg.Y = F.Y; pg8::gemm_phase(F.lds, cfg);
                wg_gemm_ksplit8(fn, TaskMap{16 * 16, 16, ERB16 - 1, ERB16}, F.lds, F.vcu, F.G, F.tid); }
            else wg_gemm_ksplit8(fn, TaskMap{NE * ERB16 * 16, 16, 0, 1}, F.lds, F.vcu, F.G, F.tid);
            } SEAM(pb + 12); }
    }
}
#undef IN
#undef SEAM

__global__ void __launch_bounds__(512, 2) mega(Args args) {
    extern __shared__ __attribute__((aligned(16))) unsigned char lds_raw[];
    Frame F;
    F.lds = (LAS unsigned char*)lds_raw;
    F.tid = threadIdx.x; F.lane = F.tid & 63; F.wave = __builtin_amdgcn_readfirstlane(F.tid >> 6);
    F.G = gridDim.x; { const int bx = blockIdx.x; F.vcu = (F.G % 8 == 0) ? (bx % 8) * (F.G / 8) + bx / 8 : bx; }
    F.x = args.in[0]; F.meta = args.in[1]; F.norm_mix = args.in[2]; F.norm_ffn = args.in[3]; F.norm_final = args.in[4]; F.pool_w = args.in[5]; F.pool_scale = args.in[6]; F.w_in = args.in[7]; F.conv_w = args.in[8];
    F.conv_b = args.in[9]; F.w_gates = args.in[10]; F.b_gates = args.in[11]; F.lam = args.in[12]; F.w_out = args.in[13]; F.router_w = args.in[14]; F.moe_g = args.in[15]; F.moe_u = args.in[16]; F.moe_d = args.in[17];
    F.out = args.out; F.ws = args.ws;
    unsigned char* ws = args.ws;
    F.WG1 = (bf16*)(ws + WS_WG1); F.WD = (bf16*)(ws + WS_WD); F.WIN = (bf16*)(ws + WS_WIN); F.WGT = (bf16*)(ws + WS_WGT); F.WOUT = (bf16*)(ws + WS_WOUT); F.WPOOL = (bf16*)(ws + WS_WPOOL);
    F.H = (bf16*)(ws + WS_H); F.U = (bf16*)(ws + WS_U); F.P = (bf16*)(ws + WS_P); F.XB = (bf16*)(ws + WS_XB); F.GY = (bf16*)(ws + WS_GY); F.HG = (bf16*)(ws + WS_HG); F.HF = (float*)(ws + WS_Y);
    F.LA = (bf16*)(ws + WS_BIG); F.BV = (bf16*)(ws + WS_BIG + 2 * LA_BYTES); F.HID = (bf16*)(ws + WS_BIG); F.Y = (bf16*)(ws + WS_Y);
    F.AFF = (float*)(ws + WS_AFF); F.SLOT = (int*)(ws + WS_SLOT); F.GMAP = (float*)(ws + WS_GMAP); F.ROWL = (int*)(ws + WS_ROWL); F.AGG = (float*)(ws + WS_AGG); F.SPT = (float*)(ws + WS_SPT); F.RSTD = (float*)(ws + WS_RSTD);
    volatile LAS unsigned* MISC = (volatile LAS unsigned*)(F.lds + MISC_OFF);
    if (F.tid < 32) MISC[F.tid] = 0u;
    __syncthreads();
    const int lo = args.lo, hi = args.hi;
    const bool multi = (hi - lo) > 1;
    XcdBarrier bar; bar.bar = (unsigned*)(ws + WS_CTL) + CW_BAR; bar.x = 0; bar.st = nullptr;
    if (multi) bar = xcd_barrier_post((unsigned*)(ws + WS_CTL) + CW_BAR, MISC + 8);
#define IN(k) (lo <= (k) && (k) < hi)
#define SEAM(k) do { if ((k) + 1 < hi) xcd_barrier(bar); } while (0)
    run_layer<0>(F, lo, hi, bar); run_layer<1>(F, lo, hi, bar); run_layer<2>(F, lo, hi, bar); run_layer<3>(F, lo, hi, bar);
    if (IN(64)) { if (REP_RA > 1) phase_rowA<true, false>(F, DEPTH); phase_rowA<true, false>(F, DEPTH); }
#undef IN
#undef SEAM
}

extern "C" void kernel_launch(void* const* d_in, const int* in_sizes, int n_in, void* d_out, int out_size, void* d_ws, size_t ws_size, hipStream_t stream) {
    static int grid = 0;
    if (grid == 0) {
        if (n_in != 18 || in_sizes[0] != NB * SEQ * D || out_size != NB * SEQ * D || ws_size < WS_END) {
            fprintf(stderr, "kernel_launch: unexpected shapes (n_in %d, in0 %d, out %d, ws %zu < %zu)\n", n_in, n_in > 0 ? in_sizes[0] : -1, out_size, ws_size, (size_t)WS_END); grid = -1; return; }
        int dev = 0, cus = 0;
        if (hipGetDevice(&dev) != hipSuccess || hipDeviceGetAttribute(&cus, hipDeviceAttributeMultiprocessorCount, dev) != hipSuccess) { grid = -1; return; }
        if (hipFuncSetAttribute((const void*)mega, hipFuncAttributeMaxDynamicSharedMemorySize, LDS_BYTES) != hipSuccess) { fprintf(stderr, "kernel_launch: hipFuncSetAttribute failed\n"); grid = -1; return; }
        int per_cu = 0;
        if (hipOccupancyMaxActiveBlocksPerMultiprocessor(&per_cu, (const void*)mega, 512, LDS_BYTES) != hipSuccess || per_cu < 1) fprintf(stderr, "kernel_launch: occupancy query reports %d\n", per_cu);
        (void)hipGetLastError();
        grid = cus;
    }
    if (grid < 0) return;
    if (hipMemsetAsync((char*)d_ws + WS_CTL, 0, CTL_ZERO_BYTES, stream) != hipSuccess) return;
    Args a{};
    for (int i = 0; i < 18; ++i) a.in[i] = (const float*)d_in[i];
    a.out = (float*)d_out; a.ws = (unsigned char*)d_ws;
#if SINGLE_LAUNCH
    a.lo = 0; a.hi = 65;
    hipLaunchKernelGGL(mega, dim3(grid), dim3(512), LDS_BYTES, stream, a);
#else
    for (int layer = 0; layer < DEPTH; ++layer) {
        static const int pool_ph[] = {0, 1, 2, 9, 10, 11, 12}, lru_ph[] = {0, 3, 4, 5, 6, 7, 8, 9, 10, 11, 12};
        const int* ph = (layer & 1) ? lru_ph : pool_ph; const int n = (layer & 1) ? 11 : 7;
        for (int q = 0; q < n; ++q) { a.lo = layer * 16 + ph[q]; a.hi = a.lo + 1; hipLaunchKernelGGL(mega, dim3(grid), dim3(512), LDS_BYTES, stream, a); }
    }
    a.lo = 64; a.hi = 65; hipLaunchKernelGGL(mega, dim3(grid), dim3(512), LDS_BYTES, stream, a);
#endif
}
```

```cpp
#include <hip/hip_runtime.h>
#include <cstdio>
#include <cstdint>

#ifndef SINGLE_LAUNCH
#define SINGLE_LAUNCH 1
#endif

constexpr int NB = 8, SEQ = 4096, NMETA = 16, T = SEQ + NMETA, D = 1024, NE = 16, CAP = 2 * T / NE, DF = 2048, DEPTH = 4;
constexpr int MMAIN = NB * SEQ;
constexpr int MROWS = NB * T;
constexpr int MPAD = 33024;
constexpr int EROWS = NB * CAP;
constexpr int EPAD = 4352;
constexpr int HIDP8 = 2112, WDP8 = 2112;
constexpr float WSCALE = 32.0f, WINV = 1.0f / 32.0f;
constexpr int NCHUNK = 33, CHL = 128;
static_assert(CAP == 514 && T == 4112 && EROWS == 4112, "shapes");
constexpr float RMS_EPS = 1e-6f;

constexpr size_t MiB = 1u << 20;
constexpr size_t WS_CTL = 0, CTL_ZERO_BYTES = 1 * MiB;
constexpr size_t WS_WG1 = 1 * MiB;
constexpr size_t WS_WD = WS_WG1 + 512 * MiB;
constexpr size_t WS_WIN = WS_WD + 264 * MiB;
constexpr size_t WS_WGT = WS_WIN + 8 * MiB;
constexpr size_t WS_WOUT = WS_WGT + 4 * MiB;
constexpr size_t WS_WPOOL = WS_WOUT + 4 * MiB;
constexpr size_t WS_H = WS_WPOOL + 1 * MiB;
constexpr size_t WS_U = WS_H + 129 * MiB;
constexpr size_t WS_P = WS_U + 65 * MiB;
constexpr size_t WS_XB = WS_P + 65 * MiB;
constexpr size_t WS_GY = WS_XB + 65 * MiB;
constexpr size_t WS_HG = WS_GY + 65 * MiB;
constexpr size_t WS_BIG = WS_HG + 65 * MiB;
constexpr size_t WS_Y = WS_BIG + 282 * MiB;
constexpr size_t WS_AFF = WS_Y + 136 * MiB;
constexpr size_t WS_SLOT = WS_AFF + 3 * MiB;
constexpr size_t WS_GMAP = WS_SLOT + 3 * MiB;
constexpr size_t WS_ROWL = WS_GMAP + 3 * MiB;
constexpr size_t WS_AGG = WS_ROWL + 1 * MiB;
constexpr size_t WS_SPT = WS_AGG + 9 * MiB / 2;
constexpr size_t WS_RSTD = WS_SPT + 64 * 1024;
constexpr size_t WS_END = WS_AGG + 5 * MiB;
constexpr size_t LA_BYTES = (size_t)MPAD * 1024 * 2;

constexpr int CW_BAR = 4096;

constexpr int RING_BYTES = 131072;
constexpr int MISC_OFF = RING_BYTES + 320;
constexpr int LDS_BYTES = 147456;

#define LAS __attribute__((address_space(3)))
typedef unsigned short bf16;
typedef short bf16x8 __attribute__((ext_vector_type(8)));
typedef float f32x4 __attribute__((ext_vector_type(4)));
typedef float f32x2 __attribute__((ext_vector_type(2)));
typedef unsigned u32x4 __attribute__((ext_vector_type(4)));
typedef unsigned u32x2 __attribute__((ext_vector_type(2)));

__device__ __forceinline__ unsigned cvt_pk_bf16(float lo, float hi) { unsigned r; asm volatile("v_cvt_pk_bf16_f32 %0, %1, %2" : "=v"(r) : "v"(lo), "v"(hi)); return r; }
__device__ __forceinline__ float bflo(unsigned w) { return __uint_as_float(w << 16); }
__device__ __forceinline__ float bfhi(unsigned w) { return __uint_as_float(w & 0xffff0000u); }
__device__ __forceinline__ float fast_exp(float x) { return __builtin_amdgcn_exp2f(x * 1.44269504089f); }
__device__ __forceinline__ float fast_rcp(float x) { return __builtin_amdgcn_rcpf(x); }
__device__ __forceinline__ float sigmoidf_(float x) { return fast_rcp(1.0f + fast_exp(-x)); }
__device__ __forceinline__ float siluf_(float x) { return x * sigmoidf_(x); }
typedef int v4i __attribute__((ext_vector_type(4)));
typedef int v8i __attribute__((ext_vector_type(8)));
__device__ __forceinline__ unsigned pk4_fp8(float a, float b, float c, float d) {
    a = __builtin_amdgcn_fmed3f(a, -448.f, 448.f); b = __builtin_amdgcn_fmed3f(b, -448.f, 448.f); c = __builtin_amdgcn_fmed3f(c, -448.f, 448.f); d = __builtin_amdgcn_fmed3f(d, -448.f, 448.f);
    unsigned r = 0; r = (unsigned)__builtin_amdgcn_cvt_pk_fp8_f32(a, b, (int)r, false); r = (unsigned)__builtin_amdgcn_cvt_pk_fp8_f32(c, d, (int)r, true); return r; }
__device__ __forceinline__ f32x4 fp8x4_to_f32(unsigned w) { const f32x2 lo = __builtin_amdgcn_cvt_pk_f32_fp8((int)w, false), hi = __builtin_amdgcn_cvt_pk_f32_fp8((int)w, true); return (f32x4){lo.x, lo.y, hi.x, hi.y}; }
__device__ __forceinline__ float silu_mul_s(float G, float U) { const float e = __builtin_amdgcn_exp2f(G * (-1.44269504089f * WINV)); return (G * U) * fast_rcp(__builtin_fmaf(e, 1024.0f, 1024.0f)); }
__device__ __forceinline__ unsigned pk4_u8(float a, float b, float c, float d) { return (unsigned)(a * 255.0f + 0.5f) | ((unsigned)(b * 255.0f + 0.5f) << 8) | ((unsigned)(c * 255.0f + 0.5f) << 16) | ((unsigned)(d * 255.0f + 0.5f) << 24); }
__device__ __forceinline__ unsigned silu_mul_fp8x4(const f32x4 G, const f32x4 U) {
    const f32x2 g0 = (f32x2){G.x, G.y}, g1 = (f32x2){G.z, G.w}, u0 = (f32x2){U.x, U.y}, u1 = (f32x2){U.z, U.w};
    const f32x2 t0 = g0 * (-1.44269504089f * WINV), t1 = g1 * (-1.44269504089f * WINV);
    f32x2 e0, e1; e0.x = __builtin_amdgcn_exp2f(t0.x); e0.y = __builtin_amdgcn_exp2f(t0.y); e1.x = __builtin_amdgcn_exp2f(t1.x); e1.y = __builtin_amdgcn_exp2f(t1.y);
    const f32x2 d0 = e0 * 1024.0f + 1024.0f, d1 = e1 * 1024.0f + 1024.0f;
    f32x2 r0, r1; r0.x = fast_rcp(d0.x); r0.y = fast_rcp(d0.y); r1.x = fast_rcp(d1.x); r1.y = fast_rcp(d1.y);
    const f32x2 o0 = (g0 * u0) * r0, o1 = (g1 * u1) * r1;
    return pk4_fp8(o0.x, o0.y, o1.x, o1.y);
}
__device__ __forceinline__ float gelu_tanh(float x) { const float z = 0.7978845608f * (x + 0.044715f * x * x * x); return x * sigmoidf_(2.0f * z); }
__device__ __forceinline__ float wave_sum(float v) {
#pragma unroll
    for (int o = 1; o < 64; o <<= 1) v += __shfl_xor(v, o);
    return v;
}
__device__ __forceinline__ int opaque(int v) { asm volatile("" : "+v"(v)); return v; }
__device__ __forceinline__ int row_of(int b, int t) { return t >= NMETA ? b * SEQ + (t - NMETA) : MMAIN + b * NMETA + t; }

#define XB_TMO      128
#define XB_XCNT(j)  (256  + 64 * (j))
#define XB_XSUB(j)  (1280 + 64 * (j))
#define XB_XGEN(j)  (2304 + 64 * (j))
#define XB_TOP      3328
#define XB_TOPGEN   3392
#define XCD_BAR_WORDS 3456
#define XB_SPIN_CAP (1u << 18)
__device__ __forceinline__ unsigned xb_ld(unsigned* p)              { return __hip_atomic_load(p, __ATOMIC_RELAXED, __HIP_MEMORY_SCOPE_AGENT); }
__device__ __forceinline__ unsigned xb_add(unsigned* p, unsigned v) { return __hip_atomic_fetch_add(p, v, __ATOMIC_RELAXED, __HIP_MEMORY_SCOPE_AGENT); }
__device__ __forceinline__ unsigned xb_xcc_id() { return (unsigned)__builtin_amdgcn_s_getreg((3 << 11) | 20) & 0xFu; }
#define XB_SPIN(cond, bar) do { unsigned _sp = 0; while (cond) { __builtin_amdgcn_s_sleep(1); \
    if ((++_sp & 255u) == 0u) { if (xb_ld(&(bar)[XB_TMO])) break; if (_sp > XB_SPIN_CAP) { atomicAdd(&(bar)[XB_TMO], 1u); break; } } } } while (0)
struct XcdBarrier { unsigned* bar; unsigned x; volatile LAS unsigned* st; };
__device__ __forceinline__ XcdBarrier xcd_barrier_post(unsigned* bar, volatile LAS unsigned* st) {
    XcdBarrier b; b.bar = bar; b.x = xb_xcc_id(); b.st = st;
    if (threadIdx.x == 0) (void)xb_add(&bar[XB_XCNT(b.x)], 1u);
    return b;
}
__device__ __forceinline__ void xcd_barrier_complete(unsigned* bar, unsigned x, unsigned& nloc, unsigned& nx) {
    const unsigned G = gridDim.x * gridDim.y * gridDim.z;
    unsigned sum, cnt, mine, sp = 0u;
    for (;;) {
        sum = 0u; cnt = 0u; mine = 0u;
#pragma unroll
        for (unsigned j = 0; j < 16; ++j) { const unsigned c = xb_ld(&bar[XB_XCNT(j)]); sum += c; cnt += (c > 0u) ? 1u : 0u; mine = (j == x) ? c : mine; }
        if (sum == G) break;
        __builtin_amdgcn_s_sleep(1);
        if ((++sp & 255u) == 0u) { if (xb_ld(&bar[XB_TMO])) break; if (sp > XB_SPIN_CAP) { atomicAdd(&bar[XB_TMO], 1u); break; } }
    }
    nloc = mine > 0u ? mine : 1u; nx = cnt > 0u ? cnt : 1u;
}
__device__ __forceinline__ void xcd_barrier(const XcdBarrier& b) {
    asm volatile("s_waitcnt vmcnt(0)" ::: "memory");
    __syncthreads();
    if (threadIdx.x == 0) {
        unsigned* bar = b.bar;
        __builtin_amdgcn_s_waitcnt(0);
        unsigned nloc = b.st[0], nx = b.st[1];
        if (nloc == 0u) { xcd_barrier_complete(bar, b.x, nloc, nx); b.st[0] = nloc; b.st[1] = nx; }
        const unsigned old = xb_add(&bar[XB_XSUB(b.x)], 1u);
        const unsigned gen = old / nloc;
        if (old + 1u == (gen + 1u) * nloc) {
            __builtin_amdgcn_fence(__ATOMIC_RELEASE, "agent");
            asm volatile("s_waitcnt vmcnt(0)" ::: "memory");
            const unsigned og = xb_add(&bar[XB_TOP], 1u);
            const unsigned tg = og / nx;
            if (og + 1u == (tg + 1u) * nx) xb_add(&bar[XB_TOPGEN], 1u);
            else XB_SPIN(xb_ld(&bar[XB_TOPGEN]) == tg, bar);
            __builtin_amdgcn_fence(__ATOMIC_ACQUIRE, "agent");
            xb_add(&bar[XB_XGEN(b.x)], 1u);
            asm volatile("s_waitcnt vmcnt(0)" ::: "memory");
        } else {
            XB_SPIN(xb_ld(&bar[XB_XGEN(b.x)]) == gen, bar);
            __builtin_amdgcn_fence(__ATOMIC_ACQUIRE, "agent");
            asm volatile("s_waitcnt vmcnt(0)" ::: "memory");
        }
    }
    __syncthreads();
}

struct Args { const float* in[18]; float* out; unsigned char* ws; int lo, hi; };
struct Frame {
    LAS unsigned char* lds;
    int tid, lane, wave, vcu, G;
    const float *x, *meta, *norm_mix, *norm_ffn, *norm_final, *pool_w, *pool_scale, *w_in, *conv_w, *conv_b, *w_gates, *b_gates, *lam, *w_out, *router_w, *moe_g, *moe_u, *moe_d;
    float* out; unsigned char* ws;
    bf16 *WG1, *WD, *WIN, *WGT, *WOUT, *WPOOL;
    bf16* H; float* HF; bf16 *U, *P, *XB, *GY, *HG, *LA, *BV, *HID, *Y;
    float* AFF; int* SLOT; float* GMAP; int* ROWL; float* AGG; float* SPT; float* RSTD;
};

struct ProItem { const float* src; unsigned char* dst; const float* ks; int ldw, ldt, f8; };
__device__ __forceinline__ ProItem pro_decode(const Frame& F, int it) {
    constexpr int I_MOE = 64 * 512, I_IN = 2 * 512, I_OUT = 2 * 256, I_GT = 32 * 16;
    ProItem p; p.ks = nullptr; int r = it;
    if (r < 2 * I_MOE) {
        const int up = r >= I_MOE; if (up) r -= I_MOE;
        const int le = r >> 9, q = r & 511, k0 = (q >> 6) * 128, n0 = (q & 63) * 32;
        p.src = (up ? F.moe_u : F.moe_g) + (size_t)le * 1024 * 2048 + (size_t)k0 * 2048 + n0; p.ldw = 2048;
        p.dst = (unsigned char*)F.WG1 + ((size_t)le * 4096 + (n0 >> 7) * 256 + up * 128 + (n0 & 127)) * 1024 + k0; p.ldt = 1024; p.f8 = 1; return p; }
    r -= 2 * I_MOE;
    if (r < I_MOE) {
        const int le = r >> 9, q = r & 511, k0 = (q >> 5) * 128, n0 = (q & 31) * 32;
        p.src = F.moe_d + (size_t)le * 2048 * 1024 + (size_t)k0 * 1024 + n0; p.ldw = 1024;
        p.dst = (unsigned char*)F.WD + ((size_t)le * 1024 + n0) * WDP8 + k0; p.ldt = WDP8; p.f8 = 1; return p; }
    r -= I_MOE; p.f8 = 0;
    if (r < I_IN) {
        const int j = r >> 9, q = r & 511, k0 = (q >> 6) * 128, n0 = (q & 63) * 32;
        p.src = F.w_in + (size_t)j * 1024 * 2048 + (size_t)k0 * 2048 + n0; p.ldw = 2048; p.dst = (unsigned char*)(F.WIN + ((size_t)j * 2048 + n0) * 1024 + k0); p.ldt = 2048; p.ks = F.norm_mix + (size_t)(2 * j + 1) * D + k0; return p; }
    r -= I_IN;
    if (r < I_OUT) {
        const int j = r >> 8, q = r & 255, k0 = (q >> 5) * 128, n0 = (q & 31) * 32;
        p.src = F.w_out + (size_t)j * 1024 * 1024 + (size_t)k0 * 1024 + n0; p.ldw = 1024; p.dst = (unsigned char*)(F.WOUT + ((size_t)j * 1024 + n0) * 1024 + k0); p.ldt = 2048; return p; }
    r -= I_OUT;
    if (r < I_GT) {
        const int mat = r >> 4, q = r & 15, k0 = (q >> 3) * 128, n0 = (q & 7) * 32;
        const int j = mat >> 4, d = (mat >> 3) & 1, g = (mat >> 2) & 1, h = mat & 3, nt = d * 8 + h * 2 + (n0 >> 7);
        p.src = F.w_gates + (size_t)mat * 65536 + (size_t)k0 * 256 + n0; p.ldw = 256; p.dst = (unsigned char*)(F.WGT + (((size_t)j * 16 + nt) * 256 + g * 128 + (n0 & 127)) * 256 + k0); p.ldt = 512; return p; }
    r -= I_GT;
    {
        const int mat = r >> 4, q = r & 15, k0 = (q >> 3) * 128, n0 = (q & 7) * 32;
        p.src = F.pool_w + (size_t)mat * 65536 + (size_t)k0 * 256 + n0; p.ldw = 256; p.dst = (unsigned char*)(F.WPOOL + ((size_t)mat * 256 + n0) * 256 + k0); p.ldt = 512; return p; }
}
__device__ __forceinline__ void pro_load(const ProItem& p, f32x4 (&v)[16], int lane) {
    const int rr = lane >> 3, sg = lane & 7;
#pragma unroll
    for (int i = 0; i < 16; ++i) v[i] = __builtin_nontemporal_load((const f32x4*)(p.src + (size_t)(8 * i + rr) * p.ldw + 4 * sg));
}
__device__ __forceinline__ void pro_finish(const ProItem& p, const f32x4 (&v)[16], LAS float* scr, int lane) {
    { const int rr = lane >> 3, sg = lane & 7;
#pragma unroll
        for (int i = 0; i < 16; ++i) *(LAS f32x4*)(scr + (8 * i + rr) * 32 + ((4 * sg) ^ (((i >> 1) & 3) << 3))) = v[i]; }
    asm volatile("s_waitcnt lgkmcnt(0)" ::: "memory");
    const int c = lane & 7;
#pragma unroll
    for (int j = 0; j < 4; ++j) { const int n = (lane >> 3) + 8 * j; const LAS float* s = scr + (16 * c) * 32 + (n ^ ((c & 3) << 3));
        float t[16];
#pragma unroll
        for (int q = 0; q < 16; ++q) t[q] = s[q * 32];
        if (p.f8) { u32x4 o; o.x = pk4_fp8(t[0] * WSCALE, t[1] * WSCALE, t[2] * WSCALE, t[3] * WSCALE); o.y = pk4_fp8(t[4] * WSCALE, t[5] * WSCALE, t[6] * WSCALE, t[7] * WSCALE);
            o.z = pk4_fp8(t[8] * WSCALE, t[9] * WSCALE, t[10] * WSCALE, t[11] * WSCALE); o.w = pk4_fp8(t[12] * WSCALE, t[13] * WSCALE, t[14] * WSCALE, t[15] * WSCALE);
            __builtin_nontemporal_store(o, (u32x4*)(p.dst + (size_t)n * p.ldt + 16 * c)); }
        else { if (p.ks) { const float* ks = p.ks + 16 * c;
#pragma unroll
                for (int q4 = 0; q4 < 4; ++q4) { const f32x4 g4 = *(const f32x4*)(ks + 4 * q4); t[4 * q4] *= g4.x; t[4 * q4 + 1] *= g4.y; t[4 * q4 + 2] *= g4.z; t[4 * q4 + 3] *= g4.w; } }
            u32x4 o0, o1; o0.x = cvt_pk_bf16(t[0], t[1]); o0.y = cvt_pk_bf16(t[2], t[3]); o0.z = cvt_pk_bf16(t[4], t[5]); o0.w = cvt_pk_bf16(t[6], t[7]);
            o1.x = cvt_pk_bf16(t[8], t[9]); o1.y = cvt_pk_bf16(t[10], t[11]); o1.z = cvt_pk_bf16(t[12], t[13]); o1.w = cvt_pk_bf16(t[14], t[15]);
            unsigned char* d = p.dst + (size_t)n * p.ldt + 32 * c; __builtin_nontemporal_store(o0, (u32x4*)d); __builtin_nontemporal_store(o1, (u32x4*)(d + 16)); } }
    asm volatile("s_waitcnt lgkmcnt(0)" ::: "memory");
}
__device__ __forceinline__ void phase_prologue(const Frame& F) {
    LAS float* scr = (LAS float*)(F.lds + F.wave * 16384);
    const int gw = F.vcu * 8 + F.wave, NGW = F.G * 8, lane = F.lane;
    for (int i = gw * 64 + lane; i < 4 * D; i += NGW * 64) F.SPT[i] = -8.0f * log1pf(expf(-F.lam[i]));
    constexpr int NITEMS = 3 * 64 * 512 + 2 * 512 + 2 * 256 + 32 * 16 + 8 * 16;
    int it = gw; if (it >= NITEMS) return;
    ProItem cur = pro_decode(F, it); f32x4 v[16], w[16]; pro_load(cur, v, lane);
    for (;;) {
        const int nit = it + NGW; const bool more = nit < NITEMS; ProItem nxt = cur;
        if (more) nxt = pro_decode(F, nit);
        pro_load(nxt, w, lane);
        pro_finish(cur, v, scr, lane);
        if (!more) break;
        cur = nxt; it = nit;
#pragma unroll
        for (int i = 0; i < 16; ++i) v[i] = w[i];
    }
}

template <bool FINAL, bool FIRST, bool DRY = false>
__device__ __forceinline__ void phase_rowA(const Frame& F, int layer) {
    const int gw = F.vcu * 8 + F.wave, NGW = F.G * 8, lane = F.lane;
    const float* gain = FINAL ? F.norm_final : F.norm_mix + layer * D;
    f32x4 gn[4];
#pragma unroll
    for (int j = 0; j < 4; ++j) gn[j] = *(const f32x4*)(gain + 4 * lane + 256 * j);
    const int rend = FINAL ? MMAIN : MROWS;
    int sl_n = -1; float gg_n = 0.f;
    if (!FIRST) { if (lane < 16 && gw < rend) { sl_n = F.SLOT[(size_t)gw * 16 + lane]; gg_n = F.GMAP[(size_t)gw * 16 + lane]; } }
    for (int r = gw; r < rend; r += NGW) {
        f32x4 v[4];
        if (FIRST) {
            const float* src = r < MMAIN ? F.x + (size_t)r * D : F.meta + (size_t)((r - MMAIN) & 15) * D;
#pragma unroll
            for (int j = 0; j < 4; ++j) v[j] = *(const f32x4*)(src + 4 * lane + 256 * j);
        } else {
            const int sl = sl_n; const float gg = gg_n;
            const bf16* src = F.H + (size_t)r * D;
#pragma unroll
            for (int j = 0; j < 4; ++j) { const u32x2 w = *(const u32x2*)(src + 4 * lane + 256 * j); v[j] = (f32x4){bflo(w.x), bfhi(w.x), bflo(w.y), bfhi(w.y)}; }
            { const int rn = r + NGW; sl_n = -1; if (lane < 16 && rn < rend) { sl_n = F.SLOT[(size_t)rn * 16 + lane]; gg_n = F.GMAP[(size_t)rn * 16 + lane]; } }
            unsigned mask = (unsigned)__ballot(sl >= 0) & 0xffffu;
            while (mask) {
                int ee[4]; float gq[4]; const unsigned char* yr[4];
#pragma unroll
                for (int q = 0; q < 4; ++q) { const bool on = mask != 0u; const int e = on ? (__builtin_ffs((int)mask) - 1) : 0; mask &= mask - 1u;
                    const int s = __builtin_amdgcn_readlane(sl, e); const float g = __uint_as_float(__builtin_amdgcn_readlane(__float_as_uint(gg), e));
                    ee[q] = e; gq[q] = on ? g : 0.f; yr[q] = (const unsigned char*)F.Y + ((size_t)e * EPAD + (on ? s : 0)) * D; }
                unsigned w[4][4];
#pragma unroll
                for (int q = 0; q < 4; ++q)
#pragma unroll
                    for (int j = 0; j < 4; ++j) w[q][j] = *(const unsigned*)(yr[q] + 4 * lane + 256 * j);
#pragma unroll
                for (int q = 0; q < 4; ++q)
#pragma unroll
                    for (int j = 0; j < 4; ++j) v[j] += fp8x4_to_f32(w[q][j]) * gq[q];
                (void)ee;
            }
        }
        if (!FINAL && !DRY) {
            bf16* dst = F.H + (size_t)r * D;
#pragma unroll
            for (int j = 0; j < 4; ++j) { u32x2 w; w.x = cvt_pk_bf16(v[j].x, v[j].y); w.y = cvt_pk_bf16(v[j].z, v[j].w); *(u32x2*)(dst + 4 * lane + 256 * j) = w; }
        }
        float ss = 0.f;
#pragma unroll
        for (int j = 0; j < 4; ++j) ss += (v[j].x * v[j].x + v[j].y * v[j].y) + (v[j].z * v[j].z + v[j].w * v[j].w);
        const float rstd = 1.0f / sqrtf(wave_sum(ss) * (1.0f / D) + RMS_EPS);
        if (FINAL) {
            float* dst = F.out + (size_t)r * D;
#pragma unroll
            for (int j = 0; j < 4; ++j) *(f32x4*)(dst + 4 * lane + 256 * j) = v[j] * rstd * gn[j];
        } else {
            if (lane == 0) F.RSTD[r] = rstd;
        }
    }
}
constexpr int RB_PITCH = 2064;
__device__ __forceinline__ unsigned short bf16_rne(float x) { return (unsigned short)(cvt_pk_bf16(x, 0.f) & 0xffffu); }
__device__ __forceinline__ void phase_rowB(const Frame& F, int layer) {
    const int gw = F.vcu * 8 + F.wave, NGW = F.G * 8, lane = F.lane, fr = lane & 15, fq = lane >> 4;
    LAS unsigned char* wl = F.lds;
    LAS float* gl = (LAS float*)(F.lds + 3 * 16 * RB_PITCH);
    const float* rw = F.router_w + (size_t)layer * D * NE;
    const float* gain = F.norm_ffn + layer * D;
    {   f32x4 rv[8]; float gk[8];
#pragma unroll
        for (int i = 0; i < 8; ++i) { const int i4 = F.tid + 512 * i; rv[i] = *(const f32x4*)(rw + 4 * i4); gk[i] = gain[i4 >> 2]; }
#pragma unroll
        for (int i = 0; i < 8; ++i) { const int i4 = F.tid + 512 * i, k = i4 >> 2, e0 = (i4 & 3) * 4;
#pragma unroll
            for (int x = 0; x < 4; ++x) { const float w = rv[i][x] * gk[i];
                const unsigned short hi = bf16_rne(w); const float r1 = w - __uint_as_float((unsigned)hi << 16);
                const unsigned short mid = bf16_rne(r1); const float r2 = r1 - __uint_as_float((unsigned)mid << 16);
                const unsigned short lo = bf16_rne(r2);
                LAS unsigned char* p = wl + (e0 + x) * RB_PITCH + 2 * k;
                *(LAS unsigned short*)p = hi; *(LAS unsigned short*)(p + 16 * RB_PITCH) = mid; *(LAS unsigned short*)(p + 32 * RB_PITCH) = lo; } }
        for (int k = F.tid; k < D; k += 512) gl[k] = gain[k];
    }
    __syncthreads();
    constexpr int NBLK = MROWS / 16;
    for (int blk = gw; blk < NBLK; blk += NGW) {
        const int row = blk * 16 + fr;
        const bf16* src = F.H + (size_t)row * D + 16 * fq;
        u32x4 hv[32];
#pragma unroll
        for (int kk = 0; kk < 32; ++kk) hv[kk] = *(const u32x4*)(src + 64 * (kk >> 1) + 8 * (kk & 1));
        f32x4 acc3[3], acch; acc3[0] = (f32x4){0.f, 0.f, 0.f, 0.f}; acc3[1] = acc3[0]; acc3[2] = acc3[0]; acch = acc3[0];
        const int woff = opaque(fr * RB_PITCH + 32 * fq);
#pragma unroll
        for (int k2 = 0; k2 < 32; k2 += 2) {
            bf16x8 wv[2][3];
#pragma unroll
            for (int u = 0; u < 2; ++u)
#pragma unroll
                for (int p = 0; p < 3; ++p) wv[u][p] = *(const LAS bf16x8*)(wl + woff + p * 16 * RB_PITCH + 64 * k2 + 16 * u);
#pragma unroll
            for (int u = 0; u < 2; ++u) { const bf16x8 a = __builtin_bit_cast(bf16x8, hv[k2 + u]);
#pragma unroll
                for (int p = 0; p < 3; ++p) acc3[p] = __builtin_amdgcn_mfma_f32_16x16x32_bf16(wv[u][p], a, acc3[p], 0, 0, 0);
                acch = __builtin_amdgcn_mfma_f32_16x16x32_bf16(a, a, acch, 0, 0, 0); }
            asm volatile("" ::: "memory");
        }
        const f32x4 acc = (acc3[2] + acc3[1]) + acc3[0];
        const int jd = fr & 3; const float dg = jd == 0 ? acch.x : jd == 1 ? acch.y : jd == 2 ? acch.z : acch.w;
        const float ss = __shfl(dg, fr + 16 * (fr >> 2));
        const float rstd = 1.0f / sqrtf(ss * (1.0f / D) + RMS_EPS);
        unsigned char* dst = (unsigned char*)F.U + (size_t)row * D + 16 * fq;
        const int goff = opaque(16 * fq);
#pragma unroll
        for (int k2 = 0; k2 < 32; k2 += 2) {
            u32x4 o;
#pragma unroll
            for (int u = 0; u < 2; ++u) {
                const u32x4 h4 = hv[k2 + u]; const f32x4 g0 = *(const LAS f32x4*)(gl + goff + 32 * k2 + 8 * u), g1 = *(const LAS f32x4*)(gl + goff + 32 * k2 + 8 * u + 4);
                const unsigned lo = pk4_fp8(bflo(h4.x) * rstd * g0.x, bfhi(h4.x) * rstd * g0.y, bflo(h4.y) * rstd * g0.z, bfhi(h4.y) * rstd * g0.w);
                const unsigned hi = pk4_fp8(bflo(h4.z) * rstd * g1.x, bfhi(h4.z) * rstd * g1.y, bflo(h4.w) * rstd * g1.z, bfhi(h4.w) * rstd * g1.w);
                if (u == 0) { o.x = lo; o.y = hi; } else { o.z = lo; o.w = hi; }
            }
            *(u32x4*)(dst + 32 * k2) = o;
            asm volatile("" ::: "memory");
        }
        const f32x4 lg = acc * rstd;
        float mx = fmaxf(fmaxf(lg.x, lg.y), fmaxf(lg.z, lg.w)); mx = fmaxf(mx, __shfl_xor(mx, 16)); mx = fmaxf(mx, __shfl_xor(mx, 32));
        const f32x4 p = (f32x4){expf(lg.x - mx), expf(lg.y - mx), expf(lg.z - mx), expf(lg.w - mx)};
        float sum = (p.x + p.y) + (p.z + p.w); sum += __shfl_xor(sum, 16); sum += __shfl_xor(sum, 32);
        int b, t; if (row < MMAIN) { b = row >> 12; t = (row & 4095) + NMETA; } else { b = (row - MMAIN) >> 4; t = (row - MMAIN) & 15; }
        float* ap = F.AFF + ((size_t)b * NE + 4 * fq) * T + t;
        ap[0] = p.x / sum; ap[T] = p.y / sum; ap[2 * T] = p.z / sum; ap[3 * T] = p.w / sum;
    }
    __syncthreads();
}

__device__ __forceinline__ int block_excl_scan(int v, LAS int* wsum, int tid, int lane, int wave, int& total) {
    int s = v;
#pragma unroll
    for (int o = 1; o < 64; o <<= 1) { const int t = __shfl_up(s, o); if (lane >= o) s += t; }
    __syncthreads();
    if (lane == 63) wsum[wave] = s;
    __syncthreads();
    int base = 0, tot = 0;
#pragma unroll
    for (int w = 0; w < 8; ++w) { const int x = wsum[w]; if (w < wave) base += x; tot += x; }
    total = tot;
    return base + s - v;
}
__device__ __forceinline__ void phase_topk(const Frame& F) {
    LAS unsigned* keys = (LAS unsigned*)F.lds;
    LAS int* hist = (LAS int*)(F.lds + 20480);
    LAS int* misc = (LAS int*)(F.lds + 20480 + 1024);
    const int tid = F.tid, lane = F.lane, wave = F.wave;
    for (int task = blockIdx.x; task < NB * NE; task += F.G) {
        const int b = task >> 4, e = task & 15;
        const float* aff = F.AFF + ((size_t)b * NE + e) * T;
        __syncthreads();
        {   unsigned kv[9];
#pragma unroll
            for (int i = 0; i < 9; ++i) { const int t = tid + 512 * i; kv[i] = __float_as_uint(aff[t < T ? t : T - 1]); }
#pragma unroll
            for (int i = 0; i < 9; ++i) { const int t = tid + 512 * i; if (t < T) keys[t] = kv[i]; } }
        unsigned prefix = 0u, pmask = 0u; int need = CAP;
        for (int p = 3; p >= 0; --p) {
            if (tid < 256) hist[tid] = 0;
            __syncthreads();
            for (int t = tid; t < T; t += 512) { const unsigned k = keys[t]; if ((k & pmask) == prefix) __hip_atomic_fetch_add(&hist[(k >> (8 * p)) & 255u], 1, __ATOMIC_RELAXED, __HIP_MEMORY_SCOPE_WORKGROUP); }
            __syncthreads();
            if (wave == 0) {
                int c[4]; int tot = 0;
#pragma unroll
                for (int q = 0; q < 4; ++q) { c[q] = hist[4 * lane + q]; tot += c[q]; }
                int s = tot;
#pragma unroll
                for (int o = 1; o < 64; o <<= 1) { const int x = __shfl_down(s, o); if (lane + o < 64) s += x; }
                int above = s - tot;
                if (above < need && need <= s) {
                    int a = above;
#pragma unroll
                    for (int q = 3; q >= 0; --q) { if (need <= a + c[q] && need > a) { misc[0] = 4 * lane + q; misc[1] = need - a; } a += c[q]; }
                }
            }
            __syncthreads();
            prefix |= (unsigned)misc[0] << (8 * p); pmask |= 0xFFu << (8 * p); need = misc[1];
            __syncthreads();
        }
        const unsigned vstar = prefix;
        const int t0 = tid * 9, t1 = (t0 + 9 < T) ? t0 + 9 : T;
        int neq = 0;
        for (int t = t0; t < t1; ++t) neq += (keys[t] == vstar) ? 1 : 0;
        int toteq; int eqbase = block_excl_scan(neq, misc + 8, tid, lane, wave, toteq);
        int nsel = 0; unsigned selmask = 0u; { int er = eqbase;
            for (int t = t0; t < t1; ++t) { const unsigned k = keys[t]; bool s = k > vstar; if (k == vstar) { s = er < need; ++er; } if (s) { selmask |= 1u << (t - t0); ++nsel; } } }
        int totsel; int sbase = block_excl_scan(nsel, misc + 8, tid, lane, wave, totsel);
        for (int t = t0; t < t1; ++t) {
            const int row = row_of(b, t);
            if ((selmask >> (t - t0)) & 1u) { const int pos = b * CAP + sbase; ++sbase;
                F.ROWL[e * EPAD + pos] = row; F.SLOT[(size_t)row * 16 + e] = pos; F.GMAP[(size_t)row * 16 + e] = __uint_as_float(keys[t]); }
            else F.SLOT[(size_t)row * 16 + e] = -1;
        }
        if (b == 0 && tid < EPAD - EROWS) F.ROWL[e * EPAD + EROWS + tid] = 0;
    }
    __syncthreads();
}

__device__ __forceinline__ void phase_poolwin(const Frame& F, int layer) {
    const int gw = F.vcu * 8 + F.wave, NGW = F.G * 8, lane = F.lane;
    constexpr int CHS = 33, NTC = (T + CHS - 1) / CHS;
    for (int it = gw; it < NB * NTC * 2; it += NGW) {
        const int half = it & 1, tc = (it >> 1) % NTC, b = (it >> 1) / NTC;
        const int col = half * 512 + lane * 8, g = col >> 8, hw = 1 << g;
        const int t0 = tc * CHS, t1 = (t0 + CHS < T) ? t0 + CHS : T;
        float sum[8];
#pragma unroll
        for (int q = 0; q < 8; ++q) sum[q] = 0.f;
        const u32x4 zero4 = (u32x4){0u, 0u, 0u, 0u};
        const bf16* ucol = F.H + col;
        float gnv[8];
        { const float* gp = F.norm_mix + (size_t)layer * D + col; const f32x4 g0 = *(const f32x4*)gp, g1 = *(const f32x4*)(gp + 4); gnv[0] = g0.x; gnv[1] = g0.y; gnv[2] = g0.z; gnv[3] = g0.w; gnv[4] = g1.x; gnv[5] = g1.y; gnv[6] = g1.z; gnv[7] = g1.w; }
#define PW_FMA(V_, S_) do { sum[0] += bflo(V_.x) * (S_); sum[1] += bfhi(V_.x) * (S_); sum[2] += bflo(V_.y) * (S_); sum[3] += bfhi(V_.y) * (S_); sum[4] += bflo(V_.z) * (S_); sum[5] += bfhi(V_.z) * (S_); sum[6] += bflo(V_.w) * (S_); sum[7] += bfhi(V_.w) * (S_); } while (0)
        {
            u32x4 iw[16]; float ir[16];
#pragma unroll
            for (int q = 0; q < 16; ++q) { const int dt = q - 8, tt = t0 + dt; const bool v = dt >= -hw && dt < hw && tt >= 0 && tt < T; const int row = row_of(b, v ? tt : t0); iw[q] = *(const u32x4*)(ucol + (size_t)row * D); ir[q] = F.RSTD[row]; }
#pragma unroll
            for (int q = 0; q < 16; ++q) { const int dt = q - 8, tt = t0 + dt; const bool v = dt >= -hw && dt < hw && tt >= 0 && tt < T; const float sc = v ? ir[q] : 0.f; PW_FMA(iw[q], sc); }
        }
        for (int tb = t0; tb < t1; tb += 11) {
            u32x4 c[11], wp[11], wm[11]; float rc[11], rp[11], rm[11];
#pragma unroll
            for (int q = 0; q < 11; ++q) { const int t = (tb + q < t1) ? tb + q : t1 - 1; const bool vp = t + hw < T, vm = t - hw >= 0;
                const int r0_ = row_of(b, t), r1_ = row_of(b, vp ? t + hw : t), r2_ = row_of(b, vm ? t - hw : t);
                c[q] = *(const u32x4*)(ucol + (size_t)r0_ * D); wp[q] = *(const u32x4*)(ucol + (size_t)r1_ * D); wm[q] = *(const u32x4*)(ucol + (size_t)r2_ * D);
                rc[q] = F.RSTD[r0_]; rp[q] = F.RSTD[r1_]; rm[q] = F.RSTD[r2_]; }
#pragma unroll
            for (int q = 0; q < 11; ++q) { const int t = tb + q;
                if (t < t1) {
                    const int lo = (t - hw > 0) ? t - hw : 0, hi = (t + hw < T) ? t + hw : T;
                    const float inv = 1.0f / (float)(hi - lo), cs = rc[q];
                    u32x4 o;
                    o.x = cvt_pk_bf16((sum[0] * inv - bflo(c[q].x) * cs) * gnv[0], (sum[1] * inv - bfhi(c[q].x) * cs) * gnv[1]); o.y = cvt_pk_bf16((sum[2] * inv - bflo(c[q].y) * cs) * gnv[2], (sum[3] * inv - bfhi(c[q].y) * cs) * gnv[3]);
                    o.z = cvt_pk_bf16((sum[4] * inv - bflo(c[q].z) * cs) * gnv[4], (sum[5] * inv - bfhi(c[q].z) * cs) * gnv[5]); o.w = cvt_pk_bf16((sum[6] * inv - bflo(c[q].w) * cs) * gnv[6], (sum[7] * inv - bfhi(c[q].w) * cs) * gnv[7]);
                    *(u32x4*)(F.P + (size_t)row_of(b, t) * D + col) = o;
                    const float sa = (t + hw < T) ? rp[q] : 0.f, sm = (t - hw >= 0) ? -rm[q] : 0.f;
                    PW_FMA(wp[q], sa); PW_FMA(wm[q], sm);
                }
            }
        }
#undef PW_FMA
    }
}
__device__ __forceinline__ void phase_conv(const Frame& F, int j) {
    const int gw = F.vcu * 8 + F.wave, NGW = F.G * 8, lane = F.lane;
    constexpr int CHS = 33, NTC = (T + CHS - 1) / CHS;
    const float* cw = F.conv_w + (size_t)j * 4 * D; const float* cb = F.conv_b + (size_t)j * D;
    for (int it = gw; it < NB * NTC * 2; it += NGW) {
        const int half = it & 1, tc = (it >> 1) % NTC, b = (it >> 1) / NTC;
        const int col = half * 512 + lane * 8;
        const int t0 = tc * CHS, t1 = (t0 + CHS < T) ? t0 + CHS : T;
        float w[4][8], bias[8];
#pragma unroll
        for (int k = 0; k < 4; ++k) { const f32x4 a = *(const f32x4*)(cw + k * D + col), c = *(const f32x4*)(cw + k * D + col + 4);
            w[k][0] = a.x; w[k][1] = a.y; w[k][2] = a.z; w[k][3] = a.w; w[k][4] = c.x; w[k][5] = c.y; w[k][6] = c.z; w[k][7] = c.w; }
        { const f32x4 a = *(const f32x4*)(cb + col), c = *(const f32x4*)(cb + col + 4); bias[0] = a.x; bias[1] = a.y; bias[2] = a.z; bias[3] = a.w; bias[4] = c.x; bias[5] = c.y; bias[6] = c.z; bias[7] = c.w; }
        u32x4 xm1 = (u32x4){0u, 0u, 0u, 0u}, x0 = xm1, xp1 = xm1, xp2 = xm1;
        if (t0 - 1 >= 0) xm1 = *(const u32x4*)(F.XB + (size_t)row_of(b, t0 - 1) * D + col);
        x0 = *(const u32x4*)(F.XB + (size_t)row_of(b, t0) * D + col);
        if (t0 + 1 < T) xp1 = *(const u32x4*)(F.XB + (size_t)row_of(b, t0 + 1) * D + col);
        for (int tb = t0; tb < t1; tb += 11) {
            u32x4 xn[11];
#pragma unroll
            for (int q = 0; q < 11; ++q) { const int tt = tb + q + 2; xn[q] = *(const u32x4*)(F.XB + (size_t)row_of(b, tt < T ? tt : T - 1) * D + col); }
#pragma unroll
            for (int q = 0; q < 11; ++q) { const int t = tb + q;
                if (t < t1) {
                    xp2 = (t + 2 < T) ? xn[q] : (u32x4){0u, 0u, 0u, 0u};
                    float o[8];
#define CONV2(q_, m) o[2 * q_] = bias[2 * q_] + w[0][2 * q_] * bflo(xm1.m) + w[1][2 * q_] * bflo(x0.m) + w[2][2 * q_] * bflo(xp1.m) + w[3][2 * q_] * bflo(xp2.m); \
                     o[2 * q_ + 1] = bias[2 * q_ + 1] + w[0][2 * q_ + 1] * bfhi(xm1.m) + w[1][2 * q_ + 1] * bfhi(x0.m) + w[2][2 * q_ + 1] * bfhi(xp1.m) + w[3][2 * q_ + 1] * bfhi(xp2.m);
                    CONV2(0, x) CONV2(1, y) CONV2(2, z) CONV2(3, w)
#undef CONV2
                    u32x4 ov; ov.x = cvt_pk_bf16(o[0], o[1]); ov.y = cvt_pk_bf16(o[2], o[3]); ov.z = cvt_pk_bf16(o[4], o[5]); ov.w = cvt_pk_bf16(o[6], o[7]);
                    *(u32x4*)(F.P + (size_t)row_of(b, t) * D + col) = ov;
                    xm1 = x0; x0 = xp1; xp1 = xp2;
                }
            }
        }
    }
}
__device__ __forceinline__ void chunk_rows(int b, int k, int& r0, int& n) { if (k == 0) { r0 = MMAIN + b * NMETA; n = NMETA; } else { r0 = b * SEQ + (k - 1) * CHL; n = CHL; } }
__device__ __forceinline__ void phase_scan1(const Frame& F, int j) {
    const int lane = F.lane;
    for (int it = F.wave * F.G + F.vcu; it < 2 * NB * NCHUNK * 8; it += 8 * F.G) {
        int cq, k, b, d;
        if (it < 4096) { cq = it & 7; k = 1 + ((it >> 3) & 31); b = (it >> 8) & 7; d = it >> 11; } else { const int u = it - 4096; cq = u & 7; k = 0; b = (u >> 3) & 7; d = u >> 6; }
        const int c0 = cq * 128 + lane * 2;
        int r0, n; chunk_rows(b, k, r0, n);
        const unsigned char* la = (const unsigned char*)F.LA + (size_t)d * MPAD * D + c0; const bf16* bv = F.BV + (size_t)d * MPAD * D + c0;
        const f32x2 spq = *(const f32x2*)(F.SPT + (size_t)(j * 2 + d) * D + c0) * (1.0f / 255.0f);
        float h0 = 0.f, h1 = 0.f, s0 = 0.f, s1 = 0.f;
        for (int s = 0; s < n; s += 32) {
            unsigned lw[32], bw[32];
#pragma unroll
            for (int q = 0; q < 32; ++q) { const int sq = (s + q < n) ? s + q : n - 1; const int r = d ? (r0 + n - 1 - sq) : (r0 + sq); lw[q] = *(const unsigned short*)(la + (size_t)r * D); bw[q] = *(const unsigned*)(bv + (size_t)r * D); }
#pragma unroll
            for (int q = 0; q < 32; ++q) { const bool ok = s + q < n; const unsigned lq = ok ? lw[q] : 0u, bq = ok ? bw[q] : 0u;
                const float l0 = (float)(lq & 255u) * spq.x, l1 = (float)(lq >> 8) * spq.y; s0 += l0; s1 += l1; h0 = fast_exp(l0) * h0 + bflo(bq); h1 = fast_exp(l1) * h1 + bfhi(bq); }
        }
        float* agg = F.AGG + ((size_t)(d * NB + b) * NCHUNK + k) * D + c0;
        *(f32x2*)agg = (f32x2){s0, s1};
        *(f32x2*)(agg + (size_t)2 * NB * NCHUNK * D) = (f32x2){h0, h1};
    }
}
template <int N>
__device__ __forceinline__ void scan3_rows(const Frame& F, int j, int r0, int c0, float hf0, float hf1, float hb0, float hb1) {
    constexpr int HALF = N / 2;
    const unsigned char* laf = (const unsigned char*)F.LA + c0; const bf16* bvf = F.BV + c0; const unsigned char* lab = laf + (size_t)MPAD * D; const bf16* bvb = bvf + (size_t)MPAD * D;
    const f32x2 sqf = *(const f32x2*)(F.SPT + (size_t)(j * 2 + 0) * D + c0) * (1.0f / 255.0f), sqb = *(const f32x2*)(F.SPT + (size_t)(j * 2 + 1) * D + c0) * (1.0f / 255.0f);
#define L8LO(W_, S_) ((float)((W_) & 255u) * (S_).x)
#define L8HI(W_, S_) ((float)((W_) >> 8) * (S_).y)
    unsigned sf[HALF], sb[HALF];
#pragma unroll
    for (int s = 0; s < HALF; s += 8) {
        unsigned lf[8], bf_[8], lb[8], bb[8];
#pragma unroll
        for (int q = 0; q < 8; ++q) { const size_t rf = (size_t)(r0 + s + q) * D, rb = (size_t)(r0 + N - 1 - s - q) * D;
            lf[q] = *(const unsigned short*)(laf + rf); bf_[q] = *(const unsigned*)(bvf + rf); lb[q] = *(const unsigned short*)(lab + rb); bb[q] = *(const unsigned*)(bvb + rb); }
#pragma unroll
        for (int q = 0; q < 8; ++q) {
            hf0 = fast_exp(L8LO(lf[q], sqf)) * hf0 + bflo(bf_[q]); hf1 = fast_exp(L8HI(lf[q], sqf)) * hf1 + bfhi(bf_[q]); sf[s + q] = cvt_pk_bf16(hf0, hf1);
            hb0 = fast_exp(L8LO(lb[q], sqb)) * hb0 + bflo(bb[q]); hb1 = fast_exp(L8HI(lb[q], sqb)) * hb1 + bfhi(bb[q]); sb[s + q] = cvt_pk_bf16(hb0, hb1); }
    }
#pragma unroll
    for (int s = HALF; s < N; s += 8) {
        unsigned lf[8], bf_[8], lb[8], bb[8], gf[8], gb[8];
#pragma unroll
        for (int q = 0; q < 8; ++q) { const size_t rf = (size_t)(r0 + s + q) * D, rb = (size_t)(r0 + N - 1 - s - q) * D;
            lf[q] = *(const unsigned short*)(laf + rf); bf_[q] = *(const unsigned*)(bvf + rf); lb[q] = *(const unsigned short*)(lab + rb); bb[q] = *(const unsigned*)(bvb + rb);
            gf[q] = *(const unsigned*)(F.GY + rf + c0); gb[q] = *(const unsigned*)(F.GY + rb + c0); }
#pragma unroll
        for (int q = 0; q < 8; ++q) { const size_t rf = (size_t)(r0 + s + q) * D, rb = (size_t)(r0 + N - 1 - s - q) * D;
            const unsigned xf = sb[N - 1 - s - q], xb = sf[N - 1 - s - q];
            hf0 = fast_exp(L8LO(lf[q], sqf)) * hf0 + bflo(bf_[q]); hf1 = fast_exp(L8HI(lf[q], sqf)) * hf1 + bfhi(bf_[q]);
            *(unsigned*)(F.HG + rf + c0) = cvt_pk_bf16((hf0 + bflo(xf)) * bflo(gf[q]), (hf1 + bfhi(xf)) * bfhi(gf[q]));
            hb0 = fast_exp(L8LO(lb[q], sqb)) * hb0 + bflo(bb[q]); hb1 = fast_exp(L8HI(lb[q], sqb)) * hb1 + bfhi(bb[q]);
            *(unsigned*)(F.HG + rb + c0) = cvt_pk_bf16((bflo(xb) + hb0) * bflo(gb[q]), (bfhi(xb) + hb1) * bfhi(gb[q])); }
    }
#undef L8LO
#undef L8HI
}
__device__ __forceinline__ void phase_scan3(const Frame& F, int j) {
    const int lane = F.lane;
    constexpr size_t HOFF = (size_t)2 * NB * NCHUNK * D;
    for (int it = F.wave * F.G + F.vcu; it < NB * NCHUNK * 8; it += 8 * F.G) {
        int cq, k, b;
        if (it < 2048) { cq = it & 7; k = 1 + ((it >> 3) & 31); b = it >> 8; } else { const int u = it - 2048; cq = u & 7; k = 0; b = u >> 3; }
        const int c0 = cq * 128 + lane * 2;
        int r0, n; chunk_rows(b, k, r0, n);
        float hf0 = 0.f, hf1 = 0.f, hb0 = 0.f, hb1 = 0.f;
        for (int j0 = 0; j0 < k; j0 += 8) {
            f32x2 al[8], he[8];
#pragma unroll
            for (int q = 0; q < 8; ++q) { const int jx = (j0 + q < k) ? j0 + q : 0; const float* agg = F.AGG + ((size_t)(0 * NB + b) * NCHUNK + jx) * D + c0; al[q] = *(const f32x2*)agg; he[q] = *(const f32x2*)(agg + HOFF); }
#pragma unroll
            for (int q = 0; q < 8; ++q) if (j0 + q < k) { hf0 = fast_exp(al[q].x) * hf0 + he[q].x; hf1 = fast_exp(al[q].y) * hf1 + he[q].y; }
        }
        for (int j0 = NCHUNK - 1; j0 > k; j0 -= 8) {
            f32x2 al[8], he[8];
#pragma unroll
            for (int q = 0; q < 8; ++q) { const int jx = (j0 - q > k) ? j0 - q : NCHUNK - 1; const float* agg = F.AGG + ((size_t)(1 * NB + b) * NCHUNK + jx) * D + c0; al[q] = *(const f32x2*)agg; he[q] = *(const f32x2*)(agg + HOFF); }
#pragma unroll
            for (int q = 0; q < 8; ++q) if (j0 - q > k) { hb0 = fast_exp(al[q].x) * hb0 + he[q].x; hb1 = fast_exp(al[q].y) * hb1 + he[q].y; }
        }
        if (k == 0) scan3_rows<NMETA>(F, j, r0, c0, hf0, hf1, hb0, hb1); else scan3_rows<CHL>(F, j, r0, c0, hf0, hf1, hb0, hb1);
    }
}

struct TaskMap { int ntask, ncb, rb0, rbstride; };
template <class Fn>
__device__ __forceinline__ void wave_gemm(const Fn& fn, const TaskMap tm, int gw, int ngw, int lane_) {
    const int lane = opaque(lane_), fr = lane & 15, fq = lane >> 4;
    for (int task = gw; task < tm.ntask; task += ngw) {
        const int cb = task % tm.ncb, rb = tm.rb0 + (task / tm.ncb) * tm.rbstride;
        const bf16* ap[2]; const bf16* bp[4];
#pragma unroll
        for (int mi = 0; mi < 2; ++mi) ap[mi] = fn.arow(rb, cb, mi * 16 + fr) + 8 * fq;
#pragma unroll
        for (int nb = 0; nb < 4; ++nb) bp[nb] = fn.brow(rb, cb, nb * 16 + fr) + 8 * fq;
        f32x4 acc[2][4];
#pragma unroll
        for (int mi = 0; mi < 2; ++mi)
#pragma unroll
            for (int nb = 0; nb < 4; ++nb) acc[mi][nb] = (f32x4){0.f, 0.f, 0.f, 0.f};
#pragma unroll 2
        for (int k0 = 0; k0 < fn.K; k0 += 32) {
            bf16x8 a[2], bb[4];
#pragma unroll
            for (int mi = 0; mi < 2; ++mi) a[mi] = *(const bf16x8*)(ap[mi] + k0);
#pragma unroll
            for (int nb = 0; nb < 4; ++nb) bb[nb] = *(const bf16x8*)(bp[nb] + k0);
#pragma unroll
            for (int mi = 0; mi < 2; ++mi)
#pragma unroll
                for (int nb = 0; nb < 4; ++nb) acc[mi][nb] = __builtin_amdgcn_mfma_f32_16x16x32_bf16(bb[nb], a[mi], acc[mi][nb], 0, 0, 0);
        }
#pragma unroll
        for (int mi = 0; mi < 2; ++mi)
#pragma unroll
            for (int nb = 0; nb < (Fn::PAIRED ? 2 : 4); ++nb) fn.epi_blk(rb, cb, mi, nb, acc[mi][nb], acc[mi][Fn::PAIRED ? nb + 2 : nb], fr, fq);
    }
}
struct FnPool {
    static constexpr int nrb = MROWS / 32, ncb = 16, K = 256; static constexpr bool PAIRED = false;
    const bf16* P; const bf16* W; bf16* H; const float* scale;
    __device__ __forceinline__ const bf16* arow(int rb, int cb, int r) const { return P + (size_t)(rb * 32 + r) * D + (cb >> 2) * 256; }
    __device__ __forceinline__ const bf16* brow(int rb, int cb, int n) const { return W + (size_t)(cb * 64 + n) * 256; }
    __device__ __forceinline__ void epi_blk(int rb, int cb, int mi, int nb, const f32x4& v, const f32x4&, int fr, int fq) const {
        const int c = cb * 64 + nb * 16 + 4 * fq; bf16* p = H + (size_t)(rb * 32 + mi * 16 + fr) * D + c; const u32x2 w = *(const u32x2*)p; const f32x4 o = (f32x4){bflo(w.x), bfhi(w.x), bflo(w.y), bfhi(w.y)} + v * *(const f32x4*)(scale + c);
        u32x2 ow; ow.x = cvt_pk_bf16(o.x, o.y); ow.y = cvt_pk_bf16(o.z, o.w); *(u32x2*)p = ow; }
};
struct FnIn {
    static constexpr int nrb = MROWS / 32, ncb = 32, K = 1024; static constexpr bool PAIRED = false;
    const bf16* U; const bf16* W; bf16* XB; bf16* GY; const float* RS;
    __device__ __forceinline__ const bf16* arow(int rb, int cb, int r) const { return U + (size_t)(rb * 32 + r) * D; }
    __device__ __forceinline__ const bf16* brow(int rb, int cb, int n) const { return W + (size_t)(cb * 64 + n) * 1024; }
    __device__ __forceinline__ void epi_blk(int rb, int cb, int mi, int nb, const f32x4& v_, const f32x4&, int fr, int fq) const {
        const int c = cb * 64 + nb * 16 + 4 * fq; const size_t ro = (size_t)(rb * 32 + mi * 16 + fr) * D; u32x2 w; const f32x4 v = v_ * RS[rb * 32 + mi * 16 + fr];
        if (cb < 16) { w.x = cvt_pk_bf16(v.x, v.y); w.y = cvt_pk_bf16(v.z, v.w); *(u32x2*)(XB + ro + c) = w; }
        else { w.x = cvt_pk_bf16(gelu_tanh(v.x), gelu_tanh(v.y)); w.y = cvt_pk_bf16(gelu_tanh(v.z), gelu_tanh(v.w)); *(u32x2*)(GY + ro + c - 1024) = w; } }
};
__device__ __forceinline__ void lru_gate2(f32x2 zr, f32x2 zi, f32x2 sp, f32x2 x, bool slow, f32x2& rg, f32x2& bv) {
    const f32x2 tr = zr * (-1.44269504089f), ti = zi * (-1.44269504089f);
    f32x2 e1, e2; e1.x = __builtin_amdgcn_exp2f(tr.x); e1.y = __builtin_amdgcn_exp2f(tr.y); e2.x = __builtin_amdgcn_exp2f(ti.x); e2.y = __builtin_amdgcn_exp2f(ti.y);
    const f32x2 d1 = e1 + 1.0f, d2 = e2 + 1.0f, dd = d1 * d2;
    f32x2 inv; inv.x = fast_rcp(dd.x); inv.y = fast_rcp(dd.y);
    const f32x2 rgate = inv * d2, l = rgate * sp, x2 = l * 2.0f;
    f32x2 q = x2 * 0.0001984127f + 0.0013888889f; q = q * x2 + 0.0083333333f; q = q * x2 + 0.041666667f; q = q * x2 + 0.16666667f; q = q * x2 + 0.5f; q = q * x2 + 1.0f;
    f32x2 em = -x2 * q;
    if (__builtin_expect(slow, 0)) { asm volatile("" ::: "memory"); em.x = 1.0f - fast_exp(x2.x); em.y = 1.0f - fast_exp(x2.y); }
    f32x2 sq; sq.x = __builtin_amdgcn_sqrtf(em.x); sq.y = __builtin_amdgcn_sqrtf(em.y);
    rg = rgate; bv = sq * (inv * d1) * x;
}
struct FnGates {
    static constexpr int nrb = MROWS / 32, ncb = 64, K = 256; static constexpr bool PAIRED = true;
    const bf16* XC; const bf16* W; bf16* LA; bf16* BV; const float* bg; const float* lam;
    __device__ __forceinline__ const bf16* arow(int rb, int cb, int r) const { return XC + (size_t)(rb * 32 + r) * D + (((cb & 31) * 32) >> 8) * 256; }
    __device__ __forceinline__ const bf16* brow(int rb, int cb, int n) const {
        const int d = cb >> 5, nb = n >> 4, frn = n & 15, ch = (cb & 31) * 32 + (nb & 1) * 16 + frn, g = nb >> 1, h = ch >> 8, jl = ch & 255;
        return W + (((size_t)(d * 8 + h * 2 + (jl >> 7)) * 256) + g * 128 + (jl & 127)) * 256; }
    __device__ __forceinline__ void epi_blk(int rb, int cb, int mi, int nb, const f32x4& vr, const f32x4& vi, int fr, int fq) const {
        const int d = cb >> 5, ch = (cb & 31) * 32 + nb * 16 + 4 * fq;
        const f32x4 br = *(const f32x4*)(bg + (d * 2 + 0) * D + ch), bi = *(const f32x4*)(bg + (d * 2 + 1) * D + ch), lm = *(const f32x4*)(lam + d * D + ch);
        const size_t ro = (size_t)(rb * 32 + mi * 16 + fr) * D + ch;
        const u32x2 xw = *(const u32x2*)(XC + ro); const float xv[4] = {bflo(xw.x), bfhi(xw.x), bflo(xw.y), bfhi(xw.y)};
        float la[4], bvv[4];
        const bool slow = __any((lm.x < -0.25f) | (lm.y < -0.25f) | (lm.z < -0.25f) | (lm.w < -0.25f));
#pragma unroll
        for (int q = 0; q < 4; q += 2) { f32x2 l2, b2; lru_gate2((f32x2){vr[q] + br[q], vr[q + 1] + br[q + 1]}, (f32x2){vi[q] + bi[q], vi[q + 1] + bi[q + 1]}, (f32x2){lm[q], lm[q + 1]}, (f32x2){xv[q], xv[q + 1]}, slow, l2, b2);
            la[q] = l2.x; la[q + 1] = l2.y; bvv[q] = b2.x; bvv[q + 1] = b2.y; }
        *(unsigned*)((unsigned char*)LA + (size_t)d * MPAD * D + ro) = pk4_u8(la[0], la[1], la[2], la[3]);
        u32x2 w; w.x = cvt_pk_bf16(bvv[0], bvv[1]); w.y = cvt_pk_bf16(bvv[2], bvv[3]); *(u32x2*)(BV + (size_t)d * MPAD * D + ro) = w; }
};
struct FnOut {
    static constexpr int nrb = MROWS / 32, ncb = 16, K = 1024; static constexpr bool PAIRED = false;
    const bf16* A; const bf16* W; bf16* H;
    __device__ __forceinline__ const bf16* arow(int rb, int cb, int r) const { return A + (size_t)(rb * 32 + r) * D; }
    __device__ __forceinline__ const bf16* brow(int rb, int cb, int n) const { return W + (size_t)(cb * 64 + n) * 1024; }
    __device__ __forceinline__ void epi_blk(int rb, int cb, int mi, int nb, const f32x4& v, const f32x4&, int fr, int fq) const {
        bf16* p = H + (size_t)(rb * 32 + mi * 16 + fr) * D + cb * 64 + nb * 16 + 4 * fq; const u32x2 w = *(const u32x2*)p; const f32x4 o = (f32x4){bflo(w.x), bfhi(w.x), bflo(w.y), bfhi(w.y)} + v;
        u32x2 ow; ow.x = cvt_pk_bf16(o.x, o.y); ow.y = cvt_pk_bf16(o.z, o.w); *(u32x2*)p = ow; }
};
constexpr int ERB = (EROWS + 31) / 32;
constexpr int ERB16 = (EROWS + 15) / 16;
struct FnM1f8 {
    static constexpr int KB = 1024; static constexpr bool PAIRED = true;
    const unsigned char* U; const unsigned char* W; const int* ROWL; unsigned char* HID;
    __device__ __forceinline__ const unsigned char* arow(int rb, int cb, int r) const { const int e = rb / ERB16, pos = (rb % ERB16) * 16 + r; return U + (size_t)ROWL[e * EPAD + pos] * 1024; }
    __device__ __forceinline__ const unsigned char* brow(int rb, int cb, int n) const { const int e = rb / ERB16, nb = n >> 4, f = cb * 32 + (nb & 1) * 16 + (n & 15);
        return W + ((size_t)e * 4096 + (f >> 7) * 256 + (nb >> 1) * 128 + (f & 127)) * 1024; }
    __device__ __forceinline__ void epi_blk(int rb, int cb, int nb, const f32x4& gs, const f32x4& us, int fr, int fq) const {
        const int e = rb / ERB16, pos = (rb % ERB16) * 16 + fr, f = cb * 32 + nb * 16 + 4 * fq; const f32x4 g = gs * WINV, u = us * WINV;
        *(unsigned*)(HID + ((size_t)e * EPAD + pos) * HIDP8 + f) = pk4_fp8(siluf_(g.x) * u.x, siluf_(g.y) * u.y, siluf_(g.z) * u.z, siluf_(g.w) * u.w); }
};
struct FnM2f8 {
    static constexpr int KB = 2048; static constexpr bool PAIRED = false;
    const unsigned char* HID; const unsigned char* W; bf16* Y;
    __device__ __forceinline__ const unsigned char* arow(int rb, int cb, int r) const { const int e = rb / ERB16, pos = (rb % ERB16) * 16 + r; return HID + ((size_t)e * EPAD + pos) * HIDP8; }
    __device__ __forceinline__ const unsigned char* brow(int rb, int cb, int n) const { const int e = rb / ERB16; return W + ((size_t)e * 1024 + cb * 64 + n) * WDP8; }
    __device__ __forceinline__ void epi_blk(int rb, int cb, int nb, const f32x4& vs, const f32x4&, int fr, int fq) const {
        const int e = rb / ERB16, pos = (rb % ERB16) * 16 + fr; const f32x4 v = vs * WINV;
        *(unsigned*)((unsigned char*)Y + ((size_t)e * EPAD + pos) * D + cb * 64 + nb * 16 + 4 * fq) = pk4_fp8(v.x, v.y, v.z, v.w); }
};
template <class Fn>
__device__ __forceinline__ void wg_gemm_ksplit8(const Fn& fn, const TaskMap tm, LAS unsigned char* lds, int vcu, int G, int tid_) {
    const int tid = opaque(tid_), lane = tid & 63, wave = __builtin_amdgcn_readfirstlane(tid >> 6), fr = lane & 15, fq = lane >> 4;
    constexpr int KW = Fn::KB / 8, NS = KW / 128;
    LAS f32x4* part = (LAS f32x4*)lds;
    for (int task = vcu; task < tm.ntask; task += G) {
        const int cb = task % tm.ncb, rb = tm.rb0 + (task / tm.ncb) * tm.rbstride;
        const unsigned char* ap = fn.arow(rb, cb, fr) + wave * KW + 32 * fq; const unsigned char* bp[4];
#pragma unroll
        for (int nb = 0; nb < 4; ++nb) bp[nb] = fn.brow(rb, cb, nb * 16 + fr) + wave * KW + 32 * fq;
        v4i a[NS][2], bb[NS][4][2];
#pragma unroll
        for (int s = 0; s < NS; ++s) { a[s][0] = *(const v4i*)(ap + s * 128); a[s][1] = *(const v4i*)(ap + s * 128 + 16);
#pragma unroll
            for (int nb = 0; nb < 4; ++nb) { bb[s][nb][0] = *(const v4i*)(bp[nb] + s * 128); bb[s][nb][1] = *(const v4i*)(bp[nb] + s * 128 + 16); } }
        f32x4 acc[4];
#pragma unroll
        for (int nb = 0; nb < 4; ++nb) acc[nb] = (f32x4){0.f, 0.f, 0.f, 0.f};
#pragma unroll
        for (int s = 0; s < NS; ++s)
#pragma unroll
            for (int nb = 0; nb < 4; ++nb) acc[nb] = __builtin_amdgcn_mfma_scale_f32_16x16x128_f8f6f4(__builtin_shufflevector(bb[s][nb][0], bb[s][nb][1], 0, 1, 2, 3, 4, 5, 6, 7),
                                                                                                     __builtin_shufflevector(a[s][0], a[s][1], 0, 1, 2, 3, 4, 5, 6, 7), acc[nb], 0, 0, 0, 0, 0, 0);
#pragma unroll
        for (int nb = 0; nb < 4; ++nb) part[(wave * 4 + nb) * 64 + lane] = acc[nb];
        __syncthreads();
        if (wave < 4 && (!Fn::PAIRED || wave < 2)) {
            const int nb = wave;
            f32x4 v = (f32x4){0.f, 0.f, 0.f, 0.f}, v2 = v;
#pragma unroll
            for (int w = 0; w < 8; ++w) { v += part[(w * 4 + nb) * 64 + lane]; if (Fn::PAIRED) v2 += part[(w * 4 + nb + 2) * 64 + lane]; }
            fn.epi_blk(rb, cb, nb, v, v2, fr, fq);
        }
        __syncthreads();
    }
}

template <int MI, class Fn>
__device__ __forceinline__ void wg_gemm_ksplit(const Fn& fn, const TaskMap tm, LAS unsigned char* lds, int vcu, int G, int tid_) {
    const int tid = opaque(tid_), lane = tid & 63, wave = __builtin_amdgcn_readfirstlane(tid >> 6), fr = lane & 15, fq = lane >> 4;
    constexpr int KW = Fn::K / 8, NS = KW / 32;
    LAS f32x4* part = (LAS f32x4*)lds;
    for (int task = vcu; task < tm.ntask; task += G) {
        const int cb = task % tm.ncb, rb = tm.rb0 + (task / tm.ncb) * tm.rbstride;
        const bf16* ap[MI]; const bf16* bp[4];
#pragma unroll
        for (int mi = 0; mi < MI; ++mi) ap[mi] = fn.arow(rb, cb, mi * 16 + fr) + wave * KW + 8 * fq;
#pragma unroll
        for (int nb = 0; nb < 4; ++nb) bp[nb] = fn.brow(rb, cb, nb * 16 + fr) + wave * KW + 8 * fq;
        f32x4 acc[MI][4];
#pragma unroll
        for (int mi = 0; mi < MI; ++mi)
#pragma unroll
            for (int nb = 0; nb < 4; ++nb) acc[mi][nb] = (f32x4){0.f, 0.f, 0.f, 0.f};
#pragma unroll
        for (int s0 = 0; s0 < NS; s0 += 4) {
            bf16x8 a[4][MI], bb[4][4];
#pragma unroll
            for (int s = 0; s < 4; ++s) if (s0 + s < NS) {
#pragma unroll
                for (int mi = 0; mi < MI; ++mi) a[s][mi] = *(const bf16x8*)(ap[mi] + (s0 + s) * 32);
#pragma unroll
                for (int nb = 0; nb < 4; ++nb) bb[s][nb] = *(const bf16x8*)(bp[nb] + (s0 + s) * 32); }
#pragma unroll
            for (int s = 0; s < 4; ++s) if (s0 + s < NS) {
#pragma unroll
                for (int mi = 0; mi < MI; ++mi)
#pragma unroll
                    for (int nb = 0; nb < 4; ++nb) acc[mi][nb] = __builtin_amdgcn_mfma_f32_16x16x32_bf16(bb[s][nb], a[s][mi], acc[mi][nb], 0, 0, 0); }
        }
#pragma unroll
        for (int mi = 0; mi < MI; ++mi)
#pragma unroll
            for (int nb = 0; nb < 4; ++nb) part[((wave * MI + mi) * 4 + nb) * 64 + lane] = acc[mi][nb];
        __syncthreads();
        if (wave < MI * 4) {
            const int mi = wave >> 2, nb = wave & 3;
            if (!Fn::PAIRED || nb < 2) {
                f32x4 v = (f32x4){0.f, 0.f, 0.f, 0.f}, v2 = v;
#pragma unroll
                for (int w = 0; w < 8; ++w) { v += part[((w * MI + mi) * 4 + nb) * 64 + lane]; if (Fn::PAIRED) v2 += part[((w * MI + mi) * 4 + nb + 2) * 64 + lane]; }
                fn.epi_blk(rb, cb, mi, nb, v, v2, fr, fq);
            }
        }
        __syncthreads();
    }
}

namespace pg8 {
constexpr int BM = 256, BK = 64, HALF = 128, HTB = HALF * BK * 2, STAGE_BYTES = 8 * HTB;
__device__ __forceinline__ int lds_byte(int r, int c) { const int st = (r >> 4) * 2 + (c >> 5), rr = r & 15, cc = c & 31, ob = rr * 64 + cc * 2; return st * 1024 + (ob ^ (((ob >> 9) & 1) << 5)); }
__device__ __forceinline__ void stage_rc(int b, int& R, int& C) { const int st = b / 1024, sb = b % 1024, swz = sb ^ (((sb >> 9) & 1) << 5); R = (st >> 1) * 16 + swz / 64; C = (st & 1) * 32 + (swz % 64) / 2; }
__device__ __forceinline__ int perm32(int rho) { const int n = rho >> 4, i = rho & 15; return 8 * (i >> 2) + 4 * n + (i & 3); }
struct Unit { int pm, pn, e; };
struct SchedStd {
    int nM, nN, nwg, G, c;
    __device__ __forceinline__ void init(int nM_, int nN_, int G_, int c_) { nM = nM_; nN = nN_; nwg = nM * nN; G = G_; c = c_; }
    __device__ __forceinline__ bool next(int i, Unit& u) const {
        const int L = i * G + c; if (L >= nwg) return false;
        int wgid = L; { const int q = nwg / 8, r = nwg % 8, xcd = wgid % 8, off = wgid / 8; wgid = (xcd < r ? xcd * (q + 1) : r * (q + 1) + (xcd - r) * q) + off; }
        const int nig = 8 * nN, gid = wgid / nig, fm = gid * 8, gsz = (nM - fm) < 8 ? (nM - fm) : 8;
        u.pm = fm + ((wgid % nig) % gsz); u.pn = (wgid % nig) / gsz; u.e = 0; return true;
    }
};
struct SchedMoe {
    int nN, total, G, c, rev, gm;
    __device__ __forceinline__ void init(int nN_, int G_, int c_, int rev_ = 0, int gm_ = 8) { nN = nN_; total = 16 * 16 * nN_; G = G_; c = c_; rev = rev_; gm = gm_; }
    __device__ __forceinline__ bool next(int i, Unit& u) const {
        const int L = i * G + c; if (L >= total) return false;
        const int off = rev ? (total / 8 - 1 - L / 8) : L / 8;
        const int wgid = (L % 8) * (total / 8) + off, per = 16 * nN, w = wgid % per, nig = gm * nN;
        u.e = wgid / per; u.pm = (w / nig) * gm + (w % nig) % gm; u.pn = (w % nig) / gm; return true;
    }
};
template <class Cfg>
__device__ __forceinline__ void gemm_phase(LAS unsigned char* lds, const Cfg& cfg) {
    const int tid = opaque((int)threadIdx.x), wid = __builtin_amdgcn_readfirstlane(tid >> 6), lane = tid & 63, wr = wid >> 2, wc = wid & 3, fr = lane & 15, fq = lane >> 4;
    constexpr bool F8 = Cfg::FP8;
    constexpr int nt = Cfg::KB / 128;
    int Rr[2], Cc[2]; unsigned voffB[2];
#pragma unroll
    for (int i = 0; i < 2; ++i) { stage_rc(tid * 16 + i * 8192, Rr[i], Cc[i]); const int R = Rr[i];
        const int Rb = Cfg::PERMX ? (((R >> 5) & 3) * 64 + 16 * ((R & 15) >> 2) + 4 * ((R >> 4) & 1) + (R & 3)) : (Cfg::PERM ? ((R & ~31) + perm32(R & 31)) : R);
        voffB[i] = (unsigned)Rb * (unsigned)Cfg::ldb + (unsigned)Cc[i] * 2u; }
    const size_t kstep = (size_t)(BK * 2);
    const size_t hstepB = (size_t)(Cfg::PERMX ? 8 : HALF) * Cfg::ldb;
    const unsigned ldsw = (unsigned)wid * 1024u;
    const int aoff = lds_byte(wr * 64 + fr, F8 ? fq * 16 : fq * 8), boff = lds_byte(wc * 32 + fr, F8 ? fq * 16 : fq * 8);

#define PG8_SA(b, h) (((b) * 2 + (h)) * HTB)
#define PG8_SB(b, h) ((4 + (b) * 2 + (h)) * HTB)
#define PG8_STAGE(bufoff, gbase, voff) do { _Pragma("unroll") for (int _i = 0; _i < 2; ++_i) \
        __builtin_amdgcn_global_load_lds((const unsigned*)((const char*)(gbase) + (voff)[_i]), (LAS unsigned*)(lds + (bufoff) + ldsw + _i * 8192), 16, 0, 0); } while (0)
typedef v8i v8i_a16 __attribute__((aligned(16)));
#define PG8_LD32(p) (*(const LAS v8i_a16*)(p))
#define PG8_LDA(dst, b, h) do { if constexpr (F8) { _Pragma("unroll") for (int m = 0; m < 4; ++m) dst##8[m] = PG8_LD32(lds + PG8_SA(b, h) + aoff + m * 2048); } \
        else { _Pragma("unroll") for (int m = 0; m < 4; ++m) _Pragma("unroll") for (int k = 0; k < 2; ++k) dst[m][k] = *(const LAS bf16x8*)(lds + PG8_SA(b, h) + aoff + m * 2048 + k * 1024); } } while (0)
#define PG8_LDB(dst, b, h) do { if constexpr (F8) { _Pragma("unroll") for (int n = 0; n < 2; ++n) dst##8[n] = PG8_LD32(lds + PG8_SB(b, h) + boff + n * 2048); } \
        else { _Pragma("unroll") for (int n = 0; n < 2; ++n) _Pragma("unroll") for (int k = 0; k < 2; ++k) dst[n][k] = *(const LAS bf16x8*)(lds + PG8_SB(b, h) + boff + n * 2048 + k * 1024); } } while (0)
#define PG8_MMA(ai, bj, At, Bt) do { __builtin_amdgcn_s_setprio(1); _Pragma("unroll") for (int m = 0; m < 4; ++m) _Pragma("unroll") for (int n = 0; n < 2; ++n) { \
        if constexpr (F8) asm volatile("v_mfma_f32_16x16x128_f8f6f4 %0, %1, %2, %0" : "+v"(acc[ai][bj][m][n]) : "v"(Bt##8[n]), "v"(At##8[m]));   \
        else { _Pragma("unroll") for (int k = 0; k < 2; ++k) acc[ai][bj][m][n] = __builtin_amdgcn_mfma_f32_16x16x32_bf16(Bt[n][k], At[m][k], acc[ai][bj][m][n], 0, 0, 0); } } __builtin_amdgcn_s_setprio(0); } while (0)
#define PG8_WAIT_V(n) asm volatile("s_waitcnt vmcnt(" #n ")" ::: "memory")
#define PG8_WAIT_L(n) asm volatile("s_waitcnt lgkmcnt(" #n ")" ::: "memory")
#define PG8_BAR __builtin_amdgcn_s_barrier()
#define PG8_SCHED __builtin_amdgcn_sched_barrier(0)
    Unit cur, nxt; int ui = 0;
    if (!cfg.next(0, cur)) return;
    f32x4 acc[2][2][4][2];
#pragma unroll
    for (int a = 0; a < 2; ++a)
#pragma unroll
        for (int b = 0; b < 2; ++b)
#pragma unroll
            for (int m = 0; m < 4; ++m)
#pragma unroll
                for (int n = 0; n < 2; ++n) acc[a][b][m][n] = (f32x4){0.f, 0.f, 0.f, 0.f};
    bf16x8 At[4][2], B0[2][2], B1[2][2]; v8i At8[4], B08[2], B18[2];
    unsigned voffA[2][2], voffAn[2][2];
    cfg.a_offs(cur, 0, Rr, Cc, voffA);
    const char* cA = cfg.a_base(cur); const char* cB = cfg.b_base(cur);
    PG8_STAGE(PG8_SB(0, 0), cB, voffB); PG8_STAGE(PG8_SB(0, 1), cB + hstepB, voffB); PG8_STAGE(PG8_SA(0, 0), cA, voffA[0]); PG8_STAGE(PG8_SA(0, 1), cA, voffA[1]);
    if (wr == 1) PG8_BAR;
    PG8_WAIT_V(2); PG8_BAR;
    PG8_STAGE(PG8_SB(1, 0), cB + kstep, voffB); PG8_STAGE(PG8_SA(1, 0), cA + kstep, voffA[0]); PG8_STAGE(PG8_SB(1, 1), cB + hstepB + kstep, voffB);
    PG8_WAIT_V(6); PG8_BAR;
    for (;;) {
        const bool has_next = cfg.next(ui + 1, nxt);
        const char* nA = has_next ? cfg.a_base(nxt) : cA; const char* nB = has_next ? cfg.b_base(nxt) : cB;
#pragma unroll 1
        for (int t = 0; t < nt; t += 2) {
            const bool last = (t == nt - 2);
            const char* a1 = cA + (size_t)(t + 1) * kstep;
            const char* a2 = last ? nA : cA + (size_t)(t + 2) * kstep; const char* b2 = last ? nB : cB + (size_t)(t + 2) * kstep;
            const char* a3 = a2 + kstep; const char* b3 = b2 + kstep;
            unsigned o2[2][2];
            if constexpr (Cfg::GATHER) {
                if (last) { if (has_next) { int R2[2], C2[2]; stage_rc(tid * 16, R2[0], C2[0]); stage_rc(tid * 16 + 8192, R2[1], C2[1]); cfg.a_offs(nxt, ui + 1, R2, C2, voffAn); } else {
#pragma unroll
                    for (int h = 0; h < 2; ++h) { voffAn[h][0] = voffA[h][0]; voffAn[h][1] = voffA[h][1]; } } }
#pragma unroll
                for (int h = 0; h < 2; ++h) { o2[h][0] = last ? voffAn[h][0] : voffA[h][0]; o2[h][1] = last ? voffAn[h][1] : voffA[h][1]; }
            } else {
#pragma unroll
                for (int h = 0; h < 2; ++h) { o2[h][0] = voffA[h][0]; o2[h][1] = voffA[h][1]; }
            }
            PG8_LDB(B0, 0, 0); PG8_LDB(B1, 0, 1); PG8_SCHED; PG8_LDA(At, 0, 0); PG8_STAGE(PG8_SA(1, 1), a1, voffA[1]);
            PG8_WAIT_V(8); PG8_WAIT_L(0); PG8_BAR; PG8_MMA(0, 0, At, B0); PG8_MMA(0, 1, At, B1); PG8_BAR; PG8_SCHED;
            PG8_LDA(At, 0, 1); PG8_STAGE(PG8_SB(0, 0), b2, voffB); PG8_STAGE(PG8_SB(0, 1), b2 + hstepB, voffB); PG8_STAGE(PG8_SA(0, 0), a2, o2[0]);
            PG8_WAIT_V(8); PG8_WAIT_L(0); PG8_BAR; PG8_MMA(1, 0, At, B0); PG8_MMA(1, 1, At, B1); PG8_BAR; PG8_SCHED;
            PG8_LDB(B0, 1, 0); PG8_LDB(B1, 1, 1); PG8_SCHED; PG8_LDA(At, 1, 0); PG8_STAGE(PG8_SA(0, 1), a2, o2[1]);
            PG8_WAIT_V(8); PG8_WAIT_L(0); PG8_BAR; PG8_MMA(0, 0, At, B0); PG8_MMA(0, 1, At, B1); PG8_BAR; PG8_SCHED;
            PG8_LDA(At, 1, 1); PG8_STAGE(PG8_SB(1, 0), b3, voffB); PG8_STAGE(PG8_SB(1, 1), b3 + hstepB, voffB); PG8_STAGE(PG8_SA(1, 0), a3, o2[0]);
            PG8_WAIT_V(8); PG8_WAIT_L(0); PG8_BAR; PG8_MMA(1, 0, At, B0); PG8_MMA(1, 1, At, B1); PG8_BAR; PG8_SCHED;
        }
        if (wr == 0) PG8_BAR;
        if constexpr (F8) asm volatile("s_nop 15\n\ts_nop 15" ::: "memory");
        cfg.epi(acc, cur, wr, wc, fr, fq);
        if (!has_next) break;
#pragma unroll
        for (int a = 0; a < 2; ++a)
#pragma unroll
            for (int b = 0; b < 2; ++b)
#pragma unroll
                for (int m = 0; m < 4; ++m)
#pragma unroll
                    for (int n = 0; n < 2; ++n) acc[a][b][m][n] = (f32x4){0.f, 0.f, 0.f, 0.f};
        cur = nxt; cA = nA; cB = nB; ++ui;
        if constexpr (Cfg::GATHER) {
#pragma unroll
            for (int h = 0; h < 2; ++h) { voffA[h][0] = voffAn[h][0]; voffA[h][1] = voffAn[h][1]; } }
        if (wr == 1) PG8_BAR;
    }
    PG8_WAIT_V(0);
    PG8_BAR;
#undef PG8_SA
#undef PG8_SB
#undef PG8_STAGE
#undef PG8_LDA
#undef PG8_LDB
#undef PG8_MMA
#undef PG8_LD32
#undef PG8_WAIT_V
#undef PG8_WAIT_L
#undef PG8_BAR
#undef PG8_SCHED
}
template <int LDA> __device__ __forceinline__ void lin_offs(const int (&R)[2], const int (&C)[2], unsigned (&off)[2][2]) {
#pragma unroll
    for (int h = 0; h < 2; ++h)
#pragma unroll
        for (int i = 0; i < 2; ++i) off[h][i] = (unsigned)(h * HALF + R[i]) * (unsigned)LDA + (unsigned)C[i] * 2u;
}
struct CfgPool {
    static constexpr bool PERMX = false; static constexpr bool GATHER = false; static constexpr bool FP8 = false; static constexpr int KB = 256 * 2; static constexpr bool PERM = true; static constexpr int K = 256, ldb = 512;
    SchedStd S; const bf16* P; const bf16* W; bf16* H; const float* scale;
    __device__ __forceinline__ bool next(int i, Unit& u) const { return S.next(i, u); }
    __device__ __forceinline__ const char* a_base(const Unit& u) const { return (const char*)(P + (size_t)u.pm * 256 * D + u.pn * 256); }
    __device__ __forceinline__ void a_offs(const Unit&, int, const int (&R)[2], const int (&C)[2], unsigned (&off)[2][2]) const { lin_offs<2048>(R, C, off); }
    __device__ __forceinline__ const char* b_base(const Unit& u) const { return (const char*)(W + (size_t)u.pn * 65536); }
    __device__ __forceinline__ void epi(const f32x4 (&acc)[2][2][4][2], const Unit& u, int wr, int wc, int fr, int fq) const {
        const int row0 = u.pm * 256 + wr * 64 + fr, col0 = u.pn * 256 + wc * 32 + 8 * fq;
        f32x4 sc[2][2];
#pragma unroll
        for (int bj = 0; bj < 2; ++bj)
#pragma unroll
            for (int n = 0; n < 2; ++n) sc[bj][n] = *(const f32x4*)(scale + col0 + bj * 128 + n * 4);
#pragma unroll
        for (int ai = 0; ai < 2; ++ai) {
            u32x4 hw[4][2];
#pragma unroll
            for (int m = 0; m < 4; ++m)
#pragma unroll
                for (int bj = 0; bj < 2; ++bj) hw[m][bj] = *(const u32x4*)(H + (size_t)(row0 + ai * 128 + m * 16) * D + col0 + bj * 128);
            asm volatile("" ::: "memory");
#pragma unroll
            for (int m = 0; m < 4; ++m) { bf16* rowp = H + (size_t)(row0 + ai * 128 + m * 16) * D + col0;
#pragma unroll
                for (int bj = 0; bj < 2; ++bj) { const u32x4 w = hw[m][bj];
                    const f32x4 o0 = (f32x4){bflo(w.x), bfhi(w.x), bflo(w.y), bfhi(w.y)} + acc[ai][bj][m][0] * sc[bj][0], o1 = (f32x4){bflo(w.z), bfhi(w.z), bflo(w.w), bfhi(w.w)} + acc[ai][bj][m][1] * sc[bj][1];
                    u32x4 ow; ow.x = cvt_pk_bf16(o0.x, o0.y); ow.y = cvt_pk_bf16(o0.z, o0.w); ow.z = cvt_pk_bf16(o1.x, o1.y); ow.w = cvt_pk_bf16(o1.z, o1.w);
                    *(u32x4*)(rowp + bj * 128) = ow; } }
            asm volatile("" ::: "memory");
        }
    }
};
struct CfgOut {
    static constexpr bool PERMX = false; static constexpr bool GATHER = false; static constexpr bool FP8 = false; static constexpr int KB = 1024 * 2; static constexpr bool PERM = true; static constexpr int K = 1024, ldb = 2048;
    SchedStd S; const bf16* A; const bf16* W; bf16* H;
    __device__ __forceinline__ bool next(int i, Unit& u) const { return S.next(i, u); }
    __device__ __forceinline__ const char* a_base(const Unit& u) const { return (const char*)(A + (size_t)u.pm * 256 * D); }
    __device__ __forceinline__ void a_offs(const Unit&, int, const int (&R)[2], const int (&C)[2], unsigned (&off)[2][2]) const { lin_offs<2048>(R, C, off); }
    __device__ __forceinline__ const char* b_base(const Unit& u) const { return (const char*)(W + (size_t)u.pn * 256 * 1024); }
    __device__ __forceinline__ void epi(const f32x4 (&acc)[2][2][4][2], const Unit& u, int wr, int wc, int fr, int fq) const {
        const int row0 = u.pm * 256 + wr * 64 + fr, col0 = u.pn * 256 + wc * 32 + 8 * fq;
#pragma unroll
        for (int ai = 0; ai < 2; ++ai) {
            u32x4 hw[4][2];
#pragma unroll
            for (int m = 0; m < 4; ++m)
#pragma unroll
                for (int bj = 0; bj < 2; ++bj) hw[m][bj] = *(const u32x4*)(H + (size_t)(row0 + ai * 128 + m * 16) * D + col0 + bj * 128);
            asm volatile("" ::: "memory");
#pragma unroll
            for (int m = 0; m < 4; ++m) { bf16* rowp = H + (size_t)(row0 + ai * 128 + m * 16) * D + col0;
#pragma unroll
                for (int bj = 0; bj < 2; ++bj) { const u32x4 w = hw[m][bj];
                    const f32x4 o0 = (f32x4){bflo(w.x), bfhi(w.x), bflo(w.y), bfhi(w.y)} + acc[ai][bj][m][0], o1 = (f32x4){bflo(w.z), bfhi(w.z), bflo(w.w), bfhi(w.w)} + acc[ai][bj][m][1];
                    u32x4 ow; ow.x = cvt_pk_bf16(o0.x, o0.y); ow.y = cvt_pk_bf16(o0.z, o0.w); ow.z = cvt_pk_bf16(o1.x, o1.y); ow.w = cvt_pk_bf16(o1.z, o1.w);
                    *(u32x4*)(rowp + bj * 128) = ow; } }
            asm volatile("" ::: "memory");
        }
    }
};
struct CfgIn {
    static constexpr bool PERMX = false; static constexpr bool GATHER = false; static constexpr bool FP8 = false; static constexpr int KB = 1024 * 2; static constexpr bool PERM = true; static constexpr int K = 1024, ldb = 2048;
    SchedStd S; const bf16* U; const bf16* W; bf16* XB; bf16* GY; const float* RS;
    __device__ __forceinline__ bool next(int i, Unit& u) const { return S.next(i, u); }
    __device__ __forceinline__ const char* a_base(const Unit& u) const { return (const char*)(U + (size_t)u.pm * 256 * D); }
    __device__ __forceinline__ void a_offs(const Unit&, int, const int (&R)[2], const int (&C)[2], unsigned (&off)[2][2]) const { lin_offs<2048>(R, C, off); }
    __device__ __forceinline__ const char* b_base(const Unit& u) const { return (const char*)(W + (size_t)u.pn * 256 * 1024); }
    __device__ __forceinline__ void epi(const f32x4 (&acc)[2][2][4][2], const Unit& u, int wr, int wc, int fr, int fq) const {
        const int row0 = u.pm * 256 + wr * 64 + fr, col0 = (u.pn & 3) * 256 + wc * 32 + 8 * fq; const bool act = u.pn >= 4; bf16* base = act ? GY : XB;
        float rs[2][4];
#pragma unroll
        for (int ai = 0; ai < 2; ++ai)
#pragma unroll
            for (int m = 0; m < 4; ++m) rs[ai][m] = RS[row0 + ai * 128 + m * 16];
#pragma unroll
        for (int ai = 0; ai < 2; ++ai)
#pragma unroll
            for (int m = 0; m < 4; ++m) { bf16* rowp = base + (size_t)(row0 + ai * 128 + m * 16) * D + col0;
#pragma unroll
                for (int bj = 0; bj < 2; ++bj) { f32x4 v0 = acc[ai][bj][m][0] * rs[ai][m], v1 = acc[ai][bj][m][1] * rs[ai][m];
                    if (act) { v0.x = gelu_tanh(v0.x); v0.y = gelu_tanh(v0.y); v0.z = gelu_tanh(v0.z); v0.w = gelu_tanh(v0.w); v1.x = gelu_tanh(v1.x); v1.y = gelu_tanh(v1.y); v1.z = gelu_tanh(v1.z); v1.w = gelu_tanh(v1.w); }
                    u32x4 w; w.x = cvt_pk_bf16(v0.x, v0.y); w.y = cvt_pk_bf16(v0.z, v0.w); w.z = cvt_pk_bf16(v1.x, v1.y); w.w = cvt_pk_bf16(v1.z, v1.w);
                    *(u32x4*)(rowp + bj * 128) = w; } }
    }
};
struct CfgGates {
    static constexpr bool PERMX = false; static constexpr bool GATHER = false; static constexpr bool FP8 = false; static constexpr int KB = 256 * 2; static constexpr bool PERM = true; static constexpr int K = 256, ldb = 512;
    SchedStd S; const bf16* XC; const bf16* W; bf16* LA; bf16* BV; const float* bg; const float* lam;
    __device__ __forceinline__ bool next(int i, Unit& u) const { return S.next(i, u); }
    __device__ __forceinline__ const char* a_base(const Unit& u) const { return (const char*)(XC + (size_t)u.pm * 256 * D + ((u.pn & 7) >> 1) * 256); }
    __device__ __forceinline__ void a_offs(const Unit&, int, const int (&R)[2], const int (&C)[2], unsigned (&off)[2][2]) const { lin_offs<2048>(R, C, off); }
    __device__ __forceinline__ const char* b_base(const Unit& u) const { return (const char*)(W + (size_t)u.pn * 65536); }
    __device__ __forceinline__ void epi(const f32x4 (&acc)[2][2][4][2], const Unit& u, int wr, int wc, int fr, int fq) const {
        const int d = u.pn >> 3, ch0 = (u.pn & 7) * 128 + wc * 32 + 8 * fq, row0 = u.pm * 256 + wr * 64 + fr;
        float br[8], bi[8], sp[8];
#pragma unroll
        for (int q = 0; q < 2; ++q) { const f32x4 a = *(const f32x4*)(bg + (d * 2 + 0) * D + ch0 + 4 * q), b = *(const f32x4*)(bg + (d * 2 + 1) * D + ch0 + 4 * q), l = *(const f32x4*)(lam + d * D + ch0 + 4 * q);
#pragma unroll
            for (int x = 0; x < 4; ++x) { br[4 * q + x] = a[x]; bi[4 * q + x] = b[x]; sp[4 * q + x] = l[x]; } }
        bool sl = false;
#pragma unroll
        for (int q = 0; q < 8; ++q) sl |= sp[q] < -0.25f;
        const bool slow = __any(sl);
        u32x4 xin[2][4];
#pragma unroll
        for (int ai = 0; ai < 2; ++ai)
#pragma unroll
            for (int m = 0; m < 4; ++m) xin[ai][m] = *(const u32x4*)(XC + (size_t)(row0 + ai * 128 + m * 16) * D + ch0);
        asm volatile("" ::: "memory");
#pragma unroll
        for (int ai = 0; ai < 2; ++ai)
#pragma unroll
            for (int m = 0; m < 4; ++m) { const size_t ro = (size_t)(row0 + ai * 128 + m * 16) * D + ch0;
                const u32x4 xw = xin[ai][m];
                const float xv[8] = {bflo(xw.x), bfhi(xw.x), bflo(xw.y), bfhi(xw.y), bflo(xw.z), bfhi(xw.z), bflo(xw.w), bfhi(xw.w)};
                float la[8], bv[8];
#pragma unroll
                for (int q = 0; q < 8; q += 2) { f32x2 l2, b2;
                    lru_gate2((f32x2){acc[ai][0][m][q >> 2][q & 3] + br[q], acc[ai][0][m][q >> 2][(q & 3) + 1] + br[q + 1]}, (f32x2){acc[ai][1][m][q >> 2][q & 3] + bi[q], acc[ai][1][m][q >> 2][(q & 3) + 1] + bi[q + 1]},
                              (f32x2){sp[q], sp[q + 1]}, (f32x2){xv[q], xv[q + 1]}, slow, l2, b2);
                    la[q] = l2.x; la[q + 1] = l2.y; bv[q] = b2.x; bv[q + 1] = b2.y; }
                { u32x2 w8; w8.x = pk4_u8(la[0], la[1], la[2], la[3]); w8.y = pk4_u8(la[4], la[5], la[6], la[7]); *(u32x2*)((unsigned char*)LA + (size_t)d * MPAD * D + ro) = w8; }
                u32x4 w; w.x = cvt_pk_bf16(bv[0], bv[1]); w.y = cvt_pk_bf16(bv[2], bv[3]); w.z = cvt_pk_bf16(bv[4], bv[5]); w.w = cvt_pk_bf16(bv[6], bv[7]);
                *(u32x4*)(BV + (size_t)d * MPAD * D + ro) = w; }
    }
};
struct CfgM1 {
    static constexpr bool PERMX = false; static constexpr bool GATHER = true; static constexpr bool FP8 = true; static constexpr int KB = 1024; static constexpr bool PERM = true; static constexpr int K = 1024, ldb = 1024;
    SchedMoe S; const unsigned char* U; const unsigned char* W; unsigned char* HID; const LAS unsigned short* idx;
    __device__ __forceinline__ bool next(int i, Unit& u) const { return S.next(i, u); }
    __device__ __forceinline__ const char* a_base(const Unit&) const { return (const char*)U; }
    __device__ __forceinline__ void a_offs(const Unit&, int ui, const int (&R)[2], const int (&C)[2], unsigned (&off)[2][2]) const {
#pragma unroll
        for (int h = 0; h < 2; ++h)
#pragma unroll
            for (int i = 0; i < 2; ++i) off[h][i] = (unsigned)idx[ui * 256 + h * HALF + R[i]] * 1024u + (unsigned)C[i] * 2u;
    }
    __device__ __forceinline__ const char* b_base(const Unit& u) const { return (const char*)(W + ((size_t)u.e * 4096 + u.pn * 256) * 1024); }
    __device__ __forceinline__ void epi(const f32x4 (&acc)[2][2][4][2], const Unit& u, int wr, int wc, int fr, int fq) const {
        const int row0 = u.e * EPAD + u.pm * 256 + wr * 64 + fr, col0 = u.pn * 128 + wc * 32 + 8 * fq;
#pragma unroll
        for (int ai = 0; ai < 2; ++ai)
#pragma unroll
            for (int m = 0; m < 4; ++m) { const f32x4 g0 = acc[ai][0][m][0], g1 = acc[ai][0][m][1], u0 = acc[ai][1][m][0], u1 = acc[ai][1][m][1];
                u32x2 w; w.x = silu_mul_fp8x4(g0, u0); w.y = silu_mul_fp8x4(g1, u1);
                *(u32x2*)(HID + (size_t)(row0 + ai * 128 + m * 16) * HIDP8 + col0) = w; }
    }
};
struct CfgM2 {
    static constexpr bool PERMX = true; static constexpr bool GATHER = false; static constexpr bool FP8 = true; static constexpr int KB = 2048; static constexpr bool PERM = true; static constexpr int K = 2048, ldb = WDP8;
    SchedMoe S; const unsigned char* HID; const unsigned char* W; bf16* Y;
    __device__ __forceinline__ bool next(int i, Unit& u) const { return S.next(i, u); }
    __device__ __forceinline__ const char* a_base(const Unit& u) const { return (const char*)(HID + ((size_t)u.e * EPAD + u.pm * 256) * HIDP8); }
    __device__ __forceinline__ void a_offs(const Unit&, int, const int (&R)[2], const int (&C)[2], unsigned (&off)[2][2]) const { lin_offs<HIDP8>(R, C, off); }
    __device__ __forceinline__ const char* b_base(const Unit& u) const { return (const char*)(W + ((size_t)u.e * 1024 + u.pn * 256) * WDP8); }
    __device__ __forceinline__ void epi(const f32x4 (&acc)[2][2][4][2], const Unit& u, int wr, int wc, int fr, int fq) const {
        const int row0 = u.e * EPAD + u.pm * 256 + wr * 64 + fr, col0 = u.pn * 256 + wc * 64 + 16 * fq;
#pragma unroll
        for (int ai = 0; ai < 2; ++ai)
#pragma unroll
            for (int m = 0; m < 4; ++m) { const f32x4 v0 = acc[ai][0][m][0] * WINV, v1 = acc[ai][0][m][1] * WINV, v2 = acc[ai][1][m][0] * WINV, v3 = acc[ai][1][m][1] * WINV;
                u32x4 w; w.x = pk4_fp8(v0.x, v0.y, v0.z, v0.w); w.y = pk4_fp8(v1.x, v1.y, v1.z, v1.w); w.z = pk4_fp8(v2.x, v2.y, v2.z, v2.w); w.w = pk4_fp8(v3.x, v3.y, v3.z, v3.w);
                *(u32x4*)((unsigned char*)Y + (size_t)(row0 + ai * 128 + m * 16) * D + col0) = w; }
    }
};
}

#ifndef FAST_PG
#define FAST_PG 1
#endif
#ifndef FAST_LIN
#define FAST_LIN 1
#endif
#ifndef FAST_LGT
#define FAST_LGT 1
#endif
#ifndef FAST_LOUT
#define FAST_LOUT 1
#endif
#ifndef FAST_M1
#define FAST_M1 1
#endif
#ifndef FAST_M2
#define FAST_M2 1
#endif
constexpr int IDX_OFF = RING_BYTES + 1024;

#ifndef REP_PRO
#define REP_PRO 1
#endif
#ifndef REP_PP
#define REP_PP 1
#endif
#ifndef REP_LIN
#define REP_LIN 1
#endif
#ifndef REP_LCV
#define REP_LCV 1
#endif
#ifndef REP_LGT
#define REP_LGT 1
#endif
#ifndef REP_LS1
#define REP_LS1 1
#endif
#ifndef REP_LS3
#define REP_LS3 1
#endif
#ifndef REP_RB
#define REP_RB 1
#endif
#ifndef REP_TK
#define REP_TK 1
#endif
#ifndef REP_M1
#define REP_M1 1
#endif
#ifndef REP_M2
#define REP_M2 1
#endif
#ifndef REP_RA
#define REP_RA 1
#endif
#ifndef REP_LOUT
#define REP_LOUT 1
#endif
#ifndef REP_PG
#define REP_PG 1
#endif
#define REPEAT(n) _Pragma("unroll") for (int rep_ = 0; rep_ < (n); ++rep_)
#define IN(k) (lo <= (k) && (k) < hi)
#define SEAM(k) do { if ((k) + 1 < hi) xcd_barrier(bar); } while (0)
template <int layer>
__device__ __forceinline__ void run_layer(const Frame& F, const int lo, const int hi, const XcdBarrier& bar) {
    const int gw = F.vcu * 8 + F.wave, NGW = F.G * 8;
    const bool fast = (F.G == 256);
    {
        const int pb = layer * 16, j = layer >> 1;
        if (IN(pb + 0)) { if constexpr (layer == 0) REPEAT(REP_PRO) phase_prologue(F); if (REP_RA > 1) phase_rowA<false, layer == 0, true>(F, layer); phase_rowA<false, layer == 0>(F, layer); SEAM(pb + 0); }
        if constexpr ((layer & 1) == 0) {
            if (IN(pb + 1)) { REPEAT(REP_PP) phase_poolwin(F, layer); SEAM(pb + 1); }
            if (IN(pb + 2)) { FnPool fn{F.P, F.WPOOL + (size_t)j * 4 * 65536, F.H, F.pool_scale + (size_t)j * D};
                if (FAST_PG && fast) { pg8::CfgPool cfg; cfg.S.init(128, 4, F.G, (int)blockIdx.x); cfg.P = F.P; cfg.W = fn.W; cfg.scale = fn.scale; if (REP_PG > 1) { cfg.H = (bf16*)F.HF; pg8::gemm_phase(F.lds, cfg); } cfg.H = F.H; pg8::gemm_phase(F.lds, cfg);
                    wg_gemm_ksplit<2>(fn, TaskMap{4 * 16, 16, 1024, 1}, F.lds, F.vcu, F.G, F.tid); }
                else wave_gemm(fn, TaskMap{FnPool::nrb * 16, 16, 0, 1}, gw, NGW, F.lane);
                SEAM(pb + 2); }
        } else {
            if (IN(pb + 3)) { REPEAT(REP_LIN) { FnIn fn{F.H, F.WIN + (size_t)j * 2048 * 1024, F.XB, F.GY, F.RSTD};
                if (FAST_LIN && fast) { pg8::CfgIn cfg; cfg.S.init(128, 8, F.G, (int)blockIdx.x); cfg.U = F.H; cfg.W = fn.W; cfg.XB = F.XB; cfg.GY = F.GY; cfg.RS = F.RSTD; pg8::gemm_phase(F.lds, cfg);
                    wg_gemm_ksplit<2>(fn, TaskMap{4 * 32, 32, 1024, 1}, F.lds, F.vcu, F.G, F.tid); }
                else wave_gemm(fn, TaskMap{FnIn::nrb * 32, 32, 0, 1}, gw, NGW, F.lane);
                } SEAM(pb + 3); }
            if (IN(pb + 4)) { REPEAT(REP_LCV) phase_conv(F, j); SEAM(pb + 4); }
            if (IN(pb + 5)) { REPEAT(REP_LGT) { FnGates fn{F.P, F.WGT + (size_t)j * 16 * 65536, F.LA, F.BV, F.b_gates + (size_t)j * 4 * D, F.SPT + (size_t)j * 2 * D};
                if (FAST_LGT && fast) { pg8::CfgGates cfg; cfg.S.init(128, 16, F.G, (int)blockIdx.x); cfg.XC = F.P; cfg.W = fn.W; cfg.LA = F.LA; cfg.BV = F.BV; cfg.bg = fn.bg; cfg.lam = fn.lam; pg8::gemm_phase(F.lds, cfg);
                    wg_gemm_ksplit<2>(fn, TaskMap{4 * 64, 64, 1024, 1}, F.lds, F.vcu, F.G, F.tid); }
                else wave_gemm(fn, TaskMap{FnGates::nrb * 64, 64, 0, 1}, gw, NGW, F.lane);
                } SEAM(pb + 5); }
            if (IN(pb + 6)) { REPEAT(REP_LS1) phase_scan1(F, j); SEAM(pb + 6); }
            if (IN(pb + 7)) { REPEAT(REP_LS3) phase_scan3(F, j); SEAM(pb + 7); }
            if (IN(pb + 8)) { FnOut fn{F.HG, F.WOUT + (size_t)j * 1024 * 1024, F.H};
                if (FAST_LOUT && fast) { pg8::CfgOut cfg; cfg.S.init(128, 4, F.G, (int)blockIdx.x); cfg.A = F.HG; cfg.W = fn.W; if (REP_LOUT > 1) { cfg.H = (bf16*)F.HF; pg8::gemm_phase(F.lds, cfg); } cfg.H = F.H; pg8::gemm_phase(F.lds, cfg);
                    wg_gemm_ksplit<2>(fn, TaskMap{4 * 16, 16, 1024, 1}, F.lds, F.vcu, F.G, F.tid); }
                else wave_gemm(fn, TaskMap{FnOut::nrb * 16, 16, 0, 1}, gw, NGW, F.lane);
                SEAM(pb + 8); }
        }
        if (IN(pb + 9)) { REPEAT(REP_RB) phase_rowB(F, layer); SEAM(pb + 9); }
        if (IN(pb + 10)) { REPEAT(REP_TK) phase_topk(F); SEAM(pb + 10); }
        if (IN(pb + 11)) { REPEAT(REP_M1) { FnM1f8 fn{(const unsigned char*)F.U, (const unsigned char*)F.WG1 + (size_t)layer * NE * 4096 * 1024, F.ROWL, (unsigned char*)F.HID};
            if (FAST_M1 && fast) { pg8::CfgM1 cfg; cfg.S.init(16, F.G, (int)blockIdx.x, 0, 4); cfg.U = fn.U; cfg.W = fn.W; cfg.HID = fn.HID;
                LAS unsigned short* idx = (LAS unsigned short*)(F.lds + IDX_OFF); cfg.idx = idx;
                {
                    int rl[16];
#pragma unroll
                    for (int ui = 0; ui < 16; ++ui) { pg8::Unit u; const bool ok = cfg.S.next(ui, u); rl[ui] = F.ROWL[(ok ? u.e * EPAD + u.pm * 256 : 0) + (F.tid & 255)]; }
#pragma unroll
                    for (int ui = 0; ui < 16; ++ui) if (F.tid < 256) idx[ui * 256 + F.tid] = (unsigned short)rl[ui];
                }
                __syncthreads();
                pg8::gemm_phase(F.lds, cfg);
                wg_gemm_ksplit8(fn, TaskMap{16 * 64, 64, ERB16 - 1, ERB16}, F.lds, F.vcu, F.G, F.tid); }
            else wg_gemm_ksplit8(fn, TaskMap{NE * ERB16 * 64, 64, 0, 1}, F.lds, F.vcu, F.G, F.tid);
            } SEAM(pb + 11); }
        if (IN(pb + 12)) { REPEAT(REP_M2) { FnM2f8 fn{(const unsigned char*)F.HID, (const unsigned char*)F.WD + (size_t)layer * NE * 1024 * WDP8, F.Y};
            if (FAST_M2 && fast) { pg8::CfgM2 cfg; cfg.S.init(4, F.G, (int)blockIdx.x); cfg.HID = fn.HID; cfg.W = fn.W; cfg.Y = F.Y; pg8::gemm_phase(F.lds, cfg);
                wg_gemm_ksplit8(fn, TaskMap{16 * 16, 16, ERB16 - 1, ERB16}, F.lds, F.vcu, F.G, F.tid); }
            else wg_gemm_ksplit8(fn, TaskMap{NE * ERB16 * 16, 16, 0, 1}, F.lds, F.vcu, F.G, F.tid);
            } SEAM(pb + 12); }
    }
}
#undef IN
#undef SEAM

__global__ void __launch_bounds__(512, 2) mega(Args args) {
    extern __shared__ __attribute__((aligned(16))) unsigned char lds_raw[];
    Frame F;
    F.lds = (LAS unsigned char*)lds_raw;
    F.tid = threadIdx.x; F.lane = F.tid & 63; F.wave = __builtin_amdgcn_readfirstlane(F.tid >> 6);
    F.G = gridDim.x; { const int bx = blockIdx.x; F.vcu = (F.G % 8 == 0) ? (bx % 8) * (F.G / 8) + bx / 8 : bx; }
    F.x = args.in[0]; F.meta = args.in[1]; F.norm_mix = args.in[2]; F.norm_ffn = args.in[3]; F.norm_final = args.in[4]; F.pool_w = args.in[5]; F.pool_scale = args.in[6]; F.w_in = args.in[7]; F.conv_w = args.in[8];
    F.conv_b = args.in[9]; F.w_gates = args.in[10]; F.b_gates = args.in[11]; F.lam = args.in[12]; F.w_out = args.in[13]; F.router_w = args.in[14]; F.moe_g = args.in[15]; F.moe_u = args.in[16]; F.moe_d = args.in[17];
    F.out = args.out; F.ws = args.ws;
    unsigned char* ws = args.ws;
    F.WG1 = (bf16*)(ws + WS_WG1); F.WD = (bf16*)(ws + WS_WD); F.WIN = (bf16*)(ws + WS_WIN); F.WGT = (bf16*)(ws + WS_WGT); F.WOUT = (bf16*)(ws + WS_WOUT); F.WPOOL = (bf16*)(ws + WS_WPOOL);
    F.H = (bf16*)(ws + WS_H); F.U = (bf16*)(ws + WS_U); F.P = (bf16*)(ws + WS_P); F.XB = (bf16*)(ws + WS_XB); F.GY = (bf16*)(ws + WS_GY); F.HG = (bf16*)(ws + WS_HG); F.HF = (float*)(ws + WS_Y);
    F.LA = (bf16*)(ws + WS_BIG); F.BV = (bf16*)(ws + WS_BIG + 2 * LA_BYTES); F.HID = (bf16*)(ws + WS_BIG); F.Y = (bf16*)(ws + WS_Y);
    F.AFF = (float*)(ws + WS_AFF); F.SLOT = (int*)(ws + WS_SLOT); F.GMAP = (float*)(ws + WS_GMAP); F.ROWL = (int*)(ws + WS_ROWL); F.AGG = (float*)(ws + WS_AGG); F.SPT = (float*)(ws + WS_SPT); F.RSTD = (float*)(ws + WS_RSTD);
    volatile LAS unsigned* MISC = (volatile LAS unsigned*)(F.lds + MISC_OFF);
    if (F.tid < 32) MISC[F.tid] = 0u;
    __syncthreads();
    const int lo = args.lo, hi = args.hi;
    const bool multi = (hi - lo) > 1;
    XcdBarrier bar; bar.bar = (unsigned*)(ws + WS_CTL) + CW_BAR; bar.x = 0; bar.st = nullptr;
    if (multi) bar = xcd_barrier_post((unsigned*)(ws + WS_CTL) + CW_BAR, MISC + 8);
#define IN(k) (lo <= (k) && (k) < hi)
#define SEAM(k) do { if ((k) + 1 < hi) xcd_barrier(bar); } while (0)
    run_layer<0>(F, lo, hi, bar); run_layer<1>(F, lo, hi, bar); run_layer<2>(F, lo, hi, bar); run_layer<3>(F, lo, hi, bar);
    if (IN(64)) { if (REP_RA > 1) phase_rowA<true, false>(F, DEPTH); phase_rowA<true, false>(F, DEPTH); }
#undef IN
#undef SEAM
}

extern "C" void kernel_launch(void* const* d_in, const int* in_sizes, int n_in, void* d_out, int out_size, void* d_ws, size_t ws_size, hipStream_t stream) {
    static int grid = 0;
    if (grid == 0) {
        if (n_in != 18 || in_sizes[0] != NB * SEQ * D || out_size != NB * SEQ * D || ws_size < WS_END) {
            fprintf(stderr, "kernel_launch: unexpected shapes (n_in %d, in0 %d, out %d, ws %zu < %zu)\n", n_in, n_in > 0 ? in_sizes[0] : -1, out_size, ws_size, (size_t)WS_END); grid = -1; return; }
        int dev = 0, cus = 0;
        if (hipGetDevice(&dev) != hipSuccess || hipDeviceGetAttribute(&cus, hipDeviceAttributeMultiprocessorCount, dev) != hipSuccess) { grid = -1; return; }
        if (hipFuncSetAttribute((const void*)mega, hipFuncAttributeMaxDynamicSharedMemorySize, LDS_BYTES) != hipSuccess) { fprintf(stderr, "kernel_launch: hipFuncSetAttribute failed\n"); grid = -1; return; }
        int per_cu = 0;
        if (hipOccupancyMaxActiveBlocksPerMultiprocessor(&per_cu, (const void*)mega, 512, LDS_BYTES) != hipSuccess || per_cu < 1) fprintf(stderr, "kernel_launch: occupancy query reports %d\n", per_cu);
        (void)hipGetLastError();
        grid = cus;
    }
    if (grid < 0) return;
    if (hipMemsetAsync((char*)d_ws + WS_CTL, 0, CTL_ZERO_BYTES, stream) != hipSuccess) return;
    Args a{};
    for (int i = 0; i < 18; ++i) a.in[i] = (const float*)d_in[i];
    a.out = (float*)d_out; a.ws = (unsigned char*)d_ws;
#if SINGLE_LAUNCH
    a.lo = 0; a.hi = 65;
    hipLaunchKernelGGL(mega, dim3(grid), dim3(512), LDS_BYTES, stream, a);
#else
    for (int layer = 0; layer < DEPTH; ++layer) {
        static const int pool_ph[] = {0, 1, 2, 9, 10, 11, 12}, lru_ph[] = {0, 3, 4, 5, 6, 7, 8, 9, 10, 11, 12};
        const int* ph = (layer & 1) ? lru_ph : pool_ph; const int n = (layer & 1) ? 11 : 7;
        for (int q = 0; q < n; ++q) { a.lo = layer * 16 + ph[q]; a.hi = a.lo + 1; hipLaunchKernelGGL(mega, dim3(grid), dim3(512), LDS_BYTES, stream, a); }
    }
    a.lo = 64; a.hi = 65; hipLaunchKernelGGL(mega, dim3(grid), dim3(512), LDS_BYTES, stream, a);
#endif
}
```

```cpp
#include <hip/hip_runtime.h>
#include <cstdio>
#include <cstdint>

#ifndef SINGLE_LAUNCH
#define SINGLE_LAUNCH 1
#endif

constexpr int NB = 8, SEQ = 4096, NMETA = 16, T = SEQ + NMETA, D = 1024, NE = 16, CAP = 2 * T / NE, DF = 2048, DEPTH = 4;
constexpr int MMAIN = NB * SEQ;
constexpr int MROWS = NB * T;
constexpr int MPAD = 33024;
constexpr int EROWS = NB * CAP;
constexpr int EPAD = 4352;
constexpr int HIDP8 = 2112, WDP8 = 2112;
constexpr float WSCALE = 32.0f, WINV = 1.0f / 32.0f;
constexpr int NCHUNK = 33, CHL = 128;
static_assert(CAP == 514 && T == 4112 && EROWS == 4112, "shapes");
constexpr float RMS_EPS = 1e-6f;

constexpr size_t MiB = 1u << 20;
constexpr size_t WS_CTL = 0, CTL_ZERO_BYTES = 1 * MiB;
constexpr size_t WS_WG1 = 1 * MiB;
constexpr size_t WS_WD = WS_WG1 + 512 * MiB;
constexpr size_t WS_WIN = WS_WD + 264 * MiB;
constexpr size_t WS_WGT = WS_WIN + 8 * MiB;
constexpr size_t WS_WOUT = WS_WGT + 4 * MiB;
constexpr size_t WS_WPOOL = WS_WOUT + 4 * MiB;
constexpr size_t WS_H = WS_WPOOL + 1 * MiB;
constexpr size_t WS_U = WS_H + 129 * MiB;
constexpr size_t WS_P = WS_U + 65 * MiB;
constexpr size_t WS_XB = WS_P + 65 * MiB;
constexpr size_t WS_GY = WS_XB + 65 * MiB;
constexpr size_t WS_HG = WS_GY + 65 * MiB;
constexpr size_t WS_BIG = WS_HG + 65 * MiB;
constexpr size_t WS_Y = WS_BIG + 282 * MiB;
constexpr size_t WS_AFF = WS_Y + 136 * MiB;
constexpr size_t WS_SLOT = WS_AFF + 3 * MiB;
constexpr size_t WS_GMAP = WS_SLOT + 3 * MiB;
constexpr size_t WS_ROWL = WS_GMAP + 3 * MiB;
constexpr size_t WS_AGG = WS_ROWL + 1 * MiB;
constexpr size_t WS_SPT = WS_AGG + 9 * MiB / 2;
constexpr size_t WS_RSTD = WS_SPT + 64 * 1024;
constexpr size_t WS_END = WS_AGG + 5 * MiB;
constexpr size_t LA_BYTES = (size_t)MPAD * 1024 * 2;

constexpr int CW_BAR = 4096;

constexpr int RING_BYTES = 131072;
constexpr int MISC_OFF = RING_BYTES + 320;
constexpr int LDS_BYTES = 147456;

#define LAS __attribute__((address_space(3)))
typedef unsigned short bf16;
typedef short bf16x8 __attribute__((ext_vector_type(8)));
typedef float f32x4 __attribute__((ext_vector_type(4)));
typedef float f32x2 __attribute__((ext_vector_type(2)));
typedef unsigned u32x4 __attribute__((ext_vector_type(4)));
typedef unsigned u32x2 __attribute__((ext_vector_type(2)));

__device__ __forceinline__ unsigned cvt_pk_bf16(float lo, float hi) { unsigned r; asm volatile("v_cvt_pk_bf16_f32 %0, %1, %2" : "=v"(r) : "v"(lo), "v"(hi)); return r; }
__device__ __forceinline__ float bflo(unsigned w) { return __uint_as_float(w << 16); }
__device__ __forceinline__ float bfhi(unsigned w) { return __uint_as_float(w & 0xffff0000u); }
__device__ __forceinline__ float fast_exp(float x) { return __builtin_amdgcn_exp2f(x * 1.44269504089f); }
__device__ __forceinline__ float fast_rcp(float x) { return __builtin_amdgcn_rcpf(x); }
__device__ __forceinline__ float sigmoidf_(float x) { return fast_rcp(1.0f + fast_exp(-x)); }
__device__ __forceinline__ float siluf_(float x) { return x * sigmoidf_(x); }
typedef int v4i __attribute__((ext_vector_type(4)));
typedef int v8i __attribute__((ext_vector_type(8)));
__device__ __forceinline__ unsigned pk4_fp8(float a, float b, float c, float d) {
    a = __builtin_amdgcn_fmed3f(a, -448.f, 448.f); b = __builtin_amdgcn_fmed3f(b, -448.f, 448.f); c = __builtin_amdgcn_fmed3f(c, -448.f, 448.f); d = __builtin_amdgcn_fmed3f(d, -448.f, 448.f);
    unsigned r = 0; r = (unsigned)__builtin_amdgcn_cvt_pk_fp8_f32(a, b, (int)r, false); r = (unsigned)__builtin_amdgcn_cvt_pk_fp8_f32(c, d, (int)r, true); return r; }
__device__ __forceinline__ f32x4 fp8x4_to_f32(unsigned w) { const f32x2 lo = __builtin_amdgcn_cvt_pk_f32_fp8((int)w, false), hi = __builtin_amdgcn_cvt_pk_f32_fp8((int)w, true); return (f32x4){lo.x, lo.y, hi.x, hi.y}; }
__device__ __forceinline__ float silu_mul_s(float G, float U) { const float e = __builtin_amdgcn_exp2f(G * (-1.44269504089f * WINV)); return (G * U) * fast_rcp(__builtin_fmaf(e, 1024.0f, 1024.0f)); }
__device__ __forceinline__ unsigned pk4_u8(float a, float b, float c, float d) { return (unsigned)(a * 255.0f + 0.5f) | ((unsigned)(b * 255.0f + 0.5f) << 8) | ((unsigned)(c * 255.0f + 0.5f) << 16) | ((unsigned)(d * 255.0f + 0.5f) << 24); }
__device__ __forceinline__ f32x2 gelu_tanh2(f32x2 x) {
    const f32x2 t = (x * x) * 0.044715f + 1.0f, a = (x * t) * (-2.0f * 0.7978845608f * 1.44269504089f);
    f32x2 e; e.x = __builtin_amdgcn_exp2f(a.x); e.y = __builtin_amdgcn_exp2f(a.y);
    const f32x2 d = e + 1.0f; f32x2 r; r.x = fast_rcp(d.x); r.y = fast_rcp(d.y);
    return x * r; }
__device__ __forceinline__ unsigned silu_mul_fp8x4(const f32x4 G, const f32x4 U) {
    const f32x2 g0 = (f32x2){G.x, G.y}, g1 = (f32x2){G.z, G.w}, u0 = (f32x2){U.x, U.y}, u1 = (f32x2){U.z, U.w};
    const f32x2 t0 = g0 * (-1.44269504089f * WINV), t1 = g1 * (-1.44269504089f * WINV);
    f32x2 e0, e1; e0.x = __builtin_amdgcn_exp2f(t0.x); e0.y = __builtin_amdgcn_exp2f(t0.y); e1.x = __builtin_amdgcn_exp2f(t1.x); e1.y = __builtin_amdgcn_exp2f(t1.y);
    const f32x2 d0 = e0 * 1024.0f + 1024.0f, d1 = e1 * 1024.0f + 1024.0f;
    f32x2 r0, r1; r0.x = fast_rcp(d0.x); r0.y = fast_rcp(d0.y); r1.x = fast_rcp(d1.x); r1.y = fast_rcp(d1.y);
    const f32x2 o0 = (g0 * u0) * r0, o1 = (g1 * u1) * r1;
    return pk4_fp8(o0.x, o0.y, o1.x, o1.y);
}
__device__ __forceinline__ float gelu_tanh(float x) { const float z = 0.7978845608f * (x + 0.044715f * x * x * x); return x * sigmoidf_(2.0f * z); }
__device__ __forceinline__ float wave_sum(float v) {
#pragma unroll
    for (int o = 1; o < 64; o <<= 1) v += __shfl_xor(v, o);
    return v;
}
__device__ __forceinline__ int opaque(int v) { asm volatile("" : "+v"(v)); return v; }
__device__ __forceinline__ int row_of(int b, int t) { return t >= NMETA ? b * SEQ + (t - NMETA) : MMAIN + b * NMETA + t; }

#define XB_TMO      128
#define XB_XCNT(j)  (256  + 64 * (j))
#define XB_XSUB(j)  (1280 + 64 * (j))
#define XB_XGEN(j)  (2304 + 64 * (j))
#define XB_TOP      3328
#define XB_TOPGEN   3392
#define XCD_BAR_WORDS 3456
#define XB_SPIN_CAP (1u << 18)
__device__ __forceinline__ unsigned xb_ld(unsigned* p)              { return __hip_atomic_load(p, __ATOMIC_RELAXED, __HIP_MEMORY_SCOPE_AGENT); }
__device__ __forceinline__ unsigned xb_add(unsigned* p, unsigned v) { return __hip_atomic_fetch_add(p, v, __ATOMIC_RELAXED, __HIP_MEMORY_SCOPE_AGENT); }
__device__ __forceinline__ unsigned xb_xcc_id() { return (unsigned)__builtin_amdgcn_s_getreg((3 << 11) | 20) & 0xFu; }
#define XB_SPIN(cond, bar) do { unsigned _sp = 0; while (cond) { __builtin_amdgcn_s_sleep(1); \
    if ((++_sp & 255u) == 0u) { if (xb_ld(&(bar)[XB_TMO])) break; if (_sp > XB_SPIN_CAP) { atomicAdd(&(bar)[XB_TMO], 1u); break; } } } } while (0)
struct XcdBarrier { unsigned* bar; unsigned x; volatile LAS unsigned* st; };
__device__ __forceinline__ XcdBarrier xcd_barrier_post(unsigned* bar, volatile LAS unsigned* st) {
    XcdBarrier b; b.bar = bar; b.x = xb_xcc_id(); b.st = st;
    if (threadIdx.x == 0) (void)xb_add(&bar[XB_XCNT(b.x)], 1u);
    return b;
}
__device__ __forceinline__ void xcd_barrier_complete(unsigned* bar, unsigned x, unsigned& nloc, unsigned& nx) {
    const unsigned G = gridDim.x * gridDim.y * gridDim.z;
    unsigned sum, cnt, mine, sp = 0u;
    for (;;) {
        sum = 0u; cnt = 0u; mine = 0u;
#pragma unroll
        for (unsigned j = 0; j < 16; ++j) { const unsigned c = xb_ld(&bar[XB_XCNT(j)]); sum += c; cnt += (c > 0u) ? 1u : 0u; mine = (j == x) ? c : mine; }
        if (sum == G) break;
        __builtin_amdgcn_s_sleep(1);
        if ((++sp & 255u) == 0u) { if (xb_ld(&bar[XB_TMO])) break; if (sp > XB_SPIN_CAP) { atomicAdd(&bar[XB_TMO], 1u); break; } }
    }
    nloc = mine > 0u ? mine : 1u; nx = cnt > 0u ? cnt : 1u;
}
__device__ __forceinline__ void xcd_barrier(const XcdBarrier& b) {
    asm volatile("s_waitcnt vmcnt(0)" ::: "memory");
    __syncthreads();
    if (threadIdx.x == 0) {
        unsigned* bar = b.bar;
        __builtin_amdgcn_s_waitcnt(0);
        unsigned nloc = b.st[0], nx = b.st[1];
        if (nloc == 0u) { xcd_barrier_complete(bar, b.x, nloc, nx); b.st[0] = nloc; b.st[1] = nx; }
        const unsigned old = xb_add(&bar[XB_XSUB(b.x)], 1u);
        const unsigned gen = old / nloc;
        if (old + 1u == (gen + 1u) * nloc) {
            __builtin_amdgcn_fence(__ATOMIC_RELEASE, "agent");
            asm volatile("s_waitcnt vmcnt(0)" ::: "memory");
            const unsigned og = xb_add(&bar[XB_TOP], 1u);
            const unsigned tg = og / nx;
            if (og + 1u == (tg + 1u) * nx) xb_add(&bar[XB_TOPGEN], 1u);
            else XB_SPIN(xb_ld(&bar[XB_TOPGEN]) == tg, bar);
            __builtin_amdgcn_fence(__ATOMIC_ACQUIRE, "agent");
            xb_add(&bar[XB_XGEN(b.x)], 1u);
            asm volatile("s_waitcnt vmcnt(0)" ::: "memory");
        } else {
            XB_SPIN(xb_ld(&bar[XB_XGEN(b.x)]) == gen, bar);
            __builtin_amdgcn_fence(__ATOMIC_ACQUIRE, "agent");
            asm volatile("s_waitcnt vmcnt(0)" ::: "memory");
        }
    }
    __syncthreads();
}

struct Args { const float* in[18]; float* out; unsigned char* ws; int lo, hi; };
struct Frame {
    LAS unsigned char* lds;
    int tid, lane, wave, vcu, G;
    const float *x, *meta, *norm_mix, *norm_ffn, *norm_final, *pool_w, *pool_scale, *w_in, *conv_w, *conv_b, *w_gates, *b_gates, *lam, *w_out, *router_w, *moe_g, *moe_u, *moe_d;
    float* out; unsigned char* ws;
    bf16 *WG1, *WD, *WIN, *WGT, *WOUT, *WPOOL;
    bf16* H; float* HF; bf16 *U, *P, *XB, *GY, *HG, *LA, *BV, *HID, *Y;
    float* AFF; int* SLOT; float* GMAP; int* ROWL; float* AGG; float* SPT; float* RSTD;
};

struct ProItem { const float* src; unsigned char* dst; const float* ks; int ldw, ldt, f8; };
__device__ __forceinline__ ProItem pro_decode(const Frame& F, int it) {
    constexpr int I_MOE = 64 * 512, I_IN = 2 * 512, I_OUT = 2 * 256, I_GT = 32 * 16;
    ProItem p; p.ks = nullptr; int r = it;
    if (r < 2 * I_MOE) {
        const int up = r >= I_MOE; if (up) r -= I_MOE;
        const int le = r >> 9, q = r & 511, k0 = (q >> 6) * 128, n0 = (q & 63) * 32;
        p.src = (up ? F.moe_u : F.moe_g) + (size_t)le * 1024 * 2048 + (size_t)k0 * 2048 + n0; p.ldw = 2048;
        p.dst = (unsigned char*)F.WG1 + ((size_t)le * 4096 + (n0 >> 7) * 256 + up * 128 + (n0 & 127)) * 1024 + k0; p.ldt = 1024; p.f8 = 1; return p; }
    r -= 2 * I_MOE;
    if (r < I_MOE) {
        const int le = r >> 9, q = r & 511, k0 = (q >> 5) * 128, n0 = (q & 31) * 32;
        p.src = F.moe_d + (size_t)le * 2048 * 1024 + (size_t)k0 * 1024 + n0; p.ldw = 1024;
        p.dst = (unsigned char*)F.WD + ((size_t)le * 1024 + n0) * WDP8 + k0; p.ldt = WDP8; p.f8 = 1; return p; }
    r -= I_MOE; p.f8 = 0;
    if (r < I_IN) {
        const int j = r >> 9, q = r & 511, k0 = (q >> 6) * 128, n0 = (q & 63) * 32;
        p.src = F.w_in + (size_t)j * 1024 * 2048 + (size_t)k0 * 2048 + n0; p.ldw = 2048; p.dst = (unsigned char*)(F.WIN + ((size_t)j * 2048 + n0) * 1024 + k0); p.ldt = 2048; p.ks = F.norm_mix + (size_t)(2 * j + 1) * D + k0; return p; }
    r -= I_IN;
    if (r < I_OUT) {
        const int j = r >> 8, q = r & 255, k0 = (q >> 5) * 128, n0 = (q & 31) * 32;
        p.src = F.w_out + (size_t)j * 1024 * 1024 + (size_t)k0 * 1024 + n0; p.ldw = 1024; p.dst = (unsigned char*)(F.WOUT + ((size_t)j * 1024 + n0) * 1024 + k0); p.ldt = 2048; return p; }
    r -= I_OUT;
    if (r < I_GT) {
        const int mat = r >> 4, q = r & 15, k0 = (q >> 3) * 128, n0 = (q & 7) * 32;
        const int j = mat >> 4, d = (mat >> 3) & 1, g = (mat >> 2) & 1, h = mat & 3, nt = d * 8 + h * 2 + (n0 >> 7);
        p.src = F.w_gates + (size_t)mat * 65536 + (size_t)k0 * 256 + n0; p.ldw = 256; p.dst = (unsigned char*)(F.WGT + (((size_t)j * 16 + nt) * 256 + g * 128 + (n0 & 127)) * 256 + k0); p.ldt = 512; return p; }
    r -= I_GT;
    {
        const int mat = r >> 4, q = r & 15, k0 = (q >> 3) * 128, n0 = (q & 7) * 32;
        p.src = F.pool_w + (size_t)mat * 65536 + (size_t)k0 * 256 + n0; p.ldw = 256; p.dst = (unsigned char*)(F.WPOOL + ((size_t)mat * 256 + n0) * 256 + k0); p.ldt = 512; return p; }
}
__device__ __forceinline__ void pro_load(const ProItem& p, f32x4 (&v)[16], int lane) {
    const int rr = lane >> 3, sg = lane & 7;
#pragma unroll
    for (int i = 0; i < 16; ++i) v[i] = __builtin_nontemporal_load((const f32x4*)(p.src + (size_t)(8 * i + rr) * p.ldw + 4 * sg));
}
__device__ __forceinline__ void pro_finish(const ProItem& p, const f32x4 (&v)[16], LAS float* scr, int lane) {
    { const int rr = lane >> 3, sg = lane & 7;
#pragma unroll
        for (int i = 0; i < 16; ++i) *(LAS f32x4*)(scr + (8 * i + rr) * 32 + ((4 * sg) ^ (((i >> 1) & 3) << 3))) = v[i]; }
    asm volatile("s_waitcnt lgkmcnt(0)" ::: "memory");
    const int c = lane & 7;
#pragma unroll
    for (int j = 0; j < 4; ++j) { const int n = (lane >> 3) + 8 * j; const LAS float* s = scr + (16 * c) * 32 + (n ^ ((c & 3) << 3));
        float t[16];
#pragma unroll
        for (int q = 0; q < 16; ++q) t[q] = s[q * 32];
        if (p.f8) { u32x4 o; o.x = pk4_fp8(t[0] * WSCALE, t[1] * WSCALE, t[2] * WSCALE, t[3] * WSCALE); o.y = pk4_fp8(t[4] * WSCALE, t[5] * WSCALE, t[6] * WSCALE, t[7] * WSCALE);
            o.z = pk4_fp8(t[8] * WSCALE, t[9] * WSCALE, t[10] * WSCALE, t[11] * WSCALE); o.w = pk4_fp8(t[12] * WSCALE, t[13] * WSCALE, t[14] * WSCALE, t[15] * WSCALE);
            __builtin_nontemporal_store(o, (u32x4*)(p.dst + (size_t)n * p.ldt + 16 * c)); }
        else { if (p.ks) { const float* ks = p.ks + 16 * c;
#pragma unroll
                for (int q4 = 0; q4 < 4; ++q4) { const f32x4 g4 = *(const f32x4*)(ks + 4 * q4); t[4 * q4] *= g4.x; t[4 * q4 + 1] *= g4.y; t[4 * q4 + 2] *= g4.z; t[4 * q4 + 3] *= g4.w; } }
            u32x4 o0, o1; o0.x = cvt_pk_bf16(t[0], t[1]); o0.y = cvt_pk_bf16(t[2], t[3]); o0.z = cvt_pk_bf16(t[4], t[5]); o0.w = cvt_pk_bf16(t[6], t[7]);
            o1.x = cvt_pk_bf16(t[8], t[9]); o1.y = cvt_pk_bf16(t[10], t[11]); o1.z = cvt_pk_bf16(t[12], t[13]); o1.w = cvt_pk_bf16(t[14], t[15]);
            unsigned char* d = p.dst + (size_t)n * p.ldt + 32 * c; __builtin_nontemporal_store(o0, (u32x4*)d); __builtin_nontemporal_store(o1, (u32x4*)(d + 16)); } }
    asm volatile("s_waitcnt lgkmcnt(0)" ::: "memory");
}
__device__ __forceinline__ void phase_prologue(const Frame& F) {
    LAS float* scr = (LAS float*)(F.lds + F.wave * 16384);
    const int gw = F.vcu * 8 + F.wave, NGW = F.G * 8, lane = F.lane;
    for (int i = gw * 64 + lane; i < 4 * D; i += NGW * 64) F.SPT[i] = -8.0f * log1pf(expf(-F.lam[i]));
    constexpr int NITEMS = 3 * 64 * 512 + 2 * 512 + 2 * 256 + 32 * 16 + 8 * 16;
    int it = gw; if (it >= NITEMS) return;
    ProItem cur = pro_decode(F, it); f32x4 v[16], w[16]; pro_load(cur, v, lane);
    for (;;) {
        const int nit = it + NGW; const bool more = nit < NITEMS; ProItem nxt = cur;
        if (more) nxt = pro_decode(F, nit);
        pro_load(nxt, w, lane);
        pro_finish(cur, v, scr, lane);
        if (!more) break;
        cur = nxt; it = nit;
#pragma unroll
        for (int i = 0; i < 16; ++i) v[i] = w[i];
    }
}

template <bool FINAL, bool FIRST, bool DRY = false>
__device__ __forceinline__ void phase_rowA(const Frame& F, int layer) {
    const int gw = F.vcu * 8 + F.wave, NGW = F.G * 8, lane = F.lane;
    const float* gain = FINAL ? F.norm_final : F.norm_mix + layer * D;
    f32x4 gn[4];
#pragma unroll
    for (int j = 0; j < 4; ++j) gn[j] = *(const f32x4*)(gain + 4 * lane + 256 * j);
    const int rend = FINAL ? MMAIN : MROWS;
    int sl_n = -1; float gg_n = 0.f;
    if (!FIRST) { if (lane < 16 && gw < rend) { sl_n = F.SLOT[(size_t)gw * 16 + lane]; gg_n = F.GMAP[(size_t)gw * 16 + lane]; } }
    for (int r = gw; r < rend; r += NGW) {
        f32x4 v[4];
        if (FIRST) {
            const float* src = r < MMAIN ? F.x + (size_t)r * D : F.meta + (size_t)((r - MMAIN) & 15) * D;
#pragma unroll
            for (int j = 0; j < 4; ++j) v[j] = *(const f32x4*)(src + 4 * lane + 256 * j);
        } else {
            const int sl = sl_n; const float gg = gg_n;
            const bf16* src = F.H + (size_t)r * D;
#pragma unroll
            for (int j = 0; j < 4; ++j) { const u32x2 w = *(const u32x2*)(src + 4 * lane + 256 * j); v[j] = (f32x4){bflo(w.x), bfhi(w.x), bflo(w.y), bfhi(w.y)}; }
            { const int rn = r + NGW; sl_n = -1; if (lane < 16 && rn < rend) { sl_n = F.SLOT[(size_t)rn * 16 + lane]; gg_n = F.GMAP[(size_t)rn * 16 + lane]; } }
            unsigned mask = (unsigned)__ballot(sl >= 0) & 0xffffu;
            while (mask) {
                int ee[4]; float gq[4]; const unsigned char* yr[4];
#pragma unroll
                for (int q = 0; q < 4; ++q) { const bool on = mask != 0u; const int e = on ? (__builtin_ffs((int)mask) - 1) : 0; mask &= mask - 1u;
                    const int s = __builtin_amdgcn_readlane(sl, e); const float g = __uint_as_float(__builtin_amdgcn_readlane(__float_as_uint(gg), e));
                    ee[q] = e; gq[q] = on ? g : 0.f; yr[q] = (const unsigned char*)F.Y + ((size_t)e * EPAD + (on ? s : 0)) * D; }
                unsigned w[4][4];
#pragma unroll
                for (int q = 0; q < 4; ++q)
#pragma unroll
                    for (int j = 0; j < 4; ++j) w[q][j] = *(const unsigned*)(yr[q] + 4 * lane + 256 * j);
#pragma unroll
                for (int q = 0; q < 4; ++q)
#pragma unroll
                    for (int j = 0; j < 4; ++j) v[j] += fp8x4_to_f32(w[q][j]) * gq[q];
                (void)ee;
            }
        }
        if (!FINAL && !DRY) {
            bf16* dst = F.H + (size_t)r * D;
#pragma unroll
            for (int j = 0; j < 4; ++j) { u32x2 w; w.x = cvt_pk_bf16(v[j].x, v[j].y); w.y = cvt_pk_bf16(v[j].z, v[j].w); *(u32x2*)(dst + 4 * lane + 256 * j) = w; }
        }
        float ss = 0.f;
#pragma unroll
        for (int j = 0; j < 4; ++j) ss += (v[j].x * v[j].x + v[j].y * v[j].y) + (v[j].z * v[j].z + v[j].w * v[j].w);
        const float rstd = 1.0f / sqrtf(wave_sum(ss) * (1.0f / D) + RMS_EPS);
        if (FINAL) {
            float* dst = F.out + (size_t)r * D;
#pragma unroll
            for (int j = 0; j < 4; ++j) *(f32x4*)(dst + 4 * lane + 256 * j) = v[j] * rstd * gn[j];
        } else {
            if (lane == 0) F.RSTD[r] = rstd;
        }
    }
}
constexpr int RB_PITCH = 2064;
__device__ __forceinline__ unsigned short bf16_rne(float x) { return (unsigned short)(cvt_pk_bf16(x, 0.f) & 0xffffu); }
__device__ __forceinline__ void phase_rowB(const Frame& F, int layer) {
    const int gw = F.vcu * 8 + F.wave, NGW = F.G * 8, lane = F.lane, fr = lane & 15, fq = lane >> 4;
    LAS unsigned char* wl = F.lds;
    LAS float* gl = (LAS float*)(F.lds + 3 * 16 * RB_PITCH);
    const float* rw = F.router_w + (size_t)layer * D * NE;
    const float* gain = F.norm_ffn + layer * D;
    {   f32x4 rv[8]; float gk[8];
#pragma unroll
        for (int i = 0; i < 8; ++i) { const int i4 = F.tid + 512 * i; rv[i] = *(const f32x4*)(rw + 4 * i4); gk[i] = gain[i4 >> 2]; }
#pragma unroll
        for (int i = 0; i < 8; ++i) { const int i4 = F.tid + 512 * i, k = i4 >> 2, e0 = (i4 & 3) * 4;
#pragma unroll
            for (int x = 0; x < 4; ++x) { const float w = rv[i][x] * gk[i];
                const unsigned short hi = bf16_rne(w); const float r1 = w - __uint_as_float((unsigned)hi << 16);
                const unsigned short mid = bf16_rne(r1); const float r2 = r1 - __uint_as_float((unsigned)mid << 16);
                const unsigned short lo = bf16_rne(r2);
                LAS unsigned char* p = wl + (e0 + x) * RB_PITCH + 2 * k;
                *(LAS unsigned short*)p = hi; *(LAS unsigned short*)(p + 16 * RB_PITCH) = mid; *(LAS unsigned short*)(p + 32 * RB_PITCH) = lo; } }
        for (int k = F.tid; k < D; k += 512) gl[k] = gain[k];
    }
    __syncthreads();
    constexpr int NBLK = MROWS / 16;
    for (int blk = gw; blk < NBLK; blk += NGW) {
        const int row = blk * 16 + fr;
        const bf16* src = F.H + (size_t)row * D + 16 * fq;
        u32x4 hv[32];
#pragma unroll
        for (int kk = 0; kk < 32; ++kk) hv[kk] = *(const u32x4*)(src + 64 * (kk >> 1) + 8 * (kk & 1));
        f32x4 acc3[3], acch; acc3[0] = (f32x4){0.f, 0.f, 0.f, 0.f}; acc3[1] = acc3[0]; acc3[2] = acc3[0]; acch = acc3[0];
        const int woff = opaque(fr * RB_PITCH + 32 * fq);
#pragma unroll
        for (int k2 = 0; k2 < 32; k2 += 2) {
            bf16x8 wv[2][3];
#pragma unroll
            for (int u = 0; u < 2; ++u)
#pragma unroll
                for (int p = 0; p < 3; ++p) wv[u][p] = *(const LAS bf16x8*)(wl + woff + p * 16 * RB_PITCH + 64 * k2 + 16 * u);
#pragma unroll
            for (int u = 0; u < 2; ++u) { const bf16x8 a = __builtin_bit_cast(bf16x8, hv[k2 + u]);
#pragma unroll
                for (int p = 0; p < 3; ++p) acc3[p] = __builtin_amdgcn_mfma_f32_16x16x32_bf16(wv[u][p], a, acc3[p], 0, 0, 0);
                acch = __builtin_amdgcn_mfma_f32_16x16x32_bf16(a, a, acch, 0, 0, 0); }
            asm volatile("" ::: "memory");
        }
        const f32x4 acc = (acc3[2] + acc3[1]) + acc3[0];
        const int jd = fr & 3; const float dg = jd == 0 ? acch.x : jd == 1 ? acch.y : jd == 2 ? acch.z : acch.w;
        const float ss = __shfl(dg, fr + 16 * (fr >> 2));
        const float rstd = 1.0f / sqrtf(ss * (1.0f / D) + RMS_EPS);
        unsigned char* dst = (unsigned char*)F.U + (size_t)row * D + 16 * fq;
        const int goff = opaque(16 * fq);
#pragma unroll
        for (int k2 = 0; k2 < 32; k2 += 2) {
            u32x4 o;
#pragma unroll
            for (int u = 0; u < 2; ++u) {
                const u32x4 h4 = hv[k2 + u]; const f32x4 g0 = *(const LAS f32x4*)(gl + goff + 32 * k2 + 8 * u), g1 = *(const LAS f32x4*)(gl + goff + 32 * k2 + 8 * u + 4);
                const unsigned lo = pk4_fp8(bflo(h4.x) * rstd * g0.x, bfhi(h4.x) * rstd * g0.y, bflo(h4.y) * rstd * g0.z, bfhi(h4.y) * rstd * g0.w);
                const unsigned hi = pk4_fp8(bflo(h4.z) * rstd * g1.x, bfhi(h4.z) * rstd * g1.y, bflo(h4.w) * rstd * g1.z, bfhi(h4.w) * rstd * g1.w);
                if (u == 0) { o.x = lo; o.y = hi; } else { o.z = lo; o.w = hi; }
            }
            *(u32x4*)(dst + 32 * k2) = o;
            asm volatile("" ::: "memory");
        }
        const f32x4 lg = acc * rstd;
        float mx = fmaxf(fmaxf(lg.x, lg.y), fmaxf(lg.z, lg.w)); mx = fmaxf(mx, __shfl_xor(mx, 16)); mx = fmaxf(mx, __shfl_xor(mx, 32));
        const f32x4 p = (f32x4){expf(lg.x - mx), expf(lg.y - mx), expf(lg.z - mx), expf(lg.w - mx)};
        float sum = (p.x + p.y) + (p.z + p.w); sum += __shfl_xor(sum, 16); sum += __shfl_xor(sum, 32);
        int b, t; if (row < MMAIN) { b = row >> 12; t = (row & 4095) + NMETA; } else { b = (row - MMAIN) >> 4; t = (row - MMAIN) & 15; }
        float* ap = F.AFF + ((size_t)b * NE + 4 * fq) * T + t;
        ap[0] = p.x / sum; ap[T] = p.y / sum; ap[2 * T] = p.z / sum; ap[3 * T] = p.w / sum;
    }
    __syncthreads();
}

__device__ __forceinline__ int block_excl_scan(int v, LAS int* wsum, int tid, int lane, int wave, int& total) {
    int s = v;
#pragma unroll
    for (int o = 1; o < 64; o <<= 1) { const int t = __shfl_up(s, o); if (lane >= o) s += t; }
    __syncthreads();
    if (lane == 63) wsum[wave] = s;
    __syncthreads();
    int base = 0, tot = 0;
#pragma unroll
    for (int w = 0; w < 8; ++w) { const int x = wsum[w]; if (w < wave) base += x; tot += x; }
    total = tot;
    return base + s - v;
}
__device__ __forceinline__ void phase_topk(const Frame& F) {
    LAS unsigned* keys = (LAS unsigned*)F.lds;
    LAS int* hist = (LAS int*)(F.lds + 20480);
    LAS int* misc = (LAS int*)(F.lds + 20480 + 1024);
    const int tid = F.tid, lane = F.lane, wave = F.wave;
    for (int task = blockIdx.x; task < NB * NE; task += F.G) {
        const int b = task >> 4, e = task & 15;
        const float* aff = F.AFF + ((size_t)b * NE + e) * T;
        __syncthreads();
        {   unsigned kv[9];
#pragma unroll
            for (int i = 0; i < 9; ++i) { const int t = tid + 512 * i; kv[i] = __float_as_uint(aff[t < T ? t : T - 1]); }
#pragma unroll
            for (int i = 0; i < 9; ++i) { const int t = tid + 512 * i; if (t < T) keys[t] = kv[i]; } }
        unsigned prefix = 0u, pmask = 0u; int need = CAP;
        for (int p = 3; p >= 0; --p) {
            if (tid < 256) hist[tid] = 0;
            __syncthreads();
            for (int t = tid; t < T; t += 512) { const unsigned k = keys[t]; if ((k & pmask) == prefix) __hip_atomic_fetch_add(&hist[(k >> (8 * p)) & 255u], 1, __ATOMIC_RELAXED, __HIP_MEMORY_SCOPE_WORKGROUP); }
            __syncthreads();
            if (wave == 0) {
                int c[4]; int tot = 0;
#pragma unroll
                for (int q = 0; q < 4; ++q) { c[q] = hist[4 * lane + q]; tot += c[q]; }
                int s = tot;
#pragma unroll
                for (int o = 1; o < 64; o <<= 1) { const int x = __shfl_down(s, o); if (lane + o < 64) s += x; }
                int above = s - tot;
                if (above < need && need <= s) {
                    int a = above;
#pragma unroll
                    for (int q = 3; q >= 0; --q) { if (need <= a + c[q] && need > a) { misc[0] = 4 * lane + q; misc[1] = need - a; } a += c[q]; }
                }
            }
            __syncthreads();
            prefix |= (unsigned)misc[0] << (8 * p); pmask |= 0xFFu << (8 * p); need = misc[1];
            __syncthreads();
        }
        const unsigned vstar = prefix;
        const int t0 = tid * 9, t1 = (t0 + 9 < T) ? t0 + 9 : T;
        int neq = 0;
        for (int t = t0; t < t1; ++t) neq += (keys[t] == vstar) ? 1 : 0;
        int toteq; int eqbase = block_excl_scan(neq, misc + 8, tid, lane, wave, toteq);
        int nsel = 0; unsigned selmask = 0u; { int er = eqbase;
            for (int t = t0; t < t1; ++t) { const unsigned k = keys[t]; bool s = k > vstar; if (k == vstar) { s = er < need; ++er; } if (s) { selmask |= 1u << (t - t0); ++nsel; } } }
        int totsel; int sbase = block_excl_scan(nsel, misc + 8, tid, lane, wave, totsel);
        for (int t = t0; t < t1; ++t) {
            const int row = row_of(b, t);
            if ((selmask >> (t - t0)) & 1u) { const int pos = b * CAP + sbase; ++sbase;
                F.ROWL[e * EPAD + pos] = row; F.SLOT[(size_t)row * 16 + e] = pos; F.GMAP[(size_t)row * 16 + e] = __uint_as_float(keys[t]); }
            else F.SLOT[(size_t)row * 16 + e] = -1;
        }
        if (b == 0 && tid < EPAD - EROWS) F.ROWL[e * EPAD + EROWS + tid] = 0;
    }
    __syncthreads();
}

__device__ __forceinline__ void phase_poolwin(const Frame& F, int layer) {
    const int gw = F.vcu * 8 + F.wave, NGW = F.G * 8, lane = F.lane;
    constexpr int CHS = 33, NTC = (T + CHS - 1) / CHS;
    for (int it = gw; it < NB * NTC * 2; it += NGW) {
        const int half = it & 1, tc = (it >> 1) % NTC, b = (it >> 1) / NTC;
        const int col = half * 512 + lane * 8, g = col >> 8, hw = 1 << g;
        const int t0 = tc * CHS, t1 = (t0 + CHS < T) ? t0 + CHS : T;
        float sum[8];
#pragma unroll
        for (int q = 0; q < 8; ++q) sum[q] = 0.f;
        const u32x4 zero4 = (u32x4){0u, 0u, 0u, 0u};
        const bf16* ucol = F.H + col;
        float gnv[8];
        { const float* gp = F.norm_mix + (size_t)layer * D + col; const f32x4 g0 = *(const f32x4*)gp, g1 = *(const f32x4*)(gp + 4); gnv[0] = g0.x; gnv[1] = g0.y; gnv[2] = g0.z; gnv[3] = g0.w; gnv[4] = g1.x; gnv[5] = g1.y; gnv[6] = g1.z; gnv[7] = g1.w; }
#define PW_FMA(V_, S_) do { sum[0] += bflo(V_.x) * (S_); sum[1] += bfhi(V_.x) * (S_); sum[2] += bflo(V_.y) * (S_); sum[3] += bfhi(V_.y) * (S_); sum[4] += bflo(V_.z) * (S_); sum[5] += bfhi(V_.z) * (S_); sum[6] += bflo(V_.w) * (S_); sum[7] += bfhi(V_.w) * (S_); } while (0)
        {
            u32x4 iw[16]; float ir[16];
#pragma unroll
            for (int q = 0; q < 16; ++q) { const int dt = q - 8, tt = t0 + dt; const bool v = dt >= -hw && dt < hw && tt >= 0 && tt < T; const int row = row_of(b, v ? tt : t0); iw[q] = *(const u32x4*)(ucol + (size_t)row * D); ir[q] = F.RSTD[row]; }
#pragma unroll
            for (int q = 0; q < 16; ++q) { const int dt = q - 8, tt = t0 + dt; const bool v = dt >= -hw && dt < hw && tt >= 0 && tt < T; const float sc = v ? ir[q] : 0.f; PW_FMA(iw[q], sc); }
        }
        for (int tb = t0; tb < t1; tb += 11) {
            u32x4 c[11], wp[11], wm[11]; float rc[11], rp[11], rm[11];
#pragma unroll
            for (int q = 0; q < 11; ++q) { const int t = (tb + q < t1) ? tb + q : t1 - 1; const bool vp = t + hw < T, vm = t - hw >= 0;
                const int r0_ = row_of(b, t), r1_ = row_of(b, vp ? t + hw : t), r2_ = row_of(b, vm ? t - hw : t);
                c[q] = *(const u32x4*)(ucol + (size_t)r0_ * D); wp[q] = *(const u32x4*)(ucol + (size_t)r1_ * D); wm[q] = *(const u32x4*)(ucol + (size_t)r2_ * D);
                rc[q] = F.RSTD[r0_]; rp[q] = F.RSTD[r1_]; rm[q] = F.RSTD[r2_]; }
#pragma unroll
            for (int q = 0; q < 11; ++q) { const int t = tb + q;
                if (t < t1) {
                    const int lo = (t - hw > 0) ? t - hw : 0, hi = (t + hw < T) ? t + hw : T;
                    const float inv = 1.0f / (float)(hi - lo), cs = rc[q];
                    u32x4 o;
                    o.x = cvt_pk_bf16((sum[0] * inv - bflo(c[q].x) * cs) * gnv[0], (sum[1] * inv - bfhi(c[q].x) * cs) * gnv[1]); o.y = cvt_pk_bf16((sum[2] * inv - bflo(c[q].y) * cs) * gnv[2], (sum[3] * inv - bfhi(c[q].y) * cs) * gnv[3]);
                    o.z = cvt_pk_bf16((sum[4] * inv - bflo(c[q].z) * cs) * gnv[4], (sum[5] * inv - bfhi(c[q].z) * cs) * gnv[5]); o.w = cvt_pk_bf16((sum[6] * inv - bflo(c[q].w) * cs) * gnv[6], (sum[7] * inv - bfhi(c[q].w) * cs) * gnv[7]);
                    *(u32x4*)(F.P + (size_t)row_of(b, t) * D + col) = o;
                    const float sa = (t + hw < T) ? rp[q] : 0.f, sm = (t - hw >= 0) ? -rm[q] : 0.f;
                    PW_FMA(wp[q], sa); PW_FMA(wm[q], sm);
                }
            }
        }
#undef PW_FMA
    }
}
__device__ __forceinline__ void phase_conv(const Frame& F, int j) {
    const int gw = F.vcu * 8 + F.wave, NGW = F.G * 8, lane = F.lane;
    constexpr int CHS = 33, NTC = (T + CHS - 1) / CHS;
    const float* cw = F.conv_w + (size_t)j * 4 * D; const float* cb = F.conv_b + (size_t)j * D;
    for (int it = gw; it < NB * NTC * 2; it += NGW) {
        const int half = it & 1, tc = (it >> 1) % NTC, b = (it >> 1) / NTC;
        const int col = half * 512 + lane * 8;
        const int t0 = tc * CHS, t1 = (t0 + CHS < T) ? t0 + CHS : T;
        float w[4][8], bias[8];
#pragma unroll
        for (int k = 0; k < 4; ++k) { const f32x4 a = *(const f32x4*)(cw + k * D + col), c = *(const f32x4*)(cw + k * D + col + 4);
            w[k][0] = a.x; w[k][1] = a.y; w[k][2] = a.z; w[k][3] = a.w; w[k][4] = c.x; w[k][5] = c.y; w[k][6] = c.z; w[k][7] = c.w; }
        { const f32x4 a = *(const f32x4*)(cb + col), c = *(const f32x4*)(cb + col + 4); bias[0] = a.x; bias[1] = a.y; bias[2] = a.z; bias[3] = a.w; bias[4] = c.x; bias[5] = c.y; bias[6] = c.z; bias[7] = c.w; }
        u32x4 xm1 = (u32x4){0u, 0u, 0u, 0u}, x0 = xm1, xp1 = xm1, xp2 = xm1;
        if (t0 - 1 >= 0) xm1 = *(const u32x4*)(F.XB + (size_t)row_of(b, t0 - 1) * D + col);
        x0 = *(const u32x4*)(F.XB + (size_t)row_of(b, t0) * D + col);
        if (t0 + 1 < T) xp1 = *(const u32x4*)(F.XB + (size_t)row_of(b, t0 + 1) * D + col);
        for (int tb = t0; tb < t1; tb += 11) {
            u32x4 xn[11];
#pragma unroll
            for (int q = 0; q < 11; ++q) { const int tt = tb + q + 2; xn[q] = *(const u32x4*)(F.XB + (size_t)row_of(b, tt < T ? tt : T - 1) * D + col); }
#pragma unroll
            for (int q = 0; q < 11; ++q) { const int t = tb + q;
                if (t < t1) {
                    xp2 = (t + 2 < T) ? xn[q] : (u32x4){0u, 0u, 0u, 0u};
                    float o[8];
#define CONV2(q_, m) o[2 * q_] = bias[2 * q_] + w[0][2 * q_] * bflo(xm1.m) + w[1][2 * q_] * bflo(x0.m) + w[2][2 * q_] * bflo(xp1.m) + w[3][2 * q_] * bflo(xp2.m); \
                     o[2 * q_ + 1] = bias[2 * q_ + 1] + w[0][2 * q_ + 1] * bfhi(xm1.m) + w[1][2 * q_ + 1] * bfhi(x0.m) + w[2][2 * q_ + 1] * bfhi(xp1.m) + w[3][2 * q_ + 1] * bfhi(xp2.m);
                    CONV2(0, x) CONV2(1, y) CONV2(2, z) CONV2(3, w)
#undef CONV2
                    u32x4 ov; ov.x = cvt_pk_bf16(o[0], o[1]); ov.y = cvt_pk_bf16(o[2], o[3]); ov.z = cvt_pk_bf16(o[4], o[5]); ov.w = cvt_pk_bf16(o[6], o[7]);
                    *(u32x4*)(F.P + (size_t)row_of(b, t) * D + col) = ov;
                    xm1 = x0; x0 = xp1; xp1 = xp2;
                }
            }
        }
    }
}
__device__ __forceinline__ void chunk_rows(int b, int k, int& r0, int& n) { if (k == 0) { r0 = MMAIN + b * NMETA; n = NMETA; } else { r0 = b * SEQ + (k - 1) * CHL; n = CHL; } }
__device__ __forceinline__ void phase_scan1(const Frame& F, int j) {
    const int lane = F.lane;
    for (int it = F.wave * F.G + F.vcu; it < 2 * NB * NCHUNK * 8; it += 8 * F.G) {
        int cq, k, b, d;
        if (it < 4096) { cq = it & 7; k = 1 + ((it >> 3) & 31); b = (it >> 8) & 7; d = it >> 11; } else { const int u = it - 4096; cq = u & 7; k = 0; b = (u >> 3) & 7; d = u >> 6; }
        const int c0 = cq * 128 + lane * 2;
        int r0, n; chunk_rows(b, k, r0, n);
        const unsigned char* la = (const unsigned char*)F.LA + (size_t)d * MPAD * D + c0; const bf16* bv = F.BV + (size_t)d * MPAD * D + c0;
        const f32x2 spq = *(const f32x2*)(F.SPT + (size_t)(j * 2 + d) * D + c0) * (1.0f / 255.0f);
        float h0 = 0.f, h1 = 0.f, s0 = 0.f, s1 = 0.f;
        for (int s = 0; s < n; s += 32) {
            unsigned lw[32], bw[32];
#pragma unroll
            for (int q = 0; q < 32; ++q) { const int sq = (s + q < n) ? s + q : n - 1; const int r = d ? (r0 + n - 1 - sq) : (r0 + sq); lw[q] = *(const unsigned short*)(la + (size_t)r * D); bw[q] = *(const unsigned*)(bv + (size_t)r * D); }
#pragma unroll
            for (int q = 0; q < 32; ++q) { const bool ok = s + q < n; const unsigned lq = ok ? lw[q] : 0u, bq = ok ? bw[q] : 0u;
                const float l0 = (float)(lq & 255u) * spq.x, l1 = (float)(lq >> 8) * spq.y; s0 += l0; s1 += l1; h0 = fast_exp(l0) * h0 + bflo(bq); h1 = fast_exp(l1) * h1 + bfhi(bq); }
        }
        float* agg = F.AGG + ((size_t)(d * NB + b) * NCHUNK + k) * D + c0;
        *(f32x2*)agg = (f32x2){s0, s1};
        *(f32x2*)(agg + (size_t)2 * NB * NCHUNK * D) = (f32x2){h0, h1};
    }
}
template <int N>
__device__ __forceinline__ void scan3_rows(const Frame& F, int j, int r0, int c0, float hf0, float hf1, float hb0, float hb1) {
    constexpr int HALF = N / 2;
    const unsigned char* laf = (const unsigned char*)F.LA + c0; const bf16* bvf = F.BV + c0; const unsigned char* lab = laf + (size_t)MPAD * D; const bf16* bvb = bvf + (size_t)MPAD * D;
    const f32x2 sqf = *(const f32x2*)(F.SPT + (size_t)(j * 2 + 0) * D + c0) * (1.0f / 255.0f), sqb = *(const f32x2*)(F.SPT + (size_t)(j * 2 + 1) * D + c0) * (1.0f / 255.0f);
#define L8LO(W_, S_) ((float)((W_) & 255u) * (S_).x)
#define L8HI(W_, S_) ((float)((W_) >> 8) * (S_).y)
    unsigned sf[HALF], sb[HALF];
#pragma unroll
    for (int s = 0; s < HALF; s += 8) {
        unsigned lf[8], bf_[8], lb[8], bb[8];
#pragma unroll
        for (int q = 0; q < 8; ++q) { const size_t rf = (size_t)(r0 + s + q) * D, rb = (size_t)(r0 + N - 1 - s - q) * D;
            lf[q] = *(const unsigned short*)(laf + rf); bf_[q] = *(const unsigned*)(bvf + rf); lb[q] = *(const unsigned short*)(lab + rb); bb[q] = *(const unsigned*)(bvb + rb); }
#pragma unroll
        for (int q = 0; q < 8; ++q) {
            hf0 = fast_exp(L8LO(lf[q], sqf)) * hf0 + bflo(bf_[q]); hf1 = fast_exp(L8HI(lf[q], sqf)) * hf1 + bfhi(bf_[q]); sf[s + q] = cvt_pk_bf16(hf0, hf1);
            hb0 = fast_exp(L8LO(lb[q], sqb)) * hb0 + bflo(bb[q]); hb1 = fast_exp(L8HI(lb[q], sqb)) * hb1 + bfhi(bb[q]); sb[s + q] = cvt_pk_bf16(hb0, hb1); }
    }
#pragma unroll
    for (int s = HALF; s < N; s += 8) {
        unsigned lf[8], bf_[8], lb[8], bb[8], gf[8], gb[8];
#pragma unroll
        for (int q = 0; q < 8; ++q) { const size_t rf = (size_t)(r0 + s + q) * D, rb = (size_t)(r0 + N - 1 - s - q) * D;
            lf[q] = *(const unsigned short*)(laf + rf); bf_[q] = *(const unsigned*)(bvf + rf); lb[q] = *(const unsigned short*)(lab + rb); bb[q] = *(const unsigned*)(bvb + rb);
            gf[q] = *(const unsigned*)(F.GY + rf + c0); gb[q] = *(const unsigned*)(F.GY + rb + c0); }
#pragma unroll
        for (int q = 0; q < 8; ++q) { const size_t rf = (size_t)(r0 + s + q) * D, rb = (size_t)(r0 + N - 1 - s - q) * D;
            const unsigned xf = sb[N - 1 - s - q], xb = sf[N - 1 - s - q];
            hf0 = fast_exp(L8LO(lf[q], sqf)) * hf0 + bflo(bf_[q]); hf1 = fast_exp(L8HI(lf[q], sqf)) * hf1 + bfhi(bf_[q]);
            *(unsigned*)(F.HG + rf + c0) = cvt_pk_bf16((hf0 + bflo(xf)) * bflo(gf[q]), (hf1 + bfhi(xf)) * bfhi(gf[q]));
            hb0 = fast_exp(L8LO(lb[q], sqb)) * hb0 + bflo(bb[q]); hb1 = fast_exp(L8HI(lb[q], sqb)) * hb1 + bfhi(bb[q]);
            *(unsigned*)(F.HG + rb + c0) = cvt_pk_bf16((bflo(xb) + hb0) * bflo(gb[q]), (bfhi(xb) + hb1) * bfhi(gb[q])); }
    }
#undef L8LO
#undef L8HI
}
__device__ __forceinline__ void phase_scan3(const Frame& F, int j) {
    const int lane = F.lane;
    constexpr size_t HOFF = (size_t)2 * NB * NCHUNK * D;
    for (int it = F.wave * F.G + F.vcu; it < NB * NCHUNK * 8; it += 8 * F.G) {
        int cq, k, b;
        if (it < 2048) { cq = it & 7; k = 1 + ((it >> 3) & 31); b = it >> 8; } else { const int u = it - 2048; cq = u & 7; k = 0; b = u >> 3; }
        const int c0 = cq * 128 + lane * 2;
        int r0, n; chunk_rows(b, k, r0, n);
        float hf0 = 0.f, hf1 = 0.f, hb0 = 0.f, hb1 = 0.f;
        for (int j0 = 0; j0 < k; j0 += 8) {
            f32x2 al[8], he[8];
#pragma unroll
            for (int q = 0; q < 8; ++q) { const int jx = (j0 + q < k) ? j0 + q : 0; const float* agg = F.AGG + ((size_t)(0 * NB + b) * NCHUNK + jx) * D + c0; al[q] = *(const f32x2*)agg; he[q] = *(const f32x2*)(agg + HOFF); }
#pragma unroll
            for (int q = 0; q < 8; ++q) if (j0 + q < k) { hf0 = fast_exp(al[q].x) * hf0 + he[q].x; hf1 = fast_exp(al[q].y) * hf1 + he[q].y; }
        }
        for (int j0 = NCHUNK - 1; j0 > k; j0 -= 8) {
            f32x2 al[8], he[8];
#pragma unroll
            for (int q = 0; q < 8; ++q) { const int jx = (j0 - q > k) ? j0 - q : NCHUNK - 1; const float* agg = F.AGG + ((size_t)(1 * NB + b) * NCHUNK + jx) * D + c0; al[q] = *(const f32x2*)agg; he[q] = *(const f32x2*)(agg + HOFF); }
#pragma unroll
            for (int q = 0; q < 8; ++q) if (j0 - q > k) { hb0 = fast_exp(al[q].x) * hb0 + he[q].x; hb1 = fast_exp(al[q].y) * hb1 + he[q].y; }
        }
        if (k == 0) scan3_rows<NMETA>(F, j, r0, c0, hf0, hf1, hb0, hb1); else scan3_rows<CHL>(F, j, r0, c0, hf0, hf1, hb0, hb1);
    }
}

struct TaskMap { int ntask, ncb, rb0, rbstride; };
template <class Fn>
__device__ __forceinline__ void wave_gemm(const Fn& fn, const TaskMap tm, int gw, int ngw, int lane_) {
    const int lane = opaque(lane_), fr = lane & 15, fq = lane >> 4;
    for (int task = gw; task < tm.ntask; task += ngw) {
        const int cb = task % tm.ncb, rb = tm.rb0 + (task / tm.ncb) * tm.rbstride;
        const bf16* ap[2]; const bf16* bp[4];
#pragma unroll
        for (int mi = 0; mi < 2; ++mi) ap[mi] = fn.arow(rb, cb, mi * 16 + fr) + 8 * fq;
#pragma unroll
        for (int nb = 0; nb < 4; ++nb) bp[nb] = fn.brow(rb, cb, nb * 16 + fr) + 8 * fq;
        f32x4 acc[2][4];
#pragma unroll
        for (int mi = 0; mi < 2; ++mi)
#pragma unroll
            for (int nb = 0; nb < 4; ++nb) acc[mi][nb] = (f32x4){0.f, 0.f, 0.f, 0.f};
#pragma unroll 2
        for (int k0 = 0; k0 < fn.K; k0 += 32) {
            bf16x8 a[2], bb[4];
#pragma unroll
            for (int mi = 0; mi < 2; ++mi) a[mi] = *(const bf16x8*)(ap[mi] + k0);
#pragma unroll
            for (int nb = 0; nb < 4; ++nb) bb[nb] = *(const bf16x8*)(bp[nb] + k0);
#pragma unroll
            for (int mi = 0; mi < 2; ++mi)
#pragma unroll
                for (int nb = 0; nb < 4; ++nb) acc[mi][nb] = __builtin_amdgcn_mfma_f32_16x16x32_bf16(bb[nb], a[mi], acc[mi][nb], 0, 0, 0);
        }
#pragma unroll
        for (int mi = 0; mi < 2; ++mi)
#pragma unroll
            for (int nb = 0; nb < (Fn::PAIRED ? 2 : 4); ++nb) fn.epi_blk(rb, cb, mi, nb, acc[mi][nb], acc[mi][Fn::PAIRED ? nb + 2 : nb], fr, fq);
    }
}
struct FnPool {
    static constexpr int nrb = MROWS / 32, ncb = 16, K = 256; static constexpr bool PAIRED = false;
    const bf16* P; const bf16* W; bf16* H; const float* scale;
    __device__ __forceinline__ const bf16* arow(int rb, int cb, int r) const { return P + (size_t)(rb * 32 + r) * D + (cb >> 2) * 256; }
    __device__ __forceinline__ const bf16* brow(int rb, int cb, int n) const { return W + (size_t)(cb * 64 + n) * 256; }
    __device__ __forceinline__ void epi_blk(int rb, int cb, int mi, int nb, const f32x4& v, const f32x4&, int fr, int fq) const {
        const int c = cb * 64 + nb * 16 + 4 * fq; bf16* p = H + (size_t)(rb * 32 + mi * 16 + fr) * D + c; const u32x2 w = *(const u32x2*)p; const f32x4 o = (f32x4){bflo(w.x), bfhi(w.x), bflo(w.y), bfhi(w.y)} + v * *(const f32x4*)(scale + c);
        u32x2 ow; ow.x = cvt_pk_bf16(o.x, o.y); ow.y = cvt_pk_bf16(o.z, o.w); *(u32x2*)p = ow; }
};
struct FnIn {
    static constexpr int nrb = MROWS / 32, ncb = 32, K = 1024; static constexpr bool PAIRED = false;
    const bf16* U; const bf16* W; bf16* XB; bf16* GY; const float* RS;
    __device__ __forceinline__ const bf16* arow(int rb, int cb, int r) const { return U + (size_t)(rb * 32 + r) * D; }
    __device__ __forceinline__ const bf16* brow(int rb, int cb, int n) const { return W + (size_t)(cb * 64 + n) * 1024; }
    __device__ __forceinline__ void epi_blk(int rb, int cb, int mi, int nb, const f32x4& v_, const f32x4&, int fr, int fq) const {
        const int c = cb * 64 + nb * 16 + 4 * fq; const size_t ro = (size_t)(rb * 32 + mi * 16 + fr) * D; u32x2 w; const f32x4 v = v_ * RS[rb * 32 + mi * 16 + fr];
        if (cb < 16) { w.x = cvt_pk_bf16(v.x, v.y); w.y = cvt_pk_bf16(v.z, v.w); *(u32x2*)(XB + ro + c) = w; }
        else { w.x = cvt_pk_bf16(gelu_tanh(v.x), gelu_tanh(v.y)); w.y = cvt_pk_bf16(gelu_tanh(v.z), gelu_tanh(v.w)); *(u32x2*)(GY + ro + c - 1024) = w; } }
};
__device__ __forceinline__ void lru_gate2(f32x2 zr, f32x2 zi, f32x2 sp, f32x2 x, bool slow, f32x2& rg, f32x2& bv) {
    const f32x2 tr = zr * (-1.44269504089f), ti = zi * (-1.44269504089f);
    f32x2 e1, e2; e1.x = __builtin_amdgcn_exp2f(tr.x); e1.y = __builtin_amdgcn_exp2f(tr.y); e2.x = __builtin_amdgcn_exp2f(ti.x); e2.y = __builtin_amdgcn_exp2f(ti.y);
    const f32x2 d1 = e1 + 1.0f, d2 = e2 + 1.0f, dd = d1 * d2;
    f32x2 inv; inv.x = fast_rcp(dd.x); inv.y = fast_rcp(dd.y);
    const f32x2 rgate = inv * d2, l = rgate * sp, x2 = l * 2.0f;
    f32x2 q = x2 * 0.0001984127f + 0.0013888889f; q = q * x2 + 0.0083333333f; q = q * x2 + 0.041666667f; q = q * x2 + 0.16666667f; q = q * x2 + 0.5f; q = q * x2 + 1.0f;
    f32x2 em = -x2 * q;
    if (__builtin_expect(slow, 0)) { asm volatile("" ::: "memory"); em.x = 1.0f - fast_exp(x2.x); em.y = 1.0f - fast_exp(x2.y); }
    f32x2 sq; sq.x = __builtin_amdgcn_sqrtf(em.x); sq.y = __builtin_amdgcn_sqrtf(em.y);
    rg = rgate; bv = sq * (inv * d1) * x;
}
struct FnGates {
    static constexpr int nrb = MROWS / 32, ncb = 64, K = 256; static constexpr bool PAIRED = true;
    const bf16* XC; const bf16* W; bf16* LA; bf16* BV; const float* bg; const float* lam;
    __device__ __forceinline__ const bf16* arow(int rb, int cb, int r) const { return XC + (size_t)(rb * 32 + r) * D + (((cb & 31) * 32) >> 8) * 256; }
    __device__ __forceinline__ const bf16* brow(int rb, int cb, int n) const {
        const int d = cb >> 5, nb = n >> 4, frn = n & 15, ch = (cb & 31) * 32 + (nb & 1) * 16 + frn, g = nb >> 1, h = ch >> 8, jl = ch & 255;
        return W + (((size_t)(d * 8 + h * 2 + (jl >> 7)) * 256) + g * 128 + (jl & 127)) * 256; }
    __device__ __forceinline__ void epi_blk(int rb, int cb, int mi, int nb, const f32x4& vr, const f32x4& vi, int fr, int fq) const {
        const int d = cb >> 5, ch = (cb & 31) * 32 + nb * 16 + 4 * fq;
        const f32x4 br = *(const f32x4*)(bg + (d * 2 + 0) * D + ch), bi = *(const f32x4*)(bg + (d * 2 + 1) * D + ch), lm = *(const f32x4*)(lam + d * D + ch);
        const size_t ro = (size_t)(rb * 32 + mi * 16 + fr) * D + ch;
        const u32x2 xw = *(const u32x2*)(XC + ro); const float xv[4] = {bflo(xw.x), bfhi(xw.x), bflo(xw.y), bfhi(xw.y)};
        float la[4], bvv[4];
        const bool slow = __any((lm.x < -0.25f) | (lm.y < -0.25f) | (lm.z < -0.25f) | (lm.w < -0.25f));
#pragma unroll
        for (int q = 0; q < 4; q += 2) { f32x2 l2, b2; lru_gate2((f32x2){vr[q] + br[q], vr[q + 1] + br[q + 1]}, (f32x2){vi[q] + bi[q], vi[q + 1] + bi[q + 1]}, (f32x2){lm[q], lm[q + 1]}, (f32x2){xv[q], xv[q + 1]}, slow, l2, b2);
            la[q] = l2.x; la[q + 1] = l2.y; bvv[q] = b2.x; bvv[q + 1] = b2.y; }
        *(unsigned*)((unsigned char*)LA + (size_t)d * MPAD * D + ro) = pk4_u8(la[0], la[1], la[2], la[3]);
        u32x2 w; w.x = cvt_pk_bf16(bvv[0], bvv[1]); w.y = cvt_pk_bf16(bvv[2], bvv[3]); *(u32x2*)(BV + (size_t)d * MPAD * D + ro) = w; }
};
struct FnOut {
    static constexpr int nrb = MROWS / 32, ncb = 16, K = 1024; static constexpr bool PAIRED = false;
    const bf16* A; const bf16* W; bf16* H;
    __device__ __forceinline__ const bf16* arow(int rb, int cb, int r) const { return A + (size_t)(rb * 32 + r) * D; }
    __device__ __forceinline__ const bf16* brow(int rb, int cb, int n) const { return W + (size_t)(cb * 64 + n) * 1024; }
    __device__ __forceinline__ void epi_blk(int rb, int cb, int mi, int nb, const f32x4& v, const f32x4&, int fr, int fq) const {
        bf16* p = H + (size_t)(rb * 32 + mi * 16 + fr) * D + cb * 64 + nb * 16 + 4 * fq; const u32x2 w = *(const u32x2*)p; const f32x4 o = (f32x4){bflo(w.x), bfhi(w.x), bflo(w.y), bfhi(w.y)} + v;
        u32x2 ow; ow.x = cvt_pk_bf16(o.x, o.y); ow.y = cvt_pk_bf16(o.z, o.w); *(u32x2*)p = ow; }
};
constexpr int ERB = (EROWS + 31) / 32;
constexpr int ERB16 = (EROWS + 15) / 16;
struct FnM1f8 {
    static constexpr int KB = 1024; static constexpr bool PAIRED = true;
    const unsigned char* U; const unsigned char* W; const int* ROWL; unsigned char* HID;
    __device__ __forceinline__ const unsigned char* arow(int rb, int cb, int r) const { const int e = rb / ERB16, pos = (rb % ERB16) * 16 + r; return U + (size_t)ROWL[e * EPAD + pos] * 1024; }
    __device__ __forceinline__ const unsigned char* brow(int rb, int cb, int n) const { const int e = rb / ERB16, nb = n >> 4, f = cb * 32 + (nb & 1) * 16 + (n & 15);
        return W + ((size_t)e * 4096 + (f >> 7) * 256 + (nb >> 1) * 128 + (f & 127)) * 1024; }
    __device__ __forceinline__ void epi_blk(int rb, int cb, int nb, const f32x4& gs, const f32x4& us, int fr, int fq) const {
        const int e = rb / ERB16, pos = (rb % ERB16) * 16 + fr, f = cb * 32 + nb * 16 + 4 * fq; const f32x4 g = gs * WINV, u = us * WINV;
        *(unsigned*)(HID + ((size_t)e * EPAD + pos) * HIDP8 + f) = pk4_fp8(siluf_(g.x) * u.x, siluf_(g.y) * u.y, siluf_(g.z) * u.z, siluf_(g.w) * u.w); }
};
struct FnM2f8 {
    static constexpr int KB = 2048; static constexpr bool PAIRED = false;
    const unsigned char* HID; const unsigned char* W; bf16* Y;
    __device__ __forceinline__ const unsigned char* arow(int rb, int cb, int r) const { const int e = rb / ERB16, pos = (rb % ERB16) * 16 + r; return HID + ((size_t)e * EPAD + pos) * HIDP8; }
    __device__ __forceinline__ const unsigned char* brow(int rb, int cb, int n) const { const int e = rb / ERB16; return W + ((size_t)e * 1024 + cb * 64 + n) * WDP8; }
    __device__ __forceinline__ void epi_blk(int rb, int cb, int nb, const f32x4& vs, const f32x4&, int fr, int fq) const {
        const int e = rb / ERB16, pos = (rb % ERB16) * 16 + fr; const f32x4 v = vs * WINV;
        *(unsigned*)((unsigned char*)Y + ((size_t)e * EPAD + pos) * D + cb * 64 + nb * 16 + 4 * fq) = pk4_fp8(v.x, v.y, v.z, v.w); }
};
template <class Fn>
__device__ __forceinline__ void wg_gemm_ksplit8(const Fn& fn, const TaskMap tm, LAS unsigned char* lds, int vcu, int G, int tid_) {
    const int tid = opaque(tid_), lane = tid & 63, wave = __builtin_amdgcn_readfirstlane(tid >> 6), fr = lane & 15, fq = lane >> 4;
    constexpr int KW = Fn::KB / 8, NS = KW / 128;
    LAS f32x4* part = (LAS f32x4*)lds;
    for (int task = vcu; task < tm.ntask; task += G) {
        const int cb = task % tm.ncb, rb = tm.rb0 + (task / tm.ncb) * tm.rbstride;
        const unsigned char* ap = fn.arow(rb, cb, fr) + wave * KW + 32 * fq; const unsigned char* bp[4];
#pragma unroll
        for (int nb = 0; nb < 4; ++nb) bp[nb] = fn.brow(rb, cb, nb * 16 + fr) + wave * KW + 32 * fq;
        v4i a[NS][2], bb[NS][4][2];
#pragma unroll
        for (int s = 0; s < NS; ++s) { a[s][0] = *(const v4i*)(ap + s * 128); a[s][1] = *(const v4i*)(ap + s * 128 + 16);
#pragma unroll
            for (int nb = 0; nb < 4; ++nb) { bb[s][nb][0] = *(const v4i*)(bp[nb] + s * 128); bb[s][nb][1] = *(const v4i*)(bp[nb] + s * 128 + 16); } }
        f32x4 acc[4];
#pragma unroll
        for (int nb = 0; nb < 4; ++nb) acc[nb] = (f32x4){0.f, 0.f, 0.f, 0.f};
#pragma unroll
        for (int s = 0; s < NS; ++s)
#pragma unroll
            for (int nb = 0; nb < 4; ++nb) acc[nb] = __builtin_amdgcn_mfma_scale_f32_16x16x128_f8f6f4(__builtin_shufflevector(bb[s][nb][0], bb[s][nb][1], 0, 1, 2, 3, 4, 5, 6, 7),
                                                                                                     __builtin_shufflevector(a[s][0], a[s][1], 0, 1, 2, 3, 4, 5, 6, 7), acc[nb], 0, 0, 0, 0, 0, 0);
#pragma unroll
        for (int nb = 0; nb < 4; ++nb) part[(wave * 4 + nb) * 64 + lane] = acc[nb];
        __syncthreads();
        if (wave < 4 && (!Fn::PAIRED || wave < 2)) {
            const int nb = wave;
            f32x4 v = (f32x4){0.f, 0.f, 0.f, 0.f}, v2 = v;
#pragma unroll
            for (int w = 0; w < 8; ++w) { v += part[(w * 4 + nb) * 64 + lane]; if (Fn::PAIRED) v2 += part[(w * 4 + nb + 2) * 64 + lane]; }
            fn.epi_blk(rb, cb, nb, v, v2, fr, fq);
        }
        __syncthreads();
    }
}

template <int MI, class Fn>
__device__ __forceinline__ void wg_gemm_ksplit(const Fn& fn, const TaskMap tm, LAS unsigned char* lds, int vcu, int G, int tid_) {
    const int tid = opaque(tid_), lane = tid & 63, wave = __builtin_amdgcn_readfirstlane(tid >> 6), fr = lane & 15, fq = lane >> 4;
    constexpr int KW = Fn::K / 8, NS = KW / 32;
    LAS f32x4* part = (LAS f32x4*)lds;
    for (int task = vcu; task < tm.ntask; task += G) {
        const int cb = task % tm.ncb, rb = tm.rb0 + (task / tm.ncb) * tm.rbstride;
        const bf16* ap[MI]; const bf16* bp[4];
#pragma unroll
        for (int mi = 0; mi < MI; ++mi) ap[mi] = fn.arow(rb, cb, mi * 16 + fr) + wave * KW + 8 * fq;
#pragma unroll
        for (int nb = 0; nb < 4; ++nb) bp[nb] = fn.brow(rb, cb, nb * 16 + fr) + wave * KW + 8 * fq;
        f32x4 acc[MI][4];
#pragma unroll
        for (int mi = 0; mi < MI; ++mi)
#pragma unroll
            for (int nb = 0; nb < 4; ++nb) acc[mi][nb] = (f32x4){0.f, 0.f, 0.f, 0.f};
#pragma unroll
        for (int s0 = 0; s0 < NS; s0 += 4) {
            bf16x8 a[4][MI], bb[4][4];
#pragma unroll
            for (int s = 0; s < 4; ++s) if (s0 + s < NS) {
#pragma unroll
                for (int mi = 0; mi < MI; ++mi) a[s][mi] = *(const bf16x8*)(ap[mi] + (s0 + s) * 32);
#pragma unroll
                for (int nb = 0; nb < 4; ++nb) bb[s][nb] = *(const bf16x8*)(bp[nb] + (s0 + s) * 32); }
#pragma unroll
            for (int s = 0; s < 4; ++s) if (s0 + s < NS) {
#pragma unroll
                for (int mi = 0; mi < MI; ++mi)
#pragma unroll
                    for (int nb = 0; nb < 4; ++nb) acc[mi][nb] = __builtin_amdgcn_mfma_f32_16x16x32_bf16(bb[s][nb], a[s][mi], acc[mi][nb], 0, 0, 0); }
        }
#pragma unroll
        for (int mi = 0; mi < MI; ++mi)
#pragma unroll
            for (int nb = 0; nb < 4; ++nb) part[((wave * MI + mi) * 4 + nb) * 64 + lane] = acc[mi][nb];
        __syncthreads();
        if (wave < MI * 4) {
            const int mi = wave >> 2, nb = wave & 3;
            if (!Fn::PAIRED || nb < 2) {
                f32x4 v = (f32x4){0.f, 0.f, 0.f, 0.f}, v2 = v;
#pragma unroll
                for (int w = 0; w < 8; ++w) { v += part[((w * MI + mi) * 4 + nb) * 64 + lane]; if (Fn::PAIRED) v2 += part[((w * MI + mi) * 4 + nb + 2) * 64 + lane]; }
                fn.epi_blk(rb, cb, mi, nb, v, v2, fr, fq);
            }
        }
        __syncthreads();
    }
}

namespace pg8 {
constexpr int BM = 256, BK = 64, HALF = 128, HTB = HALF * BK * 2, STAGE_BYTES = 8 * HTB;
__device__ __forceinline__ int lds_byte(int r, int c) { const int st = (r >> 4) * 2 + (c >> 5), rr = r & 15, cc = c & 31, ob = rr * 64 + cc * 2; return st * 1024 + (ob ^ (((ob >> 9) & 1) << 5)); }
__device__ __forceinline__ void stage_rc(int b, int& R, int& C) { const int st = b / 1024, sb = b % 1024, swz = sb ^ (((sb >> 9) & 1) << 5); R = (st >> 1) * 16 + swz / 64; C = (st & 1) * 32 + (swz % 64) / 2; }
__device__ __forceinline__ int perm32(int rho) { const int n = rho >> 4, i = rho & 15; return 8 * (i >> 2) + 4 * n + (i & 3); }
struct Unit { int pm, pn, e; };
struct SchedStd {
    int nM, nN, nwg, G, c;
    __device__ __forceinline__ void init(int nM_, int nN_, int G_, int c_) { nM = nM_; nN = nN_; nwg = nM * nN; G = G_; c = c_; }
    __device__ __forceinline__ bool next(int i, Unit& u) const {
        const int L = i * G + c; if (L >= nwg) return false;
        int wgid = L; { const int q = nwg / 8, r = nwg % 8, xcd = wgid % 8, off = wgid / 8; wgid = (xcd < r ? xcd * (q + 1) : r * (q + 1) + (xcd - r) * q) + off; }
        const int nig = 8 * nN, gid = wgid / nig, fm = gid * 8, gsz = (nM - fm) < 8 ? (nM - fm) : 8;
        u.pm = fm + ((wgid % nig) % gsz); u.pn = (wgid % nig) / gsz; u.e = 0; return true;
    }
};
struct SchedMoe {
    int nN, total, G, c, rev, gm;
    __device__ __forceinline__ void init(int nN_, int G_, int c_, int rev_ = 0, int gm_ = 8) { nN = nN_; total = 16 * 16 * nN_; G = G_; c = c_; rev = rev_; gm = gm_; }
    __device__ __forceinline__ bool next(int i, Unit& u) const {
        const int L = i * G + c; if (L >= total) return false;
        const int off = rev ? (total / 8 - 1 - L / 8) : L / 8;
        const int wgid = (L % 8) * (total / 8) + off, per = 16 * nN, w = wgid % per, nig = gm * nN;
        u.e = wgid / per; u.pm = (w / nig) * gm + (w % nig) % gm; u.pn = (w % nig) / gm; return true;
    }
};
template <class Cfg>
__device__ __forceinline__ void gemm_phase(LAS unsigned char* lds, const Cfg& cfg) {
    const int tid = opaque((int)threadIdx.x), wid = __builtin_amdgcn_readfirstlane(tid >> 6), lane = tid & 63, wr = wid >> 2, wc = wid & 3, fr = lane & 15, fq = lane >> 4;
    constexpr bool F8 = Cfg::FP8;
    constexpr int nt = Cfg::KB / 128;
    int Rr[2], Cc[2]; unsigned voffB[2];
#pragma unroll
    for (int i = 0; i < 2; ++i) { stage_rc(tid * 16 + i * 8192, Rr[i], Cc[i]); const int R = Rr[i];
        const int Rb = Cfg::PERMX ? (((R >> 5) & 3) * 64 + 16 * ((R & 15) >> 2) + 4 * ((R >> 4) & 1) + (R & 3)) : (Cfg::PERM ? ((R & ~31) + perm32(R & 31)) : R);
        voffB[i] = (unsigned)Rb * (unsigned)Cfg::ldb + (unsigned)Cc[i] * 2u; }
    const size_t kstep = (size_t)(BK * 2);
    const size_t hstepB = (size_t)(Cfg::PERMX ? 8 : HALF) * Cfg::ldb;
    const unsigned ldsw = (unsigned)wid * 1024u;
    const int aoff = lds_byte(wr * 64 + fr, F8 ? fq * 16 : fq * 8), boff = lds_byte(wc * 32 + fr, F8 ? fq * 16 : fq * 8);

#define PG8_SA(b, h) (((b) * 2 + (h)) * HTB)
#define PG8_SB(b, h) ((4 + (b) * 2 + (h)) * HTB)
#define PG8_STAGE(bufoff, gbase, voff) do { _Pragma("unroll") for (int _i = 0; _i < 2; ++_i) \
        __builtin_amdgcn_global_load_lds((const unsigned*)((const char*)(gbase) + (voff)[_i]), (LAS unsigned*)(lds + (bufoff) + ldsw + _i * 8192), 16, 0, 0); } while (0)
typedef v8i v8i_a16 __attribute__((aligned(16)));
#define PG8_LD32(p) (*(const LAS v8i_a16*)(p))
#define PG8_LDA(dst, b, h) do { if constexpr (F8) { _Pragma("unroll") for (int m = 0; m < 4; ++m) dst##8[m] = PG8_LD32(lds + PG8_SA(b, h) + aoff + m * 2048); } \
        else { _Pragma("unroll") for (int m = 0; m < 4; ++m) _Pragma("unroll") for (int k = 0; k < 2; ++k) dst[m][k] = *(const LAS bf16x8*)(lds + PG8_SA(b, h) + aoff + m * 2048 + k * 1024); } } while (0)
#define PG8_LDB(dst, b, h) do { if constexpr (F8) { _Pragma("unroll") for (int n = 0; n < 2; ++n) dst##8[n] = PG8_LD32(lds + PG8_SB(b, h) + boff + n * 2048); } \
        else { _Pragma("unroll") for (int n = 0; n < 2; ++n) _Pragma("unroll") for (int k = 0; k < 2; ++k) dst[n][k] = *(const LAS bf16x8*)(lds + PG8_SB(b, h) + boff + n * 2048 + k * 1024); } } while (0)
#define PG8_MMA(ai, bj, At, Bt) do { __builtin_amdgcn_s_setprio(1); _Pragma("unroll") for (int m = 0; m < 4; ++m) _Pragma("unroll") for (int n = 0; n < 2; ++n) { \
        if constexpr (F8) asm volatile("v_mfma_f32_16x16x128_f8f6f4 %0, %1, %2, %0" : "+v"(acc[ai][bj][m][n]) : "v"(Bt##8[n]), "v"(At##8[m]));   \
        else { _Pragma("unroll") for (int k = 0; k < 2; ++k) acc[ai][bj][m][n] = __builtin_amdgcn_mfma_f32_16x16x32_bf16(Bt[n][k], At[m][k], acc[ai][bj][m][n], 0, 0, 0); } } __builtin_amdgcn_s_setprio(0); } while (0)
#define PG8_WAIT_V(n) asm volatile("s_waitcnt vmcnt(" #n ")" ::: "memory")
#define PG8_WAIT_L(n) asm volatile("s_waitcnt lgkmcnt(" #n ")" ::: "memory")
#define PG8_BAR __builtin_amdgcn_s_barrier()
#define PG8_SCHED __builtin_amdgcn_sched_barrier(0)
    Unit cur, nxt; int ui = 0;
    if (!cfg.next(0, cur)) return;
    f32x4 acc[2][2][4][2];
#pragma unroll
    for (int a = 0; a < 2; ++a)
#pragma unroll
        for (int b = 0; b < 2; ++b)
#pragma unroll
            for (int m = 0; m < 4; ++m)
#pragma unroll
                for (int n = 0; n < 2; ++n) acc[a][b][m][n] = (f32x4){0.f, 0.f, 0.f, 0.f};
    bf16x8 At[4][2], B0[2][2], B1[2][2]; v8i At8[4], B08[2], B18[2];
    unsigned voffA[2][2], voffAn[2][2];
    cfg.a_offs(cur, 0, Rr, Cc, voffA);
    const char* cA = cfg.a_base(cur); const char* cB = cfg.b_base(cur);
    PG8_STAGE(PG8_SB(0, 0), cB, voffB); PG8_STAGE(PG8_SB(0, 1), cB + hstepB, voffB); PG8_STAGE(PG8_SA(0, 0), cA, voffA[0]); PG8_STAGE(PG8_SA(0, 1), cA, voffA[1]);
    if (wr == 1) PG8_BAR;
    PG8_WAIT_V(2); PG8_BAR;
    PG8_STAGE(PG8_SB(1, 0), cB + kstep, voffB); PG8_STAGE(PG8_SA(1, 0), cA + kstep, voffA[0]); PG8_STAGE(PG8_SB(1, 1), cB + hstepB + kstep, voffB);
    PG8_WAIT_V(6); PG8_BAR;
    for (;;) {
        const bool has_next = cfg.next(ui + 1, nxt);
        const char* nA = has_next ? cfg.a_base(nxt) : cA; const char* nB = has_next ? cfg.b_base(nxt) : cB;
#pragma unroll 1
        for (int t = 0; t < nt; t += 2) {
            const bool last = (t == nt - 2);
            const char* a1 = cA + (size_t)(t + 1) * kstep;
            const char* a2 = last ? nA : cA + (size_t)(t + 2) * kstep; const char* b2 = last ? nB : cB + (size_t)(t + 2) * kstep;
            const char* a3 = a2 + kstep; const char* b3 = b2 + kstep;
            unsigned o2[2][2];
            if constexpr (Cfg::GATHER) {
                if (last) { if (has_next) { int R2[2], C2[2]; stage_rc(tid * 16, R2[0], C2[0]); stage_rc(tid * 16 + 8192, R2[1], C2[1]); cfg.a_offs(nxt, ui + 1, R2, C2, voffAn); } else {
#pragma unroll
                    for (int h = 0; h < 2; ++h) { voffAn[h][0] = voffA[h][0]; voffAn[h][1] = voffA[h][1]; } } }
#pragma unroll
                for (int h = 0; h < 2; ++h) { o2[h][0] = last ? voffAn[h][0] : voffA[h][0]; o2[h][1] = last ? voffAn[h][1] : voffA[h][1]; }
            } else {
#pragma unroll
                for (int h = 0; h < 2; ++h) { o2[h][0] = voffA[h][0]; o2[h][1] = voffA[h][1]; }
            }
            PG8_LDB(B0, 0, 0); PG8_LDB(B1, 0, 1); PG8_SCHED; PG8_LDA(At, 0, 0); PG8_STAGE(PG8_SA(1, 1), a1, voffA[1]);
            PG8_WAIT_V(8); PG8_WAIT_L(0); PG8_BAR; PG8_MMA(0, 0, At, B0); PG8_MMA(0, 1, At, B1); PG8_BAR; PG8_SCHED;
            PG8_LDA(At, 0, 1); PG8_STAGE(PG8_SB(0, 0), b2, voffB); PG8_STAGE(PG8_SB(0, 1), b2 + hstepB, voffB); PG8_STAGE(PG8_SA(0, 0), a2, o2[0]);
            PG8_WAIT_V(8); PG8_WAIT_L(0); PG8_BAR; PG8_MMA(1, 0, At, B0); PG8_MMA(1, 1, At, B1); PG8_BAR; PG8_SCHED;
            PG8_LDB(B0, 1, 0); PG8_LDB(B1, 1, 1); PG8_SCHED; PG8_LDA(At, 1, 0); PG8_STAGE(PG8_SA(0, 1), a2, o2[1]);
            PG8_WAIT_V(8); PG8_WAIT_L(0); PG8_BAR; PG8_MMA(0, 0, At, B0); PG8_MMA(0, 1, At, B1); PG8_BAR; PG8_SCHED;
            PG8_LDA(At, 1, 1); PG8_STAGE(PG8_SB(1, 0), b3, voffB); PG8_STAGE(PG8_SB(1, 1), b3 + hstepB, voffB); PG8_STAGE(PG8_SA(1, 0), a3, o2[0]);
            PG8_WAIT_V(8); PG8_WAIT_L(0); PG8_BAR; PG8_MMA(1, 0, At, B0); PG8_MMA(1, 1, At, B1); PG8_BAR; PG8_SCHED;
        }
        if (wr == 0) PG8_BAR;
        if constexpr (F8) asm volatile("s_nop 15\n\ts_nop 15" ::: "memory");
        cfg.epi(acc, cur, wr, wc, fr, fq);
        if (!has_next) break;
#pragma unroll
        for (int a = 0; a < 2; ++a)
#pragma unroll
            for (int b = 0; b < 2; ++b)
#pragma unroll
                for (int m = 0; m < 4; ++m)
#pragma unroll
                    for (int n = 0; n < 2; ++n) acc[a][b][m][n] = (f32x4){0.f, 0.f, 0.f, 0.f};
        cur = nxt; cA = nA; cB = nB; ++ui;
        if constexpr (Cfg::GATHER) {
#pragma unroll
            for (int h = 0; h < 2; ++h) { voffA[h][0] = voffAn[h][0]; voffA[h][1] = voffAn[h][1]; } }
        if (wr == 1) PG8_BAR;
    }
    PG8_WAIT_V(0);
    PG8_BAR;
#undef PG8_SA
#undef PG8_SB
#undef PG8_STAGE
#undef PG8_LDA
#undef PG8_LDB
#undef PG8_MMA
#undef PG8_LD32
#undef PG8_WAIT_V
#undef PG8_WAIT_L
#undef PG8_BAR
#undef PG8_SCHED
}
template <int LDA> __device__ __forceinline__ void lin_offs(const int (&R)[2], const int (&C)[2], unsigned (&off)[2][2]) {
#pragma unroll
    for (int h = 0; h < 2; ++h)
#pragma unroll
        for (int i = 0; i < 2; ++i) off[h][i] = (unsigned)(h * HALF + R[i]) * (unsigned)LDA + (unsigned)C[i] * 2u;
}
struct CfgPool {
    static constexpr bool PERMX = false; static constexpr bool GATHER = false; static constexpr bool FP8 = false; static constexpr int KB = 256 * 2; static constexpr bool PERM = true; static constexpr int K = 256, ldb = 512;
    SchedStd S; const bf16* P; const bf16* W; bf16* H; const float* scale;
    __device__ __forceinline__ bool next(int i, Unit& u) const { return S.next(i, u); }
    __device__ __forceinline__ const char* a_base(const Unit& u) const { return (const char*)(P + (size_t)u.pm * 256 * D + u.pn * 256); }
    __device__ __forceinline__ void a_offs(const Unit&, int, const int (&R)[2], const int (&C)[2], unsigned (&off)[2][2]) const { lin_offs<2048>(R, C, off); }
    __device__ __forceinline__ const char* b_base(const Unit& u) const { return (const char*)(W + (size_t)u.pn * 65536); }
    __device__ __forceinline__ void epi(const f32x4 (&acc)[2][2][4][2], const Unit& u, int wr, int wc, int fr, int fq) const {
        const int row0 = u.pm * 256 + wr * 64 + fr, col0 = u.pn * 256 + wc * 32 + 8 * fq;
        f32x4 sc[2][2];
#pragma unroll
        for (int bj = 0; bj < 2; ++bj)
#pragma unroll
            for (int n = 0; n < 2; ++n) sc[bj][n] = *(const f32x4*)(scale + col0 + bj * 128 + n * 4);
#pragma unroll
        for (int ai = 0; ai < 2; ++ai) {
            u32x4 hw[4][2];
#pragma unroll
            for (int m = 0; m < 4; ++m)
#pragma unroll
                for (int bj = 0; bj < 2; ++bj) hw[m][bj] = *(const u32x4*)(H + (size_t)(row0 + ai * 128 + m * 16) * D + col0 + bj * 128);
            asm volatile("" ::: "memory");
#pragma unroll
            for (int m = 0; m < 4; ++m) { bf16* rowp = H + (size_t)(row0 + ai * 128 + m * 16) * D + col0;
#pragma unroll
                for (int bj = 0; bj < 2; ++bj) { const u32x4 w = hw[m][bj];
                    const f32x4 o0 = (f32x4){bflo(w.x), bfhi(w.x), bflo(w.y), bfhi(w.y)} + acc[ai][bj][m][0] * sc[bj][0], o1 = (f32x4){bflo(w.z), bfhi(w.z), bflo(w.w), bfhi(w.w)} + acc[ai][bj][m][1] * sc[bj][1];
                    u32x4 ow; ow.x = cvt_pk_bf16(o0.x, o0.y); ow.y = cvt_pk_bf16(o0.z, o0.w); ow.z = cvt_pk_bf16(o1.x, o1.y); ow.w = cvt_pk_bf16(o1.z, o1.w);
                    *(u32x4*)(rowp + bj * 128) = ow; } }
            asm volatile("" ::: "memory");
        }
    }
};
struct CfgOut {
    static constexpr bool PERMX = false; static constexpr bool GATHER = false; static constexpr bool FP8 = false; static constexpr int KB = 1024 * 2; static constexpr bool PERM = true; static constexpr int K = 1024, ldb = 2048;
    SchedStd S; const bf16* A; const bf16* W; bf16* H;
    __device__ __forceinline__ bool next(int i, Unit& u) const { return S.next(i, u); }
    __device__ __forceinline__ const char* a_base(const Unit& u) const { return (const char*)(A + (size_t)u.pm * 256 * D); }
    __device__ __forceinline__ void a_offs(const Unit&, int, const int (&R)[2], const int (&C)[2], unsigned (&off)[2][2]) const { lin_offs<2048>(R, C, off); }
    __device__ __forceinline__ const char* b_base(const Unit& u) const { return (const char*)(W + (size_t)u.pn * 256 * 1024); }
    __device__ __forceinline__ void epi(const f32x4 (&acc)[2][2][4][2], const Unit& u, int wr, int wc, int fr, int fq) const {
        const int row0 = u.pm * 256 + wr * 64 + fr, col0 = u.pn * 256 + wc * 32 + 8 * fq;
#pragma unroll
        for (int ai = 0; ai < 2; ++ai) {
            u32x4 hw[4][2];
#pragma unroll
            for (int m = 0; m < 4; ++m)
#pragma unroll
                for (int bj = 0; bj < 2; ++bj) hw[m][bj] = *(const u32x4*)(H + (size_t)(row0 + ai * 128 + m * 16) * D + col0 + bj * 128);
            asm volatile("" ::: "memory");
#pragma unroll
            for (int m = 0; m < 4; ++m) { bf16* rowp = H + (size_t)(row0 + ai * 128 + m * 16) * D + col0;
#pragma unroll
                for (int bj = 0; bj < 2; ++bj) { const u32x4 w = hw[m][bj];
                    const f32x4 o0 = (f32x4){bflo(w.x), bfhi(w.x), bflo(w.y), bfhi(w.y)} + acc[ai][bj][m][0], o1 = (f32x4){bflo(w.z), bfhi(w.z), bflo(w.w), bfhi(w.w)} + acc[ai][bj][m][1];
                    u32x4 ow; ow.x = cvt_pk_bf16(o0.x, o0.y); ow.y = cvt_pk_bf16(o0.z, o0.w); ow.z = cvt_pk_bf16(o1.x, o1.y); ow.w = cvt_pk_bf16(o1.z, o1.w);
                    *(u32x4*)(rowp + bj * 128) = ow; } }
            asm volatile("" ::: "memory");
        }
    }
};
struct CfgIn {
    static constexpr bool PERMX = false; static constexpr bool GATHER = false; static constexpr bool FP8 = false; static constexpr int KB = 1024 * 2; static constexpr bool PERM = true; static constexpr int K = 1024, ldb = 2048;
    SchedStd S; const bf16* U; const bf16* W; bf16* XB; bf16* GY; const float* RS;
    __device__ __forceinline__ bool next(int i, Unit& u) const { return S.next(i, u); }
    __device__ __forceinline__ const char* a_base(const Unit& u) const { return (const char*)(U + (size_t)u.pm * 256 * D); }
    __device__ __forceinline__ void a_offs(const Unit&, int, const int (&R)[2], const int (&C)[2], unsigned (&off)[2][2]) const { lin_offs<2048>(R, C, off); }
    __device__ __forceinline__ const char* b_base(const Unit& u) const { return (const char*)(W + (size_t)u.pn * 256 * 1024); }
    __device__ __forceinline__ void epi(const f32x4 (&acc)[2][2][4][2], const Unit& u, int wr, int wc, int fr, int fq) const {
        const int row0 = u.pm * 256 + wr * 64 + fr, col0 = (u.pn & 3) * 256 + wc * 32 + 8 * fq; const bool act = u.pn >= 4; bf16* base = act ? GY : XB;
        float rs[2][4];
#pragma unroll
        for (int ai = 0; ai < 2; ++ai)
#pragma unroll
            for (int m = 0; m < 4; ++m) rs[ai][m] = RS[row0 + ai * 128 + m * 16];
#pragma unroll
        for (int ai = 0; ai < 2; ++ai)
#pragma unroll
            for (int m = 0; m < 4; ++m) { bf16* rowp = base + (size_t)(row0 + ai * 128 + m * 16) * D + col0;
#pragma unroll
                for (int bj = 0; bj < 2; ++bj) { f32x4 v0 = acc[ai][bj][m][0] * rs[ai][m], v1 = acc[ai][bj][m][1] * rs[ai][m];
                    if (act) { const f32x2 a0 = gelu_tanh2((f32x2){v0.x, v0.y}), a1 = gelu_tanh2((f32x2){v0.z, v0.w}), a2 = gelu_tanh2((f32x2){v1.x, v1.y}), a3 = gelu_tanh2((f32x2){v1.z, v1.w});
                        v0 = (f32x4){a0.x, a0.y, a1.x, a1.y}; v1 = (f32x4){a2.x, a2.y, a3.x, a3.y}; }
                    u32x4 w; w.x = cvt_pk_bf16(v0.x, v0.y); w.y = cvt_pk_bf16(v0.z, v0.w); w.z = cvt_pk_bf16(v1.x, v1.y); w.w = cvt_pk_bf16(v1.z, v1.w);
                    *(u32x4*)(rowp + bj * 128) = w; } }
    }
};
struct CfgGates {
    static constexpr bool PERMX = false; static constexpr bool GATHER = false; static constexpr bool FP8 = false; static constexpr int KB = 256 * 2; static constexpr bool PERM = true; static constexpr int K = 256, ldb = 512;
    SchedStd S; const bf16* XC; const bf16* W; bf16* LA; bf16* BV; const float* bg; const float* lam;
    __device__ __forceinline__ bool next(int i, Unit& u) const { return S.next(i, u); }
    __device__ __forceinline__ const char* a_base(const Unit& u) const { return (const char*)(XC + (size_t)u.pm * 256 * D + ((u.pn & 7) >> 1) * 256); }
    __device__ __forceinline__ void a_offs(const Unit&, int, const int (&R)[2], const int (&C)[2], unsigned (&off)[2][2]) const { lin_offs<2048>(R, C, off); }
    __device__ __forceinline__ const char* b_base(const Unit& u) const { return (const char*)(W + (size_t)u.pn * 65536); }
    __device__ __forceinline__ void epi(const f32x4 (&acc)[2][2][4][2], const Unit& u, int wr, int wc, int fr, int fq) const {
        const int d = u.pn >> 3, ch0 = (u.pn & 7) * 128 + wc * 32 + 8 * fq, row0 = u.pm * 256 + wr * 64 + fr;
        float br[8], bi[8], sp[8];
#pragma unroll
        for (int q = 0; q < 2; ++q) { const f32x4 a = *(const f32x4*)(bg + (d * 2 + 0) * D + ch0 + 4 * q), b = *(const f32x4*)(bg + (d * 2 + 1) * D + ch0 + 4 * q), l = *(const f32x4*)(lam + d * D + ch0 + 4 * q);
#pragma unroll
            for (int x = 0; x < 4; ++x) { br[4 * q + x] = a[x]; bi[4 * q + x] = b[x]; sp[4 * q + x] = l[x]; } }
        bool sl = false;
#pragma unroll
        for (int q = 0; q < 8; ++q) sl |= sp[q] < -0.25f;
        const bool slow = __any(sl);
        u32x4 xin[2][4];
#pragma unroll
        for (int ai = 0; ai < 2; ++ai)
#pragma unroll
            for (int m = 0; m < 4; ++m) xin[ai][m] = *(const u32x4*)(XC + (size_t)(row0 + ai * 128 + m * 16) * D + ch0);
        asm volatile("" ::: "memory");
#pragma unroll
        for (int ai = 0; ai < 2; ++ai)
#pragma unroll
            for (int m = 0; m < 4; ++m) { const size_t ro = (size_t)(row0 + ai * 128 + m * 16) * D + ch0;
                const u32x4 xw = xin[ai][m];
                const float xv[8] = {bflo(xw.x), bfhi(xw.x), bflo(xw.y), bfhi(xw.y), bflo(xw.z), bfhi(xw.z), bflo(xw.w), bfhi(xw.w)};
                float la[8], bv[8];
#pragma unroll
                for (int q = 0; q < 8; q += 2) { f32x2 l2, b2;
                    lru_gate2((f32x2){acc[ai][0][m][q >> 2][q & 3] + br[q], acc[ai][0][m][q >> 2][(q & 3) + 1] + br[q + 1]}, (f32x2){acc[ai][1][m][q >> 2][q & 3] + bi[q], acc[ai][1][m][q >> 2][(q & 3) + 1] + bi[q + 1]},
                              (f32x2){sp[q], sp[q + 1]}, (f32x2){xv[q], xv[q + 1]}, slow, l2, b2);
                    la[q] = l2.x; la[q + 1] = l2.y; bv[q] = b2.x; bv[q + 1] = b2.y; }
                { u32x2 w8; w8.x = pk4_u8(la[0], la[1], la[2], la[3]); w8.y = pk4_u8(la[4], la[5], la[6], la[7]); *(u32x2*)((unsigned char*)LA + (size_t)d * MPAD * D + ro) = w8; }
                u32x4 w; w.x = cvt_pk_bf16(bv[0], bv[1]); w.y = cvt_pk_bf16(bv[2], bv[3]); w.z = cvt_pk_bf16(bv[4], bv[5]); w.w = cvt_pk_bf16(bv[6], bv[7]);
                *(u32x4*)(BV + (size_t)d * MPAD * D + ro) = w; }
    }
};
struct CfgM1 {
    static constexpr bool PERMX = false; static constexpr bool GATHER = true; static constexpr bool FP8 = true; static constexpr int KB = 1024; static constexpr bool PERM = true; static constexpr int K = 1024, ldb = 1024;
    SchedMoe S; const unsigned char* U; const unsigned char* W; unsigned char* HID; const LAS unsigned short* idx;
    __device__ __forceinline__ bool next(int i, Unit& u) const { return S.next(i, u); }
    __device__ __forceinline__ const char* a_base(const Unit&) const { return (const char*)U; }
    __device__ __forceinline__ void a_offs(const Unit&, int ui, const int (&R)[2], const int (&C)[2], unsigned (&off)[2][2]) const {
#pragma unroll
        for (int h = 0; h < 2; ++h)
#pragma unroll
            for (int i = 0; i < 2; ++i) off[h][i] = (unsigned)idx[ui * 256 + h * HALF + R[i]] * 1024u + (unsigned)C[i] * 2u;
    }
    __device__ __forceinline__ const char* b_base(const Unit& u) const { return (const char*)(W + ((size_t)u.e * 4096 + u.pn * 256) * 1024); }
    __device__ __forceinline__ void epi(const f32x4 (&acc)[2][2][4][2], const Unit& u, int wr, int wc, int fr, int fq) const {
        const int row0 = u.e * EPAD + u.pm * 256 + wr * 64 + fr, col0 = u.pn * 128 + wc * 32 + 8 * fq;
#pragma unroll
        for (int ai = 0; ai < 2; ++ai)
#pragma unroll
            for (int m = 0; m < 4; ++m) { const f32x4 g0 = acc[ai][0][m][0], g1 = acc[ai][0][m][1], u0 = acc[ai][1][m][0], u1 = acc[ai][1][m][1];
                u32x2 w; w.x = silu_mul_fp8x4(g0, u0); w.y = silu_mul_fp8x4(g1, u1);
                *(u32x2*)(HID + (size_t)(row0 + ai * 128 + m * 16) * HIDP8 + col0) = w; }
    }
};
struct CfgM2 {
    static constexpr bool PERMX = true; static constexpr bool GATHER = false; static constexpr bool FP8 = true; static constexpr int KB = 2048; static constexpr bool PERM = true; static constexpr int K = 2048, ldb = WDP8;
    SchedMoe S; const unsigned char* HID; const unsigned char* W; bf16* Y;
    __device__ __forceinline__ bool next(int i, Unit& u) const { return S.next(i, u); }
    __device__ __forceinline__ const char* a_base(const Unit& u) const { return (const char*)(HID + ((size_t)u.e * EPAD + u.pm * 256) * HIDP8); }
    __device__ __forceinline__ void a_offs(const Unit&, int, const int (&R)[2], const int (&C)[2], unsigned (&off)[2][2]) const { lin_offs<HIDP8>(R, C, off); }
    __device__ __forceinline__ const char* b_base(const Unit& u) const { return (const char*)(W + ((size_t)u.e * 1024 + u.pn * 256) * WDP8); }
    __device__ __forceinline__ void epi(const f32x4 (&acc)[2][2][4][2], const Unit& u, int wr, int wc, int fr, int fq) const {
        const int row0 = u.e * EPAD + u.pm * 256 + wr * 64 + fr, col0 = u.pn * 256 + wc * 64 + 16 * fq;
#pragma unroll
        for (int ai = 0; ai < 2; ++ai)
#pragma unroll
            for (int m = 0; m < 4; ++m) { const f32x4 v0 = acc[ai][0][m][0] * WINV, v1 = acc[ai][0][m][1] * WINV, v2 = acc[ai][1][m][0] * WINV, v3 = acc[ai][1][m][1] * WINV;
                u32x4 w; w.x = pk4_fp8(v0.x, v0.y, v0.z, v0.w); w.y = pk4_fp8(v1.x, v1.y, v1.z, v1.w); w.z = pk4_fp8(v2.x, v2.y, v2.z, v2.w); w.w = pk4_fp8(v3.x, v3.y, v3.z, v3.w);
                *(u32x4*)((unsigned char*)Y + (size_t)(row0 + ai * 128 + m * 16) * D + col0) = w; }
    }
};
}

#ifndef FAST_PG
#define FAST_PG 1
#endif
#ifndef FAST_LIN
#define FAST_LIN 1
#endif
#ifndef FAST_LGT
#define FAST_LGT 1
#endif
#ifndef FAST_LOUT
#define FAST_LOUT 1
#endif
#ifndef FAST_M1
#define FAST_M1 1
#endif
#ifndef FAST_M2
#define FAST_M2 1
#endif
constexpr int IDX_OFF = RING_BYTES + 1024;

#ifndef REP_PRO
#define REP_PRO 1
#endif
#ifndef REP_PP
#define REP_PP 1
#endif
#ifndef REP_LIN
#define REP_LIN 1
#endif
#ifndef REP_LCV
#define REP_LCV 1
#endif
#ifndef REP_LGT
#define REP_LGT 1
#endif
#ifndef REP_LS1
#define REP_LS1 1
#endif
#ifndef REP_LS3
#define REP_LS3 1
#endif
#ifndef REP_RB
#define REP_RB 1
#endif
#ifndef REP_TK
#define REP_TK 1
#endif
#ifndef REP_M1
#define REP_M1 1
#endif
#ifndef REP_M2
#define REP_M2 1
#endif
#ifndef REP_RA
#define REP_RA 1
#endif
#ifndef REP_LOUT
#define REP_LOUT 1
#endif
#ifndef REP_PG
#define REP_PG 1
#endif
#define REPEAT(n) _Pragma("unroll") for (int rep_ = 0; rep_ < (n); ++rep_)
#define IN(k) (lo <= (k) && (k) < hi)
#define SEAM(k) do { if ((k) + 1 < hi) xcd_barrier(bar); } while (0)
template <int layer>
__device__ __forceinline__ void run_layer(const Frame& F, const int lo, const int hi, const XcdBarrier& bar) {
    const int gw = F.vcu * 8 + F.wave, NGW = F.G * 8;
    const bool fast = (F.G == 256);
    {
        const int pb = layer * 16, j = layer >> 1;
        if (IN(pb + 0)) { if constexpr (layer == 0) REPEAT(REP_PRO) phase_prologue(F); if (REP_RA > 1) phase_rowA<false, layer == 0, true>(F, layer); phase_rowA<false, layer == 0>(F, layer); SEAM(pb + 0); }
        if constexpr ((layer & 1) == 0) {
            if (IN(pb + 1)) { REPEAT(REP_PP) phase_poolwin(F, layer); SEAM(pb + 1); }
            if (IN(pb + 2)) { FnPool fn{F.P, F.WPOOL + (size_t)j * 4 * 65536, F.H, F.pool_scale + (size_t)j * D};
                if (FAST_PG && fast) { pg8::CfgPool cfg; cfg.S.init(128, 4, F.G, (int)blockIdx.x); cfg.P = F.P; cfg.W = fn.W; cfg.scale = fn.scale; if (REP_PG > 1) { cfg.H = (bf16*)F.HF; pg8::gemm_phase(F.lds, cfg); } cfg.H = F.H; pg8::gemm_phase(F.lds, cfg);
                    wg_gemm_ksplit<2>(fn, TaskMap{4 * 16, 16, 1024, 1}, F.lds, F.vcu, F.G, F.tid); }
                else wave_gemm(fn, TaskMap{FnPool::nrb * 16, 16, 0, 1}, gw, NGW, F.lane);
                SEAM(pb + 2); }
        } else {
            if (IN(pb + 3)) { REPEAT(REP_LIN) { FnIn fn{F.H, F.WIN + (size_t)j * 2048 * 1024, F.XB, F.GY, F.RSTD};
                if (FAST_LIN && fast) { pg8::CfgIn cfg; cfg.S.init(128, 8, F.G, (int)blockIdx.x); cfg.U = F.H; cfg.W = fn.W; cfg.XB = F.XB; cfg.GY = F.GY; cfg.RS = F.RSTD; pg8::gemm_phase(F.lds, cfg);
                    wg_gemm_ksplit<2>(fn, TaskMap{4 * 32, 32, 1024, 1}, F.lds, F.vcu, F.G, F.tid); }
                else wave_gemm(fn, TaskMap{FnIn::nrb * 32, 32, 0, 1}, gw, NGW, F.lane);
                } SEAM(pb + 3); }
            if (IN(pb + 4)) { REPEAT(REP_LCV) phase_conv(F, j); SEAM(pb + 4); }
            if (IN(pb + 5)) { REPEAT(REP_LGT) { FnGates fn{F.P, F.WGT + (size_t)j * 16 * 65536, F.LA, F.BV, F.b_gates + (size_t)j * 4 * D, F.SPT + (size_t)j * 2 * D};
                if (FAST_LGT && fast) { pg8::CfgGates cfg; cfg.S.init(128, 16, F.G, (int)blockIdx.x); cfg.XC = F.P; cfg.W = fn.W; cfg.LA = F.LA; cfg.BV = F.BV; cfg.bg = fn.bg; cfg.lam = fn.lam; pg8::gemm_phase(F.lds, cfg);
                    wg_gemm_ksplit<2>(fn, TaskMap{4 * 64, 64, 1024, 1}, F.lds, F.vcu, F.G, F.tid); }
                else wave_gemm(fn, TaskMap{FnGates::nrb * 64, 64, 0, 1}, gw, NGW, F.lane);
                } SEAM(pb + 5); }
            if (IN(pb + 6)) { REPEAT(REP_LS1) phase_scan1(F, j); SEAM(pb + 6); }
            if (IN(pb + 7)) { REPEAT(REP_LS3) phase_scan3(F, j); SEAM(pb + 7); }
            if (IN(pb + 8)) { FnOut fn{F.HG, F.WOUT + (size_t)j * 1024 * 1024, F.H};
                if (FAST_LOUT && fast) { pg8::CfgOut cfg; cfg.S.init(128, 4, F.G, (int)blockIdx.x); cfg.A = F.HG; cfg.W = fn.W; if (REP_LOUT > 1) { cfg.H = (bf16*)F.HF; pg8::gemm_phase(F.lds, cfg); } cfg.H = F.H; pg8::gemm_phase(F.lds, cfg);
                    wg_gemm_ksplit<2>(fn, TaskMap{4 * 16, 16, 1024, 1}, F.lds, F.vcu, F.G, F.tid); }
                else wave_gemm(fn, TaskMap{FnOut::nrb * 16, 16, 0, 1}, gw, NGW, F.lane);
                SEAM(pb + 8); }
        }
        if (IN(pb + 9)) { REPEAT(REP_RB) phase_rowB(F, layer); SEAM(pb + 9); }
        if (IN(pb + 10)) { REPEAT(REP_TK) phase_topk(F); SEAM(pb + 10); }
        if (IN(pb + 11)) { REPEAT(REP_M1) { FnM1f8 fn{(const unsigned char*)F.U, (const unsigned char*)F.WG1 + (size_t)layer * NE * 4096 * 1024, F.ROWL, (unsigned char*)F.HID};
            if (FAST_M1 && fast) { pg8::CfgM1 cfg; cfg.S.init(16, F.G, (int)blockIdx.x, 0, 4); cfg.U = fn.U; cfg.W = fn.W; cfg.HID = fn.HID;
                LAS unsigned short* idx = (LAS unsigned short*)(F.lds + IDX_OFF); cfg.idx = idx;
                {
                    int rl[16];
#pragma unroll
                    for (int ui = 0; ui < 16; ++ui) { pg8::Unit u; const bool ok = cfg.S.next(ui, u); rl[ui] = F.ROWL[(ok ? u.e * EPAD + u.pm * 256 : 0) + (F.tid & 255)]; }
#pragma unroll
                    for (int ui = 0; ui < 16; ++ui) if (F.tid < 256) idx[ui * 256 + F.tid] = (unsigned short)rl[ui];
                }
                __syncthreads();
                pg8::gemm_phase(F.lds, cfg);
                wg_gemm_ksplit8(fn, TaskMap{16 * 64, 64, ERB16 - 1, ERB16}, F.lds, F.vcu, F.G, F.tid); }
            else wg_gemm_ksplit8(fn, TaskMap{NE * ERB16 * 64, 64, 0, 1}, F.lds, F.vcu, F.G, F.tid);
            } SEAM(pb + 11); }
        if (IN(pb + 12)) { REPEAT(REP_M2) { FnM2f8 fn{(const unsigned char*)F.HID, (const unsigned char*)F.WD + (size_t)layer * NE * 1024 * WDP8, F.Y};
            if (FAST_M2 && fast) { pg8::CfgM2 cfg; cfg.S.init(4, F.G, (int)blockIdx.x); cfg.HID = fn.HID; cfg.W = fn.W; cfg.Y = F.Y; pg8::gemm_phase(F.lds, cfg);
                wg_gemm_ksplit8(fn, TaskMap{16 * 16, 16, ERB16 - 1, ERB16}, F.lds, F.vcu, F.G, F.tid); }
            else wg_gemm_ksplit8(fn, TaskMap{NE * ERB16 * 16, 16, 0, 1}, F.lds, F.vcu, F.G, F.tid);
            } SEAM(pb + 12); }
    }
}
#undef IN
#undef SEAM

__global__ void __launch_bounds__(512, 2) mega(Args args) {
    extern __shared__ __attribute__((aligned(16))) unsigned char lds_raw[];
    Frame F;
    F.lds = (LAS unsigned char*)lds_raw;
    F.tid = threadIdx.x; F.lane = F.tid & 63; F.wave = __builtin_amdgcn_readfirstlane(F.tid >> 6);
    F.G = gridDim.x; { const int bx = blockIdx.x; F.vcu = (F.G % 8 == 0) ? (bx % 8) * (F.G / 8) + bx / 8 : bx; }
    F.x = args.in[0]; F.meta = args.in[1]; F.norm_mix = args.in[2]; F.norm_ffn = args.in[3]; F.norm_final = args.in[4]; F.pool_w = args.in[5]; F.pool_scale = args.in[6]; F.w_in = args.in[7]; F.conv_w = args.in[8];
    F.conv_b = args.in[9]; F.w_gates = args.in[10]; F.b_gates = args.in[11]; F.lam = args.in[12]; F.w_out = args.in[13]; F.router_w = args.in[14]; F.moe_g = args.in[15]; F.moe_u = args.in[16]; F.moe_d = args.in[17];
    F.out = args.out; F.ws = args.ws;
    unsigned char* ws = args.ws;
    F.WG1 = (bf16*)(ws + WS_WG1); F.WD = (bf16*)(ws + WS_WD); F.WIN = (bf16*)(ws + WS_WIN); F.WGT = (bf16*)(ws + WS_WGT); F.WOUT = (bf16*)(ws + WS_WOUT); F.WPOOL = (bf16*)(ws + WS_WPOOL);
    F.H = (bf16*)(ws + WS_H); F.U = (bf16*)(ws + WS_U); F.P = (bf16*)(ws + WS_P); F.XB = (bf16*)(ws + WS_XB); F.GY = (bf16*)(ws + WS_GY); F.HG = (bf16*)(ws + WS_HG); F.HF = (float*)(ws + WS_Y);
    F.LA = (bf16*)(ws + WS_BIG); F.BV = (bf16*)(ws + WS_BIG + 2 * LA_BYTES); F.HID = (bf16*)(ws + WS_BIG); F.Y = (bf16*)(ws + WS_Y);
    F.AFF = (float*)(ws + WS_AFF); F.SLOT = (int*)(ws + WS_SLOT); F.GMAP = (float*)(ws + WS_GMAP); F.ROWL = (int*)(ws + WS_ROWL); F.AGG = (float*)(ws + WS_AGG); F.SPT = (float*)(ws + WS_SPT); F.RSTD = (float*)(ws + WS_RSTD);
    volatile LAS unsigned* MISC = (volatile LAS unsigned*)(F.lds + MISC_OFF);
    if (F.tid < 32) MISC[F.tid] = 0u;
    __syncthreads();
    const int lo = args.lo, hi = args.hi;
    const bool multi = (hi - lo) > 1;
    XcdBarrier bar; bar.bar = (unsigned*)(ws + WS_CTL) + CW_BAR; bar.x = 0; bar.st = nullptr;
    if (multi) bar = xcd_barrier_post((unsigned*)(ws + WS_CTL) + CW_BAR, MISC + 8);
#define IN(k) (lo <= (k) && (k) < hi)
#define SEAM(k) do { if ((k) + 1 < hi) xcd_barrier(bar); } while (0)
    run_layer<0>(F, lo, hi, bar); run_layer<1>(F, lo, hi, bar); run_layer<2>(F, lo, hi, bar); run_layer<3>(F, lo, hi, bar);
    if (IN(64)) { if (REP_RA > 1) phase_rowA<true, false>(F, DEPTH); phase_rowA<true, false>(F, DEPTH); }
#undef IN
#undef SEAM
}

extern "C" void kernel_launch(void* const* d_in, const int* in_sizes, int n_in, void* d_out, int out_size, void* d_ws, size_t ws_size, hipStream_t stream) {
    static int grid = 0;
    if (grid == 0) {
        if (n_in != 18 || in_sizes[0] != NB * SEQ * D || out_size != NB * SEQ * D || ws_size < WS_END) {
            fprintf(stderr, "kernel_launch: unexpected shapes (n_in %d, in0 %d, out %d, ws %zu < %zu)\n", n_in, n_in > 0 ? in_sizes[0] : -1, out_size, ws_size, (size_t)WS_END); grid = -1; return; }
        int dev = 0, cus = 0;
        if (hipGetDevice(&dev) != hipSuccess || hipDeviceGetAttribute(&cus, hipDeviceAttributeMultiprocessorCount, dev) != hipSuccess) { grid = -1; return; }
        if (hipFuncSetAttribute((const void*)mega, hipFuncAttributeMaxDynamicSharedMemorySize, LDS_BYTES) != hipSuccess) { fprintf(stderr, "kernel_launch: hipFuncSetAttribute failed\n"); grid = -1; return; }
        int per_cu = 0;
        if (hipOccupancyMaxActiveBlocksPerMultiprocessor(&per_cu, (const void*)mega, 512, LDS_BYTES) != hipSuccess || per_cu < 1) fprintf(stderr, "kernel_launch: occupancy query reports %d\n", per_cu);
        (void)hipGetLastError();
        grid = cus;
    }
    if (grid < 0) return;
    if (hipMemsetAsync((char*)d_ws + WS_CTL, 0, CTL_ZERO_BYTES, stream) != hipSuccess) return;
    Args a{};
    for (int i = 0; i < 18; ++i) a.in[i] = (const float*)d_in[i];
    a.out = (float*)d_out; a.ws = (unsigned char*)d_ws;
#if SINGLE_LAUNCH
    a.lo = 0; a.hi = 65;
    hipLaunchKernelGGL(mega, dim3(grid), dim3(512), LDS_BYTES, stream, a);
#else
    for (int layer = 0; layer < DEPTH; ++layer) {
        static const int pool_ph[] = {0, 1, 2, 9, 10, 11, 12}, lru_ph[] = {0, 3, 4, 5, 6, 7, 8, 9, 10, 11, 12};
        const int* ph = (layer & 1) ? lru_ph : pool_ph; const int n = (layer & 1) ? 11 : 7;
        for (int q = 0; q < n; ++q) { a.lo = layer * 16 + ph[q]; a.hi = a.lo + 1; hipLaunchKernelGGL(mega, dim3(grid), dim3(512), LDS_BYTES, stream, a); }
    }
    a.lo = 64; a.hi = 65; hipLaunchKernelGGL(mega, dim3(grid), dim3(512), LDS_BYTES, stream, a);
#endif
}
```

```cpp
#include <hip/hip_runtime.h>
#include <cstdio>
#include <cstdint>

#ifndef SINGLE_LAUNCH
#define SINGLE_LAUNCH 1
#endif

constexpr int NB = 8, SEQ = 4096, NMETA = 16, T = SEQ + NMETA, D = 1024, NE = 16, CAP = 2 * T / NE, DF = 2048, DEPTH = 4;
constexpr int MMAIN = NB * SEQ;
constexpr int MROWS = NB * T;
constexpr int MPAD = 33024;
constexpr int EROWS = NB * CAP;
constexpr int EPAD = 4352;
constexpr int HIDP8 = 2112, WDP8 = 2112;
constexpr float WSCALE = 32.0f, WINV = 1.0f / 32.0f;
constexpr int NCHUNK = 33, CHL = 128;
static_assert(CAP == 514 && T == 4112 && EROWS == 4112, "shapes");
constexpr float RMS_EPS = 1e-6f;

constexpr size_t MiB = 1u << 20;
constexpr size_t WS_CTL = 0, CTL_ZERO_BYTES = 1 * MiB;
constexpr size_t WS_WG1 = 1 * MiB;
constexpr size_t WS_WD = WS_WG1 + 512 * MiB;
constexpr size_t WS_WIN = WS_WD + 264 * MiB;
constexpr size_t WS_WGT = WS_WIN + 8 * MiB;
constexpr size_t WS_WOUT = WS_WGT + 4 * MiB;
constexpr size_t WS_WPOOL = WS_WOUT + 4 * MiB;
constexpr size_t WS_H = WS_WPOOL + 1 * MiB;
constexpr size_t WS_U = WS_H + 129 * MiB;
constexpr size_t WS_P = WS_U + 65 * MiB;
constexpr size_t WS_XB = WS_P + 65 * MiB;
constexpr size_t WS_GY = WS_XB + 65 * MiB;
constexpr size_t WS_HG = WS_GY + 65 * MiB;
constexpr size_t WS_BIG = WS_HG + 65 * MiB;
constexpr size_t WS_Y = WS_BIG + 282 * MiB;
constexpr size_t WS_AFF = WS_Y + 136 * MiB;
constexpr size_t WS_SLOT = WS_AFF + 3 * MiB;
constexpr size_t WS_GMAP = WS_SLOT + 3 * MiB;
constexpr size_t WS_ROWL = WS_GMAP + 3 * MiB;
constexpr size_t WS_AGG = WS_ROWL + 1 * MiB;
constexpr size_t WS_SPT = WS_AGG + 9 * MiB / 2;
constexpr size_t WS_RSTD = WS_SPT + 64 * 1024;
constexpr size_t WS_END = WS_AGG + 5 * MiB;
constexpr size_t LA_BYTES = (size_t)MPAD * 1024 * 2;

constexpr int CW_BAR = 4096;

constexpr int RING_BYTES = 131072;
constexpr int MISC_OFF = RING_BYTES + 320;
constexpr int LDS_BYTES = 147456;

#define LAS __attribute__((address_space(3)))
typedef unsigned short bf16;
typedef short bf16x8 __attribute__((ext_vector_type(8)));
typedef float f32x4 __attribute__((ext_vector_type(4)));
typedef float f32x2 __attribute__((ext_vector_type(2)));
typedef unsigned u32x4 __attribute__((ext_vector_type(4)));
typedef unsigned u32x2 __attribute__((ext_vector_type(2)));

__device__ __forceinline__ unsigned cvt_pk_bf16(float lo, float hi) { unsigned r; asm volatile("v_cvt_pk_bf16_f32 %0, %1, %2" : "=v"(r) : "v"(lo), "v"(hi)); return r; }
__device__ __forceinline__ float bflo(unsigned w) { return __uint_as_float(w << 16); }
__device__ __forceinline__ float bfhi(unsigned w) { return __uint_as_float(w & 0xffff0000u); }
__device__ __forceinline__ float fast_exp(float x) { return __builtin_amdgcn_exp2f(x * 1.44269504089f); }
__device__ __forceinline__ float fast_rcp(float x) { return __builtin_amdgcn_rcpf(x); }
__device__ __forceinline__ float sigmoidf_(float x) { return fast_rcp(1.0f + fast_exp(-x)); }
__device__ __forceinline__ float siluf_(float x) { return x * sigmoidf_(x); }
typedef int v4i __attribute__((ext_vector_type(4)));
typedef int v8i __attribute__((ext_vector_type(8)));
__device__ __forceinline__ unsigned pk4_fp8(float a, float b, float c, float d) {
    a = __builtin_amdgcn_fmed3f(a, -448.f, 448.f); b = __builtin_amdgcn_fmed3f(b, -448.f, 448.f); c = __builtin_amdgcn_fmed3f(c, -448.f, 448.f); d = __builtin_amdgcn_fmed3f(d, -448.f, 448.f);
    unsigned r = 0; r = (unsigned)__builtin_amdgcn_cvt_pk_fp8_f32(a, b, (int)r, false); r = (unsigned)__builtin_amdgcn_cvt_pk_fp8_f32(c, d, (int)r, true); return r; }
__device__ __forceinline__ f32x4 fp8x4_to_f32(unsigned w) { const f32x2 lo = __builtin_amdgcn_cvt_pk_f32_fp8((int)w, false), hi = __builtin_amdgcn_cvt_pk_f32_fp8((int)w, true); return (f32x4){lo.x, lo.y, hi.x, hi.y}; }
__device__ __forceinline__ float silu_mul_s(float G, float U) { const float e = __builtin_amdgcn_exp2f(G * (-1.44269504089f * WINV)); return (G * U) * fast_rcp(__builtin_fmaf(e, 1024.0f, 1024.0f)); }
__device__ __forceinline__ unsigned pk4_u8(float a, float b, float c, float d) { return (unsigned)(a * 255.0f + 0.5f) | ((unsigned)(b * 255.0f + 0.5f) << 8) | ((unsigned)(c * 255.0f + 0.5f) << 16) | ((unsigned)(d * 255.0f + 0.5f) << 24); }
__device__ __forceinline__ f32x2 gelu_tanh2(f32x2 x) {
    const f32x2 t = (x * x) * 0.044715f + 1.0f, a = (x * t) * (-2.0f * 0.7978845608f * 1.44269504089f);
    f32x2 e; e.x = __builtin_amdgcn_exp2f(a.x); e.y = __builtin_amdgcn_exp2f(a.y);
    const f32x2 d = e + 1.0f; f32x2 r; r.x = fast_rcp(d.x); r.y = fast_rcp(d.y);
    return x * r; }
__device__ __forceinline__ unsigned silu_mul_fp8x4(const f32x4 G, const f32x4 U) {
    const f32x2 g0 = (f32x2){G.x, G.y}, g1 = (f32x2){G.z, G.w}, u0 = (f32x2){U.x, U.y}, u1 = (f32x2){U.z, U.w};
    const f32x2 t0 = g0 * (-1.44269504089f * WINV), t1 = g1 * (-1.44269504089f * WINV);
    f32x2 e0, e1; e0.x = __builtin_amdgcn_exp2f(t0.x); e0.y = __builtin_amdgcn_exp2f(t0.y); e1.x = __builtin_amdgcn_exp2f(t1.x); e1.y = __builtin_amdgcn_exp2f(t1.y);
    const f32x2 d0 = e0 * 1024.0f + 1024.0f, d1 = e1 * 1024.0f + 1024.0f;
    f32x2 r0, r1; r0.x = fast_rcp(d0.x); r0.y = fast_rcp(d0.y); r1.x = fast_rcp(d1.x); r1.y = fast_rcp(d1.y);
    const f32x2 o0 = (g0 * u0) * r0, o1 = (g1 * u1) * r1;
    return pk4_fp8(o0.x, o0.y, o1.x, o1.y);
}
__device__ __forceinline__ float gelu_tanh(float x) { const float z = 0.7978845608f * (x + 0.044715f * x * x * x); return x * sigmoidf_(2.0f * z); }
__device__ __forceinline__ float wave_sum(float v) {
#pragma unroll
    for (int o = 1; o < 64; o <<= 1) v += __shfl_xor(v, o);
    return v;
}
__device__ __forceinline__ int opaque(int v) { asm volatile("" : "+v"(v)); return v; }
__device__ __forceinline__ int row_of(int b, int t) { return t >= NMETA ? b * SEQ + (t - NMETA) : MMAIN + b * NMETA + t; }

#define XB_TMO      128
#define XB_XCNT(j)  (256  + 64 * (j))
#define XB_XSUB(j)  (1280 + 64 * (j))
#define XB_XGEN(j)  (2304 + 64 * (j))
#define XB_TOP      3328
#define XB_TOPGEN   3392
#define XCD_BAR_WORDS 3456
#define XB_SPIN_CAP (1u << 18)
__device__ __forceinline__ unsigned xb_ld(unsigned* p)              { return __hip_atomic_load(p, __ATOMIC_RELAXED, __HIP_MEMORY_SCOPE_AGENT); }
__device__ __forceinline__ unsigned xb_add(unsigned* p, unsigned v) { return __hip_atomic_fetch_add(p, v, __ATOMIC_RELAXED, __HIP_MEMORY_SCOPE_AGENT); }
__device__ __forceinline__ unsigned xb_xcc_id() { return (unsigned)__builtin_amdgcn_s_getreg((3 << 11) | 20) & 0xFu; }
#define XB_SPIN(cond, bar) do { unsigned _sp = 0; while (cond) { __builtin_amdgcn_s_sleep(1); \
    if ((++_sp & 255u) == 0u) { if (xb_ld(&(bar)[XB_TMO])) break; if (_sp > XB_SPIN_CAP) { atomicAdd(&(bar)[XB_TMO], 1u); break; } } } } while (0)
struct XcdBarrier { unsigned* bar; unsigned x; volatile LAS unsigned* st; };
__device__ __forceinline__ XcdBarrier xcd_barrier_post(unsigned* bar, volatile LAS unsigned* st) {
    XcdBarrier b; b.bar = bar; b.x = xb_xcc_id(); b.st = st;
    if (threadIdx.x == 0) (void)xb_add(&bar[XB_XCNT(b.x)], 1u);
    return b;
}
__device__ __forceinline__ void xcd_barrier_complete(unsigned* bar, unsigned x, unsigned& nloc, unsigned& nx) {
    const unsigned G = gridDim.x * gridDim.y * gridDim.z;
    unsigned sum, cnt, mine, sp = 0u;
    for (;;) {
        sum = 0u; cnt = 0u; mine = 0u;
#pragma unroll
        for (unsigned j = 0; j < 16; ++j) { const unsigned c = xb_ld(&bar[XB_XCNT(j)]); sum += c; cnt += (c > 0u) ? 1u : 0u; mine = (j == x) ? c : mine; }
        if (sum == G) break;
        __builtin_amdgcn_s_sleep(1);
        if ((++sp & 255u) == 0u) { if (xb_ld(&bar[XB_TMO])) break; if (sp > XB_SPIN_CAP) { atomicAdd(&bar[XB_TMO], 1u); break; } }
    }
    nloc = mine > 0u ? mine : 1u; nx = cnt > 0u ? cnt : 1u;
}
__device__ __forceinline__ void xcd_barrier(const XcdBarrier& b) {
    asm volatile("s_waitcnt vmcnt(0)" ::: "memory");
    __syncthreads();
    if (threadIdx.x == 0) {
        unsigned* bar = b.bar;
        __builtin_amdgcn_s_waitcnt(0);
        unsigned nloc = b.st[0], nx = b.st[1];
        if (nloc == 0u) { xcd_barrier_complete(bar, b.x, nloc, nx); b.st[0] = nloc; b.st[1] = nx; }
        const unsigned old = xb_add(&bar[XB_XSUB(b.x)], 1u);
        const unsigned gen = old / nloc;
        if (old + 1u == (gen + 1u) * nloc) {
            __builtin_amdgcn_fence(__ATOMIC_RELEASE, "agent");
            asm volatile("s_waitcnt vmcnt(0)" ::: "memory");
            const unsigned og = xb_add(&bar[XB_TOP], 1u);
            const unsigned tg = og / nx;
            if (og + 1u == (tg + 1u) * nx) xb_add(&bar[XB_TOPGEN], 1u);
            else XB_SPIN(xb_ld(&bar[XB_TOPGEN]) == tg, bar);
            __builtin_amdgcn_fence(__ATOMIC_ACQUIRE, "agent");
            xb_add(&bar[XB_XGEN(b.x)], 1u);
            asm volatile("s_waitcnt vmcnt(0)" ::: "memory");
        } else {
            XB_SPIN(xb_ld(&bar[XB_XGEN(b.x)]) == gen, bar);
            __builtin_amdgcn_fence(__ATOMIC_ACQUIRE, "agent");
            asm volatile("s_waitcnt vmcnt(0)" ::: "memory");
        }
    }
    __syncthreads();
}

struct Args { const float* in[18]; float* out; unsigned char* ws; int lo, hi; };
struct Frame {
    LAS unsigned char* lds;
    int tid, lane, wave, vcu, G;
    const float *x, *meta, *norm_mix, *norm_ffn, *norm_final, *pool_w, *pool_scale, *w_in, *conv_w, *conv_b, *w_gates, *b_gates, *lam, *w_out, *router_w, *moe_g, *moe_u, *moe_d;
    float* out; unsigned char* ws;
    bf16 *WG1, *WD, *WIN, *WGT, *WOUT, *WPOOL;
    bf16* H; float* HF; bf16 *U, *P, *XB, *GY, *HG, *LA, *BV, *HID, *Y;
    float* AFF; int* SLOT; float* GMAP; int* ROWL; float* AGG; float* SPT; float* RSTD;
};

struct ProItem { const float* src; unsigned char* dst; const float* ks; int ldw, ldt, f8; };
__device__ __forceinline__ ProItem pro_decode(const Frame& F, int it) {
    constexpr int I_MOE = 64 * 512, I_IN = 2 * 512, I_OUT = 2 * 256, I_GT = 32 * 16;
    ProItem p; p.ks = nullptr; int r = it;
    if (r < 2 * I_MOE) {
        const int up = r >= I_MOE; if (up) r -= I_MOE;
        const int le = r >> 9, q = r & 511, k0 = (q >> 6) * 128, n0 = (q & 63) * 32;
        p.src = (up ? F.moe_u : F.moe_g) + (size_t)le * 1024 * 2048 + (size_t)k0 * 2048 + n0; p.ldw = 2048;
        p.dst = (unsigned char*)F.WG1 + ((size_t)le * 4096 + (n0 >> 7) * 256 + up * 128 + (n0 & 127)) * 1024 + k0; p.ldt = 1024; p.f8 = 1; return p; }
    r -= 2 * I_MOE;
    if (r < I_MOE) {
        const int le = r >> 9, q = r & 511, k0 = (q >> 5) * 128, n0 = (q & 31) * 32;
        p.src = F.moe_d + (size_t)le * 2048 * 1024 + (size_t)k0 * 1024 + n0; p.ldw = 1024;
        p.dst = (unsigned char*)F.WD + ((size_t)le * 1024 + n0) * WDP8 + k0; p.ldt = WDP8; p.f8 = 1; return p; }
    r -= I_MOE; p.f8 = 0;
    if (r < I_IN) {
        const int j = r >> 9, q = r & 511, k0 = (q >> 6) * 128, n0 = (q & 63) * 32;
        p.src = F.w_in + (size_t)j * 1024 * 2048 + (size_t)k0 * 2048 + n0; p.ldw = 2048; p.dst = (unsigned char*)(F.WIN + ((size_t)j * 2048 + n0) * 1024 + k0); p.ldt = 2048; p.ks = F.norm_mix + (size_t)(2 * j + 1) * D + k0; return p; }
    r -= I_IN;
    if (r < I_OUT) {
        const int j = r >> 8, q = r & 255, k0 = (q >> 5) * 128, n0 = (q & 31) * 32;
        p.src = F.w_out + (size_t)j * 1024 * 1024 + (size_t)k0 * 1024 + n0; p.ldw = 1024; p.dst = (unsigned char*)(F.WOUT + ((size_t)j * 1024 + n0) * 1024 + k0); p.ldt = 2048; return p; }
    r -= I_OUT;
    if (r < 8 * 16) {
        const int mat = r >> 4, q = r & 15, k0 = (q >> 3) * 128, n0 = (q & 7) * 32;
        p.src = F.pool_w + (size_t)mat * 65536 + (size_t)k0 * 256 + n0; p.ldw = 256; p.dst = (unsigned char*)(F.WPOOL + ((size_t)mat * 256 + n0) * 256 + k0); p.ldt = 512; return p; }
    r -= 8 * 16;
    {
        const int mat = r >> 4, q = r & 15, k0 = (q >> 3) * 128, n0 = (q & 7) * 32;
        const int j = mat >> 4, d = (mat >> 3) & 1, g = (mat >> 2) & 1, h = mat & 3, nt = d * 8 + h * 2 + (n0 >> 7);
        p.src = F.w_gates + (size_t)mat * 65536 + (size_t)k0 * 256 + n0; p.ldw = 256; p.dst = (unsigned char*)(F.WGT + (((size_t)j * 16 + nt) * 256 + g * 128 + (n0 & 127)) * 256 + k0); p.ldt = 512; return p; }
}
__device__ __forceinline__ void pro_load(const ProItem& p, f32x4 (&v)[16], int lane) {
    const int rr = lane >> 3, sg = lane & 7;
#pragma unroll
    for (int i = 0; i < 16; ++i) v[i] = __builtin_nontemporal_load((const f32x4*)(p.src + (size_t)(8 * i + rr) * p.ldw + 4 * sg));
}
__device__ __forceinline__ void pro_finish(const ProItem& p, const f32x4 (&v)[16], LAS float* scr, int lane) {
    { const int rr = lane >> 3, sg = lane & 7;
#pragma unroll
        for (int i = 0; i < 16; ++i) *(LAS f32x4*)(scr + (8 * i + rr) * 32 + ((4 * sg) ^ (((i >> 1) & 3) << 3))) = v[i]; }
    asm volatile("s_waitcnt lgkmcnt(0)" ::: "memory");
    const int c = lane & 7;
#pragma unroll
    for (int j = 0; j < 4; ++j) { const int n = (lane >> 3) + 8 * j; const LAS float* s = scr + (16 * c) * 32 + (n ^ ((c & 3) << 3));
        float t[16];
#pragma unroll
        for (int q = 0; q < 16; ++q) t[q] = s[q * 32];
        if (p.f8) { u32x4 o; o.x = pk4_fp8(t[0] * WSCALE, t[1] * WSCALE, t[2] * WSCALE, t[3] * WSCALE); o.y = pk4_fp8(t[4] * WSCALE, t[5] * WSCALE, t[6] * WSCALE, t[7] * WSCALE);
            o.z = pk4_fp8(t[8] * WSCALE, t[9] * WSCALE, t[10] * WSCALE, t[11] * WSCALE); o.w = pk4_fp8(t[12] * WSCALE, t[13] * WSCALE, t[14] * WSCALE, t[15] * WSCALE);
            __builtin_nontemporal_store(o, (u32x4*)(p.dst + (size_t)n * p.ldt + 16 * c)); }
        else { if (p.ks) { const float* ks = p.ks + 16 * c;
#pragma unroll
                for (int q4 = 0; q4 < 4; ++q4) { const f32x4 g4 = *(const f32x4*)(ks + 4 * q4); t[4 * q4] *= g4.x; t[4 * q4 + 1] *= g4.y; t[4 * q4 + 2] *= g4.z; t[4 * q4 + 3] *= g4.w; } }
            u32x4 o0, o1; o0.x = cvt_pk_bf16(t[0], t[1]); o0.y = cvt_pk_bf16(t[2], t[3]); o0.z = cvt_pk_bf16(t[4], t[5]); o0.w = cvt_pk_bf16(t[6], t[7]);
            o1.x = cvt_pk_bf16(t[8], t[9]); o1.y = cvt_pk_bf16(t[10], t[11]); o1.z = cvt_pk_bf16(t[12], t[13]); o1.w = cvt_pk_bf16(t[14], t[15]);
            unsigned char* d = p.dst + (size_t)n * p.ldt + 32 * c; __builtin_nontemporal_store(o0, (u32x4*)d); __builtin_nontemporal_store(o1, (u32x4*)(d + 16)); } }
    asm volatile("s_waitcnt lgkmcnt(0)" ::: "memory");
}
constexpr int PRO_NITEMS = 3 * 64 * 512 + 2 * 512 + 2 * 256 + 32 * 16 + 8 * 16;
__device__ __forceinline__ bool pro_deferred(int it) { const int r = it - 2 * 64 * 512; return r >= 0 && r < 64 * 512 && ((r >> 9) & 15) >= 12; }
template <bool SKIP>
__device__ __forceinline__ void pro_items(const Frame& F, int it, const int stride, const int end) {
    LAS float* scr = (LAS float*)(F.lds + F.wave * 16384);
    const int lane = F.lane;
    if (it >= end) return;
    ProItem cur = pro_decode(F, it); f32x4 v[16], w[16]; pro_load(cur, v, lane);
    for (;;) {
        int nit = it + stride;
        if (SKIP) { while (nit < end && pro_deferred(nit)) nit += stride; }
        const bool more = nit < end; ProItem nxt = cur;
        if (more) nxt = pro_decode(F, nit);
        pro_load(nxt, w, lane);
        pro_finish(cur, v, scr, lane);
        if (!more) break;
        cur = nxt; it = nit;
#pragma unroll
        for (int i = 0; i < 16; ++i) v[i] = w[i];
    }
}
__device__ __forceinline__ void phase_prologue(const Frame& F) {
    const int gw = F.vcu * 8 + F.wave, NGW = F.G * 8, lane = F.lane;
    for (int i = gw * 64 + lane; i < 4 * D; i += NGW * 64) F.SPT[i] = -8.0f * log1pf(expf(-F.lam[i]));
    if (F.G == 256) pro_items<true>(F, gw, NGW, PRO_NITEMS - 128); else pro_items<false>(F, gw, NGW, PRO_NITEMS);
}
__device__ __forceinline__ void pro_tail128(const Frame& F) {
    if (F.G != 256 || F.vcu < 64 || F.vcu >= 80) return;
    const int it = PRO_NITEMS - 128 + (F.vcu - 64) * 8 + F.wave;
    pro_items<false>(F, it, 1 << 20, it + 1);
}
__device__ __forceinline__ void phase_prologue_deferred(const Frame& F, int layer) {
    if (F.G != 256 || (int)blockIdx.x < 128) return;
    const int base = 2 * 64 * 512 + (layer * 16 + 12) * 512;
    pro_items<false>(F, base + ((int)blockIdx.x - 128) * 8 + F.wave, 1024, base + 2048);
}

template <bool FINAL, bool FIRST, bool DRY = false>
__device__ __forceinline__ void phase_rowA(const Frame& F, int layer) {
    const int gw = F.vcu * 8 + F.wave, NGW = F.G * 8, lane = F.lane;
    const float* gain = FINAL ? F.norm_final : F.norm_mix + layer * D;
    f32x4 gn[4];
#pragma unroll
    for (int j = 0; j < 4; ++j) gn[j] = *(const f32x4*)(gain + 4 * lane + 256 * j);
    const int rend = FINAL ? MMAIN : MROWS;
    int sl_n = -1; float gg_n = 0.f;
    if (!FIRST) { if (lane < 16 && gw < rend) { sl_n = F.SLOT[(size_t)gw * 16 + lane]; gg_n = F.GMAP[(size_t)gw * 16 + lane]; } }
    for (int r = gw; r < rend; r += NGW) {
        f32x4 v[4];
        if (FIRST) {
            const float* src = r < MMAIN ? F.x + (size_t)r * D : F.meta + (size_t)((r - MMAIN) & 15) * D;
#pragma unroll
            for (int j = 0; j < 4; ++j) v[j] = *(const f32x4*)(src + 4 * lane + 256 * j);
        } else {
            const int sl = sl_n; const float gg = gg_n;
            const bf16* src = F.H + (size_t)r * D;
#pragma unroll
            for (int j = 0; j < 4; ++j) { const u32x2 w = *(const u32x2*)(src + 4 * lane + 256 * j); v[j] = (f32x4){bflo(w.x), bfhi(w.x), bflo(w.y), bfhi(w.y)}; }
            { const int rn = r + NGW; sl_n = -1; if (lane < 16 && rn < rend) { sl_n = F.SLOT[(size_t)rn * 16 + lane]; gg_n = F.GMAP[(size_t)rn * 16 + lane]; } }
            unsigned mask = (unsigned)__ballot(sl >= 0) & 0xffffu;
            while (mask) {
                int ee[4]; float gq[4]; const unsigned char* yr[4];
#pragma unroll
                for (int q = 0; q < 4; ++q) { const bool on = mask != 0u; const int e = on ? (__builtin_ffs((int)mask) - 1) : 0; mask &= mask - 1u;
                    const int s = __builtin_amdgcn_readlane(sl, e); const float g = __uint_as_float(__builtin_amdgcn_readlane(__float_as_uint(gg), e));
                    ee[q] = e; gq[q] = on ? g : 0.f; yr[q] = (const unsigned char*)F.Y + ((size_t)e * EPAD + (on ? s : 0)) * D; }
                unsigned w[4][4];
#pragma unroll
                for (int q = 0; q < 4; ++q)
#pragma unroll
                    for (int j = 0; j < 4; ++j) w[q][j] = *(const unsigned*)(yr[q] + 4 * lane + 256 * j);
#pragma unroll
                for (int q = 0; q < 4; ++q)
#pragma unroll
                    for (int j = 0; j < 4; ++j) v[j] += fp8x4_to_f32(w[q][j]) * gq[q];
                (void)ee;
            }
        }
        if (!FINAL && !DRY) {
            bf16* dst = F.H + (size_t)r * D;
#pragma unroll
            for (int j = 0; j < 4; ++j) { u32x2 w; w.x = cvt_pk_bf16(v[j].x, v[j].y); w.y = cvt_pk_bf16(v[j].z, v[j].w); *(u32x2*)(dst + 4 * lane + 256 * j) = w; }
        }
        float ss = 0.f;
#pragma unroll
        for (int j = 0; j < 4; ++j) ss += (v[j].x * v[j].x + v[j].y * v[j].y) + (v[j].z * v[j].z + v[j].w * v[j].w);
        const float rstd = 1.0f / sqrtf(wave_sum(ss) * (1.0f / D) + RMS_EPS);
        if (FINAL) {
            float* dst = F.out + (size_t)r * D;
#pragma unroll
            for (int j = 0; j < 4; ++j) *(f32x4*)(dst + 4 * lane + 256 * j) = v[j] * rstd * gn[j];
        } else {
            if (lane == 0) F.RSTD[r] = rstd;
        }
    }
}
constexpr int RB_PITCH = 2064;
__device__ __forceinline__ unsigned short bf16_rne(float x) { return (unsigned short)(cvt_pk_bf16(x, 0.f) & 0xffffu); }
__device__ __forceinline__ void phase_rowB(const Frame& F, int layer) {
    const int gw = F.vcu * 8 + F.wave, NGW = F.G * 8, lane = F.lane, fr = lane & 15, fq = lane >> 4;
    LAS unsigned char* wl = F.lds;
    LAS float* gl = (LAS float*)(F.lds + 3 * 16 * RB_PITCH);
    const float* rw = F.router_w + (size_t)layer * D * NE;
    const float* gain = F.norm_ffn + layer * D;
    {   f32x4 rv[8]; float gk[8];
#pragma unroll
        for (int i = 0; i < 8; ++i) { const int i4 = F.tid + 512 * i; rv[i] = *(const f32x4*)(rw + 4 * i4); gk[i] = gain[i4 >> 2]; }
#pragma unroll
        for (int i = 0; i < 8; ++i) { const int i4 = F.tid + 512 * i, k = i4 >> 2, e0 = (i4 & 3) * 4;
#pragma unroll
            for (int x = 0; x < 4; ++x) { const float w = rv[i][x] * gk[i];
                const unsigned short hi = bf16_rne(w); const float r1 = w - __uint_as_float((unsigned)hi << 16);
                const unsigned short mid = bf16_rne(r1); const float r2 = r1 - __uint_as_float((unsigned)mid << 16);
                const unsigned short lo = bf16_rne(r2);
                LAS unsigned char* p = wl + (e0 + x) * RB_PITCH + 2 * k;
                *(LAS unsigned short*)p = hi; *(LAS unsigned short*)(p + 16 * RB_PITCH) = mid; *(LAS unsigned short*)(p + 32 * RB_PITCH) = lo; } }
        for (int k = F.tid; k < D; k += 512) gl[k] = gain[k];
    }
    __syncthreads();
    constexpr int NBLK = MROWS / 16;
    for (int blk = gw; blk < NBLK; blk += NGW) {
        const int row = blk * 16 + fr;
        const bf16* src = F.H + (size_t)row * D + 16 * fq;
        u32x4 hv[32];
#pragma unroll
        for (int kk = 0; kk < 32; ++kk) hv[kk] = *(const u32x4*)(src + 64 * (kk >> 1) + 8 * (kk & 1));
        f32x4 acc3[3], acch; acc3[0] = (f32x4){0.f, 0.f, 0.f, 0.f}; acc3[1] = acc3[0]; acc3[2] = acc3[0]; acch = acc3[0];
        const int woff = opaque(fr * RB_PITCH + 32 * fq);
#pragma unroll
        for (int k2 = 0; k2 < 32; k2 += 2) {
            bf16x8 wv[2][3];
#pragma unroll
            for (int u = 0; u < 2; ++u)
#pragma unroll
                for (int p = 0; p < 3; ++p) wv[u][p] = *(const LAS bf16x8*)(wl + woff + p * 16 * RB_PITCH + 64 * k2 + 16 * u);
#pragma unroll
            for (int u = 0; u < 2; ++u) { const bf16x8 a = __builtin_bit_cast(bf16x8, hv[k2 + u]);
#pragma unroll
                for (int p = 0; p < 3; ++p) acc3[p] = __builtin_amdgcn_mfma_f32_16x16x32_bf16(wv[u][p], a, acc3[p], 0, 0, 0);
                acch = __builtin_amdgcn_mfma_f32_16x16x32_bf16(a, a, acch, 0, 0, 0); }
            asm volatile("" ::: "memory");
        }
        const f32x4 acc = (acc3[2] + acc3[1]) + acc3[0];
        const int jd = fr & 3; const float dg = jd == 0 ? acch.x : jd == 1 ? acch.y : jd == 2 ? acch.z : acch.w;
        const float ss = __shfl(dg, fr + 16 * (fr >> 2));
        const float rstd = 1.0f / sqrtf(ss * (1.0f / D) + RMS_EPS);
        unsigned char* dst = (unsigned char*)F.U + (size_t)row * D + 16 * fq;
        const int goff = opaque(16 * fq);
#pragma unroll
        for (int k2 = 0; k2 < 32; k2 += 2) {
            u32x4 o;
#pragma unroll
            for (int u = 0; u < 2; ++u) {
                const u32x4 h4 = hv[k2 + u]; const f32x4 g0 = *(const LAS f32x4*)(gl + goff + 32 * k2 + 8 * u), g1 = *(const LAS f32x4*)(gl + goff + 32 * k2 + 8 * u + 4);
                const unsigned lo = pk4_fp8(bflo(h4.x) * rstd * g0.x, bfhi(h4.x) * rstd * g0.y, bflo(h4.y) * rstd * g0.z, bfhi(h4.y) * rstd * g0.w);
                const unsigned hi = pk4_fp8(bflo(h4.z) * rstd * g1.x, bfhi(h4.z) * rstd * g1.y, bflo(h4.w) * rstd * g1.z, bfhi(h4.w) * rstd * g1.w);
                if (u == 0) { o.x = lo; o.y = hi; } else { o.z = lo; o.w = hi; }
            }
            *(u32x4*)(dst + 32 * k2) = o;
            asm volatile("" ::: "memory");
        }
        const f32x4 lg = acc * rstd;
        float mx = fmaxf(fmaxf(lg.x, lg.y), fmaxf(lg.z, lg.w)); mx = fmaxf(mx, __shfl_xor(mx, 16)); mx = fmaxf(mx, __shfl_xor(mx, 32));
        const f32x4 p = (f32x4){expf(lg.x - mx), expf(lg.y - mx), expf(lg.z - mx), expf(lg.w - mx)};
        float sum = (p.x + p.y) + (p.z + p.w); sum += __shfl_xor(sum, 16); sum += __shfl_xor(sum, 32);
        int b, t; if (row < MMAIN) { b = row >> 12; t = (row & 4095) + NMETA; } else { b = (row - MMAIN) >> 4; t = (row - MMAIN) & 15; }
        float* ap = F.AFF + ((size_t)b * NE + 4 * fq) * T + t;
        ap[0] = p.x / sum; ap[T] = p.y / sum; ap[2 * T] = p.z / sum; ap[3 * T] = p.w / sum;
    }
    __syncthreads();
}

__device__ __forceinline__ int block_excl_scan(int v, LAS int* wsum, int tid, int lane, int wave, int& total) {
    int s = v;
#pragma unroll
    for (int o = 1; o < 64; o <<= 1) { const int t = __shfl_up(s, o); if (lane >= o) s += t; }
    __syncthreads();
    if (lane == 63) wsum[wave] = s;
    __syncthreads();
    int base = 0, tot = 0;
#pragma unroll
    for (int w = 0; w < 8; ++w) { const int x = wsum[w]; if (w < wave) base += x; tot += x; }
    total = tot;
    return base + s - v;
}
__device__ __forceinline__ void phase_topk(const Frame& F) {
    LAS unsigned* keys = (LAS unsigned*)F.lds;
    LAS int* hist = (LAS int*)(F.lds + 20480);
    LAS int* misc = (LAS int*)(F.lds + 20480 + 1024);
    const int tid = F.tid, lane = F.lane, wave = F.wave;
    for (int task = blockIdx.x; task < NB * NE; task += F.G) {
        const int b = task >> 4, e = task & 15;
        const float* aff = F.AFF + ((size_t)b * NE + e) * T;
        __syncthreads();
        {   unsigned kv[9];
#pragma unroll
            for (int i = 0; i < 9; ++i) { const int t = tid + 512 * i; kv[i] = __float_as_uint(aff[t < T ? t : T - 1]); }
#pragma unroll
            for (int i = 0; i < 9; ++i) { const int t = tid + 512 * i; if (t < T) keys[t] = kv[i]; } }
        unsigned prefix = 0u, pmask = 0u; int need = CAP;
        for (int p = 3; p >= 0; --p) {
            if (tid < 256) hist[tid] = 0;
            __syncthreads();
            for (int t = tid; t < T; t += 512) { const unsigned k = keys[t]; if ((k & pmask) == prefix) __hip_atomic_fetch_add(&hist[(k >> (8 * p)) & 255u], 1, __ATOMIC_RELAXED, __HIP_MEMORY_SCOPE_WORKGROUP); }
            __syncthreads();
            if (wave == 0) {
                int c[4]; int tot = 0;
#pragma unroll
                for (int q = 0; q < 4; ++q) { c[q] = hist[4 * lane + q]; tot += c[q]; }
                int s = tot;
#pragma unroll
                for (int o = 1; o < 64; o <<= 1) { const int x = __shfl_down(s, o); if (lane + o < 64) s += x; }
                int above = s - tot;
                if (above < need && need <= s) {
                    int a = above;
#pragma unroll
                    for (int q = 3; q >= 0; --q) { if (need <= a + c[q] && need > a) { misc[0] = 4 * lane + q; misc[1] = need - a; } a += c[q]; }
                }
            }
            __syncthreads();
            prefix |= (unsigned)misc[0] << (8 * p); pmask |= 0xFFu << (8 * p); need = misc[1];
            __syncthreads();
        }
        const unsigned vstar = prefix;
        const int t0 = tid * 9, t1 = (t0 + 9 < T) ? t0 + 9 : T;
        int neq = 0;
        for (int t = t0; t < t1; ++t) neq += (keys[t] == vstar) ? 1 : 0;
        int toteq; int eqbase = block_excl_scan(neq, misc + 8, tid, lane, wave, toteq);
        int nsel = 0; unsigned selmask = 0u; { int er = eqbase;
            for (int t = t0; t < t1; ++t) { const unsigned k = keys[t]; bool s = k > vstar; if (k == vstar) { s = er < need; ++er; } if (s) { selmask |= 1u << (t - t0); ++nsel; } } }
        int totsel; int sbase = block_excl_scan(nsel, misc + 8, tid, lane, wave, totsel);
        for (int t = t0; t < t1; ++t) {
            const int row = row_of(b, t);
            if ((selmask >> (t - t0)) & 1u) { const int pos = b * CAP + sbase; ++sbase;
                F.ROWL[e * EPAD + pos] = row; F.SLOT[(size_t)row * 16 + e] = pos; F.GMAP[(size_t)row * 16 + e] = __uint_as_float(keys[t]); }
            else F.SLOT[(size_t)row * 16 + e] = -1;
        }
        if (b == 0 && tid < EPAD - EROWS) F.ROWL[e * EPAD + EROWS + tid] = 0;
    }
    __syncthreads();
}

__device__ __forceinline__ void phase_poolwin(const Frame& F, int layer) {
    const int gw = F.vcu * 8 + F.wave, NGW = F.G * 8, lane = F.lane;
    constexpr int CHS = 33, NTC = (T + CHS - 1) / CHS;
    for (int it = gw; it < NB * NTC * 2; it += NGW) {
        const int half = it & 1, tc = (it >> 1) % NTC, b = (it >> 1) / NTC;
        const int col = half * 512 + lane * 8, g = col >> 8, hw = 1 << g;
        const int t0 = tc * CHS, t1 = (t0 + CHS < T) ? t0 + CHS : T;
        float sum[8];
#pragma unroll
        for (int q = 0; q < 8; ++q) sum[q] = 0.f;
        const u32x4 zero4 = (u32x4){0u, 0u, 0u, 0u};
        const bf16* ucol = F.H + col;
        float gnv[8];
        { const float* gp = F.norm_mix + (size_t)layer * D + col; const f32x4 g0 = *(const f32x4*)gp, g1 = *(const f32x4*)(gp + 4); gnv[0] = g0.x; gnv[1] = g0.y; gnv[2] = g0.z; gnv[3] = g0.w; gnv[4] = g1.x; gnv[5] = g1.y; gnv[6] = g1.z; gnv[7] = g1.w; }
#define PW_FMA(V_, S_) do { sum[0] += bflo(V_.x) * (S_); sum[1] += bfhi(V_.x) * (S_); sum[2] += bflo(V_.y) * (S_); sum[3] += bfhi(V_.y) * (S_); sum[4] += bflo(V_.z) * (S_); sum[5] += bfhi(V_.z) * (S_); sum[6] += bflo(V_.w) * (S_); sum[7] += bfhi(V_.w) * (S_); } while (0)
        {
            u32x4 iw[16]; float ir[16];
#pragma unroll
            for (int q = 0; q < 16; ++q) { const int dt = q - 8, tt = t0 + dt; const bool v = dt >= -hw && dt < hw && tt >= 0 && tt < T; const int row = row_of(b, v ? tt : t0); iw[q] = *(const u32x4*)(ucol + (size_t)row * D); ir[q] = F.RSTD[row]; }
#pragma unroll
            for (int q = 0; q < 16; ++q) { const int dt = q - 8, tt = t0 + dt; const bool v = dt >= -hw && dt < hw && tt >= 0 && tt < T; const float sc = v ? ir[q] : 0.f; PW_FMA(iw[q], sc); }
        }
        for (int tb = t0; tb < t1; tb += 11) {
            u32x4 c[11], wp[11], wm[11]; float rc[11], rp[11], rm[11];
#pragma unroll
            for (int q = 0; q < 11; ++q) { const int t = (tb + q < t1) ? tb + q : t1 - 1; const bool vp = t + hw < T, vm = t - hw >= 0;
                const int r0_ = row_of(b, t), r1_ = row_of(b, vp ? t + hw : t), r2_ = row_of(b, vm ? t - hw : t);
                c[q] = *(const u32x4*)(ucol + (size_t)r0_ * D); wp[q] = *(const u32x4*)(ucol + (size_t)r1_ * D); wm[q] = *(const u32x4*)(ucol + (size_t)r2_ * D);
                rc[q] = F.RSTD[r0_]; rp[q] = F.RSTD[r1_]; rm[q] = F.RSTD[r2_]; }
#pragma unroll
            for (int q = 0; q < 11; ++q) { const int t = tb + q;
                if (t < t1) {
                    const int lo = (t - hw > 0) ? t - hw : 0, hi = (t + hw < T) ? t + hw : T;
                    const float inv = 1.0f / (float)(hi - lo), cs = rc[q];
                    u32x4 o;
                    o.x = cvt_pk_bf16((sum[0] * inv - bflo(c[q].x) * cs) * gnv[0], (sum[1] * inv - bfhi(c[q].x) * cs) * gnv[1]); o.y = cvt_pk_bf16((sum[2] * inv - bflo(c[q].y) * cs) * gnv[2], (sum[3] * inv - bfhi(c[q].y) * cs) * gnv[3]);
                    o.z = cvt_pk_bf16((sum[4] * inv - bflo(c[q].z) * cs) * gnv[4], (sum[5] * inv - bfhi(c[q].z) * cs) * gnv[5]); o.w = cvt_pk_bf16((sum[6] * inv - bflo(c[q].w) * cs) * gnv[6], (sum[7] * inv - bfhi(c[q].w) * cs) * gnv[7]);
                    *(u32x4*)(F.P + (size_t)row_of(b, t) * D + col) = o;
                    const float sa = (t + hw < T) ? rp[q] : 0.f, sm = (t - hw >= 0) ? -rm[q] : 0.f;
                    PW_FMA(wp[q], sa); PW_FMA(wm[q], sm);
                }
            }
        }
#undef PW_FMA
    }
}
__device__ __forceinline__ void phase_conv(const Frame& F, int j) {
    const int gw = F.vcu * 8 + F.wave, NGW = F.G * 8, lane = F.lane;
    constexpr int CHS = 33, NTC = (T + CHS - 1) / CHS;
    const float* cw = F.conv_w + (size_t)j * 4 * D; const float* cb = F.conv_b + (size_t)j * D;
    for (int it = gw; it < NB * NTC * 2; it += NGW) {
        const int half = it & 1, tc = (it >> 1) % NTC, b = (it >> 1) / NTC;
        const int col = half * 512 + lane * 8;
        const int t0 = tc * CHS, t1 = (t0 + CHS < T) ? t0 + CHS : T;
        float w[4][8], bias[8];
#pragma unroll
        for (int k = 0; k < 4; ++k) { const f32x4 a = *(const f32x4*)(cw + k * D + col), c = *(const f32x4*)(cw + k * D + col + 4);
            w[k][0] = a.x; w[k][1] = a.y; w[k][2] = a.z; w[k][3] = a.w; w[k][4] = c.x; w[k][5] = c.y; w[k][6] = c.z; w[k][7] = c.w; }
        { const f32x4 a = *(const f32x4*)(cb + col), c = *(const f32x4*)(cb + col + 4); bias[0] = a.x; bias[1] = a.y; bias[2] = a.z; bias[3] = a.w; bias[4] = c.x; bias[5] = c.y; bias[6] = c.z; bias[7] = c.w; }
        u32x4 xm1 = (u32x4){0u, 0u, 0u, 0u}, x0 = xm1, xp1 = xm1, xp2 = xm1;
        if (t0 - 1 >= 0) xm1 = *(const u32x4*)(F.XB + (size_t)row_of(b, t0 - 1) * D + col);
        x0 = *(const u32x4*)(F.XB + (size_t)row_of(b, t0) * D + col);
        if (t0 + 1 < T) xp1 = *(const u32x4*)(F.XB + (size_t)row_of(b, t0 + 1) * D + col);
        for (int tb = t0; tb < t1; tb += 11) {
            u32x4 xn[11];
#pragma unroll
            for (int q = 0; q < 11; ++q) { const int tt = tb + q + 2; xn[q] = *(const u32x4*)(F.XB + (size_t)row_of(b, tt < T ? tt : T - 1) * D + col); }
#pragma unroll
            for (int q = 0; q < 11; ++q) { const int t = tb + q;
                if (t < t1) {
                    xp2 = (t + 2 < T) ? xn[q] : (u32x4){0u, 0u, 0u, 0u};
                    float o[8];
#define CONV2(q_, m) o[2 * q_] = bias[2 * q_] + w[0][2 * q_] * bflo(xm1.m) + w[1][2 * q_] * bflo(x0.m) + w[2][2 * q_] * bflo(xp1.m) + w[3][2 * q_] * bflo(xp2.m); \
                     o[2 * q_ + 1] = bias[2 * q_ + 1] + w[0][2 * q_ + 1] * bfhi(xm1.m) + w[1][2 * q_ + 1] * bfhi(x0.m) + w[2][2 * q_ + 1] * bfhi(xp1.m) + w[3][2 * q_ + 1] * bfhi(xp2.m);
                    CONV2(0, x) CONV2(1, y) CONV2(2, z) CONV2(3, w)
#undef CONV2
                    u32x4 ov; ov.x = cvt_pk_bf16(o[0], o[1]); ov.y = cvt_pk_bf16(o[2], o[3]); ov.z = cvt_pk_bf16(o[4], o[5]); ov.w = cvt_pk_bf16(o[6], o[7]);
                    *(u32x4*)(F.P + (size_t)row_of(b, t) * D + col) = ov;
                    xm1 = x0; x0 = xp1; xp1 = xp2;
                }
            }
        }
    }
}
__device__ __forceinline__ void chunk_rows(int b, int k, int& r0, int& n) { if (k == 0) { r0 = MMAIN + b * NMETA; n = NMETA; } else { r0 = b * SEQ + (k - 1) * CHL; n = CHL; } }
__device__ __forceinline__ void phase_scan1(const Frame& F, int j) {
    const int lane = F.lane;
    for (int it = F.wave * F.G + F.vcu; it < 2 * NB * NCHUNK * 8; it += 8 * F.G) {
        int cq, k, b, d;
        if (it < 4096) { cq = it & 7; k = 1 + ((it >> 3) & 31); b = (it >> 8) & 7; d = it >> 11; } else { const int u = it - 4096; cq = u & 7; k = 0; b = (u >> 3) & 7; d = u >> 6; }
        const int c0 = cq * 128 + lane * 2;
        int r0, n; chunk_rows(b, k, r0, n);
        const unsigned char* la = (const unsigned char*)F.LA + (size_t)d * MPAD * D + c0; const bf16* bv = F.BV + (size_t)d * MPAD * D + c0;
        const f32x2 spq = *(const f32x2*)(F.SPT + (size_t)(j * 2 + d) * D + c0) * (1.0f / 255.0f);
        float h0 = 0.f, h1 = 0.f, s0 = 0.f, s1 = 0.f;
        for (int s = 0; s < n; s += 32) {
            unsigned lw[32], bw[32];
#pragma unroll
            for (int q = 0; q < 32; ++q) { const int sq = (s + q < n) ? s + q : n - 1; const int r = d ? (r0 + n - 1 - sq) : (r0 + sq); lw[q] = *(const unsigned short*)(la + (size_t)r * D); bw[q] = *(const unsigned*)(bv + (size_t)r * D); }
#pragma unroll
            for (int q = 0; q < 32; ++q) { const bool ok = s + q < n; const unsigned lq = ok ? lw[q] : 0u, bq = ok ? bw[q] : 0u;
                const float l0 = (float)(lq & 255u) * spq.x, l1 = (float)(lq >> 8) * spq.y; s0 += l0; s1 += l1; h0 = fast_exp(l0) * h0 + bflo(bq); h1 = fast_exp(l1) * h1 + bfhi(bq); }
        }
        float* agg = F.AGG + ((size_t)(d * NB + b) * NCHUNK + k) * D + c0;
        *(f32x2*)agg = (f32x2){s0, s1};
        *(f32x2*)(agg + (size_t)2 * NB * NCHUNK * D) = (f32x2){h0, h1};
    }
}
template <int N>
__device__ __forceinline__ void scan3_rows(const Frame& F, int j, int r0, int c0, float hf0, float hf1, float hb0, float hb1) {
    constexpr int HALF = N / 2;
    const unsigned char* laf = (const unsigned char*)F.LA + c0; const bf16* bvf = F.BV + c0; const unsigned char* lab = laf + (size_t)MPAD * D; const bf16* bvb = bvf + (size_t)MPAD * D;
    const f32x2 sqf = *(const f32x2*)(F.SPT + (size_t)(j * 2 + 0) * D + c0) * (1.0f / 255.0f), sqb = *(const f32x2*)(F.SPT + (size_t)(j * 2 + 1) * D + c0) * (1.0f / 255.0f);
#define L8LO(W_, S_) ((float)((W_) & 255u) * (S_).x)
#define L8HI(W_, S_) ((float)((W_) >> 8) * (S_).y)
    unsigned sf[HALF], sb[HALF];
#pragma unroll
    for (int s = 0; s < HALF; s += 8) {
        unsigned lf[8], bf_[8], lb[8], bb[8];
#pragma unroll
        for (int q = 0; q < 8; ++q) { const size_t rf = (size_t)(r0 + s + q) * D, rb = (size_t)(r0 + N - 1 - s - q) * D;
            lf[q] = *(const unsigned short*)(laf + rf); bf_[q] = *(const unsigned*)(bvf + rf); lb[q] = *(const unsigned short*)(lab + rb); bb[q] = *(const unsigned*)(bvb + rb); }
#pragma unroll
        for (int q = 0; q < 8; ++q) {
            hf0 = fast_exp(L8LO(lf[q], sqf)) * hf0 + bflo(bf_[q]); hf1 = fast_exp(L8HI(lf[q], sqf)) * hf1 + bfhi(bf_[q]); sf[s + q] = cvt_pk_bf16(hf0, hf1);
            hb0 = fast_exp(L8LO(lb[q], sqb)) * hb0 + bflo(bb[q]); hb1 = fast_exp(L8HI(lb[q], sqb)) * hb1 + bfhi(bb[q]); sb[s + q] = cvt_pk_bf16(hb0, hb1); }
    }
#pragma unroll
    for (int s = HALF; s < N; s += 8) {
        unsigned lf[8], bf_[8], lb[8], bb[8], gf[8], gb[8];
#pragma unroll
        for (int q = 0; q < 8; ++q) { const size_t rf = (size_t)(r0 + s + q) * D, rb = (size_t)(r0 + N - 1 - s - q) * D;
            lf[q] = *(const unsigned short*)(laf + rf); bf_[q] = *(const unsigned*)(bvf + rf); lb[q] = *(const unsigned short*)(lab + rb); bb[q] = *(const unsigned*)(bvb + rb);
            gf[q] = *(const unsigned*)(F.GY + rf + c0); gb[q] = *(const unsigned*)(F.GY + rb + c0); }
#pragma unroll
        for (int q = 0; q < 8; ++q) { const size_t rf = (size_t)(r0 + s + q) * D, rb = (size_t)(r0 + N - 1 - s - q) * D;
            const unsigned xf = sb[N - 1 - s - q], xb = sf[N - 1 - s - q];
            hf0 = fast_exp(L8LO(lf[q], sqf)) * hf0 + bflo(bf_[q]); hf1 = fast_exp(L8HI(lf[q], sqf)) * hf1 + bfhi(bf_[q]);
            *(unsigned*)(F.HG + rf + c0) = cvt_pk_bf16((hf0 + bflo(xf)) * bflo(gf[q]), (hf1 + bfhi(xf)) * bfhi(gf[q]));
            hb0 = fast_exp(L8LO(lb[q], sqb)) * hb0 + bflo(bb[q]); hb1 = fast_exp(L8HI(lb[q], sqb)) * hb1 + bfhi(bb[q]);
            *(unsigned*)(F.HG + rb + c0) = cvt_pk_bf16((bflo(xb) + hb0) * bflo(gb[q]), (bfhi(xb) + hb1) * bfhi(gb[q])); }
    }
#undef L8LO
#undef L8HI
}
__device__ __forceinline__ void phase_scan3(const Frame& F, int j) {
    const int lane = F.lane;
    constexpr size_t HOFF = (size_t)2 * NB * NCHUNK * D;
    for (int it = F.wave * F.G + F.vcu; it < NB * NCHUNK * 8; it += 8 * F.G) {
        int cq, k, b;
        if (it < 2048) { cq = it & 7; k = 1 + ((it >> 3) & 31); b = it >> 8; } else { const int u = it - 2048; cq = u & 7; k = 0; b = u >> 3; }
        const int c0 = cq * 128 + lane * 2;
        int r0, n; chunk_rows(b, k, r0, n);
        float hf0 = 0.f, hf1 = 0.f, hb0 = 0.f, hb1 = 0.f;
        for (int j0 = 0; j0 < k; j0 += 8) {
            f32x2 al[8], he[8];
#pragma unroll
            for (int q = 0; q < 8; ++q) { const int jx = (j0 + q < k) ? j0 + q : 0; const float* agg = F.AGG + ((size_t)(0 * NB + b) * NCHUNK + jx) * D + c0; al[q] = *(const f32x2*)agg; he[q] = *(const f32x2*)(agg + HOFF); }
#pragma unroll
            for (int q = 0; q < 8; ++q) if (j0 + q < k) { hf0 = fast_exp(al[q].x) * hf0 + he[q].x; hf1 = fast_exp(al[q].y) * hf1 + he[q].y; }
        }
        for (int j0 = NCHUNK - 1; j0 > k; j0 -= 8) {
            f32x2 al[8], he[8];
#pragma unroll
            for (int q = 0; q < 8; ++q) { const int jx = (j0 - q > k) ? j0 - q : NCHUNK - 1; const float* agg = F.AGG + ((size_t)(1 * NB + b) * NCHUNK + jx) * D + c0; al[q] = *(const f32x2*)agg; he[q] = *(const f32x2*)(agg + HOFF); }
#pragma unroll
            for (int q = 0; q < 8; ++q) if (j0 - q > k) { hb0 = fast_exp(al[q].x) * hb0 + he[q].x; hb1 = fast_exp(al[q].y) * hb1 + he[q].y; }
        }
        if (k == 0) scan3_rows<NMETA>(F, j, r0, c0, hf0, hf1, hb0, hb1); else scan3_rows<CHL>(F, j, r0, c0, hf0, hf1, hb0, hb1);
    }
}

struct TaskMap { int ntask, ncb, rb0, rbstride; };
template <class Fn>
__device__ __forceinline__ void wave_gemm(const Fn& fn, const TaskMap tm, int gw, int ngw, int lane_) {
    const int lane = opaque(lane_), fr = lane & 15, fq = lane >> 4;
    for (int task = gw; task < tm.ntask; task += ngw) {
        const int cb = task % tm.ncb, rb = tm.rb0 + (task / tm.ncb) * tm.rbstride;
        const bf16* ap[2]; const bf16* bp[4];
#pragma unroll
        for (int mi = 0; mi < 2; ++mi) ap[mi] = fn.arow(rb, cb, mi * 16 + fr) + 8 * fq;
#pragma unroll
        for (int nb = 0; nb < 4; ++nb) bp[nb] = fn.brow(rb, cb, nb * 16 + fr) + 8 * fq;
        f32x4 acc[2][4];
#pragma unroll
        for (int mi = 0; mi < 2; ++mi)
#pragma unroll
            for (int nb = 0; nb < 4; ++nb) acc[mi][nb] = (f32x4){0.f, 0.f, 0.f, 0.f};
#pragma unroll 2
        for (int k0 = 0; k0 < fn.K; k0 += 32) {
            bf16x8 a[2], bb[4];
#pragma unroll
            for (int mi = 0; mi < 2; ++mi) a[mi] = *(const bf16x8*)(ap[mi] + k0);
#pragma unroll
            for (int nb = 0; nb < 4; ++nb) bb[nb] = *(const bf16x8*)(bp[nb] + k0);
#pragma unroll
            for (int mi = 0; mi < 2; ++mi)
#pragma unroll
                for (int nb = 0; nb < 4; ++nb) acc[mi][nb] = __builtin_amdgcn_mfma_f32_16x16x32_bf16(bb[nb], a[mi], acc[mi][nb], 0, 0, 0);
        }
#pragma unroll
        for (int mi = 0; mi < 2; ++mi)
#pragma unroll
            for (int nb = 0; nb < (Fn::PAIRED ? 2 : 4); ++nb) fn.epi_blk(rb, cb, mi, nb, acc[mi][nb], acc[mi][Fn::PAIRED ? nb + 2 : nb], fr, fq);
    }
}
struct FnPool {
    static constexpr int nrb = MROWS / 32, ncb = 16, K = 256; static constexpr bool PAIRED = false;
    const bf16* P; const bf16* W; bf16* H; const float* scale;
    __device__ __forceinline__ const bf16* arow(int rb, int cb, int r) const { return P + (size_t)(rb * 32 + r) * D + (cb >> 2) * 256; }
    __device__ __forceinline__ const bf16* brow(int rb, int cb, int n) const { return W + (size_t)(cb * 64 + n) * 256; }
    __device__ __forceinline__ void epi_blk(int rb, int cb, int mi, int nb, const f32x4& v, const f32x4&, int fr, int fq) const {
        const int c = cb * 64 + nb * 16 + 4 * fq; bf16* p = H + (size_t)(rb * 32 + mi * 16 + fr) * D + c; const u32x2 w = *(const u32x2*)p; const f32x4 o = (f32x4){bflo(w.x), bfhi(w.x), bflo(w.y), bfhi(w.y)} + v * *(const f32x4*)(scale + c);
        u32x2 ow; ow.x = cvt_pk_bf16(o.x, o.y); ow.y = cvt_pk_bf16(o.z, o.w); *(u32x2*)p = ow; }
};
struct FnIn {
    static constexpr int nrb = MROWS / 32, ncb = 32, K = 1024; static constexpr bool PAIRED = false;
    const bf16* U; const bf16* W; bf16* XB; bf16* GY; const float* RS;
    __device__ __forceinline__ const bf16* arow(int rb, int cb, int r) const { return U + (size_t)(rb * 32 + r) * D; }
    __device__ __forceinline__ const bf16* brow(int rb, int cb, int n) const { return W + (size_t)(cb * 64 + n) * 1024; }
    __device__ __forceinline__ void epi_blk(int rb, int cb, int mi, int nb, const f32x4& v_, const f32x4&, int fr, int fq) const {
        const int c = cb * 64 + nb * 16 + 4 * fq; const size_t ro = (size_t)(rb * 32 + mi * 16 + fr) * D; u32x2 w; const f32x4 v = v_ * RS[rb * 32 + mi * 16 + fr];
        if (cb < 16) { w.x = cvt_pk_bf16(v.x, v.y); w.y = cvt_pk_bf16(v.z, v.w); *(u32x2*)(XB + ro + c) = w; }
        else { w.x = cvt_pk_bf16(gelu_tanh(v.x), gelu_tanh(v.y)); w.y = cvt_pk_bf16(gelu_tanh(v.z), gelu_tanh(v.w)); *(u32x2*)(GY + ro + c - 1024) = w; } }
};
__device__ __forceinline__ void lru_gate2(f32x2 zr, f32x2 zi, f32x2 sp, f32x2 x, bool slow, f32x2& rg, f32x2& bv) {
    const f32x2 tr = zr * (-1.44269504089f), ti = zi * (-1.44269504089f);
    f32x2 e1, e2; e1.x = __builtin_amdgcn_exp2f(tr.x); e1.y = __builtin_amdgcn_exp2f(tr.y); e2.x = __builtin_amdgcn_exp2f(ti.x); e2.y = __builtin_amdgcn_exp2f(ti.y);
    const f32x2 d1 = e1 + 1.0f, d2 = e2 + 1.0f, dd = d1 * d2;
    f32x2 inv; inv.x = fast_rcp(dd.x); inv.y = fast_rcp(dd.y);
    const f32x2 rgate = inv * d2, l = rgate * sp, x2 = l * 2.0f;
    f32x2 q = x2 * 0.0001984127f + 0.0013888889f; q = q * x2 + 0.0083333333f; q = q * x2 + 0.041666667f; q = q * x2 + 0.16666667f; q = q * x2 + 0.5f; q = q * x2 + 1.0f;
    f32x2 em = -x2 * q;
    if (__builtin_expect(slow, 0)) { asm volatile("" ::: "memory"); em.x = 1.0f - fast_exp(x2.x); em.y = 1.0f - fast_exp(x2.y); }
    f32x2 sq; sq.x = __builtin_amdgcn_sqrtf(em.x); sq.y = __builtin_amdgcn_sqrtf(em.y);
    rg = rgate; bv = sq * (inv * d1) * x;
}
struct FnGates {
    static constexpr int nrb = MROWS / 32, ncb = 64, K = 256; static constexpr bool PAIRED = true;
    const bf16* XC; const bf16* W; bf16* LA; bf16* BV; const float* bg; const float* lam;
    __device__ __forceinline__ const bf16* arow(int rb, int cb, int r) const { return XC + (size_t)(rb * 32 + r) * D + (((cb & 31) * 32) >> 8) * 256; }
    __device__ __forceinline__ const bf16* brow(int rb, int cb, int n) const {
        const int d = cb >> 5, nb = n >> 4, frn = n & 15, ch = (cb & 31) * 32 + (nb & 1) * 16 + frn, g = nb >> 1, h = ch >> 8, jl = ch & 255;
        return W + (((size_t)(d * 8 + h * 2 + (jl >> 7)) * 256) + g * 128 + (jl & 127)) * 256; }
    __device__ __forceinline__ void epi_blk(int rb, int cb, int mi, int nb, const f32x4& vr, const f32x4& vi, int fr, int fq) const {
        const int d = cb >> 5, ch = (cb & 31) * 32 + nb * 16 + 4 * fq;
        const f32x4 br = *(const f32x4*)(bg + (d * 2 + 0) * D + ch), bi = *(const f32x4*)(bg + (d * 2 + 1) * D + ch), lm = *(const f32x4*)(lam + d * D + ch);
        const size_t ro = (size_t)(rb * 32 + mi * 16 + fr) * D + ch;
        const u32x2 xw = *(const u32x2*)(XC + ro); const float xv[4] = {bflo(xw.x), bfhi(xw.x), bflo(xw.y), bfhi(xw.y)};
        float la[4], bvv[4];
        const bool slow = __any((lm.x < -0.25f) | (lm.y < -0.25f) | (lm.z < -0.25f) | (lm.w < -0.25f));
#pragma unroll
        for (int q = 0; q < 4; q += 2) { f32x2 l2, b2; lru_gate2((f32x2){vr[q] + br[q], vr[q + 1] + br[q + 1]}, (f32x2){vi[q] + bi[q], vi[q + 1] + bi[q + 1]}, (f32x2){lm[q], lm[q + 1]}, (f32x2){xv[q], xv[q + 1]}, slow, l2, b2);
            la[q] = l2.x; la[q + 1] = l2.y; bvv[q] = b2.x; bvv[q + 1] = b2.y; }
        *(unsigned*)((unsigned char*)LA + (size_t)d * MPAD * D + ro) = pk4_u8(la[0], la[1], la[2], la[3]);
        u32x2 w; w.x = cvt_pk_bf16(bvv[0], bvv[1]); w.y = cvt_pk_bf16(bvv[2], bvv[3]); *(u32x2*)(BV + (size_t)d * MPAD * D + ro) = w; }
};
struct FnOut {
    static constexpr int nrb = MROWS / 32, ncb = 16, K = 1024; static constexpr bool PAIRED = false;
    const bf16* A; const bf16* W; bf16* H;
    __device__ __forceinline__ const bf16* arow(int rb, int cb, int r) const { return A + (size_t)(rb * 32 + r) * D; }
    __device__ __forceinline__ const bf16* brow(int rb, int cb, int n) const { return W + (size_t)(cb * 64 + n) * 1024; }
    __device__ __forceinline__ void epi_blk(int rb, int cb, int mi, int nb, const f32x4& v, const f32x4&, int fr, int fq) const {
        bf16* p = H + (size_t)(rb * 32 + mi * 16 + fr) * D + cb * 64 + nb * 16 + 4 * fq; const u32x2 w = *(const u32x2*)p; const f32x4 o = (f32x4){bflo(w.x), bfhi(w.x), bflo(w.y), bfhi(w.y)} + v;
        u32x2 ow; ow.x = cvt_pk_bf16(o.x, o.y); ow.y = cvt_pk_bf16(o.z, o.w); *(u32x2*)p = ow; }
};
constexpr int ERB = (EROWS + 31) / 32;
constexpr int ERB16 = (EROWS + 15) / 16;
struct FnM1f8 {
    static constexpr int KB = 1024; static constexpr bool PAIRED = true;
    const unsigned char* U; const unsigned char* W; const int* ROWL; unsigned char* HID;
    __device__ __forceinline__ const unsigned char* arow(int rb, int cb, int r) const { const int e = rb / ERB16, pos = (rb % ERB16) * 16 + r; return U + (size_t)ROWL[e * EPAD + pos] * 1024; }
    __device__ __forceinline__ const unsigned char* brow(int rb, int cb, int n) const { const int e = rb / ERB16, nb = n >> 4, f = cb * 32 + (nb & 1) * 16 + (n & 15);
        return W + ((size_t)e * 4096 + (f >> 7) * 256 + (nb >> 1) * 128 + (f & 127)) * 1024; }
    __device__ __forceinline__ void epi_blk(int rb, int cb, int nb, const f32x4& gs, const f32x4& us, int fr, int fq) const {
        const int e = rb / ERB16, pos = (rb % ERB16) * 16 + fr, f = cb * 32 + nb * 16 + 4 * fq; const f32x4 g = gs * WINV, u = us * WINV;
        *(unsigned*)(HID + ((size_t)e * EPAD + pos) * HIDP8 + f) = pk4_fp8(siluf_(g.x) * u.x, siluf_(g.y) * u.y, siluf_(g.z) * u.z, siluf_(g.w) * u.w); }
};
struct FnM2f8 {
    static constexpr int KB = 2048; static constexpr bool PAIRED = false;
    const unsigned char* HID; const unsigned char* W; bf16* Y;
    __device__ __forceinline__ const unsigned char* arow(int rb, int cb, int r) const { const int e = rb / ERB16, pos = (rb % ERB16) * 16 + r; return HID + ((size_t)e * EPAD + pos) * HIDP8; }
    __device__ __forceinline__ const unsigned char* brow(int rb, int cb, int n) const { const int e = rb / ERB16; return W + ((size_t)e * 1024 + cb * 64 + n) * WDP8; }
    __device__ __forceinline__ void epi_blk(int rb, int cb, int nb, const f32x4& vs, const f32x4&, int fr, int fq) const {
        const int e = rb / ERB16, pos = (rb % ERB16) * 16 + fr; const f32x4 v = vs * WINV;
        *(unsigned*)((unsigned char*)Y + ((size_t)e * EPAD + pos) * D + cb * 64 + nb * 16 + 4 * fq) = pk4_fp8(v.x, v.y, v.z, v.w); }
};
template <class Fn>
__device__ __forceinline__ void wg_gemm_ksplit8(const Fn& fn, const TaskMap tm, LAS unsigned char* lds, int vcu, int G, int tid_) {
    const int tid = opaque(tid_), lane = tid & 63, wave = __builtin_amdgcn_readfirstlane(tid >> 6), fr = lane & 15, fq = lane >> 4;
    constexpr int KW = Fn::KB / 8, NS = KW / 128;
    LAS f32x4* part = (LAS f32x4*)lds;
    for (int task = vcu; task < tm.ntask; task += G) {
        const int cb = task % tm.ncb, rb = tm.rb0 + (task / tm.ncb) * tm.rbstride;
        const unsigned char* ap = fn.arow(rb, cb, fr) + wave * KW + 32 * fq; const unsigned char* bp[4];
#pragma unroll
        for (int nb = 0; nb < 4; ++nb) bp[nb] = fn.brow(rb, cb, nb * 16 + fr) + wave * KW + 32 * fq;
        v4i a[NS][2], bb[NS][4][2];
#pragma unroll
        for (int s = 0; s < NS; ++s) { a[s][0] = *(const v4i*)(ap + s * 128); a[s][1] = *(const v4i*)(ap + s * 128 + 16);
#pragma unroll
            for (int nb = 0; nb < 4; ++nb) { bb[s][nb][0] = *(const v4i*)(bp[nb] + s * 128); bb[s][nb][1] = *(const v4i*)(bp[nb] + s * 128 + 16); } }
        f32x4 acc[4];
#pragma unroll
        for (int nb = 0; nb < 4; ++nb) acc[nb] = (f32x4){0.f, 0.f, 0.f, 0.f};
#pragma unroll
        for (int s = 0; s < NS; ++s)
#pragma unroll
            for (int nb = 0; nb < 4; ++nb) acc[nb] = __builtin_amdgcn_mfma_scale_f32_16x16x128_f8f6f4(__builtin_shufflevector(bb[s][nb][0], bb[s][nb][1], 0, 1, 2, 3, 4, 5, 6, 7),
                                                                                                     __builtin_shufflevector(a[s][0], a[s][1], 0, 1, 2, 3, 4, 5, 6, 7), acc[nb], 0, 0, 0, 0, 0, 0);
#pragma unroll
        for (int nb = 0; nb < 4; ++nb) part[(wave * 4 + nb) * 64 + lane] = acc[nb];
        __syncthreads();
        if (wave < 4 && (!Fn::PAIRED || wave < 2)) {
            const int nb = wave;
            f32x4 v = (f32x4){0.f, 0.f, 0.f, 0.f}, v2 = v;
#pragma unroll
            for (int w = 0; w < 8; ++w) { v += part[(w * 4 + nb) * 64 + lane]; if (Fn::PAIRED) v2 += part[(w * 4 + nb + 2) * 64 + lane]; }
            fn.epi_blk(rb, cb, nb, v, v2, fr, fq);
        }
        __syncthreads();
    }
}

template <int MI, class Fn>
__device__ __forceinline__ void wg_gemm_ksplit(const Fn& fn, const TaskMap tm, LAS unsigned char* lds, int vcu, int G, int tid_) {
    const int tid = opaque(tid_), lane = tid & 63, wave = __builtin_amdgcn_readfirstlane(tid >> 6), fr = lane & 15, fq = lane >> 4;
    constexpr int KW = Fn::K / 8, NS = KW / 32;
    LAS f32x4* part = (LAS f32x4*)lds;
    for (int task = vcu; task < tm.ntask; task += G) {
        const int cb = task % tm.ncb, rb = tm.rb0 + (task / tm.ncb) * tm.rbstride;
        const bf16* ap[MI]; const bf16* bp[4];
#pragma unroll
        for (int mi = 0; mi < MI; ++mi) ap[mi] = fn.arow(rb, cb, mi * 16 + fr) + wave * KW + 8 * fq;
#pragma unroll
        for (int nb = 0; nb < 4; ++nb) bp[nb] = fn.brow(rb, cb, nb * 16 + fr) + wave * KW + 8 * fq;
        f32x4 acc[MI][4];
#pragma unroll
        for (int mi = 0; mi < MI; ++mi)
#pragma unroll
            for (int nb = 0; nb < 4; ++nb) acc[mi][nb] = (f32x4){0.f, 0.f, 0.f, 0.f};
#pragma unroll
        for (int s0 = 0; s0 < NS; s0 += 4) {
            bf16x8 a[4][MI], bb[4][4];
#pragma unroll
            for (int s = 0; s < 4; ++s) if (s0 + s < NS) {
#pragma unroll
                for (int mi = 0; mi < MI; ++mi) a[s][mi] = *(const bf16x8*)(ap[mi] + (s0 + s) * 32);
#pragma unroll
                for (int nb = 0; nb < 4; ++nb) bb[s][nb] = *(const bf16x8*)(bp[nb] + (s0 + s) * 32); }
#pragma unroll
            for (int s = 0; s < 4; ++s) if (s0 + s < NS) {
#pragma unroll
                for (int mi = 0; mi < MI; ++mi)
#pragma unroll
                    for (int nb = 0; nb < 4; ++nb) acc[mi][nb] = __builtin_amdgcn_mfma_f32_16x16x32_bf16(bb[s][nb], a[s][mi], acc[mi][nb], 0, 0, 0); }
        }
#pragma unroll
        for (int mi = 0; mi < MI; ++mi)
#pragma unroll
            for (int nb = 0; nb < 4; ++nb) part[((wave * MI + mi) * 4 + nb) * 64 + lane] = acc[mi][nb];
        __syncthreads();
        if (wave < MI * 4) {
            const int mi = wave >> 2, nb = wave & 3;
            if (!Fn::PAIRED || nb < 2) {
                f32x4 v = (f32x4){0.f, 0.f, 0.f, 0.f}, v2 = v;
#pragma unroll
                for (int w = 0; w < 8; ++w) { v += part[((w * MI + mi) * 4 + nb) * 64 + lane]; if (Fn::PAIRED) v2 += part[((w * MI + mi) * 4 + nb + 2) * 64 + lane]; }
                fn.epi_blk(rb, cb, mi, nb, v, v2, fr, fq);
            }
        }
        __syncthreads();
    }
}

namespace pg8 {
constexpr int BM = 256, BK = 64, HALF = 128, HTB = HALF * BK * 2, STAGE_BYTES = 8 * HTB;
__device__ __forceinline__ int lds_byte(int r, int c) { const int st = (r >> 4) * 2 + (c >> 5), rr = r & 15, cc = c & 31, ob = rr * 64 + cc * 2; return st * 1024 + (ob ^ (((ob >> 9) & 1) << 5)); }
__device__ __forceinline__ void stage_rc(int b, int& R, int& C) { const int st = b / 1024, sb = b % 1024, swz = sb ^ (((sb >> 9) & 1) << 5); R = (st >> 1) * 16 + swz / 64; C = (st & 1) * 32 + (swz % 64) / 2; }
__device__ __forceinline__ int perm32(int rho) { const int n = rho >> 4, i = rho & 15; return 8 * (i >> 2) + 4 * n + (i & 3); }
struct Unit { int pm, pn, e; };
struct SchedStd {
    int nM, nN, nwg, G, c;
    __device__ __forceinline__ void init(int nM_, int nN_, int G_, int c_) { nM = nM_; nN = nN_; nwg = nM * nN; G = G_; c = c_; }
    __device__ __forceinline__ bool next(int i, Unit& u) const {
        const int L = i * G + c; if (L >= nwg) return false;
        int wgid = L; { const int q = nwg / 8, r = nwg % 8, xcd = wgid % 8, off = wgid / 8; wgid = (xcd < r ? xcd * (q + 1) : r * (q + 1) + (xcd - r) * q) + off; }
        const int nig = 8 * nN, gid = wgid / nig, fm = gid * 8, gsz = (nM - fm) < 8 ? (nM - fm) : 8;
        u.pm = fm + ((wgid % nig) % gsz); u.pn = (wgid % nig) / gsz; u.e = 0; return true;
    }
};
struct SchedMoe {
    int nN, total, G, c, rev, gm;
    __device__ __forceinline__ void init(int nN_, int G_, int c_, int rev_ = 0, int gm_ = 8) { nN = nN_; total = 16 * 16 * nN_; G = G_; c = c_; rev = rev_; gm = gm_; }
    __device__ __forceinline__ bool next(int i, Unit& u) const {
        const int L = i * G + c; if (L >= total) return false;
        const int off = rev ? (total / 8 - 1 - L / 8) : L / 8;
        const int wgid = (L % 8) * (total / 8) + off, per = 16 * nN, w = wgid % per, nig = gm * nN;
        u.e = wgid / per; u.pm = (w / nig) * gm + (w % nig) % gm; u.pn = (w % nig) / gm; return true;
    }
};
template <class Cfg>
__device__ __forceinline__ void gemm_phase(LAS unsigned char* lds, const Cfg& cfg) {
    const int tid = opaque((int)threadIdx.x), wid = __builtin_amdgcn_readfirstlane(tid >> 6), lane = tid & 63, wr = wid >> 2, wc = wid & 3, fr = lane & 15, fq = lane >> 4;
    constexpr bool F8 = Cfg::FP8;
    constexpr int nt = Cfg::KB / 128;
    int Rr[2], Cc[2]; unsigned voffB[2];
#pragma unroll
    for (int i = 0; i < 2; ++i) { stage_rc(tid * 16 + i * 8192, Rr[i], Cc[i]); const int R = Rr[i];
        const int Rb = Cfg::PERMX ? (((R >> 5) & 3) * 64 + 16 * ((R & 15) >> 2) + 4 * ((R >> 4) & 1) + (R & 3)) : (Cfg::PERM ? ((R & ~31) + perm32(R & 31)) : R);
        voffB[i] = (unsigned)Rb * (unsigned)Cfg::ldb + (unsigned)Cc[i] * 2u; }
    const size_t kstep = (size_t)(BK * 2);
    const size_t hstepB = (size_t)(Cfg::PERMX ? 8 : HALF) * Cfg::ldb;
    const unsigned ldsw = (unsigned)wid * 1024u;
    const int aoff = lds_byte(wr * 64 + fr, F8 ? fq * 16 : fq * 8), boff = lds_byte(wc * 32 + fr, F8 ? fq * 16 : fq * 8);

#define PG8_SA(b, h) (((b) * 2 + (h)) * HTB)
#define PG8_SB(b, h) ((4 + (b) * 2 + (h)) * HTB)
#define PG8_STAGE(bufoff, gbase, voff) do { _Pragma("unroll") for (int _i = 0; _i < 2; ++_i) \
        __builtin_amdgcn_global_load_lds((const unsigned*)((const char*)(gbase) + (voff)[_i]), (LAS unsigned*)(lds + (bufoff) + ldsw + _i * 8192), 16, 0, 0); } while (0)
typedef v8i v8i_a16 __attribute__((aligned(16)));
#define PG8_LD32(p) (*(const LAS v8i_a16*)(p))
#define PG8_LDA(dst, b, h) do { if constexpr (F8) { _Pragma("unroll") for (int m = 0; m < 4; ++m) dst##8[m] = PG8_LD32(lds + PG8_SA(b, h) + aoff + m * 2048); } \
        else { _Pragma("unroll") for (int m = 0; m < 4; ++m) _Pragma("unroll") for (int k = 0; k < 2; ++k) dst[m][k] = *(const LAS bf16x8*)(lds + PG8_SA(b, h) + aoff + m * 2048 + k * 1024); } } while (0)
#define PG8_LDB(dst, b, h) do { if constexpr (F8) { _Pragma("unroll") for (int n = 0; n < 2; ++n) dst##8[n] = PG8_LD32(lds + PG8_SB(b, h) + boff + n * 2048); } \
        else { _Pragma("unroll") for (int n = 0; n < 2; ++n) _Pragma("unroll") for (int k = 0; k < 2; ++k) dst[n][k] = *(const LAS bf16x8*)(lds + PG8_SB(b, h) + boff + n * 2048 + k * 1024); } } while (0)
#define PG8_MMA(ai, bj, At, Bt) do { __builtin_amdgcn_s_setprio(1); _Pragma("unroll") for (int m = 0; m < 4; ++m) _Pragma("unroll") for (int n = 0; n < 2; ++n) { \
        if constexpr (F8) asm volatile("v_mfma_f32_16x16x128_f8f6f4 %0, %1, %2, %0" : "+v"(acc[ai][bj][m][n]) : "v"(Bt##8[n]), "v"(At##8[m]));   \
        else { _Pragma("unroll") for (int k = 0; k < 2; ++k) acc[ai][bj][m][n] = __builtin_amdgcn_mfma_f32_16x16x32_bf16(Bt[n][k], At[m][k], acc[ai][bj][m][n], 0, 0, 0); } } __builtin_amdgcn_s_setprio(0); } while (0)
#define PG8_WAIT_V(n) asm volatile("s_waitcnt vmcnt(" #n ")" ::: "memory")
#define PG8_WAIT_L(n) asm volatile("s_waitcnt lgkmcnt(" #n ")" ::: "memory")
#define PG8_BAR __builtin_amdgcn_s_barrier()
#define PG8_SCHED __builtin_amdgcn_sched_barrier(0)
    Unit cur, nxt; int ui = 0;
    if (!cfg.next(0, cur)) return;
    f32x4 acc[2][2][4][2];
#pragma unroll
    for (int a = 0; a < 2; ++a)
#pragma unroll
        for (int b = 0; b < 2; ++b)
#pragma unroll
            for (int m = 0; m < 4; ++m)
#pragma unroll
                for (int n = 0; n < 2; ++n) acc[a][b][m][n] = (f32x4){0.f, 0.f, 0.f, 0.f};
    bf16x8 At[4][2], B0[2][2], B1[2][2]; v8i At8[4], B08[2], B18[2];
    unsigned voffA[2][2], voffAn[2][2];
    cfg.a_offs(cur, 0, Rr, Cc, voffA);
    const char* cA = cfg.a_base(cur); const char* cB = cfg.b_base(cur);
    PG8_STAGE(PG8_SB(0, 0), cB, voffB); PG8_STAGE(PG8_SB(0, 1), cB + hstepB, voffB); PG8_STAGE(PG8_SA(0, 0), cA, voffA[0]); PG8_STAGE(PG8_SA(0, 1), cA, voffA[1]);
    if (wr == 1) PG8_BAR;
    PG8_WAIT_V(2); PG8_BAR;
    PG8_STAGE(PG8_SB(1, 0), cB + kstep, voffB); PG8_STAGE(PG8_SA(1, 0), cA + kstep, voffA[0]); PG8_STAGE(PG8_SB(1, 1), cB + hstepB + kstep, voffB);
    PG8_WAIT_V(6); PG8_BAR;
    for (;;) {
        const bool has_next = cfg.next(ui + 1, nxt);
        const char* nA = has_next ? cfg.a_base(nxt) : cA; const char* nB = has_next ? cfg.b_base(nxt) : cB;
#pragma unroll 1
        for (int t = 0; t < nt; t += 2) {
            const bool last = (t == nt - 2);
            const char* a1 = cA + (size_t)(t + 1) * kstep;
            const char* a2 = last ? nA : cA + (size_t)(t + 2) * kstep; const char* b2 = last ? nB : cB + (size_t)(t + 2) * kstep;
            const char* a3 = a2 + kstep; const char* b3 = b2 + kstep;
            unsigned o2[2][2];
            if constexpr (Cfg::GATHER) {
                if (last) { if (has_next) { int R2[2], C2[2]; stage_rc(tid * 16, R2[0], C2[0]); stage_rc(tid * 16 + 8192, R2[1], C2[1]); cfg.a_offs(nxt, ui + 1, R2, C2, voffAn); } else {
#pragma unroll
                    for (int h = 0; h < 2; ++h) { voffAn[h][0] = voffA[h][0]; voffAn[h][1] = voffA[h][1]; } } }
#pragma unroll
                for (int h = 0; h < 2; ++h) { o2[h][0] = last ? voffAn[h][0] : voffA[h][0]; o2[h][1] = last ? voffAn[h][1] : voffA[h][1]; }
            } else {
#pragma unroll
                for (int h = 0; h < 2; ++h) { o2[h][0] = voffA[h][0]; o2[h][1] = voffA[h][1]; }
            }
            PG8_LDB(B0, 0, 0); PG8_LDB(B1, 0, 1); PG8_SCHED; PG8_LDA(At, 0, 0); PG8_STAGE(PG8_SA(1, 1), a1, voffA[1]);
            PG8_WAIT_V(8); PG8_WAIT_L(0); PG8_BAR; PG8_MMA(0, 0, At, B0); PG8_MMA(0, 1, At, B1); PG8_BAR; PG8_SCHED;
            PG8_LDA(At, 0, 1); PG8_STAGE(PG8_SB(0, 0), b2, voffB); PG8_STAGE(PG8_SB(0, 1), b2 + hstepB, voffB); PG8_STAGE(PG8_SA(0, 0), a2, o2[0]);
            PG8_WAIT_V(8); PG8_WAIT_L(0); PG8_BAR; PG8_MMA(1, 0, At, B0); PG8_MMA(1, 1, At, B1); PG8_BAR; PG8_SCHED;
            PG8_LDB(B0, 1, 0); PG8_LDB(B1, 1, 1); PG8_SCHED; PG8_LDA(At, 1, 0); PG8_STAGE(PG8_SA(0, 1), a2, o2[1]);
            PG8_WAIT_V(8); PG8_WAIT_L(0); PG8_BAR; PG8_MMA(0, 0, At, B0); PG8_MMA(0, 1, At, B1); PG8_BAR; PG8_SCHED;
            PG8_LDA(At, 1, 1); PG8_STAGE(PG8_SB(1, 0), b3, voffB); PG8_STAGE(PG8_SB(1, 1), b3 + hstepB, voffB); PG8_STAGE(PG8_SA(1, 0), a3, o2[0]);
            PG8_WAIT_V(8); PG8_WAIT_L(0); PG8_BAR; PG8_MMA(1, 0, At, B0); PG8_MMA(1, 1, At, B1); PG8_BAR; PG8_SCHED;
        }
        if (wr == 0) PG8_BAR;
        if constexpr (F8) asm volatile("s_nop 15\n\ts_nop 15" ::: "memory");
        cfg.epi(acc, cur, wr, wc, fr, fq);
        if (!has_next) break;
#pragma unroll
        for (int a = 0; a < 2; ++a)
#pragma unroll
            for (int b = 0; b < 2; ++b)
#pragma unroll
                for (int m = 0; m < 4; ++m)
#pragma unroll
                    for (int n = 0; n < 2; ++n) acc[a][b][m][n] = (f32x4){0.f, 0.f, 0.f, 0.f};
        cur = nxt; cA = nA; cB = nB; ++ui;
        if constexpr (Cfg::GATHER) {
#pragma unroll
            for (int h = 0; h < 2; ++h) { voffA[h][0] = voffAn[h][0]; voffA[h][1] = voffAn[h][1]; } }
        if (wr == 1) PG8_BAR;
    }
    PG8_WAIT_V(0);
    PG8_BAR;
#undef PG8_SA
#undef PG8_SB
#undef PG8_STAGE
#undef PG8_LDA
#undef PG8_LDB
#undef PG8_MMA
#undef PG8_LD32
#undef PG8_WAIT_V
#undef PG8_WAIT_L
#undef PG8_BAR
#undef PG8_SCHED
}
template <int LDA> __device__ __forceinline__ void lin_offs(const int (&R)[2], const int (&C)[2], unsigned (&off)[2][2]) {
#pragma unroll
    for (int h = 0; h < 2; ++h)
#pragma unroll
        for (int i = 0; i < 2; ++i) off[h][i] = (unsigned)(h * HALF + R[i]) * (unsigned)LDA + (unsigned)C[i] * 2u;
}
struct CfgPool {
    static constexpr bool PERMX = false; static constexpr bool GATHER = false; static constexpr bool FP8 = false; static constexpr int KB = 256 * 2; static constexpr bool PERM = true; static constexpr int K = 256, ldb = 512;
    SchedStd S; const bf16* P; const bf16* W; bf16* H; const float* scale;
    __device__ __forceinline__ bool next(int i, Unit& u) const { return S.next(i, u); }
    __device__ __forceinline__ const char* a_base(const Unit& u) const { return (const char*)(P + (size_t)u.pm * 256 * D + u.pn * 256); }
    __device__ __forceinline__ void a_offs(const Unit&, int, const int (&R)[2], const int (&C)[2], unsigned (&off)[2][2]) const { lin_offs<2048>(R, C, off); }
    __device__ __forceinline__ const char* b_base(const Unit& u) const { return (const char*)(W + (size_t)u.pn * 65536); }
    __device__ __forceinline__ void epi(const f32x4 (&acc)[2][2][4][2], const Unit& u, int wr, int wc, int fr, int fq) const {
        const int row0 = u.pm * 256 + wr * 64 + fr, col0 = u.pn * 256 + wc * 32 + 8 * fq;
        f32x4 sc[2][2];
#pragma unroll
        for (int bj = 0; bj < 2; ++bj)
#pragma unroll
            for (int n = 0; n < 2; ++n) sc[bj][n] = *(const f32x4*)(scale + col0 + bj * 128 + n * 4);
#pragma unroll
        for (int ai = 0; ai < 2; ++ai) {
            u32x4 hw[4][2];
#pragma unroll
            for (int m = 0; m < 4; ++m)
#pragma unroll
                for (int bj = 0; bj < 2; ++bj) hw[m][bj] = *(const u32x4*)(H + (size_t)(row0 + ai * 128 + m * 16) * D + col0 + bj * 128);
            asm volatile("" ::: "memory");
#pragma unroll
            for (int m = 0; m < 4; ++m) { bf16* rowp = H + (size_t)(row0 + ai * 128 + m * 16) * D + col0;
#pragma unroll
                for (int bj = 0; bj < 2; ++bj) { const u32x4 w = hw[m][bj];
                    const f32x4 o0 = (f32x4){bflo(w.x), bfhi(w.x), bflo(w.y), bfhi(w.y)} + acc[ai][bj][m][0] * sc[bj][0], o1 = (f32x4){bflo(w.z), bfhi(w.z), bflo(w.w), bfhi(w.w)} + acc[ai][bj][m][1] * sc[bj][1];
                    u32x4 ow; ow.x = cvt_pk_bf16(o0.x, o0.y); ow.y = cvt_pk_bf16(o0.z, o0.w); ow.z = cvt_pk_bf16(o1.x, o1.y); ow.w = cvt_pk_bf16(o1.z, o1.w);
                    *(u32x4*)(rowp + bj * 128) = ow; } }
            asm volatile("" ::: "memory");
        }
    }
};
struct CfgOut {
    static constexpr bool PERMX = false; static constexpr bool GATHER = false; static constexpr bool FP8 = false; static constexpr int KB = 1024 * 2; static constexpr bool PERM = true; static constexpr int K = 1024, ldb = 2048;
    SchedStd S; const bf16* A; const bf16* W; bf16* H;
    __device__ __forceinline__ bool next(int i, Unit& u) const { return S.next(i, u); }
    __device__ __forceinline__ const char* a_base(const Unit& u) const { return (const char*)(A + (size_t)u.pm * 256 * D); }
    __device__ __forceinline__ void a_offs(const Unit&, int, const int (&R)[2], const int (&C)[2], unsigned (&off)[2][2]) const { lin_offs<2048>(R, C, off); }
    __device__ __forceinline__ const char* b_base(const Unit& u) const { return (const char*)(W + (size_t)u.pn * 256 * 1024); }
    __device__ __forceinline__ void epi(const f32x4 (&acc)[2][2][4][2], const Unit& u, int wr, int wc, int fr, int fq) const {
        const int row0 = u.pm * 256 + wr * 64 + fr, col0 = u.pn * 256 + wc * 32 + 8 * fq;
#pragma unroll
        for (int ai = 0; ai < 2; ++ai) {
            u32x4 hw[4][2];
#pragma unroll
            for (int m = 0; m < 4; ++m)
#pragma unroll
                for (int bj = 0; bj < 2; ++bj) hw[m][bj] = *(const u32x4*)(H + (size_t)(row0 + ai * 128 + m * 16) * D + col0 + bj * 128);
            asm volatile("" ::: "memory");
#pragma unroll
            for (int m = 0; m < 4; ++m) { bf16* rowp = H + (size_t)(row0 + ai * 128 + m * 16) * D + col0;
#pragma unroll
                for (int bj = 0; bj < 2; ++bj) { const u32x4 w = hw[m][bj];
                    const f32x4 o0 = (f32x4){bflo(w.x), bfhi(w.x), bflo(w.y), bfhi(w.y)} + acc[ai][bj][m][0], o1 = (f32x4){bflo(w.z), bfhi(w.z), bflo(w.w), bfhi(w.w)} + acc[ai][bj][m][1];
                    u32x4 ow; ow.x = cvt_pk_bf16(o0.x, o0.y); ow.y = cvt_pk_bf16(o0.z, o0.w); ow.z = cvt_pk_bf16(o1.x, o1.y); ow.w = cvt_pk_bf16(o1.z, o1.w);
                    *(u32x4*)(rowp + bj * 128) = ow; } }
            asm volatile("" ::: "memory");
        }
    }
};
struct CfgIn {
    static constexpr bool PERMX = false; static constexpr bool GATHER = false; static constexpr bool FP8 = false; static constexpr int KB = 1024 * 2; static constexpr bool PERM = true; static constexpr int K = 1024, ldb = 2048;
    SchedStd S; const bf16* U; const bf16* W; bf16* XB; bf16* GY; const float* RS;
    __device__ __forceinline__ bool next(int i, Unit& u) const { return S.next(i, u); }
    __device__ __forceinline__ const char* a_base(const Unit& u) const { return (const char*)(U + (size_t)u.pm * 256 * D); }
    __device__ __forceinline__ void a_offs(const Unit&, int, const int (&R)[2], const int (&C)[2], unsigned (&off)[2][2]) const { lin_offs<2048>(R, C, off); }
    __device__ __forceinline__ const char* b_base(const Unit& u) const { return (const char*)(W + (size_t)u.pn * 256 * 1024); }
    __device__ __forceinline__ void epi(const f32x4 (&acc)[2][2][4][2], const Unit& u, int wr, int wc, int fr, int fq) const {
        const int row0 = u.pm * 256 + wr * 64 + fr, col0 = (u.pn & 3) * 256 + wc * 32 + 8 * fq; const bool act = u.pn >= 4; bf16* base = act ? GY : XB;
        float rs[2][4];
#pragma unroll
        for (int ai = 0; ai < 2; ++ai)
#pragma unroll
            for (int m = 0; m < 4; ++m) rs[ai][m] = RS[row0 + ai * 128 + m * 16];
#pragma unroll
        for (int ai = 0; ai < 2; ++ai)
#pragma unroll
            for (int m = 0; m < 4; ++m) { bf16* rowp = base + (size_t)(row0 + ai * 128 + m * 16) * D + col0;
#pragma unroll
                for (int bj = 0; bj < 2; ++bj) { f32x4 v0 = acc[ai][bj][m][0] * rs[ai][m], v1 = acc[ai][bj][m][1] * rs[ai][m];
                    if (act) { const f32x2 a0 = gelu_tanh2((f32x2){v0.x, v0.y}), a1 = gelu_tanh2((f32x2){v0.z, v0.w}), a2 = gelu_tanh2((f32x2){v1.x, v1.y}), a3 = gelu_tanh2((f32x2){v1.z, v1.w});
                        v0 = (f32x4){a0.x, a0.y, a1.x, a1.y}; v1 = (f32x4){a2.x, a2.y, a3.x, a3.y}; }
                    u32x4 w; w.x = cvt_pk_bf16(v0.x, v0.y); w.y = cvt_pk_bf16(v0.z, v0.w); w.z = cvt_pk_bf16(v1.x, v1.y); w.w = cvt_pk_bf16(v1.z, v1.w);
                    *(u32x4*)(rowp + bj * 128) = w; } }
    }
};
struct CfgGates {
    static constexpr bool PERMX = false; static constexpr bool GATHER = false; static constexpr bool FP8 = false; static constexpr int KB = 256 * 2; static constexpr bool PERM = true; static constexpr int K = 256, ldb = 512;
    SchedStd S; const bf16* XC; const bf16* W; bf16* LA; bf16* BV; const float* bg; const float* lam;
    __device__ __forceinline__ bool next(int i, Unit& u) const { return S.next(i, u); }
    __device__ __forceinline__ const char* a_base(const Unit& u) const { return (const char*)(XC + (size_t)u.pm * 256 * D + ((u.pn & 7) >> 1) * 256); }
    __device__ __forceinline__ void a_offs(const Unit&, int, const int (&R)[2], const int (&C)[2], unsigned (&off)[2][2]) const { lin_offs<2048>(R, C, off); }
    __device__ __forceinline__ const char* b_base(const Unit& u) const { return (const char*)(W + (size_t)u.pn * 65536); }
    __device__ __forceinline__ void epi(const f32x4 (&acc)[2][2][4][2], const Unit& u, int wr, int wc, int fr, int fq) const {
        const int d = u.pn >> 3, ch0 = (u.pn & 7) * 128 + wc * 32 + 8 * fq, row0 = u.pm * 256 + wr * 64 + fr;
        float br[8], bi[8], sp[8];
#pragma unroll
        for (int q = 0; q < 2; ++q) { const f32x4 a = *(const f32x4*)(bg + (d * 2 + 0) * D + ch0 + 4 * q), b = *(const f32x4*)(bg + (d * 2 + 1) * D + ch0 + 4 * q), l = *(const f32x4*)(lam + d * D + ch0 + 4 * q);
#pragma unroll
            for (int x = 0; x < 4; ++x) { br[4 * q + x] = a[x]; bi[4 * q + x] = b[x]; sp[4 * q + x] = l[x]; } }
        bool sl = false;
#pragma unroll
        for (int q = 0; q < 8; ++q) sl |= sp[q] < -0.25f;
        const bool slow = __any(sl);
        u32x4 xin[2][4];
#pragma unroll
        for (int ai = 0; ai < 2; ++ai)
#pragma unroll
            for (int m = 0; m < 4; ++m) xin[ai][m] = *(const u32x4*)(XC + (size_t)(row0 + ai * 128 + m * 16) * D + ch0);
        asm volatile("" ::: "memory");
#pragma unroll
        for (int ai = 0; ai < 2; ++ai)
#pragma unroll
            for (int m = 0; m < 4; ++m) { const size_t ro = (size_t)(row0 + ai * 128 + m * 16) * D + ch0;
                const u32x4 xw = xin[ai][m];
                const float xv[8] = {bflo(xw.x), bfhi(xw.x), bflo(xw.y), bfhi(xw.y), bflo(xw.z), bfhi(xw.z), bflo(xw.w), bfhi(xw.w)};
                float la[8], bv[8];
#pragma unroll
                for (int q = 0; q < 8; q += 2) { f32x2 l2, b2;
                    lru_gate2((f32x2){acc[ai][0][m][q >> 2][q & 3] + br[q], acc[ai][0][m][q >> 2][(q & 3) + 1] + br[q + 1]}, (f32x2){acc[ai][1][m][q >> 2][q & 3] + bi[q], acc[ai][1][m][q >> 2][(q & 3) + 1] + bi[q + 1]},
                              (f32x2){sp[q], sp[q + 1]}, (f32x2){xv[q], xv[q + 1]}, slow, l2, b2);
                    la[q] = l2.x; la[q + 1] = l2.y; bv[q] = b2.x; bv[q + 1] = b2.y; }
                { u32x2 w8; w8.x = pk4_u8(la[0], la[1], la[2], la[3]); w8.y = pk4_u8(la[4], la[5], la[6], la[7]); *(u32x2*)((unsigned char*)LA + (size_t)d * MPAD * D + ro) = w8; }
                u32x4 w; w.x = cvt_pk_bf16(bv[0], bv[1]); w.y = cvt_pk_bf16(bv[2], bv[3]); w.z = cvt_pk_bf16(bv[4], bv[5]); w.w = cvt_pk_bf16(bv[6], bv[7]);
                *(u32x4*)(BV + (size_t)d * MPAD * D + ro) = w; }
    }
};
struct CfgM1 {
    static constexpr bool PERMX = false; static constexpr bool GATHER = true; static constexpr bool FP8 = true; static constexpr int KB = 1024; static constexpr bool PERM = true; static constexpr int K = 1024, ldb = 1024;
    SchedMoe S; const unsigned char* U; const unsigned char* W; unsigned char* HID; const LAS unsigned short* idx;
    __device__ __forceinline__ bool next(int i, Unit& u) const { return S.next(i, u); }
    __device__ __forceinline__ const char* a_base(const Unit&) const { return (const char*)U; }
    __device__ __forceinline__ void a_offs(const Unit&, int ui, const int (&R)[2], const int (&C)[2], unsigned (&off)[2][2]) const {
#pragma unroll
        for (int h = 0; h < 2; ++h)
#pragma unroll
            for (int i = 0; i < 2; ++i) off[h][i] = (unsigned)idx[ui * 256 + h * HALF + R[i]] * 1024u + (unsigned)C[i] * 2u;
    }
    __device__ __forceinline__ const char* b_base(const Unit& u) const { return (const char*)(W + ((size_t)u.e * 4096 + u.pn * 256) * 1024); }
    __device__ __forceinline__ void epi(const f32x4 (&acc)[2][2][4][2], const Unit& u, int wr, int wc, int fr, int fq) const {
        const int row0 = u.e * EPAD + u.pm * 256 + wr * 64 + fr, col0 = u.pn * 128 + wc * 32 + 8 * fq;
#pragma unroll
        for (int ai = 0; ai < 2; ++ai)
#pragma unroll
            for (int m = 0; m < 4; ++m) { const f32x4 g0 = acc[ai][0][m][0], g1 = acc[ai][0][m][1], u0 = acc[ai][1][m][0], u1 = acc[ai][1][m][1];
                u32x2 w; w.x = silu_mul_fp8x4(g0, u0); w.y = silu_mul_fp8x4(g1, u1);
                *(u32x2*)(HID + (size_t)(row0 + ai * 128 + m * 16) * HIDP8 + col0) = w; }
    }
};
struct CfgM2 {
    static constexpr bool PERMX = true; static constexpr bool GATHER = false; static constexpr bool FP8 = true; static constexpr int KB = 2048; static constexpr bool PERM = true; static constexpr int K = 2048, ldb = WDP8;
    SchedMoe S; const unsigned char* HID; const unsigned char* W; bf16* Y;
    __device__ __forceinline__ bool next(int i, Unit& u) const { return S.next(i, u); }
    __device__ __forceinline__ const char* a_base(const Unit& u) const { return (const char*)(HID + ((size_t)u.e * EPAD + u.pm * 256) * HIDP8); }
    __device__ __forceinline__ void a_offs(const Unit&, int, const int (&R)[2], const int (&C)[2], unsigned (&off)[2][2]) const { lin_offs<HIDP8>(R, C, off); }
    __device__ __forceinline__ const char* b_base(const Unit& u) const { return (const char*)(W + ((size_t)u.e * 1024 + u.pn * 256) * WDP8); }
    __device__ __forceinline__ void epi(const f32x4 (&acc)[2][2][4][2], const Unit& u, int wr, int wc, int fr, int fq) const {
        const int row0 = u.e * EPAD + u.pm * 256 + wr * 64 + fr, col0 = u.pn * 256 + wc * 64 + 16 * fq;
#pragma unroll
        for (int ai = 0; ai < 2; ++ai)
#pragma unroll
            for (int m = 0; m < 4; ++m) { const f32x4 v0 = acc[ai][0][m][0] * WINV, v1 = acc[ai][0][m][1] * WINV, v2 = acc[ai][1][m][0] * WINV, v3 = acc[ai][1][m][1] * WINV;
                u32x4 w; w.x = pk4_fp8(v0.x, v0.y, v0.z, v0.w); w.y = pk4_fp8(v1.x, v1.y, v1.z, v1.w); w.z = pk4_fp8(v2.x, v2.y, v2.z, v2.w); w.w = pk4_fp8(v3.x, v3.y, v3.z, v3.w);
                *(u32x4*)((unsigned char*)Y + (size_t)(row0 + ai * 128 + m * 16) * D + col0) = w; }
    }
};
}

#ifndef FAST_PG
#define FAST_PG 1
#endif
#ifndef FAST_LIN
#define FAST_LIN 1
#endif
#ifndef FAST_LGT
#define FAST_LGT 1
#endif
#ifndef FAST_LOUT
#define FAST_LOUT 1
#endif
#ifndef FAST_M1
#define FAST_M1 1
#endif
#ifndef FAST_M2
#define FAST_M2 1
#endif
constexpr int IDX_OFF = RING_BYTES + 1024;

#ifndef REP_PRO
#define REP_PRO 1
#endif
#ifndef REP_PP
#define REP_PP 1
#endif
#ifndef REP_LIN
#define REP_LIN 1
#endif
#ifndef REP_LCV
#define REP_LCV 1
#endif
#ifndef REP_LGT
#define REP_LGT 1
#endif
#ifndef REP_LS1
#define REP_LS1 1
#endif
#ifndef REP_LS3
#define REP_LS3 1
#endif
#ifndef REP_RB
#define REP_RB 1
#endif
#ifndef REP_TK
#define REP_TK 1
#endif
#ifndef REP_M1
#define REP_M1 1
#endif
#ifndef REP_M2
#define REP_M2 1
#endif
#ifndef REP_RA
#define REP_RA 1
#endif
#ifndef REP_LOUT
#define REP_LOUT 1
#endif
#ifndef REP_PG
#define REP_PG 1
#endif
#define REPEAT(n) _Pragma("unroll") for (int rep_ = 0; rep_ < (n); ++rep_)
#define IN(k) (lo <= (k) && (k) < hi)
#define SEAM(k) do { if ((k) + 1 < hi) xcd_barrier(bar); } while (0)
template <int layer>
__device__ __forceinline__ void run_layer(const Frame& F, const int lo, const int hi, const XcdBarrier& bar) {
    const int gw = F.vcu * 8 + F.wave, NGW = F.G * 8;
    const bool fast = (F.G == 256);
    {
        const int pb = layer * 16, j = layer >> 1;
        if (IN(pb + 0)) { if (REP_RA > 1) phase_rowA<false, layer == 0, true>(F, layer); phase_rowA<false, layer == 0>(F, layer); if constexpr (layer == 0) REPEAT(REP_PRO) phase_prologue(F); SEAM(pb + 0); }
        if constexpr ((layer & 1) == 0) {
            if (IN(pb + 1)) { REPEAT(REP_PP) phase_poolwin(F, layer); SEAM(pb + 1); }
            if (IN(pb + 2)) { FnPool fn{F.P, F.WPOOL + (size_t)j * 4 * 65536, F.H, F.pool_scale + (size_t)j * D};
                if (FAST_PG && fast) { pg8::CfgPool cfg; cfg.S.init(128, 4, F.G, (int)blockIdx.x); cfg.P = F.P; cfg.W = fn.W; cfg.scale = fn.scale; if (REP_PG > 1) { cfg.H = (bf16*)F.HF; pg8::gemm_phase(F.lds, cfg); } cfg.H = F.H;
                    wg_gemm_ksplit<2>(fn, TaskMap{4 * 16, 16, 1024, 1}, F.lds, F.vcu, F.G, F.tid); if (layer == 0) { pro_tail128(F); __syncthreads(); }
                    pg8::gemm_phase(F.lds, cfg); }
                else wave_gemm(fn, TaskMap{FnPool::nrb * 16, 16, 0, 1}, gw, NGW, F.lane);
                SEAM(pb + 2); }
        } else {
            if (IN(pb + 3)) { REPEAT(REP_LIN) { FnIn fn{F.H, F.WIN + (size_t)j * 2048 * 1024, F.XB, F.GY, F.RSTD};
                if (FAST_LIN && fast) { pg8::CfgIn cfg; cfg.S.init(128, 8, F.G, (int)blockIdx.x); cfg.U = F.H; cfg.W = fn.W; cfg.XB = F.XB; cfg.GY = F.GY; cfg.RS = F.RSTD;
                    wg_gemm_ksplit<2>(fn, TaskMap{4 * 32, 32, 1024, 1}, F.lds, F.vcu, F.G, F.tid); pg8::gemm_phase(F.lds, cfg); }
                else wave_gemm(fn, TaskMap{FnIn::nrb * 32, 32, 0, 1}, gw, NGW, F.lane);
                } SEAM(pb + 3); }
            if (IN(pb + 4)) { REPEAT(REP_LCV) phase_conv(F, j); SEAM(pb + 4); }
            if (IN(pb + 5)) { REPEAT(REP_LGT) { FnGates fn{F.P, F.WGT + (size_t)j * 16 * 65536, F.LA, F.BV, F.b_gates + (size_t)j * 4 * D, F.SPT + (size_t)j * 2 * D};
                if (FAST_LGT && fast) { pg8::CfgGates cfg; cfg.S.init(128, 16, F.G, (int)blockIdx.x); cfg.XC = F.P; cfg.W = fn.W; cfg.LA = F.LA; cfg.BV = F.BV; cfg.bg = fn.bg; cfg.lam = fn.lam;
                    wg_gemm_ksplit<2>(fn, TaskMap{4 * 64, 64, 1024, 1}, F.lds, F.vcu, F.G, F.tid); pg8::gemm_phase(F.lds, cfg); }
                else wave_gemm(fn, TaskMap{FnGates::nrb * 64, 64, 0, 1}, gw, NGW, F.lane);
                } SEAM(pb + 5); }
            if (IN(pb + 6)) { REPEAT(REP_LS1) phase_scan1(F, j); SEAM(pb + 6); }
            if (IN(pb + 7)) { REPEAT(REP_LS3) phase_scan3(F, j); SEAM(pb + 7); }
            if (IN(pb + 8)) { FnOut fn{F.HG, F.WOUT + (size_t)j * 1024 * 1024, F.H};
                if (FAST_LOUT && fast) { pg8::CfgOut cfg; cfg.S.init(128, 4, F.G, (int)blockIdx.x); cfg.A = F.HG; cfg.W = fn.W; if (REP_LOUT > 1) { cfg.H = (bf16*)F.HF; pg8::gemm_phase(F.lds, cfg); } cfg.H = F.H;
                    wg_gemm_ksplit<2>(fn, TaskMap{4 * 16, 16, 1024, 1}, F.lds, F.vcu, F.G, F.tid); pg8::gemm_phase(F.lds, cfg); }
                else wave_gemm(fn, TaskMap{FnOut::nrb * 16, 16, 0, 1}, gw, NGW, F.lane);
                SEAM(pb + 8); }
        }
        if (IN(pb + 9)) { REPEAT(REP_RB) phase_rowB(F, layer); SEAM(pb + 9); }
        if (IN(pb + 10)) { REPEAT(REP_TK) phase_topk(F); phase_prologue_deferred(F, layer); SEAM(pb + 10); }
        if (IN(pb + 11)) { REPEAT(REP_M1) { FnM1f8 fn{(const unsigned char*)F.U, (const unsigned char*)F.WG1 + (size_t)layer * NE * 4096 * 1024, F.ROWL, (unsigned char*)F.HID};
            if (FAST_M1 && fast) { pg8::CfgM1 cfg; cfg.S.init(16, F.G, (int)blockIdx.x, 0, 4); cfg.U = fn.U; cfg.W = fn.W; cfg.HID = fn.HID;
                LAS unsigned short* idx = (LAS unsigned short*)(F.lds + IDX_OFF); cfg.idx = idx;
                {
                    int rl[16];
#pragma unroll
                    for (int ui = 0; ui < 16; ++ui) { pg8::Unit u; const bool ok = cfg.S.next(ui, u); rl[ui] = F.ROWL[(ok ? u.e * EPAD + u.pm * 256 : 0) + (F.tid & 255)]; }
#pragma unroll
                    for (int ui = 0; ui < 16; ++ui) if (F.tid < 256) idx[ui * 256 + F.tid] = (unsigned short)rl[ui];
                }
                __syncthreads();
                wg_gemm_ksplit8(fn, TaskMap{16 * 64, 64, ERB16 - 1, ERB16}, F.lds, F.vcu, F.G, F.tid);
                pg8::gemm_phase(F.lds, cfg); }
            else wg_gemm_ksplit8(fn, TaskMap{NE * ERB16 * 64, 64, 0, 1}, F.lds, F.vcu, F.G, F.tid);
            } SEAM(pb + 11); }
        if (IN(pb + 12)) { REPEAT(REP_M2) { FnM2f8 fn{(const unsigned char*)F.HID, (const unsigned char*)F.WD + (size_t)layer * NE * 1024 * WDP8, F.Y};
            if (FAST_M2 && fast) { pg8::CfgM2 cfg; cfg.S.init(4, F.G, (int)blockIdx.x); cfg.HID = fn.HID; cfg.W = fn.W; cfg.Y = F.Y;
                wg_gemm_ksplit8(fn, TaskMap{16 * 16, 16, ERB16 - 1, ERB16}, F.lds, F.vcu, F.G, F.tid); pg8::gemm_phase(F.lds, cfg); }
            else wg_gemm_ksplit8(fn, TaskMap{NE * ERB16 * 16, 16, 0, 1}, F.lds, F.vcu, F.G, F.tid);
            } SEAM(pb + 12); }
    }
}
#undef IN
#undef SEAM

__global__ void __launch_bounds__(512, 2) mega(Args args) {
    extern __shared__ __attribute__((aligned(16))) unsigned char lds_raw[];
    Frame F;
    F.lds = (LAS unsigned char*)lds_raw;
    F.tid = threadIdx.x; F.lane = F.tid & 63; F.wave = __builtin_amdgcn_readfirstlane(F.tid >> 6);
    F.G = gridDim.x; { const int bx = blockIdx.x; F.vcu = (F.G % 8 == 0) ? (bx % 8) * (F.G / 8) + bx / 8 : bx; }
    F.x = args.in[0]; F.meta = args.in[1]; F.norm_mix = args.in[2]; F.norm_ffn = args.in[3]; F.norm_final = args.in[4]; F.pool_w = args.in[5]; F.pool_scale = args.in[6]; F.w_in = args.in[7]; F.conv_w = args.in[8];
    F.conv_b = args.in[9]; F.w_gates = args.in[10]; F.b_gates = args.in[11]; F.lam = args.in[12]; F.w_out = args.in[13]; F.router_w = args.in[14]; F.moe_g = args.in[15]; F.moe_u = args.in[16]; F.moe_d = args.in[17];
    F.out = args.out; F.ws = args.ws;
    unsigned char* ws = args.ws;
    F.WG1 = (bf16*)(ws + WS_WG1); F.WD = (bf16*)(ws + WS_WD); F.WIN = (bf16*)(ws + WS_WIN); F.WGT = (bf16*)(ws + WS_WGT); F.WOUT = (bf16*)(ws + WS_WOUT); F.WPOOL = (bf16*)(ws + WS_WPOOL);
    F.H = (bf16*)(ws + WS_H); F.U = (bf16*)(ws + WS_U); F.P = (bf16*)(ws + WS_P); F.XB = (bf16*)(ws + WS_XB); F.GY = (bf16*)(ws + WS_GY); F.HG = (bf16*)(ws + WS_HG); F.HF = (float*)(ws + WS_Y);
    F.LA = (bf16*)(ws + WS_BIG); F.BV = (bf16*)(ws + WS_BIG + 2 * LA_BYTES); F.HID = (bf16*)(ws + WS_BIG); F.Y = (bf16*)(ws + WS_Y);
    F.AFF = (float*)(ws + WS_AFF); F.SLOT = (int*)(ws + WS_SLOT); F.GMAP = (float*)(ws + WS_GMAP); F.ROWL = (int*)(ws + WS_ROWL); F.AGG = (float*)(ws + WS_AGG); F.SPT = (float*)(ws + WS_SPT); F.RSTD = (float*)(ws + WS_RSTD);
    volatile LAS unsigned* MISC = (volatile LAS unsigned*)(F.lds + MISC_OFF);
    if (F.tid < 32) MISC[F.tid] = 0u;
    __syncthreads();
    const int lo = args.lo, hi = args.hi;
    const bool multi = (hi - lo) > 1;
    XcdBarrier bar; bar.bar = (unsigned*)(ws + WS_CTL) + CW_BAR; bar.x = 0; bar.st = nullptr;
    if (multi) bar = xcd_barrier_post((unsigned*)(ws + WS_CTL) + CW_BAR, MISC + 8);
#define IN(k) (lo <= (k) && (k) < hi)
#define SEAM(k) do { if ((k) + 1 < hi) xcd_barrier(bar); } while (0)
    run_layer<0>(F, lo, hi, bar); run_layer<1>(F, lo, hi, bar); run_layer<2>(F, lo, hi, bar); run_layer<3>(F, lo, hi, bar);
    if (IN(64)) { if (REP_RA > 1) phase_rowA<true, false>(F, DEPTH); phase_rowA<true, false>(F, DEPTH); }
#undef IN
#undef SEAM
}

extern "C" void kernel_launch(void* const* d_in, const int* in_sizes, int n_in, void* d_out, int out_size, void* d_ws, size_t ws_size, hipStream_t stream) {
    static int grid = 0;
    if (grid == 0) {
        if (n_in != 18 || in_sizes[0] != NB * SEQ * D || out_size != NB * SEQ * D || ws_size < WS_END) {
            fprintf(stderr, "kernel_launch: unexpected shapes (n_in %d, in0 %d, out %d, ws %zu < %zu)\n", n_in, n_in > 0 ? in_sizes[0] : -1, out_size, ws_size, (size_t)WS_END); grid = -1; return; }
        int dev = 0, cus = 0;
        if (hipGetDevice(&dev) != hipSuccess || hipDeviceGetAttribute(&cus, hipDeviceAttributeMultiprocessorCount, dev) != hipSuccess) { grid = -1; return; }
        if (hipFuncSetAttribute((const void*)mega, hipFuncAttributeMaxDynamicSharedMemorySize, LDS_BYTES) != hipSuccess) { fprintf(stderr, "kernel_launch: hipFuncSetAttribute failed\n"); grid = -1; return; }
        int per_cu = 0;
        if (hipOccupancyMaxActiveBlocksPerMultiprocessor(&per_cu, (const void*)mega, 512, LDS_BYTES) != hipSuccess || per_cu < 1) fprintf(stderr, "kernel_launch: occupancy query reports %d\n", per_cu);
        (void)hipGetLastError();
        grid = cus;
    }
    if (grid < 0) return;
    if (hipMemsetAsync((char*)d_ws + WS_CTL, 0, CTL_ZERO_BYTES, stream) != hipSuccess) return;
    Args a{};
    for (int i = 0; i < 18; ++i) a.in[i] = (const float*)d_in[i];
    a.out = (float*)d_out; a.ws = (unsigned char*)d_ws;
#if SINGLE_LAUNCH
    a.lo = 0; a.hi = 65;
    hipLaunchKernelGGL(mega, dim3(grid), dim3(512), LDS_BYTES, stream, a);
#else
    for (int layer = 0; layer < DEPTH; ++layer) {
        static const int pool_ph[] = {0, 1, 2, 9, 10, 11, 12}, lru_ph[] = {0, 3, 4, 5, 6, 7, 8, 9, 10, 11, 12};
        const int* ph = (layer & 1) ? lru_ph : pool_ph; const int n = (layer & 1) ? 11 : 7;
        for (int q = 0; q < n; ++q) { a.lo = layer * 16 + ph[q]; a.hi = a.lo + 1; hipLaunchKernelGGL(mega, dim3(grid), dim3(512), LDS_BYTES, stream, a); }
    }
    a.lo = 64; a.hi = 65; hipLaunchKernelGGL(mega, dim3(grid), dim3(512), LDS_BYTES, stream, a);
#endif
}
```
